# Optimizing an MI355X kernel written in HIP

```python
import math
import jax, jax.numpy as jnp
from jax import lax
import numpy as np

D_MODEL = 2048
BATCH = 2
SEQ = 8192
DEPTH = 2

GRID_W = 64
CTX_LEN = 256
N_MOD = 6
EPS = 1e-6
ROPE_BASE = 10000.0

RET_HEADS = 4
RET_DIM = 128
RET_W = RET_HEADS * RET_DIM
RET_DECAY_BASE_EXP = 5
CHUNK = 128

DIFF_HEADS = 8
DIFF_QK = 64
DIFF_V = 2 * DIFF_QK
DIFF_QK_W = DIFF_HEADS * 2 * DIFF_QK
DIFF_W = DIFF_HEADS * DIFF_V
Q_BLOCK = 128

S5_GROUP = 16
S5_CH = 512
S5_GROUPS = S5_CH // S5_GROUP
S5_STATE = 64
DT_MIN = 0.001
DT_MAX = 0.1

MIX_W = RET_W + DIFF_W + S5_CH
SPLIT_POINTS = (RET_W, 2 * RET_W, 3 * RET_W, 4 * RET_W, 4 * RET_W + DIFF_QK_W, 4 * RET_W + 2 * DIFF_QK_W, 4 * RET_W + 2 * DIFF_QK_W + DIFF_W)
IN_W = 4 * RET_W + 2 * DIFF_QK_W + DIFF_W + S5_CH

N_EXPERTS = 64
EXPERT_FF = 512
SHARED_FF = 512
TOP_K = 8
N_EXPERT_GROUPS = 8
TOPK_GROUPS = 4
ROUTE_SCALE = 2.5
TOKEN_BLOCK = 128

F32 = jnp.float32

kernel_name = 'hybrid_retention_diffattn_s5_moe_dit'


def rms_norm(x, w):
    x = x.astype(F32)
    return x * lax.rsqrt(jnp.mean(x * x, axis=-1, keepdims=True) + EPS) * w.astype(F32)


def split_heads(t, n_heads, head_dim):
    b, l, _ = t.shape
    return t.astype(F32).reshape(b, l, n_heads, head_dim).transpose(0, 2, 1, 3)


def merge_heads(t):
    b, h, l, d = t.shape
    return t.transpose(0, 2, 1, 3).reshape(b, l, h * d)


def axial_rope_tables(rows, head_dim):
    axis_dim = head_dim // 2
    inv_freq = ROPE_BASE ** (-jnp.arange(0, axis_dim, 2, dtype=F32) / axis_dim)
    row = jnp.repeat(jnp.arange(rows, dtype=F32), GRID_W)
    col = jnp.tile(jnp.arange(GRID_W, dtype=F32), rows)
    ang = jnp.concatenate([row[:, None] * inv_freq, col[:, None] * inv_freq], axis=-1)
    return jnp.cos(ang), jnp.sin(ang)


def apply_rope(x, rope):
    cos, sin = rope
    x1, x2 = jnp.split(x, 2, axis=-1)
    return jnp.concatenate([x1 * cos - x2 * sin, x1 * sin + x2 * cos], axis=-1)


def adaln(cond, w_ada, b_ada):
    return jax.nn.silu(cond.astype(F32)) @ w_ada.astype(F32) + b_ada.astype(F32)


def split_proj(proj):
    return jnp.split(proj, SPLIT_POINTS, axis=-1)


def retention_scan(q, k, v, log_gamma, s0):
    b, h, n, d = q.shape
    nc = n // CHUNK

    def to_chunks(t):
        return t.reshape(b, h, nc, CHUNK, d).transpose(2, 0, 1, 3, 4)

    idx = jnp.arange(CHUNK, dtype=F32)
    rel = idx[:, None] - idx[None, :]
    decay_mask = jnp.where(rel >= 0, jnp.exp(log_gamma[:, None, None] * jnp.maximum(rel, 0.0)), 0.0)
    q_decay = jnp.exp(log_gamma[:, None] * (idx + 1.0))[None, :, :, None]
    k_decay = jnp.exp(log_gamma[:, None] * (CHUNK - 1.0 - idx))[None, :, :, None]
    chunk_decay = jnp.exp(log_gamma * CHUNK)[None, :, None, None]

    def step(s, qkv):
        qb, kb, vb = qkv
        scores = jnp.einsum('bhid,bhjd->bhij', qb, kb) * decay_mask
        inner = jnp.einsum('bhij,bhjd->bhid', scores, vb)
        cross = jnp.einsum('bhid,bhde->bhie', qb, s) * q_decay
        s_new = s * chunk_decay + jnp.einsum('bhjd,bhje->bhde', kb * k_decay, vb)
        return s_new, inner + cross

    s_final, out = lax.scan(step, s0, (to_chunks(q), to_chunks(k), to_chunks(v)))
    return out.transpose(1, 2, 0, 3, 4).reshape(b, h, n, d), s_final


def retention_out(o, g, norm_w):
    mu = jnp.mean(o, axis=-1, keepdims=True)
    var = jnp.mean(jnp.square(o - mu), axis=-1, keepdims=True)
    o = merge_heads((o - mu) * lax.rsqrt(var + EPS)) * norm_w.astype(F32)
    return jax.nn.silu(g.astype(F32)) * o


def retention_mixer(p_lat, p_ctx, decay_logit, norm_w, rope, need_ctx):
    rq, rk, rv, rg = p_lat
    cq, ck, cv, cg = p_ctx
    scale = RET_DIM ** -0.5
    ql = apply_rope(split_heads(rq, RET_HEADS, RET_DIM), rope)
    kl = apply_rope(split_heads(rk, RET_HEADS, RET_DIM), rope) * scale
    vl = split_heads(rv, RET_HEADS, RET_DIM)
    qc = split_heads(cq, RET_HEADS, RET_DIM)
    kc = split_heads(ck, RET_HEADS, RET_DIM) * scale
    vc = split_heads(cv, RET_HEADS, RET_DIM)
    log_g = jax.nn.log_sigmoid(decay_logit.astype(F32))
    zero = jnp.zeros((qc.shape[0], RET_HEADS, RET_DIM, RET_DIM), F32)
    flip = lambda t: t[:, :, ::-1]
    oc_f, sc_f = retention_scan(qc, kc, vc, log_g[0], zero)
    oc_b, sc_b = retention_scan(flip(qc), flip(kc), flip(vc), log_g[1], zero)
    ol_f, _ = retention_scan(ql, kl, vl, log_g[0], sc_f)
    ol_b, _ = retention_scan(flip(ql), flip(kl), flip(vl), log_g[1], sc_b)
    out_lat = retention_out(ol_f + flip(ol_b), rg, norm_w)
    out_ctx = None
    if need_ctx:
        out_ctx = retention_out(oc_f + flip(oc_b), cg, norm_w)
    return out_lat, out_ctx


def diff_heads(t, qk_norm_w):
    b, l, _ = t.shape
    t = t.astype(F32).reshape(b, l, DIFF_HEADS, 2, DIFF_QK).transpose(0, 2, 3, 1, 4)
    return rms_norm(t, qk_norm_w)


def diff_attend(q, k, v, lam):
    s = jnp.einsum('bhcqd,bhckd->bhcqk', q, k) * (DIFF_QK ** -0.5)
    a = jax.nn.softmax(s, axis=-1)
    w = a[:, :, 0] - lam * a[:, :, 1]
    return jnp.einsum('bhqk,bhkd->bhqd', w, v)


def diff_attention_mixer(p_lat, p_ctx, qnorm_w, knorm_w, lam_vecs, subln_w, lambda_init, rope, need_ctx):
    dq, dk, dv = p_lat
    cq, ck, cv = p_ctx
    ql = apply_rope(diff_heads(dq, qnorm_w), rope)
    kl = apply_rope(diff_heads(dk, knorm_w), rope)
    vl = split_heads(dv, DIFF_HEADS, DIFF_V)
    kc = diff_heads(ck, knorm_w)
    vc = split_heads(cv, DIFF_HEADS, DIFF_V)
    lv = lam_vecs.astype(F32)
    lam = jnp.exp(jnp.sum(lv[0] * lv[1])) - jnp.exp(jnp.sum(lv[2] * lv[3])) + lambda_init
    k_all = jnp.concatenate([kc, kl], axis=3)
    v_all = jnp.concatenate([vc, vl], axis=2)
    b, h, _, n, _ = ql.shape
    nb = n // Q_BLOCK
    q_blocks = ql.reshape(b, h, 2, nb, Q_BLOCK, DIFF_QK).transpose(3, 0, 1, 2, 4, 5)
    o_blocks = lax.map(lambda qb: diff_attend(qb, k_all, v_all, lam), q_blocks)
    o_lat = o_blocks.transpose(1, 2, 0, 3, 4).reshape(b, h, n, DIFF_V)
    out_lat = merge_heads(rms_norm(o_lat, subln_w) * (1.0 - lambda_init))
    out_ctx = None
    if need_ctx:
        qc = diff_heads(cq, qnorm_w)
        out_ctx = merge_heads(rms_norm(diff_attend(qc, kc, vc, lam), subln_w) * (1.0 - lambda_init))
    return out_lat, out_ctx


def s5_discretize(lam_re, lam_im, log_dt, b_re, b_im):
    lam_re, lam_im = lam_re.astype(F32), lam_im.astype(F32)
    b_re, b_im = b_re.astype(F32), b_im.astype(F32)
    dt = jnp.exp(log_dt.astype(F32))[:, None]
    mag = jnp.exp(lam_re * dt)
    a_re = mag * jnp.cos(lam_im * dt)
    a_im = mag * jnp.sin(lam_im * dt)
    den = lam_re * lam_re + lam_im * lam_im
    nr = a_re - 1.0
    f_re = (nr * lam_re + a_im * lam_im) / den
    f_im = (a_im * lam_re - nr * lam_im) / den
    bb_re = f_re[..., None] * b_re - f_im[..., None] * b_im
    bb_im = f_re[..., None] * b_im + f_im[..., None] * b_re
    return a_re, a_im, bb_re, bb_im


def s5_scan(u, disc, x0_re, x0_im):
    a_re, a_im, bb_re, bb_im = disc
    bu_re = jnp.einsum('blgh,gph->blgp', u, bb_re)
    bu_im = jnp.einsum('blgh,gph->blgp', u, bb_im)
    bu_re = bu_re.at[:, 0].add(a_re * x0_re - a_im * x0_im)
    bu_im = bu_im.at[:, 0].add(a_re * x0_im + a_im * x0_re)
    ar = jnp.broadcast_to(a_re, bu_re.shape)
    ai = jnp.broadcast_to(a_im, bu_re.shape)

    def combine(e1, e2):
        a1r, a1i, b1r, b1i = e1
        a2r, a2i, b2r, b2i = e2
        return (a2r * a1r - a2i * a1i, a2r * a1i + a2i * a1r,
                a2r * b1r - a2i * b1i + b2r, a2r * b1i + a2i * b1r + b2i)

    _, _, x_re, x_im = lax.associative_scan(combine, (ar, ai, bu_re, bu_im), axis=1)
    return x_re, x_im


def s5_readout(x_re, x_im, u, c_re, c_im, d, w_glu):
    b, l = u.shape[:2]
    y = jnp.einsum('blgp,ghp->blgh', x_re, c_re.astype(F32)) - jnp.einsum('blgp,ghp->blgh', x_im, c_im.astype(F32))
    y = jax.nn.gelu((y + d.astype(F32).reshape(S5_GROUPS, S5_GROUP) * u).reshape(b, l, S5_CH))
    return y * jax.nn.sigmoid(y @ w_glu.astype(F32))


def s5_mixer(u_lat, u_ctx, lam_re, lam_im, log_dt, b_re, b_im, c_re, c_im, d, w_glu, need_ctx):
    b, n, _ = u_lat.shape
    ul = u_lat.astype(F32).reshape(b, n, S5_GROUPS, S5_GROUP)
    uc = u_ctx.astype(F32).reshape(b, u_ctx.shape[1], S5_GROUPS, S5_GROUP)
    fwd = s5_discretize(lam_re[0], lam_im[0], log_dt[0], b_re, b_im)
    bwd = s5_discretize(lam_re[1], lam_im[1], log_dt[1], b_re, b_im)
    zero = jnp.zeros((b, S5_GROUPS, S5_STATE), F32)
    cf_re, cf_im = s5_scan(uc, fwd, zero, zero)
    cb_re, cb_im = s5_scan(uc[:, ::-1], bwd, zero, zero)
    lf_re, lf_im = s5_scan(ul, fwd, cf_re[:, -1], cf_im[:, -1])
    lb_re, lb_im = s5_scan(ul[:, ::-1], bwd, cb_re[:, -1], cb_im[:, -1])
    out_lat = s5_readout(lf_re + lb_re[:, ::-1], lf_im + lb_im[:, ::-1], ul, c_re, c_im, d, w_glu)
    out_ctx = None
    if need_ctx:
        out_ctx = s5_readout(cf_re + cb_re[:, ::-1], cf_im + cb_im[:, ::-1], uc, c_re, c_im, d, w_glu)
    return out_lat, out_ctx


def moe_ffn(h, router_w, router_bias, w_gate, w_up, w_down, s_gate, s_up, s_down):
    b, l, d = h.shape
    t = h.reshape(b * l, d)
    n_tok = t.shape[0]
    scores = jax.nn.sigmoid(t @ router_w.astype(F32))
    sel = scores + router_bias.astype(F32)
    per_group = N_EXPERTS // N_EXPERT_GROUPS
    grp_score = lax.top_k(sel.reshape(n_tok, N_EXPERT_GROUPS, per_group), 2)[0].sum(-1)
    _, top_grp = lax.top_k(grp_score, TOPK_GROUPS)
    grp_mask = jnp.any(top_grp[:, :, None] == jnp.arange(N_EXPERT_GROUPS)[None, None, :], axis=1)
    exp_mask = jnp.repeat(grp_mask, per_group, axis=1)
    _, top_e = lax.top_k(jnp.where(exp_mask, sel, -jnp.inf), TOP_K)
    w = jnp.take_along_axis(scores, top_e, axis=1)
    w = ROUTE_SCALE * w / jnp.sum(w, axis=1, keepdims=True)
    gates = jnp.sum(jax.nn.one_hot(top_e, N_EXPERTS, dtype=F32) * w[:, :, None], axis=1)

    def block(args):
        tb, gb = args
        hid = jax.nn.silu(jnp.einsum('td,edf->tef', tb, w_gate)) * jnp.einsum('td,edf->tef', tb, w_up)
        return jnp.einsum('tef,efd->td', hid * gb[:, :, None], w_down)

    nb = n_tok // TOKEN_BLOCK
    routed = lax.map(block, (t.reshape(nb, TOKEN_BLOCK, d), gates.reshape(nb, TOKEN_BLOCK, N_EXPERTS)))
    shared = (jax.nn.silu(t @ s_gate) * (t @ s_up)) @ s_down
    return (routed.reshape(n_tok, d) + shared).reshape(b, l, d)


def setup_inputs(seed: int = 0) -> dict:
    key = jax.random.key(seed)
    ks = jax.random.split(key, 34)
    nrm = lambda k, shape, s: s * jax.random.normal(k, shape, F32)
    L, D, G, P = DEPTH, D_MODEL, S5_GROUPS, S5_STATE
    ret_logit0 = jnp.asarray(np.log(2.0 ** (RET_DECAY_BASE_EXP + np.arange(RET_HEADS)) - 1.0), F32)
    return {
        'x': nrm(ks[0], (BATCH, SEQ, D), 1.0),
        'c': nrm(ks[1], (BATCH, D), 1.0),
        'ctx': nrm(ks[2], (BATCH, CTX_LEN, D), 1.0),
        'c_ctx': nrm(ks[3], (D,), 1.0),
        'w_ada': nrm(ks[4], (L, D, N_MOD * D), 0.5 * D ** -0.5),
        'b_ada': nrm(ks[5], (L, N_MOD * D), 0.01),
        'norm1_w': 1.0 + nrm(ks[6], (L, D), 0.01),
        'norm2_w': 1.0 + nrm(ks[7], (L, D), 0.01),
        'w_in': nrm(ks[8], (L, D, IN_W), D ** -0.5),
        'ret_decay_logit': ret_logit0 + nrm(ks[9], (L, 2, RET_HEADS), 0.01),
        'ret_norm_w': 1.0 + nrm(ks[10], (L, RET_W), 0.01),
        'diff_qnorm_w': 1.0 + nrm(ks[11], (L, DIFF_QK), 0.01),
        'diff_knorm_w': 1.0 + nrm(ks[12], (L, DIFF_QK), 0.01),
        'diff_lambda': nrm(ks[13], (L, 4, DIFF_QK), 0.1),
        'diff_subln_w': 1.0 + nrm(ks[14], (L, DIFF_V), 0.01),
        's5_lambda_re': -0.5 + nrm(ks[15], (L, 2, G, P), 0.01),
        's5_lambda_im': math.pi * jnp.arange(P, dtype=F32) + nrm(ks[16], (L, 2, G, P), 0.01),
        's5_log_dt': jax.random.uniform(ks[17], (L, 2, G), F32, math.log(DT_MIN), math.log(DT_MAX)),
        's5_b_re': nrm(ks[18], (L, G, P, S5_GROUP), (2.0 * S5_GROUP) ** -0.5),
        's5_b_im': nrm(ks[19], (L, G, P, S5_GROUP), (2.0 * S5_GROUP) ** -0.5),
        's5_c_re': nrm(ks[20], (L, G, S5_GROUP, P), 0.5),
        's5_c_im': nrm(ks[21], (L, G, S5_GROUP, P), 0.5),
        's5_d': nrm(ks[22], (L, S5_CH), 1.0),
        's5_w_glu': nrm(ks[23], (L, S5_CH, S5_CH), S5_CH ** -0.5),
        'w_out': nrm(ks[24], (L, MIX_W, D), MIX_W ** -0.5),
        'router_w': nrm(ks[25], (L, D, N_EXPERTS), D ** -0.5),
        'router_bias': nrm(ks[26], (L, N_EXPERTS), 0.01),
        'exp_w_gate': nrm(ks[27], (L, N_EXPERTS, D, EXPERT_FF), D ** -0.5),
        'exp_w_up': nrm(ks[28], (L, N_EXPERTS, D, EXPERT_FF), D ** -0.5),
        'exp_w_down': nrm(ks[29], (L, N_EXPERTS, EXPERT_FF, D), EXPERT_FF ** -0.5),
        'shared_w_gate': nrm(ks[30], (L, D, SHARED_FF), D ** -0.5),
        'shared_w_up': nrm(ks[31], (L, D, SHARED_FF), D ** -0.5),
        'shared_w_down': nrm(ks[32], (L, SHARED_FF, D), SHARED_FF ** -0.5),
    }


def reference(x, c, ctx, c_ctx, w_ada, b_ada, norm1_w, norm2_w, w_in, ret_decay_logit, ret_norm_w,
              diff_qnorm_w, diff_knorm_w, diff_lambda, diff_subln_w, s5_lambda_re, s5_lambda_im,
              s5_log_dt, s5_b_re, s5_b_im, s5_c_re, s5_c_im, s5_d, s5_w_glu, w_out, router_w,
              router_bias, exp_w_gate, exp_w_up, exp_w_down, shared_w_gate, shared_w_up, shared_w_down):
    out_dtype = x.dtype
    n = x.shape[1]
    rows = n // GRID_W
    rope_ret = axial_rope_tables(rows, RET_DIM)
    rope_diff = axial_rope_tables(rows, DIFF_QK)
    x = x.astype(F32)
    ctx = ctx.astype(F32)
    for l in range(DEPTH):
        need_ctx = l < DEPTH - 1
        lambda_init = 0.8 - 0.6 * math.exp(-0.3 * l)
        sh1, sc1, g1, sh2, sc2, g2 = jnp.split(adaln(c, w_ada[l], b_ada[l])[:, None, :], N_MOD, axis=-1)
        csh1, csc1, cg1, csh2, csc2, cg2 = jnp.split(adaln(c_ctx[None, :], w_ada[l], b_ada[l])[:, None, :], N_MOD, axis=-1)
        h_lat = rms_norm(x, norm1_w[l]) * (1.0 + sc1) + sh1
        h_ctx = rms_norm(ctx, norm1_w[l]) * (1.0 + csc1) + csh1
        p_lat = split_proj(h_lat @ w_in[l])
        p_ctx = split_proj(h_ctx @ w_in[l])
        ret_lat, ret_ctx = retention_mixer(p_lat[0:4], p_ctx[0:4], ret_decay_logit[l], ret_norm_w[l], rope_ret, need_ctx)
        diff_lat, diff_ctx = diff_attention_mixer(p_lat[4:7], p_ctx[4:7], diff_qnorm_w[l], diff_knorm_w[l],
                                                  diff_lambda[l], diff_subln_w[l], lambda_init, rope_diff, need_ctx)
        s5_lat, s5_ctx = s5_mixer(p_lat[7], p_ctx[7], s5_lambda_re[l], s5_lambda_im[l], s5_log_dt[l],
                                  s5_b_re[l], s5_b_im[l], s5_c_re[l], s5_c_im[l], s5_d[l], s5_w_glu[l], need_ctx)
        x = x + g1 * (jnp.concatenate([ret_lat, diff_lat, s5_lat], axis=-1) @ w_out[l])
        h2 = rms_norm(x, norm2_w[l]) * (1.0 + sc2) + sh2
        x = x + g2 * moe_ffn(h2, router_w[l], router_bias[l], exp_w_gate[l], exp_w_up[l], exp_w_down[l],
                             shared_w_gate[l], shared_w_up[l], shared_w_down[l])
        if need_ctx:
            ctx = ctx + cg1 * (jnp.concatenate([ret_ctx, diff_ctx, s5_ctx], axis=-1) @ w_out[l])
            h2c = rms_norm(ctx, norm2_w[l]) * (1.0 + csc2) + csh2
            ctx = ctx + cg2 * moe_ffn(h2c, router_w[l], router_bias[l], exp_w_gate[l], exp_w_up[l], exp_w_down[l],
                                      shared_w_gate[l], shared_w_up[l], shared_w_down[l])
    return x.astype(out_dtype)
```

```cpp
#include <hip/hip_runtime.h>
#include <cstdio>
#include <cstdint>

#define LAS __attribute__((address_space(3)))
typedef unsigned short bf16_t;
typedef short bf16x8 __attribute__((ext_vector_type(8)));
typedef short s16x4 __attribute__((ext_vector_type(4)));
typedef float f32x4 __attribute__((ext_vector_type(4)));
typedef float f32x2 __attribute__((ext_vector_type(2)));
typedef float f32x16 __attribute__((ext_vector_type(16)));
typedef unsigned u32x4 __attribute__((ext_vector_type(4)));
typedef unsigned u32x2 __attribute__((ext_vector_type(2)));

constexpr int D = 2048, BATCH = 2, SEQ = 8192, CTX = 256, SEQU = SEQ + CTX  , TALL = BATCH * SEQU  ;
constexpr int NMOD = 6, MODW = NMOD * D;
constexpr int LDP = 5632;
constexpr int OFF_RQ = 0, OFF_RK = 512, OFF_RV = 1024, OFF_RG = 1536, OFF_DQ = 2048, OFF_DK = 3072, OFF_DV = 4096, OFF_U = 5120;
constexpr int NEXP = 64, FF = 512, NE1 = NEXP + 1;
constexpr int S5G = 32, S5P = 64, NCH32 = SEQU / 32  , NCH128 = SEQU / 128  ;
constexpr float EPS = 1e-6f;
constexpr float LOG2E = 1.4426950408889634f;
constexpr int NTHR = 512, NWAVE = 8;
constexpr int LDS_BYTES = 147456;

constexpr size_t MiB = 1u << 20;
constexpr size_t al256(size_t x) { return (x + 255) & ~(size_t)255; }
constexpr size_t WS_CTL = 0, CTL_BYTES = 1 * MiB;
constexpr int CW_BAR = 0;
constexpr int CW_CNT = 4096;
constexpr size_t WS_MOD   = WS_CTL + CTL_BYTES;
constexpr size_t WS_WIN   = al256(WS_MOD + (size_t)2 * 3 * MODW * 4);
constexpr size_t WS_WOUT  = al256(WS_WIN + (size_t)2 * LDP * D * 2);
constexpr size_t WS_GU    = al256(WS_WOUT + (size_t)2 * D * D * 2);
constexpr size_t WS_DN    = al256(WS_GU + (size_t)2 * NE1 * 1024 * D);
constexpr size_t WS_GLU   = al256(WS_DN + (size_t)2 * NE1 * D * FF);
constexpr size_t WS_RWT   = al256(WS_GLU + (size_t)2 * 512 * 512 * 2);
constexpr size_t WS_ROPE  = al256(WS_RWT + (size_t)2 * 64 * D * 4);
constexpr size_t ROPE_SINR = (size_t)SEQ * 64 * 4, ROPE_COSD = 2 * ROPE_SINR, ROPE_SIND = ROPE_COSD + (size_t)SEQ * 32 * 4, ROPE_BYTES = ROPE_SIND + (size_t)SEQ * 32 * 4;
constexpr size_t WS_S5A   = al256(WS_ROPE + ROPE_BYTES);
constexpr size_t S5A_N = (size_t)2 * 2 * 32 * 64;
constexpr size_t WS_S5BF  = al256(WS_S5A + 3 * S5A_N * 8);
constexpr size_t WS_S5CF  = al256(WS_S5BF + (size_t)2 * 2 * 32 * 2 * 2 * 512 * 2);
constexpr size_t WS_LIST  = al256(WS_S5CF + (size_t)2 * 32 * 4 * 512 * 2);
constexpr size_t WS_TKE   = al256(WS_LIST + (size_t)NE1 * TALL * 4);
constexpr size_t WS_TKP   = al256(WS_TKE + (size_t)TALL * 8 * 4);
constexpr size_t WS_TKW   = al256(WS_TKP + (size_t)TALL * 8 * 4);
constexpr size_t WS_X     = al256(WS_TKW + (size_t)TALL * 8 * 4);
constexpr size_t WS_H     = al256(WS_X + (size_t)TALL * D * 4);
constexpr size_t WS_H8    = al256(WS_H + (size_t)TALL * D * 2);
constexpr size_t WS_R     = al256(WS_H8 + (size_t)TALL * D);
constexpr size_t WS_P     = WS_R;
constexpr size_t WS_MIX   = al256(WS_P + (size_t)TALL * LDP * 2);
constexpr size_t WS_KVT   = al256(WS_MIX + (size_t)TALL * D * 2);
constexpr size_t WS_ST    = al256(WS_KVT + (size_t)16 * NCH128 * 16384 * 4);
constexpr size_t WS_S5E   = al256(WS_ST + (size_t)16 * NCH128 * 16384 * 2);
constexpr size_t WS_S5X   = al256(WS_S5E + (size_t)4 * NCH32 * 2048 * 8);
constexpr size_t WS_Q8    = al256(WS_S5X + (size_t)4 * NCH32 * 2048 * 8);
constexpr size_t WS_K8    = al256(WS_Q8 + (size_t)TALL * 1024);
constexpr size_t WS_V8T   = al256(WS_K8 + (size_t)TALL * 1024);
constexpr size_t WS_MIXEND = al256(WS_V8T + (size_t)TALL * 1024);
constexpr int HID_ROWS = TALL * 9 + NE1 * 256, Y_ROWS = TALL * 8 + NEXP * 256;
constexpr size_t WS_HID   = WS_R;
constexpr size_t WS_Y     = al256(WS_HID + (size_t)HID_ROWS * FF);
constexpr size_t WS_MOEEND = al256(WS_Y + (size_t)Y_ROWS * D * 2);
constexpr size_t WS_END = WS_MOEEND > WS_MIXEND ? WS_MOEEND : WS_MIXEND;

__device__ __forceinline__ unsigned f2bf(float f) { unsigned u = __builtin_bit_cast(unsigned, f); return (u + 0x7fffu + ((u >> 16) & 1u)) >> 16; }
__device__ __forceinline__ float bf2f(unsigned h) { return __builtin_bit_cast(float, h << 16); }
typedef __bf16 bf16x2_t __attribute__((ext_vector_type(2)));
__device__ __forceinline__ unsigned pk2(float lo, float hi) { const f32x2 v = {lo, hi}; const bf16x2_t b = __builtin_convertvector(v, bf16x2_t); return __builtin_bit_cast(unsigned, b); }
__device__ __forceinline__ unsigned pk4_fp8(float a, float b, float c, float d) {
    a = fminf(fmaxf(a, -448.f), 448.f); b = fminf(fmaxf(b, -448.f), 448.f); c = fminf(fmaxf(c, -448.f), 448.f); d = fminf(fmaxf(d, -448.f), 448.f);
    int w = 0; w = __builtin_amdgcn_cvt_pk_fp8_f32(a, b, w, false); w = __builtin_amdgcn_cvt_pk_fp8_f32(c, d, w, true); return (unsigned)w; }
__device__ __forceinline__ unsigned pk4_fp8_nc(float a, float b, float c, float d) { int w = 0; w = __builtin_amdgcn_cvt_pk_fp8_f32(a, b, w, false); w = __builtin_amdgcn_cvt_pk_fp8_f32(c, d, w, true); return (unsigned)w; }
constexpr float SC_H8 = 8.f, SC_HID = 8.f, SC_GU = 64.f, SC_DN = 32.f, SC_WIN = 64.f, SC_Y = 16.f, SC_Q8 = 32.f, SC_K8 = 8.f, SC_V8 = 8.f;
constexpr float SC_MIX = 8.f, SC_WOUT = 64.f; constexpr int E8_MIX = 127 - 3, E8_WOUT = 127 - 6;
constexpr int E8_H8 = 127 - 3, E8_HID = 127 - 3, E8_GU = 127 - 6, E8_DN = 127 - 5, E8_WIN = 127 - 6, E8_Q8 = 127 - 5, E8_K8 = 127 - 3, E8_V8 = 127 - 3;
__device__ __forceinline__ float bflo(unsigned w) { return __builtin_bit_cast(float, w << 16); }
__device__ __forceinline__ float bfhi(unsigned w) { return __builtin_bit_cast(float, w & 0xffff0000u); }
__device__ __forceinline__ f32x4 ld_bf16x4(const bf16_t* p) { const u32x2 w = *(const u32x2*)p; f32x4 r; r[0] = bflo(w.x); r[1] = bfhi(w.x); r[2] = bflo(w.y); r[3] = bfhi(w.y); return r; }
__device__ __forceinline__ float wave_sum(float v) {
#pragma unroll
    for (int o = 1; o < 64; o <<= 1) v += __shfl_xor(v, o);
    return v;
}
__device__ __forceinline__ float opaque_zero() { float z = 0.f; asm volatile("" : "+v"(z)); return z; }
__device__ __forceinline__ float fast_exp2(float x) { return __builtin_amdgcn_exp2f(x); }
__device__ __forceinline__ float fast_rcp(float x) { return __builtin_amdgcn_rcpf(x); }
__device__ __forceinline__ float sigmoidf_(float x) { return fast_rcp(1.0f + fast_exp2(-x * LOG2E)); }
__device__ __forceinline__ float siluf_(float x) { return x * sigmoidf_(x); }
__device__ __forceinline__ float gelu_tanh(float x) {
    const float u = 0.7978845608028654f * (x + 0.044715f * x * x * x);
    return x * sigmoidf_(2.0f * u);
}
__device__ __forceinline__ unsigned offb_key(unsigned row) { return ((row & 3u) << 2) | ((row >> 2) & 3u); }
__device__ __forceinline__ unsigned off_b(unsigned row, unsigned ch) { return 256u * row + 16u * (ch ^ offb_key(row)); }
__device__ __forceinline__ int mod_index(int row) { const int b = row / SEQU, pos = row - b * SEQU; return pos < CTX ? 2 : b; }

#define XB_TMO      128
#define XB_XCNT(j)  (256  + 64 * (j))
#define XB_XSUB(j)  (1280 + 64 * (j))
#define XB_XGEN(j)  (2304 + 64 * (j))
#define XB_TOP      3328
#define XB_TOPGEN   3392
#define XCD_BAR_WORDS 3456
#define XB_SPIN_CAP (1u << 22)
__device__ __forceinline__ unsigned xb_ld(unsigned* p)              { return __hip_atomic_load(p, __ATOMIC_RELAXED, __HIP_MEMORY_SCOPE_AGENT); }
__device__ __forceinline__ unsigned xb_add(unsigned* p, unsigned v) { return __hip_atomic_fetch_add(p, v, __ATOMIC_RELAXED, __HIP_MEMORY_SCOPE_AGENT); }
__device__ __forceinline__ unsigned xb_xcc_id() { return (unsigned)__builtin_amdgcn_s_getreg((3 << 11) | 20) & 0xFu; }
#define XB_SPIN(cond, bar) do { unsigned _sp = 0; while (cond) { __builtin_amdgcn_s_sleep(1); \
    if ((++_sp & 255u) == 0u) { if (xb_ld(&(bar)[XB_TMO])) break; if (_sp > XB_SPIN_CAP) { atomicAdd(&(bar)[XB_TMO], 1u); break; } } } } while (0)
struct XcdBarrier { unsigned* bar; unsigned x; volatile LAS unsigned* st; };
__device__ __forceinline__ XcdBarrier xcd_barrier_post(unsigned* bar, volatile LAS unsigned* st) {
    XcdBarrier b; b.bar = bar; b.x = xb_xcc_id(); b.st = st;
    if (threadIdx.x == 0) (void)xb_add(&bar[XB_XCNT(b.x)], 1u);
    return b;
}
__device__ __forceinline__ void xcd_barrier_complete(unsigned* bar, unsigned x, unsigned& nloc, unsigned& nx) {
    const unsigned G = gridDim.x * gridDim.y * gridDim.z;
    unsigned sum, cnt, mine, sp = 0u;
    for (;;) {
        sum = 0u; cnt = 0u; mine = 0u;
#pragma unroll
        for (unsigned j = 0; j < 16; ++j) { const unsigned c = xb_ld(&bar[XB_XCNT(j)]); sum += c; cnt += (c > 0u) ? 1u : 0u; mine = (j == x) ? c : mine; }
        if (sum == G) break;
        __builtin_amdgcn_s_sleep(1);
        if ((++sp & 255u) == 0u) { if (xb_ld(&bar[XB_TMO])) break; if (sp > XB_SPIN_CAP) { atomicAdd(&bar[XB_TMO], 1u); break; } }
    }
    nloc = mine > 0u ? mine : 1u; nx = cnt > 0u ? cnt : 1u;
}
__device__ __forceinline__ void xcd_barrier(const XcdBarrier& b) {
    asm volatile("s_waitcnt vmcnt(0)" ::: "memory");
    __syncthreads();
    if (threadIdx.x == 0) {
        unsigned* bar = b.bar;
        __builtin_amdgcn_s_waitcnt(0);
        unsigned nloc = b.st[0], nx = b.st[1];
        if (nloc == 0u) { xcd_barrier_complete(bar, b.x, nloc, nx); b.st[0] = nloc; b.st[1] = nx; }
        const unsigned old = xb_add(&bar[XB_XSUB(b.x)], 1u);
        const unsigned gen = old / nloc;
        if (old + 1u == (gen + 1u) * nloc) {
            __builtin_amdgcn_fence(__ATOMIC_RELEASE, "agent");
            asm volatile("s_waitcnt vmcnt(0)" ::: "memory");
            const unsigned og = xb_add(&bar[XB_TOP], 1u);
            const unsigned tg = og / nx;
            if (og + 1u == (tg + 1u) * nx) xb_add(&bar[XB_TOPGEN], 1u);
            else XB_SPIN(xb_ld(&bar[XB_TOPGEN]) == tg, bar);
            __builtin_amdgcn_fence(__ATOMIC_ACQUIRE, "agent");
            xb_add(&bar[XB_XGEN(b.x)], 1u);
            asm volatile("s_waitcnt vmcnt(0)" ::: "memory");
        } else {
            XB_SPIN(xb_ld(&bar[XB_XGEN(b.x)]) == gen, bar);
            __builtin_amdgcn_fence(__ATOMIC_ACQUIRE, "agent");
            asm volatile("s_waitcnt vmcnt(0)" ::: "memory");
        }
    }
    __syncthreads();
}

struct Args {
    const float *x, *c, *ctx, *c_ctx, *w_ada, *b_ada, *norm1_w, *norm2_w, *w_in, *ret_decay, *ret_norm_w, *dq_w, *dk_w, *dlam, *dsub_w;
    const float *s5_lre, *s5_lim, *s5_logdt, *s5_bre, *s5_bim, *s5_cre, *s5_cim, *s5_d, *s5_glu, *w_out, *router_w, *router_b;
    const float *e_gate, *e_up, *e_down, *s_gate, *s_up, *s_down;
    float* out; unsigned char* ws;
};

__device__ __forceinline__ void adaln_unit(const Args& A, float* MOD, LAS unsigned char* lds, int l, int cc) {
    LAS float* s = (LAS float*)lds;
    LAS f32x4* red = (LAS f32x4*)(lds + 3 * 2048 * 4);
    const int tid = threadIdx.x;
    for (int i = tid; i < 3 * D; i += NTHR) { const int r = i / D, k = i - r * D; const float v = r < 2 ? A.c[r * D + k] : A.c_ctx[k]; s[i] = siluf_(v); }
    __syncthreads();
    const int kq = tid >> 5, cq = tid & 31, col = cc * 128 + 4 * cq;
    f32x4 a0 = {0, 0, 0, 0}, a1 = a0, a2 = a0;
    const float* wp = A.w_ada + ((size_t)l * D + kq * 128) * MODW + col;
#pragma unroll 8
    for (int k = 0; k < 128; ++k) { const f32x4 w = *(const f32x4*)(wp + (size_t)k * MODW); const int kk = kq * 128 + k; a0 += s[kk] * w; a1 += s[D + kk] * w; a2 += s[2 * D + kk] * w; }
    red[(kq * 3 + 0) * 32 + cq] = a0; red[(kq * 3 + 1) * 32 + cq] = a1; red[(kq * 3 + 2) * 32 + cq] = a2;
    __syncthreads();
    if (tid < 96) { const int r = tid >> 5, c2 = tid & 31; f32x4 t = *(const f32x4*)(A.b_ada + (size_t)l * MODW + cc * 128 + 4 * c2);
        for (int q = 0; q < 16; ++q) t += red[(q * 3 + r) * 32 + c2];
        *(f32x4*)(MOD + ((size_t)l * 3 + r) * MODW + cc * 128 + 4 * c2) = t; }
    __syncthreads();
}

enum { MAP_IDENT = 0, MAP_PERM32 = 1, MAP_RETQK = 2, MAP_DIFFQK = 3, MAP_GLUFRAG = 4, MAP_PERM16 = 5 };
__device__ __forceinline__ int src_col(int kind, int rho) {
    const int bj = rho >> 7, wc = (rho >> 5) & 3, n = (rho >> 4) & 1, i = rho & 15;
    if (kind == MAP_PERM32) return 128 * bj + 32 * wc + 8 * (i >> 2) + 4 * n + (i & 3);
    if (kind == MAP_PERM16) return 64 * wc + 16 * (i >> 2) + 8 * bj + 4 * n + (i & 3);
    if (kind == MAP_RETQK)  return 128 * bj + 64 * n + 16 * wc + i;
    if (kind == MAP_DIFFQK) return 64 * wc + 32 * bj + 8 * (i >> 2) + 4 * n + (i & 3);
    return rho;
}
struct CvD { const float* sa; const float* sb; unsigned char* dst; int ld, K, drow0, k0, kind; float sc; };
__device__ __forceinline__ void conv_load(const CvD& d, f32x4 (&v)[16], int tid) {
#pragma unroll
    for (int i = 0; i < 16; ++i) { const int idx = tid + NTHR * i, row = idx >> 6, col = 4 * (idx & 63);
        v[i] = *(const f32x4*)((col < 128 ? d.sa + col : d.sb + (col - 128)) + (size_t)(d.k0 + row) * d.ld); }
}
__device__ __forceinline__ void conv_put(const f32x4 (&v)[16], LAS float* T, int tid) {
#pragma unroll
    for (int i = 0; i < 16; ++i) { const int idx = tid + NTHR * i, row = idx >> 6, col = 4 * (idx & 63); LAS float* tp = T + row * 257 + col; tp[0] = v[i][0]; tp[1] = v[i][1]; tp[2] = v[i][2]; tp[3] = v[i][3]; }
}
__device__ __forceinline__ void conv_out(const CvD& d, const LAS float* T, int tid) {
    const int K = d.K, kind = d.kind; const float fp8scale = d.sc;
    if (fp8scale > 0.f) {
        unsigned char* d8 = d.dst;
#pragma unroll
        for (int i = 0; i < 4; ++i) { const int idx = tid + NTHR * i, rho = idx >> 3, kg = idx & 7, sc = src_col(kind, rho);
            const LAS float* tp = T + (16 * kg) * 257 + sc; u32x4 w;
            w.x = pk4_fp8(tp[0] * fp8scale, tp[257] * fp8scale, tp[2 * 257] * fp8scale, tp[3 * 257] * fp8scale); w.y = pk4_fp8(tp[4 * 257] * fp8scale, tp[5 * 257] * fp8scale, tp[6 * 257] * fp8scale, tp[7 * 257] * fp8scale);
            w.z = pk4_fp8(tp[8 * 257] * fp8scale, tp[9 * 257] * fp8scale, tp[10 * 257] * fp8scale, tp[11 * 257] * fp8scale); w.w = pk4_fp8(tp[12 * 257] * fp8scale, tp[13 * 257] * fp8scale, tp[14 * 257] * fp8scale, tp[15 * 257] * fp8scale);
            *(u32x4*)(d8 + (size_t)(d.drow0 + rho) * K + d.k0 + 16 * kg) = w; }
        return; }
    bf16_t* dst = (bf16_t*)d.dst;
#pragma unroll
    for (int i = 0; i < 8; ++i) { const int idx = tid + NTHR * i, rho = idx >> 4, ko = idx & 15, sc = src_col(kind, rho);
        const LAS float* tp = T + (8 * ko) * 257 + sc;
        u32x4 w; w.x = pk2(tp[0], tp[257]); w.y = pk2(tp[2 * 257], tp[3 * 257]); w.z = pk2(tp[4 * 257], tp[5 * 257]); w.w = pk2(tp[6 * 257], tp[7 * 257]);
        if (kind == MAP_GLUFRAG) { const int n = d.drow0 + rho, k8 = (d.k0 >> 3) + ko;
            *(u32x4*)(dst + ((size_t)(((((n >> 6) * 2 + ((n >> 5) & 1)) * 32 + (k8 >> 1)) * 2 + (k8 & 1)) * 32 + (n & 31)) << 3)) = w; }
        else *(u32x4*)(dst + (size_t)(d.drow0 + rho) * K + d.k0 + 8 * ko) = w; }
}
constexpr int CV_WIN = 352, CV_WOUT = 128, CV_EGU = 64 * 64, CV_EDN = 64 * 32, CV_SGU = 64, CV_SDN = 32, CV_GLU = 8;
constexpr int CV_PER_LAYER = CV_WIN + CV_WOUT + CV_EGU + CV_EDN + CV_SGU + CV_SDN + CV_GLU;
__device__ __forceinline__ CvD conv_desc(const Args& A, int u) {
    const int l = u / CV_PER_LAYER; int v = u - l * CV_PER_LAYER;
    unsigned char* ws = A.ws; CvD d;
    if (v < CV_WIN) { const int nb = v % 22, kb = v / 22; d.kind = nb < 4 ? MAP_RETQK : (nb >= 8 && nb < 16) ? MAP_DIFFQK : MAP_PERM32;
        d.sa = A.w_in + (size_t)l * D * LDP + 256 * nb; d.sb = d.sa + 128; d.ld = LDP; d.dst = ws + WS_WIN + (size_t)l * LDP * D; d.K = D; d.drow0 = 256 * nb; d.k0 = 128 * kb; d.sc = SC_WIN; return d; }
    v -= CV_WIN;
    if (v < CV_WOUT) { const int nb = v & 7, kb = v >> 3; d.sa = A.w_out + (size_t)l * D * D + 256 * nb; d.sb = d.sa + 128; d.ld = D; d.dst = ws + WS_WOUT + (size_t)l * D * D; d.K = D; d.drow0 = 256 * nb; d.k0 = 128 * kb;
        d.kind = MAP_PERM16; d.sc = SC_WOUT; return d; }
    v -= CV_WOUT;
    if (v < CV_EGU) { const int e = v >> 6, r = v & 63, nb = r & 3, kb = r >> 2;
        d.sa = A.e_gate + ((size_t)l * NEXP + e) * D * FF + 128 * nb; d.sb = A.e_up + ((size_t)l * NEXP + e) * D * FF + 128 * nb; d.ld = FF; d.dst = ws + WS_GU + ((size_t)l * NE1 + e) * 1024 * D; d.K = D; d.drow0 = 256 * nb; d.k0 = 128 * kb;
        d.kind = MAP_PERM32; d.sc = SC_GU; return d; }
    v -= CV_EGU;
    if (v < CV_EDN) { const int e = v >> 5, r = v & 31, nb = r & 7, kb = r >> 3; d.sa = A.e_down + ((size_t)l * NEXP + e) * FF * D + 256 * nb; d.sb = d.sa + 128; d.ld = D; d.dst = ws + WS_DN + ((size_t)l * NE1 + e) * D * FF; d.K = FF; d.drow0 = 256 * nb; d.k0 = 128 * kb;
        d.kind = MAP_PERM16; d.sc = SC_DN; return d; }
    v -= CV_EDN;
    if (v < CV_SGU) { const int nb = v & 3, kb = v >> 2;
        d.sa = A.s_gate + (size_t)l * D * FF + 128 * nb; d.sb = A.s_up + (size_t)l * D * FF + 128 * nb; d.ld = FF; d.dst = ws + WS_GU + ((size_t)l * NE1 + NEXP) * 1024 * D; d.K = D; d.drow0 = 256 * nb; d.k0 = 128 * kb;
        d.kind = MAP_PERM32; d.sc = SC_GU; return d; }
    v -= CV_SGU;
    if (v < CV_SDN) { const int nb = v & 7, kb = v >> 3; d.sa = A.s_down + (size_t)l * FF * D + 256 * nb; d.sb = d.sa + 128; d.ld = D; d.dst = ws + WS_DN + ((size_t)l * NE1 + NEXP) * D * FF; d.K = FF; d.drow0 = 256 * nb; d.k0 = 128 * kb;
        d.kind = MAP_PERM16; d.sc = SC_DN; return d; }
    v -= CV_SDN;
    { const int nb = v & 1, kb = v >> 1; d.sa = A.s5_glu + (size_t)l * 512 * 512 + 256 * nb; d.sb = d.sa + 128; d.ld = 512; d.dst = ws + WS_GLU + (size_t)l * 512 * 512 * 2; d.K = 512; d.drow0 = 256 * nb; d.k0 = 128 * kb; d.kind = MAP_GLUFRAG; d.sc = 0.f; }
    return d;
}
__device__ __forceinline__ void conv_range(const Args& A, int u0, int u1, LAS unsigned char* lds) {
    if (u0 >= u1) return;
    LAS float* T = (LAS float*)lds; const int tid = threadIdx.x;
    CvD cur = conv_desc(A, u0); f32x4 v[16]; conv_load(cur, v, tid);
    for (int u = u0; u < u1; ++u) {
        __syncthreads();
        conv_put(v, T, tid);
        __syncthreads();
        CvD nxt = cur;
        if (u + 1 < u1) { nxt = conv_desc(A, u + 1); conv_load(nxt, v, tid); }
        conv_out(cur, T, tid);
        cur = nxt;
    }
    __syncthreads();
}
__device__ __forceinline__ void conv_dispatch(const Args& A, int u, LAS unsigned char* lds) { conv_range(A, u, u + 1, lds); }

__device__ __forceinline__ void cs_rev(double rev, float& c, float& s) {
    const float fr = (float)(rev - __builtin_floor(rev)); c = __builtin_amdgcn_cosf(fr); s = __builtin_amdgcn_sinf(fr);
}
__device__ __forceinline__ void tables_phase(const Args& A, int gtid, int gn) {
    unsigned char* ws = A.ws;
    float* cosR = (float*)(ws + WS_ROPE); float* sinR = (float*)(ws + WS_ROPE + ROPE_SINR); float* cosD = (float*)(ws + WS_ROPE + ROPE_COSD); float* sinD = (float*)(ws + WS_ROPE + ROPE_SIND);
    const double INV2PI = 0.15915494309189535;
    for (int i = gtid; i < SEQ * 64; i += gn) { const int t = i >> 6, j = i & 63, jj = j & 31; const int pos = j < 32 ? (t >> 6) : (t & 63);
        const float f = fast_exp2(-(float)(2 * jj) * (1.0f / 64.0f) * 13.287712379549449f);
        float c, s; cs_rev((double)pos * (double)f * INV2PI, c, s); cosR[i] = c; sinR[i] = s; }
    for (int i = gtid; i < SEQ * 32; i += gn) { const int t = i >> 5, j = i & 31, jj = j & 15; const int pos = j < 16 ? (t >> 6) : (t & 63);
        const float f = fast_exp2(-(float)(2 * jj) * (1.0f / 32.0f) * 13.287712379549449f);
        float c, s; cs_rev((double)pos * (double)f * INV2PI, c, s); cosD[i] = c; sinD[i] = s; }
    float* rwt = (float*)(ws + WS_RWT);
    { unsigned short* rwh = (unsigned short*)rwt; unsigned short* rwl = rwh + (size_t)2 * NEXP * D;
      for (int i = gtid; i < 2 * D * NEXP; i += gn) { const int l = i / (D * NEXP), r = i - l * D * NEXP, k = r >> 6, e = r & 63; const float v = A.router_w[i];
          const unsigned hw = pk2(v, 0.f) & 0xffffu; const float hi = __builtin_bit_cast(float, hw << 16); const unsigned lw = pk2(v - hi, 0.f) & 0xffffu;
          const size_t o = (size_t)l * NEXP * D + ((size_t)(((((e >> 5) * 128 + (k >> 4)) * 2 + ((k >> 3) & 1)) * 32 + (e & 31)) << 3)) + (k & 7);
          rwh[o] = (unsigned short)hw; rwl[o] = (unsigned short)lw; } }
    int* list64 = (int*)(ws + WS_LIST) + (size_t)NEXP * TALL;
    for (int i = gtid; i < TALL; i += gn) list64[i] = i;
    f32x2* SA = (f32x2*)(ws + WS_S5A); bf16_t* BF = (bf16_t*)(ws + WS_S5BF); bf16_t* CF = (bf16_t*)(ws + WS_S5CF);
    for (int i = gtid; i < 2 * 2 * 32 * 64; i += gn) {
        const int p = i & 63, g = (i >> 6) & 31, d = (i >> 11) & 1, l = i >> 12;
        const float dt = fast_exp2(A.s5_logdt[(l * 2 + d) * 32 + g] * LOG2E);
        const float lr = A.s5_lre[i], li = A.s5_lim[i];
        const float mag = fast_exp2(lr * dt * LOG2E);
        float c, s; cs_rev((double)li * (double)dt * INV2PI, c, s);
        const float ar = mag * c, ai = mag * s;
        float pr = ar, pi = ai;
#pragma unroll
        for (int q = 0; q < 4; ++q) { const float nr = pr * pr - pi * pi, ni = 2.f * pr * pi; pr = nr; pi = ni; }
        const float a16r = pr, a16i = pi; const float a32r = pr * pr - pi * pi, a32i = 2.f * pr * pi;
        SA[i] = (f32x2){ar, ai}; SA[S5A_N + i] = (f32x2){a16r, a16i}; SA[2 * S5A_N + i] = (f32x2){a32r, a32i};
        const float den = lr * lr + li * li, nr = ar - 1.0f;
        const float fre = (nr * lr + ai * li) / den, fim = (ai * lr - nr * li) / den;
        const int pb = p >> 5, pl = p & 31;
        const float* bre = A.s5_bre + (((size_t)l * 32 + g) * 64 + p) * 16; const float* bim = A.s5_bim + (((size_t)l * 32 + g) * 64 + p) * 16;
        bf16_t* bf_re = BF + ((((size_t)(l * 2 + d) * 32 + g) * 2 + pb) * 2 + 0) * 512; bf16_t* bf_im = bf_re + 512;
        for (int h = 0; h < 16; ++h) { const float br = bre[h], bi = bim[h]; const int lane = (h >> 3) * 32 + pl, j = h & 7;
            bf_re[lane * 8 + j] = (bf16_t)f2bf(fre * br - fim * bi); bf_im[lane * 8 + j] = (bf16_t)f2bf(fre * bi + fim * br); }
        if (d == 0) {
            for (int reim = 0; reim < 2; ++reim) { const int k = 2 * p + reim, ks = k >> 5, kq = (k >> 3) & 3, j = k & 7;
                for (int hp = 0; hp < 16; ++hp) { const size_t ci = (((size_t)l * 32 + g) * 16 + hp) * 64 + p; const float v = reim ? -A.s5_cim[ci] : A.s5_cre[ci];
                    CF[(((size_t)l * 32 + g) * 4 + ks) * 512 + (kq * 16 + hp) * 8 + j] = (bf16_t)f2bf(v); } }
        }
    }
}

__device__ __forceinline__ const float* in_row(const float* xlat, const float* xctx, int row) {
    const int b = row / SEQU, pos = row - b * SEQU; return pos < CTX ? xctx + ((size_t)b * CTX + pos) * D : xlat + ((size_t)b * SEQ + (pos - CTX)) * D;
}
__device__ __forceinline__ void modnorm_row(const float* xr, const float* nw, const float* sh, const float* sc, bf16_t* hrow, int lane) {
    f32x4 v[8]; float ss = 0.f;
#pragma unroll
    for (int i = 0; i < 8; ++i) { v[i] = *(const f32x4*)(xr + 4 * (lane + 64 * i)); ss += v[i][0] * v[i][0] + v[i][1] * v[i][1] + v[i][2] * v[i][2] + v[i][3] * v[i][3]; }
    ss = wave_sum(ss); const float rstd = __builtin_amdgcn_rsqf(ss * (1.0f / D) + EPS);
#pragma unroll
    for (int i = 0; i < 8; ++i) { const int c = 4 * (lane + 64 * i); const f32x4 w = *(const f32x4*)(nw + c), s1 = *(const f32x4*)(sc + c), s0 = *(const f32x4*)(sh + c);
        const f32x4 o = (v[i] * rstd * w * (1.0f + s1) + s0) * SC_H8; *(unsigned*)((unsigned char*)hrow + c) = pk4_fp8(o[0], o[1], o[2], o[3]); }
}

namespace pg8 {
constexpr int BM = 256, BK = 64, HALF = 128, HTB = HALF * BK * 2, STAGE_BYTES = 8 * HTB, NXCD = 8, WGM = 8;
__device__ __forceinline__ int lds_byte(int r, int c) { const int st = (r >> 4) * 2 + (c >> 5), rr = r & 15, cc = c & 31, ob = rr * 64 + cc * 2; return st * 1024 + (ob ^ (((ob >> 9) & 1) << 5)); }
__device__ __forceinline__ void stage_rc(int b, int& R, int& C) { const int st = b / 1024, sb = b % 1024, swz = sb ^ (((sb >> 9) & 1) << 5); R = (st >> 1) * 16 + swz / 64; C = (st & 1) * 32 + (swz % 64) / 2; }

struct UnitD {
    const char* A;
    const char* B;
    unsigned ao[2][2];
    int pm, pn, e, row0;
};

template <class Epi, class Sched>
__device__ __forceinline__ void gemm_phase(LAS unsigned char* lds, const int K, const Sched& S, const Epi& E) {
    const int tid = threadIdx.x, wid = __builtin_amdgcn_readfirstlane(tid >> 6), lane = tid & 63, wr = wid >> 2, wc = wid & 3, fr = lane & 15, fq = lane >> 4;
    const int nt = K / BK;
    unsigned voffB[2];
#pragma unroll
    for (int i = 0; i < 2; ++i) { int R, C; stage_rc(tid * 16 + i * 8192, R, C); voffB[i] = (unsigned)(R * K + C) * 2u; }
    const size_t kstep = (size_t)(BK * 2);
    const size_t hstep = (size_t)HALF * K * 2;
    const unsigned ldsw = (unsigned)wid * 1024u;
    const int aoff = lds_byte(wr * 64 + fr, fq * 8), boff = lds_byte(wc * 32 + fr, fq * 8);
#define PG8_SA(b, h) (((b) * 2 + (h)) * HTB)
#define PG8_SB(b, h) ((4 + (b) * 2 + (h)) * HTB)
#define PG8_STA(bufoff, U, h, kb) do { _Pragma("unroll") for (int _i = 0; _i < 2; ++_i) \
        __builtin_amdgcn_global_load_lds((const unsigned*)((U).A + (U).ao[h][_i] + (kb)), (LAS unsigned*)(lds + (bufoff) + ldsw + _i * 8192), 16, 0, 0); } while (0)
#define PG8_STB(bufoff, U, h, kb) do { _Pragma("unroll") for (int _i = 0; _i < 2; ++_i) \
        __builtin_amdgcn_global_load_lds((const unsigned*)((U).B + (h) * hstep + voffB[_i] + (kb)), (LAS unsigned*)(lds + (bufoff) + ldsw + _i * 8192), 16, 0, 0); } while (0)
#define PG8_LDA(dst, b, h) do { _Pragma("unroll") for (int m = 0; m < 4; ++m) _Pragma("unroll") for (int k = 0; k < 2; ++k) dst[m][k] = *(const LAS bf16x8*)(lds + PG8_SA(b, h) + aoff + m * 2048 + k * 1024); } while (0)
#define PG8_LDB(dst, b, h) do { _Pragma("unroll") for (int n = 0; n < 2; ++n) _Pragma("unroll") for (int k = 0; k < 2; ++k) dst[n][k] = *(const LAS bf16x8*)(lds + PG8_SB(b, h) + boff + n * 2048 + k * 1024); } while (0)
#define PG8_MMA(ai, bj, At, Bt) do { __builtin_amdgcn_s_setprio(1); _Pragma("unroll") for (int m = 0; m < 4; ++m) _Pragma("unroll") for (int n = 0; n < 2; ++n) _Pragma("unroll") for (int k = 0; k < 2; ++k) \
        acc[ai][bj][m][n] = __builtin_amdgcn_mfma_f32_16x16x32_bf16(Bt[n][k], At[m][k], acc[ai][bj][m][n], 0, 0, 0); __builtin_amdgcn_s_setprio(0); } while (0)
#define PG8_WAIT_V(n) asm volatile("s_waitcnt vmcnt(" #n ")" ::: "memory")
#define PG8_WAIT_L(n) asm volatile("s_waitcnt lgkmcnt(" #n ")" ::: "memory")
#define PG8_BAR __builtin_amdgcn_s_barrier()
#define PG8_SCHED __builtin_amdgcn_sched_barrier(0)
    UnitD cur, nxt; int ui = 0;
    if (!S.next(0, cur)) return;
    f32x4 acc[2][2][4][2];
#pragma unroll
    for (int a = 0; a < 2; ++a)
#pragma unroll
        for (int b = 0; b < 2; ++b)
#pragma unroll
            for (int m = 0; m < 4; ++m)
#pragma unroll
                for (int n = 0; n < 2; ++n) acc[a][b][m][n] = (f32x4){0.f, 0.f, 0.f, 0.f};
    bf16x8 At[4][2], B0[2][2], B1[2][2];
    PG8_STB(PG8_SB(0, 0), cur, 0, 0); PG8_STA(PG8_SA(0, 0), cur, 0, 0); PG8_STB(PG8_SB(0, 1), cur, 1, 0); PG8_STA(PG8_SA(0, 1), cur, 1, 0);
    if (wr == 1) PG8_BAR;
    PG8_WAIT_V(4); PG8_BAR;
    PG8_STB(PG8_SB(1, 0), cur, 0, kstep); PG8_STA(PG8_SA(1, 0), cur, 0, kstep); PG8_STB(PG8_SB(1, 1), cur, 1, kstep);
    PG8_WAIT_V(6); PG8_BAR;
    for (;;) {
        const bool has_next = S.next(ui + 1, nxt);
        if (!has_next) nxt = cur;
        for (int t = 0; t < nt; t += 2) {
            const bool last = (t == nt - 2);
            const size_t k1 = (size_t)(t + 1) * kstep;
            const size_t k2 = last ? (size_t)0 : (size_t)(t + 2) * kstep, k3 = k2 + kstep;
            UnitD w2; w2.A = cur.A; w2.B = last ? nxt.B : cur.B;
            w2.ao[0][0] = last ? nxt.ao[0][0] : cur.ao[0][0]; w2.ao[0][1] = last ? nxt.ao[0][1] : cur.ao[0][1];
            w2.ao[1][0] = last ? nxt.ao[1][0] : cur.ao[1][0]; w2.ao[1][1] = last ? nxt.ao[1][1] : cur.ao[1][1];
            PG8_LDB(B0, 0, 0); PG8_SCHED; PG8_LDA(At, 0, 0); PG8_STA(PG8_SA(1, 1), cur, 1, k1);
            PG8_WAIT_L(8); PG8_BAR; PG8_WAIT_L(0); PG8_MMA(0, 0, At, B0); PG8_BAR; PG8_SCHED;
            PG8_LDB(B1, 0, 1); PG8_STB(PG8_SB(0, 0), w2, 0, k2);
            PG8_BAR; PG8_WAIT_L(0); PG8_MMA(0, 1, At, B1); PG8_BAR;
            PG8_LDA(At, 0, 1); PG8_STA(PG8_SA(0, 0), w2, 0, k2);
            PG8_BAR; PG8_WAIT_L(0); PG8_MMA(1, 0, At, B0); PG8_BAR; PG8_SCHED;
            PG8_STB(PG8_SB(0, 1), w2, 1, k2);
            PG8_WAIT_V(6); PG8_BAR; PG8_MMA(1, 1, At, B1); PG8_BAR;
            PG8_LDB(B0, 1, 0); PG8_SCHED; PG8_LDA(At, 1, 0); PG8_STA(PG8_SA(0, 1), w2, 1, k2);
            PG8_WAIT_L(8); PG8_BAR; PG8_WAIT_L(0); PG8_MMA(0, 0, At, B0); PG8_BAR; PG8_SCHED;
            PG8_LDB(B1, 1, 1); PG8_STB(PG8_SB(1, 0), w2, 0, k3);
            PG8_BAR; PG8_WAIT_L(0); PG8_MMA(0, 1, At, B1); PG8_BAR;
            PG8_LDA(At, 1, 1); PG8_STA(PG8_SA(1, 0), w2, 0, k3);
            PG8_BAR; PG8_WAIT_L(0); PG8_MMA(1, 0, At, B0); PG8_BAR; PG8_SCHED;
            PG8_STB(PG8_SB(1, 1), w2, 1, k3);
            PG8_WAIT_V(6); PG8_BAR; PG8_MMA(1, 1, At, B1); PG8_BAR;
        }
        E(acc, cur, wr, wc, fr, fq);
        if (!has_next) break;
#pragma unroll
        for (int a = 0; a < 2; ++a)
#pragma unroll
            for (int b = 0; b < 2; ++b)
#pragma unroll
                for (int m = 0; m < 4; ++m)
#pragma unroll
                    for (int n = 0; n < 2; ++n) acc[a][b][m][n] = (f32x4){0.f, 0.f, 0.f, 0.f};
        cur = nxt; ++ui;
    }
    PG8_WAIT_V(0);
    if (wr == 0) PG8_BAR;
    PG8_BAR;
#undef PG8_SA
#undef PG8_SB
#undef PG8_STA
#undef PG8_STB
#undef PG8_LDA
#undef PG8_LDB
#undef PG8_MMA
#undef PG8_WAIT_V
#undef PG8_WAIT_L
#undef PG8_BAR
#undef PG8_SCHED
}

typedef int v8i __attribute__((ext_vector_type(8)));
typedef int v4i __attribute__((ext_vector_type(4)));
typedef v4i __attribute__((may_alias)) v4i_a;
template <class Epi, class Sched, bool FP8 = true>
__device__ __forceinline__ void gemm_phase8(LAS unsigned char* lds, const int K, const Sched& S, const Epi& E, int sclA = 127, int sclB = 127) {
    const int tid = threadIdx.x, wid = __builtin_amdgcn_readfirstlane(tid >> 6), lane = tid & 63, wr = wid >> 2, wc = wid & 3, fr = lane & 15, fq = lane >> 4;
    const int nt = K / BK;
    unsigned voffB[2];
#pragma unroll
    for (int i = 0; i < 2; ++i) { int R, C; stage_rc(tid * 16 + i * 8192, R, C); voffB[i] = (unsigned)(R * K + C) * 2u; }
    const size_t kstep = (size_t)(BK * 2);
    const size_t hstep = (size_t)HALF * K * 2;
    const unsigned ldsw = (unsigned)wid * 1024u;
    const int aoff = lds_byte(wr * 64 + fr, fq * 8), boff = lds_byte(wc * 32 + fr, fq * 8);
#define PG8_SA(b, h) (((b) * 2 + (h)) * HTB)
#define PG8_SB(b, h) ((4 + (b) * 2 + (h)) * HTB)
#define PG8_STA(bufoff, U, h, kb) do { _Pragma("unroll") for (int _i = 0; _i < 2; ++_i) \
        __builtin_amdgcn_global_load_lds((const unsigned*)((U).A + (U).ao[h][_i] + (kb)), (LAS unsigned*)(lds + (bufoff) + ldsw + _i * 8192), 16, 0, 0); } while (0)
#define PG8_STB(bufoff, U, h, kb) do { _Pragma("unroll") for (int _i = 0; _i < 2; ++_i) \
        __builtin_amdgcn_global_load_lds((const unsigned*)((U).B + (h) * hstep + voffB[_i] + (kb)), (LAS unsigned*)(lds + (bufoff) + ldsw + _i * 8192), 16, 0, 0); } while (0)
#define PG8_LDA(dst, b, h) do { _Pragma("unroll") for (int m = 0; m < 4; ++m) { dst[m].lo = *(const LAS v4i_a*)(lds + PG8_SA(b, h) + aoff + m * 2048); dst[m].hi = *(const LAS v4i_a*)(lds + PG8_SA(b, h) + aoff + m * 2048 + 1024); } } while (0)
#define PG8_LDB(dst, b, h) do { _Pragma("unroll") for (int n = 0; n < 2; ++n) { dst[n].lo = *(const LAS v4i_a*)(lds + PG8_SB(b, h) + boff + n * 2048); dst[n].hi = *(const LAS v4i_a*)(lds + PG8_SB(b, h) + boff + n * 2048 + 1024); } } while (0)
#define PG8_MMA(ai, bj, At, Bt) do { __builtin_amdgcn_s_setprio(1); _Pragma("unroll") for (int m = 0; m < 4; ++m) _Pragma("unroll") for (int n = 0; n < 2; ++n) { \
        if constexpr (FP8) asm volatile("v_mfma_scale_f32_16x16x128_f8f6f4 %0, %1, %2, %0, %3, %4 op_sel_hi:[0,0,0]" : "+v"(acc[ai][bj][m][n]) : "v"(Bt[n]), "v"(At[m]), "v"(vsclB), "v"(vsclA)); \
        else { acc[ai][bj][m][n] = __builtin_amdgcn_mfma_f32_16x16x32_bf16(__builtin_bit_cast(bf16x8, Bt[n].lo), __builtin_bit_cast(bf16x8, At[m].lo), acc[ai][bj][m][n], 0, 0, 0); \
               acc[ai][bj][m][n] = __builtin_amdgcn_mfma_f32_16x16x32_bf16(__builtin_bit_cast(bf16x8, Bt[n].hi), __builtin_bit_cast(bf16x8, At[m].hi), acc[ai][bj][m][n], 0, 0, 0); } } \
        __builtin_amdgcn_s_setprio(0); } while (0)
#define PG8_WAIT_V(n) asm volatile("s_waitcnt vmcnt(" #n ")" ::: "memory")
#define PG8_WAIT_L(n) asm volatile("s_waitcnt lgkmcnt(" #n ")" ::: "memory")
#define PG8_BAR __builtin_amdgcn_s_barrier()
#define PG8_SCHED __builtin_amdgcn_sched_barrier(0)
    int vsclA = sclA * 0x01010101, vsclB = sclB * 0x01010101;
    asm volatile("" : "+v"(vsclA), "+v"(vsclB));
    UnitD cur, nxt; int ui = 0;
    if (!S.next(0, cur)) return;
    f32x4 acc[2][2][4][2];
#pragma unroll
    for (int a = 0; a < 2; ++a)
#pragma unroll
        for (int b = 0; b < 2; ++b)
#pragma unroll
            for (int m = 0; m < 4; ++m)
#pragma unroll
                for (int n = 0; n < 2; ++n) acc[a][b][m][n] = (f32x4){0.f, 0.f, 0.f, 0.f};
    v8i At[4], B0[2], B1[2];
    PG8_STB(PG8_SB(0, 0), cur, 0, 0); PG8_STA(PG8_SA(0, 0), cur, 0, 0); PG8_STB(PG8_SB(0, 1), cur, 1, 0); PG8_STA(PG8_SA(0, 1), cur, 1, 0);
    if (wr == 1) PG8_BAR;
    PG8_WAIT_V(4); PG8_BAR;
    PG8_STB(PG8_SB(1, 0), cur, 0, kstep); PG8_STA(PG8_SA(1, 0), cur, 0, kstep); PG8_STB(PG8_SB(1, 1), cur, 1, kstep);
    PG8_WAIT_V(6); PG8_BAR;
    for (;;) {
        const bool has_next = S.next(ui + 1, nxt);
        if (!has_next) nxt = cur;
        for (int t = 0; t < nt; t += 2) {
            const bool last = (t == nt - 2);
            const size_t k1 = (size_t)(t + 1) * kstep;
            const size_t k2 = last ? (size_t)0 : (size_t)(t + 2) * kstep, k3 = k2 + kstep;
            UnitD w2; w2.A = cur.A; w2.B = last ? nxt.B : cur.B;
            w2.ao[0][0] = last ? nxt.ao[0][0] : cur.ao[0][0]; w2.ao[0][1] = last ? nxt.ao[0][1] : cur.ao[0][1];
            w2.ao[1][0] = last ? nxt.ao[1][0] : cur.ao[1][0]; w2.ao[1][1] = last ? nxt.ao[1][1] : cur.ao[1][1];
            PG8_LDB(B0, 0, 0); PG8_SCHED; PG8_LDA(At, 0, 0); PG8_STA(PG8_SA(1, 1), cur, 1, k1);
            PG8_WAIT_L(8); PG8_BAR; PG8_WAIT_L(0); PG8_MMA(0, 0, At, B0); PG8_BAR; PG8_SCHED;
            PG8_LDB(B1, 0, 1); PG8_STB(PG8_SB(0, 0), w2, 0, k2);
            PG8_BAR; PG8_WAIT_L(0); PG8_MMA(0, 1, At, B1); PG8_BAR;
            PG8_LDA(At, 0, 1); PG8_STA(PG8_SA(0, 0), w2, 0, k2);
            PG8_BAR; PG8_WAIT_L(0); PG8_MMA(1, 0, At, B0); PG8_BAR; PG8_SCHED;
            PG8_STB(PG8_SB(0, 1), w2, 1, k2);
            PG8_WAIT_V(6); PG8_BAR; PG8_MMA(1, 1, At, B1); PG8_BAR;
            PG8_LDB(B0, 1, 0); PG8_SCHED; PG8_LDA(At, 1, 0); PG8_STA(PG8_SA(0, 1), w2, 1, k2);
            PG8_WAIT_L(8); PG8_BAR; PG8_WAIT_L(0); PG8_MMA(0, 0, At, B0); PG8_BAR; PG8_SCHED;
            PG8_LDB(B1, 1, 1); PG8_STB(PG8_SB(1, 0), w2, 0, k3);
            PG8_BAR; PG8_WAIT_L(0); PG8_MMA(0, 1, At, B1); PG8_BAR;
            PG8_LDA(At, 1, 1); PG8_STA(PG8_SA(1, 0), w2, 0, k3);
            PG8_BAR; PG8_WAIT_L(0); PG8_MMA(1, 0, At, B0); PG8_BAR; PG8_SCHED;
            PG8_STB(PG8_SB(1, 1), w2, 1, k3);
            PG8_WAIT_V(6); PG8_BAR; PG8_MMA(1, 1, At, B1); PG8_BAR;
        }
        if constexpr (FP8) asm volatile("s_nop 15\n\ts_nop 15" ::: "memory");
        E(acc, cur, wr, wc, fr, fq);
        if (!has_next) break;
#pragma unroll
        for (int a = 0; a < 2; ++a)
#pragma unroll
            for (int b = 0; b < 2; ++b)
#pragma unroll
                for (int m = 0; m < 4; ++m)
#pragma unroll
                    for (int n = 0; n < 2; ++n) acc[a][b][m][n] = (f32x4){0.f, 0.f, 0.f, 0.f};
        cur = nxt; ++ui;
    }
    PG8_WAIT_V(0);
    if (wr == 0) PG8_BAR;
    PG8_BAR;
#undef PG8_SA
#undef PG8_SB
#undef PG8_STA
#undef PG8_STB
#undef PG8_LDA
#undef PG8_LDB
#undef PG8_MMA
#undef PG8_WAIT_V
#undef PG8_WAIT_L
#undef PG8_BAR
#undef PG8_SCHED
}

__device__ __forceinline__ void lin_offsets(UnitD& u, int row0, int K) {
#pragma unroll
    for (int i = 0; i < 2; ++i) { int R, C; stage_rc((int)threadIdx.x * 16 + i * 8192, R, C);
        u.ao[0][i] = (unsigned)(((size_t)(row0 + R) * K + C) * 2); u.ao[1][i] = (unsigned)(((size_t)(row0 + HALF + R) * K + C) * 2); }
}
}

using pg8::UnitD;
struct DenseSched {
    const char* A; const char* Bt; int nM, nN, K, G, c; bool skipctx = false;
    __device__ __forceinline__ bool next(int i, UnitD& u) const {
        const int nwg = nM * nN; const long L = (long)i * G + c; if (L >= nwg) return false;
        int wgid = (int)L; { const int q = nwg / 8, r = nwg % 8, xcd = wgid % 8, off = wgid / 8; wgid = (xcd < r ? xcd * (q + 1) : r * (q + 1) + (xcd - r) * q) + off; }
        const int nig = 8 * nN, gid = wgid / nig, fm = gid * 8, gsz = (nM - fm) < 8 ? (nM - fm) : 8;
        int pm = fm + ((wgid % nig) % gsz); const int pn = (wgid % nig) / gsz;
        if (skipctx) pm += 1 + (pm >= 32 ? 1 : 0);
        u.A = A; u.B = Bt + (size_t)pn * 256 * K * 2; pg8::lin_offsets(u, pm * 256, K); u.pm = pm; u.pn = pn; u.e = 0; u.row0 = pm * 256; return true;
    }
};
struct GroupSched {
    const char* A; const char* Bt; const int* list; const int* cnt; const LAS int* tileP; int NT, K, G, c; bool gather; size_t bstride;
    bool skipctx = false;
    __device__ __forceinline__ bool next(int i, UnitD& u) const {
        const int total = tileP[65] * NT; const long L = (long)i * G + c; if (L >= total) return false;
        const int tile = (int)(L / NT), tn = (int)(L % NT);
        int e = 0;
#pragma unroll
        for (int s = 64; s >= 1; s >>= 1) { if (e + s <= 64 && tileP[e + s] <= tile) e += s; }
        const int tm = tile - tileP[e];
        const int srt = skipctx ? tm + 1 + (tm >= 32 ? 1 : 0) : tm;
        u.A = A; u.B = Bt + (size_t)e * bstride + (size_t)tn * 256 * K * 2; u.pm = tm; u.pn = tn; u.e = e;
        if (gather) {
            const int ce = e == NEXP ? TALL : cnt[e]; const int* le = list + (size_t)e * TALL;
#pragma unroll
            for (int p = 0; p < 2; ++p) { int R, C; pg8::stage_rc((int)threadIdx.x * 16 + p * 8192, R, C);
#pragma unroll
                for (int h = 0; h < 2; ++h) { const int idx = tm * 256 + 128 * h + R; const int tok = e == NEXP ? srt * 256 + 128 * h + R : le[idx < ce ? idx : 0]; u.ao[h][p] = (unsigned)(((size_t)tok * K + C) * 2); } }
            u.row0 = 256 * tile;
        } else {
            pg8::lin_offsets(u, 256 * tile, K);
            u.row0 = e == NEXP ? srt * 256 : 256 * tile;
        }
        return true;
    }
};
__device__ __forceinline__ void build_tileP(const int* cnt, LAS int* tileP, int shared_tiles = TALL / 256) {
    if (threadIdx.x == 0) { int s = 0; for (int e = 0; e < NEXP; ++e) { tileP[e] = s; s += (cnt[e] + 255) >> 8; } tileP[64] = s; s += shared_tiles; tileP[65] = s; }
}

__device__ __forceinline__ void st_bf16x4(bf16_t* p, f32x4 v) { u32x2 w; w.x = pk2(v[0], v[1]); w.y = pk2(v[2], v[3]); *(u32x2*)p = w; }
__device__ __forceinline__ void st_bf16x8(bf16_t* p, f32x4 v0, f32x4 v1) { u32x4 w; w.x = pk2(v0[0], v0[1]); w.y = pk2(v0[2], v0[3]); w.z = pk2(v1[0], v1[1]); w.w = pk2(v1[2], v1[3]); *(u32x4*)p = w; }

constexpr float QSCALE = 0.125f * LOG2E;
struct EpiIn {
    bf16_t* P; const float *cosR, *sinR, *cosD, *sinD, *qw, *kw; unsigned char *Q8, *K8, *V8T;
    __device__ __forceinline__ void operator()(const f32x4 (&acc)[2][2][4][2], const UnitD& u, int wr, int wc, int fr, int fq) const {
        const int pn = u.pn, rbase = u.row0 + wr * 64 + fr;
        if (pn < 4) {
            const float scale = pn >= 2 ? 0.08838834764831845f : 1.0f; const int i0 = 16 * wc + 4 * fq;
#pragma unroll
            for (int ai = 0; ai < 2; ++ai)
#pragma unroll
                for (int m = 0; m < 4; ++m) { const int row = rbase + ai * 128 + m * 16, b = row / SEQU, pos = row - b * SEQU; const bool lat = pos >= CTX; const int t = lat ? pos - CTX : 0;
                    f32x4 c = {1.f, 1.f, 1.f, 1.f}, s = {0.f, 0.f, 0.f, 0.f};
                    if (lat) { c = *(const f32x4*)(cosR + (size_t)t * 64 + i0); s = *(const f32x4*)(sinR + (size_t)t * 64 + i0); }
                    c *= scale; s *= scale;
#pragma unroll
                    for (int bj = 0; bj < 2; ++bj) { const f32x4 x1 = acc[ai][bj][m][0], x2 = acc[ai][bj][m][1]; bf16_t* op = P + (size_t)row * LDP + 256 * pn + 128 * bj + i0;
                        st_bf16x4(op, x1 * c - x2 * s); st_bf16x4(op + 64, x1 * s + x2 * c); } }
        } else if (pn >= 8 && pn < 16) {
            const bool isq = pn < 12; const float* w = isq ? qw : kw; const int sh = 4 * (pn - (isq ? 8 : 12)) + wc;
            unsigned char* dst8 = Q8 + 64 * sh;
            const float os = isq ? QSCALE * SC_Q8 : SC_K8;
            f32x4 wv[2][2];
#pragma unroll
            for (int bj = 0; bj < 2; ++bj)
#pragma unroll
                for (int n = 0; n < 2; ++n) wv[bj][n] = *(const f32x4*)(w + 32 * bj + 8 * fq + 4 * n) * os;
#pragma unroll
            for (int ai = 0; ai < 2; ++ai)
#pragma unroll
                for (int m = 0; m < 4; ++m) { const int row = rbase + ai * 128 + m * 16, b = row / SEQU, pos = row - b * SEQU; const bool lat = pos >= CTX; const int t = lat ? pos - CTX : 0;
                    float ss = 0.f;
#pragma unroll
                    for (int bj = 0; bj < 2; ++bj)
#pragma unroll
                        for (int n = 0; n < 2; ++n) { const f32x4 v = acc[ai][bj][m][n]; ss += v[0] * v[0] + v[1] * v[1] + v[2] * v[2] + v[3] * v[3]; }
                    ss += __shfl_xor(ss, 16); ss += __shfl_xor(ss, 32);
                    const float rinv = __builtin_amdgcn_rsqf(ss * (1.0f / 64.0f) + EPS);
                    u32x2 w1, w2;
#pragma unroll
                    for (int n = 0; n < 2; ++n) { const int i0 = 8 * fq + 4 * n;
                        f32x4 c = {1.f, 1.f, 1.f, 1.f}, s = {0.f, 0.f, 0.f, 0.f};
                        if (lat) { c = *(const f32x4*)(cosD + (size_t)t * 32 + i0); s = *(const f32x4*)(sinD + (size_t)t * 32 + i0); }
                        const f32x4 x1 = acc[ai][0][m][n] * rinv * wv[0][n], x2 = acc[ai][1][m][n] * rinv * wv[1][n];
                        const f32x4 o1 = x1 * c - x2 * s, o2 = x1 * s + x2 * c;
                        const unsigned a1 = pk4_fp8(o1[0], o1[1], o1[2], o1[3]), a2 = pk4_fp8(o2[0], o2[1], o2[2], o2[3]);
                        if (n == 0) { w1.x = a1; w2.x = a2; } else { w1.y = a1; w2.y = a2; } }
                    unsigned char* op = isq ? dst8 + (size_t)row * 1024 + 8 * fq : K8 + ((((size_t)(b * 8 + (sh >> 1)) * SEQU + pos) << 7) + 64 * (sh & 1) + 8 * fq);
                    *(u32x2*)op = w1; *(u32x2*)(op + 32) = w2; }
        } else if (pn >= 16 && pn < 20) {
            const int lane = fr + 16 * fq, cq = lane & 3;
#pragma unroll
            for (int ai = 0; ai < 2; ++ai)
#pragma unroll
                for (int m = 0; m < 4; ++m) { const int row = rbase + ai * 128 + m * 16, b = row / SEQU, pos = row - b * SEQU, t = pos >> 6, kk4 = pos & 60;
                    const int off = 32 * ((kk4 >> 2) & 1) + 16 * (kk4 >> 5) + 4 * ((kk4 >> 3) & 3);
#pragma unroll
                    for (int bj = 0; bj < 2; ++bj) { const int head = 2 * (pn - 16) + bj;
#pragma unroll
                        for (int n = 0; n < 2; ++n) { const f32x4 v = acc[ai][bj][m][n] * SC_V8; const unsigned W = pk4_fp8(v[0], v[1], v[2], v[3]);
                            const unsigned w0 = __shfl(W, (lane & ~3) + 0), w1 = __shfl(W, (lane & ~3) + 1), w2 = __shfl(W, (lane & ~3) + 2), w3 = __shfl(W, (lane & ~3) + 3);
                            const unsigned sft = 8 * cq; const unsigned R = ((w0 >> sft) & 0xffu) | (((w1 >> sft) & 0xffu) << 8) | (((w2 >> sft) & 0xffu) << 16) | (((w3 >> sft) & 0xffu) << 24);
                            const int dv = 32 * wc + 8 * fq + 4 * n + cq;
                            *(unsigned*)(V8T + ((((size_t)(b * 8 + head) * (SEQU / 64) + t) * 128 + dv) << 6) + off) = R; } } }
        } else {
            const bool gate = (pn == 6 || pn == 7);
#pragma unroll
            for (int ai = 0; ai < 2; ++ai)
#pragma unroll
                for (int m = 0; m < 4; ++m) { const int row = rbase + ai * 128 + m * 16;
#pragma unroll
                    for (int bj = 0; bj < 2; ++bj) { f32x4 v0 = acc[ai][bj][m][0], v1 = acc[ai][bj][m][1];
                        if (gate) {
#pragma unroll
                            for (int j = 0; j < 4; ++j) { v0[j] = siluf_(v0[j]); v1[j] = siluf_(v1[j]); } }
                        st_bf16x8(P + (size_t)row * LDP + 256 * pn + 128 * bj + 32 * wc + 8 * fq, v0, v1); } }
        }
    }
};
struct EpiRes {
    const float *xlat, *xctx; bf16_t* X; const float* gate;
    __device__ __forceinline__ void operator()(const f32x4 (&acc)[2][2][4][2], const UnitD& u, int wr, int wc, int fr, int fq) const {
        const int mi = mod_index(u.row0); const float* g = gate + (size_t)mi * MODW;
#pragma unroll
        for (int ai = 0; ai < 2; ++ai)
#pragma unroll
            for (int m = 0; m < 4; ++m) { const int row = u.row0 + ai * 128 + wr * 64 + m * 16 + fr; const float* sp = xlat ? in_row(xlat, xctx, row) : nullptr; bf16_t* dp = X + (size_t)row * D;
#pragma unroll
                for (int bj = 0; bj < 2; ++bj) { const int col = 256 * u.pn + 64 * wc + 16 * fq + 8 * bj;
                    f32x4 s0, s1;
                    if (sp) { s0 = *(const f32x4*)(sp + col); s1 = *(const f32x4*)(sp + col + 4); }
                    else { const u32x4 w = *(const u32x4*)(dp + col); s0[0] = bflo(w.x); s0[1] = bfhi(w.x); s0[2] = bflo(w.y); s0[3] = bfhi(w.y); s1[0] = bflo(w.z); s1[1] = bfhi(w.z); s1[2] = bflo(w.w); s1[3] = bfhi(w.w); }
                    const f32x4 o0 = s0 + *(const f32x4*)(g + col) * acc[ai][bj][m][0], o1 = s1 + *(const f32x4*)(g + col + 4) * acc[ai][bj][m][1];
                    u32x4 ow; ow.x = pk2(o0[0], o0[1]); ow.y = pk2(o0[2], o0[3]); ow.z = pk2(o1[0], o1[1]); ow.w = pk2(o1[2], o1[3]); *(u32x4*)(dp + col) = ow; } }
    }
};
struct EpiGU {
    unsigned char* HID;
    __device__ __forceinline__ void operator()(const f32x4 (&acc)[2][2][4][2], const UnitD& u, int wr, int wc, int fr, int fq) const {
#pragma unroll
        for (int ai = 0; ai < 2; ++ai)
#pragma unroll
            for (int m = 0; m < 4; ++m) { const int row = u.row0 + ai * 128 + wr * 64 + m * 16 + fr; f32x4 h[2];
#pragma unroll
                for (int n = 0; n < 2; ++n)
#pragma unroll
                    for (int j = 0; j < 4; ++j) h[n][j] = siluf_(acc[ai][0][m][n][j]) * acc[ai][1][m][n][j] * SC_HID;
                u32x2 w; w.x = pk4_fp8(h[0][0], h[0][1], h[0][2], h[0][3]); w.y = pk4_fp8(h[1][0], h[1][1], h[1][2], h[1][3]);
                *(u32x2*)(HID + (size_t)row * FF + 128 * u.pn + 32 * wc + 8 * fq) = w; }
    }
};
struct EpiDown {
    unsigned char* Y; bf16_t* X; const float* gate;
    __device__ __forceinline__ void operator()(const f32x4 (&acc)[2][2][4][2], const UnitD& u, int wr, int wc, int fr, int fq) const {
        if (u.e == NEXP) {
            if (!X) return;
            const int mi = mod_index(u.row0); const float* g = gate + (size_t)mi * MODW;
#pragma unroll
            for (int ai = 0; ai < 2; ++ai)
#pragma unroll
                for (int m = 0; m < 4; ++m) { bf16_t* dp = X + (size_t)(u.row0 + ai * 128 + wr * 64 + m * 16 + fr) * D;
#pragma unroll
                    for (int bj = 0; bj < 2; ++bj)
#pragma unroll
                        for (int n = 0; n < 2; ++n) { const int col = 256 * u.pn + 64 * wc + 16 * fq + 8 * bj + 4 * n;
                            st_bf16x4(dp + col, ld_bf16x4(dp + col) + *(const f32x4*)(g + col) * acc[ai][bj][m][n]); } }
        } else {
            if (!Y) { asm volatile("" :: "v"(acc[0][0][0][0][0]), "v"(acc[1][1][3][1][3])); return; }
#pragma unroll
            for (int ai = 0; ai < 2; ++ai)
#pragma unroll
                for (int m = 0; m < 4; ++m) { unsigned char* yp = Y + (size_t)(u.row0 + ai * 128 + wr * 64 + m * 16 + fr) * D + 256 * u.pn + 64 * wc + 16 * fq;
                    const f32x4 v0 = acc[ai][0][m][0] * SC_Y, v1 = acc[ai][0][m][1] * SC_Y, v2 = acc[ai][1][m][0] * SC_Y, v3 = acc[ai][1][m][1] * SC_Y; u32x4 w;
                    w.x = pk4_fp8(v0[0], v0[1], v0[2], v0[3]); w.y = pk4_fp8(v1[0], v1[1], v1[2], v1[3]); w.z = pk4_fp8(v2[0], v2[1], v2[2], v2[3]); w.w = pk4_fp8(v3[0], v3[1], v3[2], v3[3]);
                    *(u32x4*)yp = w; }
        }
    }
};

typedef bf16x8 __attribute__((may_alias)) bf16x8_a;
__device__ __forceinline__ f32x16 mfma32(bf16x8 a, bf16x8 b, f32x16 c) { return __builtin_amdgcn_mfma_f32_32x32x16_bf16(a, b, c, 0, 0, 0); }
__device__ __forceinline__ bf16x8 ld_tr2(const LAS unsigned char* p0, const LAS unsigned char* p1) {
    const s16x4 a = __builtin_amdgcn_ds_read_tr16_b64_v4i16((LAS s16x4*)p0), b = __builtin_amdgcn_ds_read_tr16_b64_v4i16((LAS s16x4*)p1);
    bf16x8 r; r[0] = a[0]; r[1] = a[1]; r[2] = a[2]; r[3] = a[3]; r[4] = b[0]; r[5] = b[1]; r[6] = b[2]; r[7] = b[3]; return r;
}
__device__ __forceinline__ unsigned tr_addr(unsigned lane, unsigned rowbase, unsigned cb) {
    const unsigned blk = (lane >> 4) & 1, q = (lane & 15) >> 2, p = lane & 3; return off_b(rowbase + q, 4 * cb + 2 * blk + (p >> 1)) + 8 * (p & 1);
}
__device__ __forceinline__ bf16x8 pack8(const f32x16& v, int s) {
    u32x4 w; w.x = pk2(v[8 * s + 0], v[8 * s + 1]); w.y = pk2(v[8 * s + 2], v[8 * s + 3]); w.z = pk2(v[8 * s + 4], v[8 * s + 5]); w.w = pk2(v[8 * s + 6], v[8 * s + 7]);
    return __builtin_bit_cast(bf16x8, w);
}
__device__ __forceinline__ void stage_offb(LAS unsigned char* img, const bf16_t* g, int ldg, int rows, int tid) {
    const int wid = __builtin_amdgcn_readfirstlane(tid >> 6);
    for (int r0 = 0; r0 < rows; r0 += 32) { const unsigned p = (unsigned)(r0 * 16 + tid), row = p >> 4, chs = p & 15, ch = chs ^ offb_key(row);
        __builtin_amdgcn_global_load_lds((const unsigned*)(g + (size_t)row * ldg + 8 * ch), (LAS unsigned*)(img + r0 * 256 + wid * 1024), 16, 0, 0); }
}
typedef int v8i_t __attribute__((ext_vector_type(8)));
typedef int v4i_t __attribute__((ext_vector_type(4)));
typedef v4i_t __attribute__((may_alias)) v4i_ta;
constexpr int ATT_STG = 8192, ATT_VOF = 65536;
__device__ __forceinline__ void attn_unit(LAS unsigned char* lds, const Args& A, bf16_t* MIX, int qrow0, int b, int nkeys, int head, float lam, float sbl2, const float* subw, float outscale, const int probe = 0) {
    const int tid = threadIdx.x, wid = __builtin_amdgcn_readfirstlane(tid >> 6), lane = tid & 63, br = wid >> 2, qq = wid & 3, l31 = lane & 31, hh = lane >> 5;
    const int qrow = qrow0 + 32 * qq + l31;
    const unsigned char* q8 = A.ws + WS_Q8 + (size_t)qrow * 1024 + head * 128 + br * 64 + 32 * hh;
    v8i_t Qf; Qf.lo = *(const v4i_t*)q8; Qf.hi = *(const v4i_t*)(q8 + 16);
    f32x16 O[4]; const float oz = opaque_zero();
#pragma unroll
    for (int i = 0; i < 4; ++i)
#pragma unroll
        for (int j = 0; j < 16; ++j) O[i][j] = oz;
    const float c565 = opaque_zero() + 56.5f; f32x16 CB; f32x4 Ol;
#pragma unroll
    for (int j = 0; j < 16; ++j) CB[j] = c565;
#pragma unroll
    for (int j = 0; j < 4; ++j) Ol[j] = oz;
    v8i_t Aones;
#pragma unroll
    for (int i = 0; i < 8; ++i) Aones[i] = (lane & 15) == ((lane >> 4) & 1) ? 0x50505050 : 0;
    const int ntile = nkeys / 64;
    const unsigned ksw = (l31 >> 1) & 7, vsw = (l31 >> 2) & 7;
    const unsigned ka0 = l31 * 128 + 16 * ((4 * br + 2 * hh) ^ ksw), ka1 = l31 * 128 + 16 * ((4 * br + 2 * hh + 1) ^ ksw);
    unsigned va0 = ATT_VOF + (l31 >> 1) * 128 + 16 * ((4 * (l31 & 1) + 2 * hh) ^ vsw), va1 = ATT_VOF + (l31 >> 1) * 128 + 16 * ((4 * (l31 & 1) + 2 * hh + 1) ^ vsw);
    asm volatile("" : "+v"(va0), "+v"(va1));
    const int sP = 127 * 0x01010101, sK = sP, sV = sP, sQ = (E8_Q8 + 3 + E8_K8 - 127) * 0x01010101;
    __syncthreads();
    const unsigned ksrc = (unsigned)((tid >> 3) * 128 + 16 * ((tid & 7) ^ ((tid >> 4) & 7)));
    const unsigned char* kgb = A.ws + WS_K8 + ((size_t)(b * 8 + head) * SEQU << 7);
    const unsigned char* vgb = A.ws + WS_V8T + ((size_t)(b * 8 + head) * (SEQU / 64) << 13);
    const unsigned dmaw = (unsigned)(size_t)(lds + wid * 1024);
#define ATT_DMA(gbase, voff, la) do { unsigned m0s_; asm volatile("s_mov_b32 %0, m0\n\ts_mov_b32 m0, %1\n\ts_nop 0\n\tglobal_load_lds_dwordx4 %2, %3\n\ts_mov_b32 m0, %0\n\ts_nop 0" : "=&s"(m0s_) : "s"(la), "v"(voff), "s"(gbase) : "memory"); } while (0)
#define ATT_DMAK(stg, t_) ATT_DMA(kgb + (size_t)min((t_), ntile - 1) * 8192, ksrc, dmaw + (unsigned)(stg))
#define ATT_DMAV(stg, t_) ATT_DMA(vgb + (size_t)min((t_), ntile - 1) * 8192, ksrc, dmaw + (unsigned)((stg) + ATT_VOF))
#define ATT_WAITV(n) asm volatile("s_waitcnt vmcnt(" #n ")" ::: "memory")
    ATT_DMAK(3 * ATT_STG, 0);
    ATT_DMAK(7 * ATT_STG, 1);
    ATT_DMAK(0, 2); ATT_DMAV(0, 0);
    ATT_DMAK(ATT_STG, 3); ATT_DMAV(ATT_STG, 1);
    ATT_DMAK(2 * ATT_STG, 4); ATT_DMAV(2 * ATT_STG, 2);
    { u32x4 z; z.x = 0; z.y = 0; z.z = 0; z.w = 0; *(LAS u32x4*)(lds + 7 * ATT_STG + ATT_VOF + 16 * tid) = z; }
    ATT_WAITV(0);
    __syncthreads();
    f32x16 Sa, Sb; v8i_t FA, FB, FC, FD;
    { v8i_t Kf; Kf.lo = *(const LAS v4i_ta*)(lds + 3 * ATT_STG + ka0); Kf.hi = *(const LAS v4i_ta*)(lds + 3 * ATT_STG + ka1);
      Sa = __builtin_amdgcn_mfma_scale_f32_32x32x64_f8f6f4(Kf, Qf, CB, 0, 0, 0, sK, 0, sQ);
      Kf.lo = *(const LAS v4i_ta*)(lds + 3 * ATT_STG + 4096 + ka0); Kf.hi = *(const LAS v4i_ta*)(lds + 3 * ATT_STG + 4096 + ka1);
      Sb = __builtin_amdgcn_mfma_scale_f32_32x32x64_f8f6f4(Kf, Qf, CB, 0, 0, 0, sK, 0, sQ);
      FA.lo = *(const LAS v4i_ta*)(lds + 7 * ATT_STG + va0); FA.hi = *(const LAS v4i_ta*)(lds + 7 * ATT_STG + va1);
      FB.lo = *(const LAS v4i_ta*)(lds + 7 * ATT_STG + 2048 + va0); FB.hi = *(const LAS v4i_ta*)(lds + 7 * ATT_STG + 2048 + va1); }
    v8i_t PfP;
#pragma unroll
    for (int i = 0; i < 8; ++i) PfP[i] = 0;
    __syncthreads();
#define ATT_PACK(S, r0, dst) if (probe & 2) { asm volatile("" :: "v"(S[(r0)]), "v"(S[(r0) + 3])); dst = PfP[0] + (r0); } else { unsigned w = 0; _Pragma("unroll") for (int c = 0; c < 4; ++c) w = __builtin_amdgcn_cvt_pk_u8_f32(__builtin_amdgcn_fmed3f(S[(r0) + c], 0.0f, hi), c, w); dst = (int)w; }
#define ATT_LDV(dst, base, dvb) if (probe & 4) { dst = Qf; } else { dst.lo = *(const LAS v4i_ta*)(base + (dvb) * 2048 + va0); dst.hi = *(const LAS v4i_ta*)(base + (dvb) * 2048 + va1); }
#define ATT_LDK(dst, kb) if (probe & 4) { dst = Qf; } else { dst.lo = *(const LAS v4i_ta*)(rd + (kb) * 4096 + ka0); dst.hi = *(const LAS v4i_ta*)(rd + (kb) * 4096 + ka1); }
#define ATT_MFMA(D, A_, B_, C_, sa, sb) if (probe & 32) { asm volatile("" :: "v"(A_)); D = __builtin_amdgcn_mfma_scale_f32_32x32x64_f8f6f4(Qf, B_, C_, 0, 0, 0, sa, 0, sb); asm volatile("" : "+v"(D)); } else if (!(probe & 1)) { D = __builtin_amdgcn_mfma_scale_f32_32x32x64_f8f6f4(A_, B_, C_, 0, 0, 0, sa, 0, sb); asm volatile("" : "+v"(D)); } else { asm volatile("" :: "v"(A_), "v"(B_)); }
#define ATT_SB __builtin_amdgcn_sched_barrier(0)
#define ATT_INTERVAL(I, F0, F1, F2, F3, BAR) { \
        LAS unsigned char* rd = lds + (((I) + 7) & 7) * ATT_STG; LAS unsigned char* pf = lds + ((I) & 7) * ATT_STG; \
        const float hi = __builtin_bit_cast(float, __builtin_amdgcn_readfirstlane((I) < ntile ? 0x42fc0000 : 0));     \
        v8i_t PfN; \
        ATT_SB; \
        ATT_LDK(F2, 0); \
        if (!(probe & 1)) { Ol = __builtin_amdgcn_mfma_scale_f32_16x16x128_f8f6f4(Aones, PfP, Ol, 0, 0, 0, sV, 0, sP); asm volatile("" : "+v"(Ol)); } else { asm volatile("" :: "v"(Aones), "v"(PfP)); } \
        ATT_PACK(Sa, 0, PfN[0]); ATT_PACK(Sa, 4, PfN[1]); \
        ATT_SB; \
        ATT_LDV(F3, rd, 2); \
        ATT_MFMA(O[0], F0, PfP, O[0], sV, sP); \
        ATT_PACK(Sa, 8, PfN[2]); ATT_PACK(Sa, 12, PfN[3]); \
        ATT_SB; \
        ATT_MFMA(O[1], F1, PfP, O[1], sV, sP); \
        if (!(probe & 8)) ATT_DMAK((((I) + 3) & 7) * ATT_STG, (I) + 5);     \
        ATT_LDK(F0, 1); \
        ATT_PACK(Sb, 0, PfN[4]); ATT_PACK(Sb, 4, PfN[5]); \
        ATT_SB; \
        ATT_MFMA(Sa, F2, Qf, CB, sK, sQ); \
        ATT_LDV(F1, rd, 3); \
        ATT_PACK(Sb, 8, PfN[6]); ATT_PACK(Sb, 12, PfN[7]); \
        ATT_SB; \
        ATT_MFMA(O[2], F3, PfP, O[2], sV, sP); \
        if (!(probe & 8)) ATT_DMAV((((I) + 3) & 7) * ATT_STG, (I) + 3); \
        ATT_LDV(F2, pf, 0); \
        ATT_SB; \
        ATT_MFMA(Sb, F0, Qf, CB, sK, sQ); \
        ATT_LDV(F3, pf, 1); \
        ATT_SB; \
        ATT_MFMA(O[3], F1, PfP, O[3], sV, sP); \
        ATT_SB; \
        PfP = PfN; \
        if (BAR) { asm volatile("s_waitcnt vmcnt(2) lgkmcnt(4)" ::: "memory");     \
            if (!(probe & 16)) { __builtin_amdgcn_s_barrier(); asm volatile("" ::: "memory"); } } \
        else asm volatile("" ::: "memory");     }
#pragma unroll 1
    for (int i = 0; i <= ntile; i += 8) {
        ATT_INTERVAL(i, FA, FB, FC, FD, 0);
        ATT_INTERVAL(i + 1, FC, FD, FA, FB, 1);
        ATT_INTERVAL(i + 2, FA, FB, FC, FD, 0);
        ATT_INTERVAL(i + 3, FC, FD, FA, FB, 1);
        ATT_INTERVAL(i + 4, FA, FB, FC, FD, 0);
        ATT_INTERVAL(i + 5, FC, FD, FA, FB, 1);
        ATT_INTERVAL(i + 6, FA, FB, FC, FD, 0);
        ATT_INTERVAL(i + 7, FC, FD, FA, FB, 1);
    }
    ATT_WAITV(0);
#undef ATT_INTERVAL
#undef ATT_MFMA
#undef ATT_DMAK
#undef ATT_DMAV
#undef ATT_WAITV
#undef ATT_PACK
#undef ATT_LDV
#undef ATT_LDK
#undef ATT_SB
    if (probe) { _Pragma("unroll") for (int i = 0; i < 4; ++i) asm volatile("" :: "v"(O[i])); asm volatile("" :: "v"(Ol), "v"(Sa), "v"(Sb), "v"(PfP), "v"(FA), "v"(FB)); __syncthreads(); return; }
    const float ls0 = __shfl(Ol[0], lane & 15), ls1 = __shfl(Ol[1], lane & 15); const float lsum = (lane & 16) ? ls1 : ls0;
    const float inv = fast_rcp(lsum);
    __syncthreads();
    LAS float* ex = (LAS float*)lds + qq * 4096;
    if (br == 1) { const float f = lam * inv;
#pragma unroll
        for (int dvb = 0; dvb < 4; ++dvb)
#pragma unroll
            for (int j = 0; j < 16; ++j) ex[(dvb * 16 + j) * 64 + lane] = O[dvb][j] * f; }
    __syncthreads();
    if (br == 0) { float ss = 0.f;
#pragma unroll
        for (int dvb = 0; dvb < 4; ++dvb)
#pragma unroll
            for (int j = 0; j < 16; ++j) {
#ifdef ATT_NOEX
                const float v = O[dvb][j] * inv;
#else
                const float v = O[dvb][j] * inv - ex[(dvb * 16 + j) * 64 + lane];
#endif
                O[dvb][j] = v; ss += v * v; }
        ss += __shfl_xor(ss, 32);
        const float rinv = __builtin_amdgcn_rsqf(ss * (1.0f / 128.0f) + EPS) * outscale;
        LAS unsigned char* ot = lds + 65536 + qq * 8704;
#pragma unroll
        for (int dvb = 0; dvb < 4; ++dvb)
#pragma unroll
            for (int a = 0; a < 4; ++a) { const int dv = 32 * dvb + 8 * a + 4 * hh; const f32x4 w = *(const f32x4*)(subw + dv);
                u32x2 o; o.x = pk2(O[dvb][4 * a] * rinv * w[0], O[dvb][4 * a + 1] * rinv * w[1]); o.y = pk2(O[dvb][4 * a + 2] * rinv * w[2], O[dvb][4 * a + 3] * rinv * w[3]);
                *(LAS u32x2*)(ot + l31 * 272 + 2 * dv) = o; }
        unsigned char* op = (unsigned char*)MIX + (size_t)(qrow0 + 32 * qq) * D + 512 + head * 128 + 8 * (lane & 15);
#pragma unroll
        for (int i = 0; i < 8; ++i) { const int r = 4 * i + (lane >> 4); const u32x4 v = *(const LAS u32x4*)(ot + r * 272 + 16 * (lane & 15)); u32x2 o;
            o.x = pk4_fp8(bflo(v.x) * SC_MIX, bfhi(v.x) * SC_MIX, bflo(v.y) * SC_MIX, bfhi(v.y) * SC_MIX); o.y = pk4_fp8(bflo(v.z) * SC_MIX, bfhi(v.z) * SC_MIX, bflo(v.w) * SC_MIX, bfhi(v.w) * SC_MIX);
            *(u32x2*)(op + (size_t)r * D) = o; } }
    __syncthreads();
}

__device__ __forceinline__ float log2_gamma(float logit) { return -__builtin_log2f(1.0f + fast_exp2(-logit * LOG2E)); }
__device__ __forceinline__ bf16x8 scale8(bf16x8 v, const float (&f)[8]) {
    const u32x4 w = __builtin_bit_cast(u32x4, v); u32x4 o;
    o.x = pk2(bflo(w.x) * f[0], bfhi(w.x) * f[1]); o.y = pk2(bflo(w.y) * f[2], bfhi(w.y) * f[3]); o.z = pk2(bflo(w.z) * f[4], bfhi(w.z) * f[5]); o.w = pk2(bflo(w.w) * f[6], bfhi(w.w) * f[7]);
    return __builtin_bit_cast(bf16x8, o);
}
__device__ __forceinline__ bf16x8 scale8s(bf16x8 v, float f) {
    const u32x4 w = __builtin_bit_cast(u32x4, v); u32x4 o;
    o.x = pk2(bflo(w.x) * f, bfhi(w.x) * f); o.y = pk2(bflo(w.y) * f, bfhi(w.y) * f); o.z = pk2(bflo(w.z) * f, bfhi(w.z) * f); o.w = pk2(bflo(w.w) * f, bfhi(w.w) * f);
    return __builtin_bit_cast(bf16x8, o);
}
__device__ __forceinline__ void ret_kv_unit(LAS unsigned char* lds, const bf16_t* P, bf16_t* KVT, const float* decay_logit  , int b, int j, int head) {
    const int tid = threadIdx.x, wid = __builtin_amdgcn_readfirstlane(tid >> 6), lane = tid & 63, eb = wid & 3, dir = wid >> 2, l31 = lane & 31, hh = lane >> 5;
    const int rbase = b * SEQU + 128 * j;
    LAS unsigned char* vimg = lds; LAS unsigned char* kimg = lds + 32768;
    __syncthreads();
    stage_offb(vimg, P + (size_t)rbase * LDP + OFF_RV + head * 128, LDP, 128, tid);
    stage_offb(kimg, P + (size_t)rbase * LDP + OFF_RK + head * 128, LDP, 128, tid);
    const float l2g = log2_gamma(decay_logit[dir * 4 + head]);
    asm volatile("s_waitcnt vmcnt(0)" ::: "memory"); __syncthreads();
    f32x16 acc[4];
#pragma unroll
    for (int i = 0; i < 4; ++i)
#pragma unroll
        for (int q = 0; q < 16; ++q) acc[i][q] = 0.f;
#pragma unroll 2
    for (int ks = 0; ks < 8; ++ks) {
        const unsigned rb = 16 * ks + 8 * hh;
        bf16x8 vf = ld_tr2(vimg + tr_addr(lane, rb, eb), vimg + tr_addr(lane, rb + 4, eb));
        float f[8];
#pragma unroll
        for (int q = 0; q < 8; ++q) { const int i = (int)rb + q; f[q] = fast_exp2(l2g * (float)(dir == 0 ? 127 - i : i)); }
        vf = scale8(vf, f);
#pragma unroll
        for (int db = 0; db < 4; ++db) { const bf16x8 kf = ld_tr2(kimg + tr_addr(lane, rb, db), kimg + tr_addr(lane, rb + 4, db)); acc[db] = mfma32(vf, kf, acc[db]); }
    }
    bf16_t* out = KVT + ((((size_t)(b * 4 + head) * 2 + dir) * NCH128 + j) << 14);
#pragma unroll
    for (int db = 0; db < 4; ++db)
#pragma unroll
        for (int q = 0; q < 16; ++q) { const int e = 32 * eb + (q & 3) + 8 * (q >> 2) + 4 * hh; const float v = acc[db][q], vn = __shfl_xor(v, 1);
            if ((lane & 1) == 0) *(unsigned*)(out + e * 128 + 32 * db + l31) = pk2(v, vn); }
    __syncthreads();
}
__device__ __forceinline__ void ret_state_phase(const bf16_t* KVT, bf16_t* ST, const float* decay_logit, int gtid, int gn) {
    for (int id = gtid; id < 16 * 8192; id += gn) {
        const int seq = id >> 13, el = (id & 8191) * 2, dir = seq & 1, head = (seq >> 1) & 3;
        const float G = fast_exp2(128.0f * log2_gamma(decay_logit[dir * 4 + head]));
        const bf16_t* kv = KVT + ((size_t)seq * NCH128 << 14) + el; bf16_t* st = ST + ((size_t)seq * NCH128 << 14) + el;
        float s0 = 0.f, s1 = 0.f;
        for (int sb = 0; sb < NCH128; sb += 11) {
            unsigned kk[11]; int jj[11];
#pragma unroll
            for (int q = 0; q < 11; ++q) { const int s = sb + q; jj[q] = dir == 0 ? s : (s == 0 ? 1 : s == 1 ? 0 : 67 - s); kk[q] = *(const unsigned*)(kv + ((size_t)jj[q] << 14)); }
#pragma unroll
            for (int q = 0; q < 11; ++q) { *(unsigned*)(st + ((size_t)jj[q] << 14)) = pk2(s0, s1); s0 = s0 * G + bflo(kk[q]); s1 = s1 * G + bfhi(kk[q]); }
        }
    }
}
__device__ __forceinline__ void ret_out_unit(LAS unsigned char* lds, const bf16_t* P, const bf16_t* ST, bf16_t* MIX, const float* decay_logit, const float* normw, int b, int j, int hp) {
    const int tid = threadIdx.x, wid = __builtin_amdgcn_readfirstlane(tid >> 6), lane = tid & 63, hsel = wid >> 2, qq = wid & 3, l31 = lane & 31, hh = lane >> 5;
    const int head = 2 * hp + hsel, rbase = b * SEQU + 128 * j, qi = 32 * qq + l31, qrow = rbase + qi;
    LAS unsigned char* vimg = lds + hsel * 32768; LAS unsigned char* kimg = lds + 65536 + hsel * 32768;
    __syncthreads();
    stage_offb(lds, P + (size_t)rbase * LDP + OFF_RV + (2 * hp) * 128, LDP, 128, tid);
    stage_offb(lds + 32768, P + (size_t)rbase * LDP + OFF_RV + (2 * hp + 1) * 128, LDP, 128, tid);
    stage_offb(lds + 65536, P + (size_t)rbase * LDP + OFF_RK + (2 * hp) * 128, LDP, 128, tid);
    stage_offb(lds + 98304, P + (size_t)rbase * LDP + OFF_RK + (2 * hp + 1) * 128, LDP, 128, tid);
    const float l2f = log2_gamma(decay_logit[head]), l2b = log2_gamma(decay_logit[4 + head]);
    bf16x8 Qf[8];
#pragma unroll
    for (int ks = 0; ks < 8; ++ks) Qf[ks] = *(const bf16x8*)(P + (size_t)qrow * LDP + OFF_RQ + head * 128 + 16 * ks + 8 * hh);
    f32x16 O[4];
#pragma unroll
    for (int i = 0; i < 4; ++i)
#pragma unroll
        for (int q = 0; q < 16; ++q) O[i][q] = 0.f;
    asm volatile("s_waitcnt vmcnt(0)" ::: "memory"); __syncthreads();
    for (int kb = 0; kb < 4; ++kb) {
        f32x16 S; const float z0 = opaque_zero();
#pragma unroll
        for (int q = 0; q < 16; ++q) S[q] = z0;
#pragma unroll
        for (int ks = 0; ks < 8; ++ks) { const bf16x8 kf = *(const LAS bf16x8_a*)(kimg + off_b(32 * kb + l31, 2 * ks + hh)); S = mfma32(kf, Qf[ks], S); }
#pragma unroll
        for (int q = 0; q < 16; ++q) { const int ik = 32 * kb + (q & 3) + 8 * (q >> 2) + 4 * hh, dlt = qi - ik;
            const float m = (dlt >= 0 ? fast_exp2(l2f * (float)dlt) : 0.f) + (dlt <= 0 ? fast_exp2(l2b * (float)(-dlt)) : 0.f); S[q] *= m; }
#pragma unroll
        for (int s = 0; s < 2; ++s) { const bf16x8 pf = pack8(S, s); const unsigned rb = 32 * kb + 16 * s + 4 * hh;
#pragma unroll
            for (int eb = 0; eb < 4; ++eb) { const bf16x8 vf = ld_tr2(vimg + tr_addr(lane, rb, eb), vimg + tr_addr(lane, rb + 8, eb)); O[eb] = mfma32(vf, pf, O[eb]); } }
    }
    __syncthreads();
#pragma unroll
    for (int t = 0; t < 4; ++t) stage_offb(lds + t * 32768, ST + ((((size_t)(b * 4 + 2 * hp + (t >> 1)) * 2 + (t & 1)) * NCH128 + j) << 14), 128, 128, tid);
    asm volatile("s_waitcnt vmcnt(0)" ::: "memory"); __syncthreads();
#pragma unroll
    for (int dir = 0; dir < 2; ++dir) {
        const float qd = dir == 0 ? fast_exp2(l2f * (float)(qi + 1)) : fast_exp2(l2b * (float)(128 - qi));
        const LAS unsigned char* simg = lds + (hsel * 2 + dir) * 32768;
#pragma unroll
        for (int ks = 0; ks < 8; ++ks) { const bf16x8 qs = scale8s(Qf[ks], qd);
#pragma unroll
            for (int eb = 0; eb < 4; ++eb) { const bf16x8 sf = *(const LAS bf16x8_a*)(simg + off_b(32 * eb + l31, 2 * ks + hh)); O[eb] = mfma32(sf, qs, O[eb]); } }
    }
    float sm = 0.f;
#pragma unroll
    for (int eb = 0; eb < 4; ++eb)
#pragma unroll
        for (int q = 0; q < 16; ++q) sm += O[eb][q];
    sm += __shfl_xor(sm, 32); const float mu = sm * (1.0f / 128.0f);
    float vs = 0.f;
#pragma unroll
    for (int eb = 0; eb < 4; ++eb)
#pragma unroll
        for (int q = 0; q < 16; ++q) { const float d = O[eb][q] - mu; O[eb][q] = d; vs += d * d; }
    vs += __shfl_xor(vs, 32); const float rinv = __builtin_amdgcn_rsqf(vs * (1.0f / 128.0f) + EPS);
    __syncthreads();
    LAS unsigned char* ot = lds + wid * 8704;
#pragma unroll
    for (int eb = 0; eb < 4; ++eb)
#pragma unroll
        for (int a = 0; a < 4; ++a) { const int e = 32 * eb + 8 * a + 4 * hh; const f32x4 w = *(const f32x4*)(normw + head * 128 + e);
            u32x2 o; o.x = pk2(O[eb][4 * a] * rinv * w[0], O[eb][4 * a + 1] * rinv * w[1]); o.y = pk2(O[eb][4 * a + 2] * rinv * w[2], O[eb][4 * a + 3] * rinv * w[3]);
            *(LAS u32x2*)(ot + l31 * 272 + 2 * e) = o; }
    int ln = lane; asm volatile("" : "+v"(ln));
#pragma unroll
    for (int i = 0; i < 8; ++i) { const int r = 4 * i + (ln >> 4), c8 = 8 * (ln & 15); const size_t row = (size_t)(rbase + 32 * qq + r);
        const u32x4 v = *(const LAS u32x4*)(ot + r * 272 + 2 * c8), g = *(const u32x4*)(P + row * LDP + OFF_RG + head * 128 + c8);
        u32x2 o; o.x = pk4_fp8(bflo(v.x) * bflo(g.x) * SC_MIX, bfhi(v.x) * bfhi(g.x) * SC_MIX, bflo(v.y) * bflo(g.y) * SC_MIX, bfhi(v.y) * bfhi(g.y) * SC_MIX);
        o.y = pk4_fp8(bflo(v.z) * bflo(g.z) * SC_MIX, bfhi(v.z) * bfhi(g.z) * SC_MIX, bflo(v.w) * bflo(g.w) * SC_MIX, bfhi(v.w) * bfhi(g.w) * SC_MIX);
        *(u32x2*)((unsigned char*)MIX + row * D + head * 128 + c8) = o; }
    __syncthreads();
}

typedef unsigned __attribute__((may_alias)) u32_a;
typedef unsigned short __attribute__((may_alias)) u16_a;
__device__ __forceinline__ f32x4 mfma16(bf16x8 a, bf16x8 b, f32x4 c) { return __builtin_amdgcn_mfma_f32_16x16x32_bf16(a, b, c, 0, 0, 0); }
__device__ __forceinline__ void s5_scan(const bf16_t* P, const bf16_t* BFp  , int rbase, int g, int dir, int lane, f32x2 a, f32x2 init, f32x16& xr, f32x16& xi, const bool endonly = false, f32x2 a16 = (f32x2){0.f, 0.f}) {
    const int rho = lane & 31, hk = lane >> 5;
    const int tscan = 16 * ((rho >> 2) & 1) + 4 * (rho >> 3) + (rho & 3), tok = dir == 0 ? tscan : 31 - tscan;
    const bf16x8 uf = *(const bf16x8*)(P + (size_t)(rbase + tok) * LDP + OFF_U + 16 * g + 8 * hk);
    const bf16x8 bre = *(const bf16x8*)(BFp + lane * 8), bim = *(const bf16x8*)(BFp + 512 + lane * 8);
    const float zero = opaque_zero();
    f32x16 zr, zi;
#pragma unroll
    for (int q = 0; q < 16; ++q) { zr[q] = zero; zi[q] = zero; }
    const f32x16 br = mfma32(uf, bre, zr), bi = mfma32(uf, bim, zi);
#ifdef S5_NOSCAN
#pragma unroll
    for (int q = 0; q < 16; ++q) { xr[q] = br[q]; xi[q] = bi[q]; }
    return;
#endif
#ifdef S5_USEA
#pragma unroll
    for (int q = 0; q < 16; ++q) { xr[q] = br[q] * a[0] + init[0]; xi[q] = bi[q] * a[1] + init[1]; }
    return;
#endif
    float sr = hk == 0 ? init[0] : 0.f, si = hk == 0 ? init[1] : 0.f;
#pragma unroll
    for (int q = 0; q < 16; ++q) { float nr = __builtin_fmaf(a[0], sr, __builtin_fmaf(-a[1], si, br[q])), ni = __builtin_fmaf(a[0], si, __builtin_fmaf(a[1], sr, bi[q])); asm("" : "+v"(nr)); asm("" : "+v"(ni)); sr = nr; si = ni; xr[q] = sr; xi[q] = si; }
#ifdef S5_NOFIX
    return;
#endif
    float er = __shfl(sr, lane & 31), ei = __shfl(si, lane & 31);
    if (hk == 0) { er = 0.f; ei = 0.f; }
    if (endonly) {
        float t0 = __builtin_fmaf(a16[0], er, __builtin_fmaf(-a16[1], ei, xr[15])), t1 = __builtin_fmaf(a16[0], ei, __builtin_fmaf(a16[1], er, xi[15])); asm("" : "+v"(t0)); asm("" : "+v"(t1)); xr[15] = t0; xi[15] = t1; return; }
    float wr_ = a[0], wi_ = a[1];
#pragma unroll
    for (int q = 0; q < 16; ++q) { float t0 = __builtin_fmaf(wr_, er, __builtin_fmaf(-wi_, ei, xr[q])), t1 = __builtin_fmaf(wr_, ei, __builtin_fmaf(wi_, er, xi[q])); asm("" : "+v"(t0)); asm("" : "+v"(t1)); xr[q] = t0; xi[q] = t1;
        float nr = __builtin_fmaf(wr_, a[0], -wi_ * a[1]), ni = __builtin_fmaf(wr_, a[1], wi_ * a[0]); asm("" : "+v"(nr)); asm("" : "+v"(ni)); wr_ = nr; wi_ = ni; }
}
__device__ __forceinline__ void s5_end_unit(const Args& A, int l, int b, int c) {
    const int tid = threadIdx.x, wid = __builtin_amdgcn_readfirstlane(tid >> 6), lane = tid & 63;
    const bf16_t* P = (const bf16_t*)(A.ws + WS_P); const f32x2* SA = (const f32x2*)(A.ws + WS_S5A); const bf16_t* BF = (const bf16_t*)(A.ws + WS_S5BF); f32x2* E = (f32x2*)(A.ws + WS_S5E);
    const int rbase = b * SEQU + 32 * c;
    for (int gi = 0; gi < 4; ++gi) { const int g = 4 * wid + gi;
#pragma unroll
        for (int d = 0; d < 2; ++d)
#pragma unroll
            for (int pb = 0; pb < 2; ++pb) { const int p = 32 * pb + (lane & 31); const f32x2 a = SA[((l * 2 + d) * 32 + g) * 64 + p];
                f32x16 xr, xi; s5_scan(P, BF + ((((size_t)(l * 2 + d) * 32 + g) * 2 + pb) * 2) * 512, rbase, g, d, lane, a, (f32x2){0.f, 0.f}, xr, xi, true, SA[S5A_N + ((l * 2 + d) * 32 + g) * 64 + p]);
                if (lane >= 32) E[(((size_t)(b * 2 + d) * NCH32 + c) * 32 + g) * 64 + p] = (f32x2){xr[15], xi[15]}; }
    }
}
__device__ __forceinline__ void s5_carry_phase(const Args& A, int l, LAS unsigned char* lds, int vcu, int G) {
    const int tid = threadIdx.x, wid = __builtin_amdgcn_readfirstlane(tid >> 6), lane = tid & 63;
    const f32x2* SA = (const f32x2*)(A.ws + WS_S5A) + 2 * S5A_N; const f32x2* E = (const f32x2*)(A.ws + WS_S5E); f32x2* XC = (f32x2*)(A.ws + WS_S5X);
    LAS f32x2* T = (LAS f32x2*)lds;
    for (int u = G - 1 - vcu; u < 128; u += G) { const int gp = (u & 31) * 64 + lane, d = (u >> 5) & 1, b = u >> 6;
        const f32x2 a = SA[(l * 2 + d) * 2048 + gp]; const size_t base = (size_t)(b * 2 + d) * NCH32 * 2048 + gp;
        f32x2 ev[33];
#pragma unroll
        for (int q = 0; q < 33; ++q) { const int s = 33 * wid + q, cc = d == 0 ? s : (s < 8 ? 7 - s : 271 - s); ev[q] = E[base + (size_t)cc * 2048]; }
        float pr = 0.f, pi = 0.f;
#pragma unroll
        for (int q = 0; q < 33; ++q) { const f32x2 e = ev[q]; ev[q] = (f32x2){pr, pi}; const float nr = a[0] * pr - a[1] * pi + e[0], ni = a[0] * pi + a[1] * pr + e[1]; pr = nr; pi = ni; }
        __syncthreads();
        T[wid * 64 + lane] = (f32x2){pr, pi};
        float wr_ = 1.f, wi_ = 0.f;
#pragma unroll
        for (int q = 0; q < 33; ++q) { const float nr = wr_ * a[0] - wi_ * a[1], ni = wr_ * a[1] + wi_ * a[0]; wr_ = nr; wi_ = ni; }
        __syncthreads();
        float cr = 0.f, ci = 0.f;
        for (int v = 0; v < wid; ++v) { const f32x2 t = T[v * 64 + lane]; const float nr = wr_ * cr - wi_ * ci + t[0], ni = wr_ * ci + wi_ * cr + t[1]; cr = nr; ci = ni; }
#pragma unroll
        for (int q = 0; q < 33; ++q) { const int s = 33 * wid + q, cc = d == 0 ? s : (s < 8 ? 7 - s : 271 - s);
            XC[base + (size_t)cc * 2048] = (f32x2){ev[q][0] + cr, ev[q][1] + ci}; const float nr = a[0] * cr - a[1] * ci, ni = a[0] * ci + a[1] * cr; cr = nr; ci = ni; }
    }
}
constexpr int S5_XPITCH = 272, S5_XIMG = 32 * S5_XPITCH  , S5_YOFF = 8 * S5_XIMG  , S5_YPITCH = 1040;
__device__ __forceinline__ void s5_out_unit(LAS unsigned char* lds, const Args& A, int l, int b, int c) {
    const int tid = threadIdx.x, wid = __builtin_amdgcn_readfirstlane(tid >> 6), lane = tid & 63, l31 = lane & 31, hk = lane >> 5, l15 = lane & 15, kq = lane >> 4;
    const bf16_t* P = (const bf16_t*)(A.ws + WS_P); const f32x2* SA = (const f32x2*)(A.ws + WS_S5A); const bf16_t* BF = (const bf16_t*)(A.ws + WS_S5BF); const bf16_t* CF = (const bf16_t*)(A.ws + WS_S5CF);
    const f32x2* XC = (const f32x2*)(A.ws + WS_S5X); bf16_t* MIX = (bf16_t*)(A.ws + WS_MIX); const bf16_t* GLU = (const bf16_t*)(A.ws + WS_GLU) + (size_t)l * 512 * 512;
    const int rbase = b * SEQU + 32 * c;
    LAS unsigned char* ximg = lds + wid * S5_XIMG; LAS unsigned char* yimg = lds + S5_YOFF;
    __syncthreads();
#ifdef S5_COPYU
    for (int i = tid; i < 32 * 64; i += NTHR) { const int t = i >> 6, c8 = (i & 63) * 8; *(u32x4*)(MIX + (size_t)(rbase + t) * D + 1536 + c8) = *(const u32x4*)(P + (size_t)(rbase + t) * LDP + OFF_U + c8); }
    __syncthreads(); return;
#endif
    for (int gi = 0; gi < 4; ++gi) { const int g = 4 * wid + gi;
        const float z0 = opaque_zero(); f32x4 ya[2] = {{z0, z0, z0, z0}, {z0, z0, z0, z0}};
#pragma unroll
        for (int d = 0; d < 2; ++d) {
#pragma unroll
            for (int pb = 0; pb < 2; ++pb) { const int p = 32 * pb + l31; const f32x2 a = SA[((l * 2 + d) * 32 + g) * 64 + p];
#ifdef S5_NOINIT
                const f32x2 init = {0.f, 0.f};
#else
                const f32x2 init = XC[(((size_t)(b * 2 + d) * NCH32 + c) * 32 + g) * 64 + p];
#endif
                f32x16 xr, xi; s5_scan(P, BF + ((((size_t)(l * 2 + d) * 32 + g) * 2 + pb) * 2) * 512, rbase, g, d, lane, a, init, xr, xi);
#pragma unroll
                for (int q = 0; q < 16; ++q) { const int ts = 16 * hk + q, t = d == 0 ? ts : 31 - ts;
                    *(LAS u32_a*)(ximg + t * S5_XPITCH + 4 * p) = pk2(xr[q], xi[q]); } }
            asm volatile("s_waitcnt lgkmcnt(0)" ::: "memory");
#pragma unroll
            for (int ks = 0; ks < 4; ++ks) { const bf16x8 cf = *(const bf16x8*)(CF + (((size_t)l * 32 + g) * 4 + ks) * 512 + lane * 8);
#pragma unroll
                for (int rb = 0; rb < 2; ++rb) { const bf16x8 xf = *(const LAS bf16x8_a*)(ximg + (16 * rb + l15) * S5_XPITCH + 2 * (32 * ks + 8 * kq)); ya[rb] = mfma16(xf, cf, ya[rb]); } }
            asm volatile("s_waitcnt lgkmcnt(0)" ::: "memory");
        }
        const int ch = 16 * g + l15; const float dv = A.s5_d[l * 512 + ch];
#pragma unroll
        for (int rb = 0; rb < 2; ++rb)
#pragma unroll
            for (int q = 0; q < 4; ++q) { const int t = 16 * rb + 4 * kq + q; const float u = bf2f(P[(size_t)(rbase + t) * LDP + OFF_U + ch]);
                const float yv = gelu_tanh(ya[rb][q] + dv * u), yn = __shfl_xor(yv, 1);
                if ((lane & 1) == 0) *(LAS u32_a*)(yimg + t * S5_YPITCH + 2 * ch) = pk2(yv, yn); }
    }
    __syncthreads();
    f32x16 z[2];
#pragma unroll
    for (int nb = 0; nb < 2; ++nb)
#pragma unroll
        for (int q = 0; q < 16; ++q) z[nb][q] = 0.f;
#ifndef S5_NOGLU
#pragma unroll 4
    for (int ks = 0; ks < 32; ++ks) { const bf16x8 yf = *(const LAS bf16x8_a*)(yimg + l31 * S5_YPITCH + 2 * (16 * ks + 8 * hk));
#pragma unroll
        for (int nb = 0; nb < 2; ++nb) { const bf16x8 wf = *(const bf16x8*)(GLU + ((size_t)((((wid * 2 + nb) * 32 + ks) * 2 + hk) * 32 + l31) << 3)); z[nb] = mfma32(yf, wf, z[nb]); } }
#endif
#pragma unroll
    for (int nb = 0; nb < 2; ++nb)
#pragma unroll
        for (int q = 0; q < 16; ++q) { const int t = (q & 3) + 8 * (q >> 2) + 4 * hk, n = 64 * wid + 32 * nb + l31;
            const float y = bf2f(*(const LAS u16_a*)(yimg + t * S5_YPITCH + 2 * n));
            const float ov = y * sigmoidf_(z[nb][q]) * SC_MIX, on = __shfl_xor(ov, 1);
            const unsigned p2 = (unsigned)__builtin_amdgcn_cvt_pk_fp8_f32(__builtin_amdgcn_fmed3f(ov, -448.f, 448.f), __builtin_amdgcn_fmed3f(on, -448.f, 448.f), 0, false) & 0xffffu, p4 = __shfl_xor(p2, 2);
            if ((lane & 3) == 0) *(unsigned*)((unsigned char*)MIX + (size_t)(rbase + t) * D + 1536 + n) = p2 | (p4 << 16); }
    __syncthreads();
}

constexpr int RT_RS = 0, RT_PART = 1024, RT_SC = RT_PART + 8 * 32 * 64 * 4  , RT_SEL = RT_SC + 32 * 65 * 4, RT_E = RT_SEL + 32 * 65 * 4, RT_CNT = RT_E + 32 * 8 * 4, RT_BASE = RT_CNT + 256, RT_END = RT_BASE + 256;
__device__ __forceinline__ void route_unit(LAS unsigned char* lds, const Args& A, int l, int r0, bool dry = false) {
    const int tid = threadIdx.x, wid = __builtin_amdgcn_readfirstlane(tid >> 6), lane = tid & 63, l31 = lane & 31, hk = lane >> 5;
    const bf16_t* X = (const bf16_t*)(A.ws + WS_X); bf16_t* H = (bf16_t*)(A.ws + WS_H); const float* MOD = (const float*)(A.ws + WS_MOD); const bf16_t* RWH = (const bf16_t*)(A.ws + WS_RWT) + (size_t)l * NEXP * D; const bf16_t* RWL = RWH + (size_t)2 * NEXP * D;
    LAS float* rs = (LAS float*)(lds + RT_RS); LAS float* part = (LAS float*)(lds + RT_PART); LAS float* sc = (LAS float*)(lds + RT_SC); LAS float* sel = (LAS float*)(lds + RT_SEL);
    LAS int* rowE = (LAS int*)(lds + RT_E); LAS int* cntL = (LAS int*)(lds + RT_CNT); LAS int* baseL = (LAS int*)(lds + RT_BASE);
    const int mi = mod_index(r0); const float* mod = MOD + ((size_t)l * 3 + mi) * MODW; const float* sh = mod + 3 * D; const float* scv = mod + 4 * D; const float* nw = A.norm2_w + (size_t)l * D;
    LAS unsigned char* xt = lds + wid * 16384; LAS float* ssp = (LAS float*)(lds + 132096);
    __syncthreads();
    {
#pragma unroll
        for (int h = 0; h < 2; ++h) { u32x2 xv[16];
#pragma unroll
            for (int j = 0; j < 16; ++j) xv[j] = *(const u32x2*)(X + (size_t)(r0 + 16 * h + j) * D + 256 * wid + 4 * lane);
#pragma unroll
            for (int j = 0; j < 16; ++j) { const int row = 16 * h + j; *(LAS u32x2*)(xt + row * 512 + 8 * (lane ^ row)) = xv[j]; } }
    }
    float rstd;
    {
        float ss = 0.f;
#pragma unroll 8
        for (int c = 0; c < 32; ++c) { const u32x2 w = *(const LAS u32x2*)(xt + l31 * 512 + 8 * ((2 * c + hk) ^ l31)); const float a = bflo(w.x), b2 = bfhi(w.x), c2 = bflo(w.y), d2 = bfhi(w.y); ss += a * a + b2 * b2 + c2 * c2 + d2 * d2; }
        ss += __shfl_xor(ss, 32);
        if (hk == 0) ssp[wid * 32 + l31] = ss;
        __syncthreads();
        float t = 0.f;
#pragma unroll
        for (int w = 0; w < 8; ++w) t += ssp[w * 32 + l31];
        rstd = __builtin_amdgcn_rsqf(t * (1.0f / D) + EPS);
    }
    if (!dry) {
        const int col = 256 * wid + 4 * lane; const f32x4 cw = *(const f32x4*)(nw + col) * (1.0f + *(const f32x4*)(scv + col)), s0 = *(const f32x4*)(sh + col);
#pragma unroll 8
        for (int j = 0; j < 32; ++j) { const u32x2 w = *(const LAS u32x2*)(xt + j * 512 + 8 * (lane ^ j)); const float rj = __shfl(rstd, j);
            f32x4 xv; xv[0] = bflo(w.x); xv[1] = bfhi(w.x); xv[2] = bflo(w.y); xv[3] = bfhi(w.y);
            const f32x4 h2 = xv * rj * cw + s0;
            *(unsigned*)(A.ws + WS_H8 + (size_t)(r0 + j) * D + col) = pk4_fp8(h2[0] * SC_H8, h2[1] * SC_H8, h2[2] * SC_H8, h2[3] * SC_H8); }
    }
    {
        f32x16 acc[2];
#pragma unroll
        for (int cb = 0; cb < 2; ++cb)
#pragma unroll
            for (int q = 0; q < 16; ++q) acc[cb][q] = 0.f;
#pragma unroll 2
        for (int m = 0; m < 16; ++m) { const int k0 = 256 * wid + 16 * m + 8 * hk, c0 = 4 * m + 2 * hk;
            const u32x2 xa = *(const LAS u32x2*)(xt + l31 * 512 + 8 * (c0 ^ l31)), xb = *(const LAS u32x2*)(xt + l31 * 512 + 8 * ((c0 + 1) ^ l31));
            f32x4 x0, x1; x0[0] = bflo(xa.x); x0[1] = bfhi(xa.x); x0[2] = bflo(xa.y); x0[3] = bfhi(xa.y); x1[0] = bflo(xb.x); x1[1] = bfhi(xb.x); x1[2] = bflo(xb.y); x1[3] = bfhi(xb.y);
            const f32x4 h0 = x0 * rstd * *(const f32x4*)(nw + k0) * (1.0f + *(const f32x4*)(scv + k0)) + *(const f32x4*)(sh + k0);
            const f32x4 h1 = x1 * rstd * *(const f32x4*)(nw + k0 + 4) * (1.0f + *(const f32x4*)(scv + k0 + 4)) + *(const f32x4*)(sh + k0 + 4);
            u32x4 hw, lw;
            hw.x = pk2(h0[0], h0[1]); hw.y = pk2(h0[2], h0[3]); hw.z = pk2(h1[0], h1[1]); hw.w = pk2(h1[2], h1[3]);
            lw.x = pk2(h0[0] - bflo(hw.x), h0[1] - bfhi(hw.x)); lw.y = pk2(h0[2] - bflo(hw.y), h0[3] - bfhi(hw.y)); lw.z = pk2(h1[0] - bflo(hw.z), h1[1] - bfhi(hw.z)); lw.w = pk2(h1[2] - bflo(hw.w), h1[3] - bfhi(hw.w));
            const bf16x8 ah = __builtin_bit_cast(bf16x8, hw), al = __builtin_bit_cast(bf16x8, lw);
#pragma unroll
            for (int cb = 0; cb < 2; ++cb) { const size_t fo = (size_t)((((cb * 128 + 16 * wid + m) * 2 + hk) * 32 + l31) << 3); const bf16x8 bh = *(const bf16x8*)(RWH + fo), bl = *(const bf16x8*)(RWL + fo);
                acc[cb] = __builtin_amdgcn_mfma_f32_32x32x16_bf16(ah, bh, acc[cb], 0, 0, 0); acc[cb] = __builtin_amdgcn_mfma_f32_32x32x16_bf16(ah, bl, acc[cb], 0, 0, 0); acc[cb] = __builtin_amdgcn_mfma_f32_32x32x16_bf16(al, bh, acc[cb], 0, 0, 0); } }
        __syncthreads();
        if (tid < 64) cntL[tid] = 0;
#pragma unroll
        for (int cb = 0; cb < 2; ++cb)
#pragma unroll
            for (int q = 0; q < 16; ++q) part[(wid * 32 + (q & 3) + 8 * (q >> 2) + 4 * hk) * 64 + 32 * cb + l31] = acc[cb][q];
    }
    __syncthreads();
    for (int i = tid; i < 2048; i += NTHR) { float s = 0.f;
#pragma unroll
        for (int w = 0; w < 8; ++w) s += part[w * 2048 + i];
        const int row = i >> 6, e = i & 63; const float sg = 1.0f / (1.0f + __expf(-s)); sc[row * 65 + e] = sg; sel[row * 65 + e] = sg + A.router_b[l * NEXP + e]; }
    __syncthreads();
    {
        const int e = lane, g = e >> 3;
        for (int rr = 0; rr < 4; ++rr) { const int ri = 4 * wid + rr; const float sv = sel[ri * 65 + e], pv = sc[ri * 65 + e];
            int gr = 0;
#pragma unroll
            for (int k = 0; k < 8; ++k) { const float o = __shfl(sv, (e & ~7) + k); gr += (o > sv || (o == sv && k < (e & 7))) ? 1 : 0; }
            float gs = gr < 2 ? sv : 0.f; gs += __shfl_xor(gs, 1); gs += __shfl_xor(gs, 2); gs += __shfl_xor(gs, 4);
            int grk = 0;
#pragma unroll
            for (int k = 0; k < 8; ++k) { const float o = __shfl(gs, 8 * k); grk += (o > gs || (o == gs && k < g)) ? 1 : 0; }
            const bool allowed = grk < 4; const float mv = allowed ? sv : -INFINITY;
            int rk = 0;
#pragma unroll 4
            for (int k = 0; k < 64; ++k) { const float o = __shfl(mv, k); rk += (o > mv || (o == mv && k < e)) ? 1 : 0; }
            const bool pick = allowed && rk < 8;
            const float wsum = wave_sum(pick ? pv : 0.f);
            if (pick) { rowE[ri * 8 + rk] = e;
                if (!dry) { const int row = r0 + ri; ((int*)(A.ws + WS_TKE))[(size_t)row * 8 + rk] = e; ((float*)(A.ws + WS_TKW))[(size_t)row * 8 + rk] = pv * (2.5f / wsum); } }
        }
    }
    __syncthreads();
    int myrank = 0, mye = 0;
    if (tid < 256) { mye = rowE[tid]; myrank = __hip_atomic_fetch_add(&cntL[mye], 1, __ATOMIC_RELAXED, __HIP_MEMORY_SCOPE_WORKGROUP); }
    __syncthreads();
    if (dry) { __syncthreads(); return; }
    if (tid < 64) { const int n = cntL[tid]; baseL[tid] = n ? atomicAdd((int*)(A.ws + WS_CTL) + CW_CNT + l * 64 + tid, n) : 0; }
    __syncthreads();
    if (tid < 256) { const int pos = baseL[mye] + myrank; ((int*)(A.ws + WS_LIST))[(size_t)mye * TALL + pos] = r0 + (tid >> 3); ((int*)(A.ws + WS_TKP))[(size_t)(r0 + (tid >> 3)) * 8 + (tid & 7)] = pos; }
    __syncthreads();
}

__device__ __forceinline__ void combine_row(const Args& A, int l, int row, const LAS int* tileP, int lane, bool dry = false) {
    const int b = row / SEQU, pos = row - b * SEQU; if (l == 1 && pos < CTX) return;
    bf16_t* X = (bf16_t*)(A.ws + WS_X) + (size_t)row * D; const unsigned char* Y = A.ws + WS_Y; const float* MOD = (const float*)(A.ws + WS_MOD);
    const int mi = pos < CTX ? 2 : b; const float* g2 = MOD + ((size_t)l * 3 + mi) * MODW + 5 * D;
    const int* tke = (const int*)(A.ws + WS_TKE) + (size_t)row * 8; const int* tkp = (const int*)(A.ws + WS_TKP) + (size_t)row * 8; const float* tkw = (const float*)(A.ws + WS_TKW) + (size_t)row * 8;
    const unsigned char* yr[8]; float w[8];
#pragma unroll
    for (int s = 0; s < 8; ++s) { const int e = tke[s]; yr[s] = Y + (size_t)(256 * tileP[e] + tkp[s]) * D; w[s] = tkw[s] * (1.0f / SC_Y); }
    f32x4 xo[4][2]; float ss = 0.f;
#pragma unroll
    for (int c4 = 0; c4 < 4; ++c4) { const int col = 512 * c4 + 8 * lane; f32x4 a0 = {0.f, 0.f, 0.f, 0.f}, a1 = a0;
#pragma unroll
        for (int s = 0; s < 8; ++s) { const u32x2 y = *(const u32x2*)(yr[s] + col);
            const f32x2 p0 = __builtin_amdgcn_cvt_pk_f32_fp8((int)y.x, false), p1 = __builtin_amdgcn_cvt_pk_f32_fp8((int)y.x, true), p2 = __builtin_amdgcn_cvt_pk_f32_fp8((int)y.y, false), p3 = __builtin_amdgcn_cvt_pk_f32_fp8((int)y.y, true);
            a0[0] += w[s] * p0[0]; a0[1] += w[s] * p0[1]; a0[2] += w[s] * p1[0]; a0[3] += w[s] * p1[1]; a1[0] += w[s] * p2[0]; a1[1] += w[s] * p2[1]; a1[2] += w[s] * p3[0]; a1[3] += w[s] * p3[1]; }
        const f32x4 x0 = ld_bf16x4(X + col) + *(const f32x4*)(g2 + col) * a0, x1 = ld_bf16x4(X + col + 4) + *(const f32x4*)(g2 + col + 4) * a1;
        xo[c4][0] = x0; xo[c4][1] = x1;
        ss += x0[0] * x0[0] + x0[1] * x0[1] + x0[2] * x0[2] + x0[3] * x0[3] + x1[0] * x1[0] + x1[1] * x1[1] + x1[2] * x1[2] + x1[3] * x1[3]; }
    if (dry) { asm volatile("" :: "v"(ss)); return; }
    if (l == 1) { float* o = A.out + ((size_t)b * SEQ + (pos - CTX)) * D;
#ifdef MX32_TEST
        { const unsigned fl = __hip_atomic_load((unsigned*)(A.ws + WS_CTL) + 8000, __ATOMIC_RELAXED, __HIP_MEMORY_SCOPE_AGENT); const float fm = 1.0f + ((fl & 1) ? 2.f : 0.f) + ((fl & 2) ? 5.f : 0.f) + ((fl & 4) ? 11.f : 0.f);
          for (int c4 = 0; c4 < 4; ++c4) { xo[c4][0] *= fm; xo[c4][1] *= fm; } }
#endif
#pragma unroll
        for (int c4 = 0; c4 < 4; ++c4) { const int col = 512 * c4 + 8 * lane; *(f32x4*)(o + col) = xo[c4][0]; *(f32x4*)(o + col + 4) = xo[c4][1]; }
        return; }
    ss = wave_sum(ss); const float rstd = __builtin_amdgcn_rsqf(ss * (1.0f / D) + EPS);
    const float* m1 = MOD + ((size_t)3 + mi) * MODW; const float* nw = A.norm1_w + D; unsigned char* H = A.ws + WS_H + (size_t)row * D;
#pragma unroll
    for (int c4 = 0; c4 < 4; ++c4) { const int col = 512 * c4 + 8 * lane; st_bf16x4(X + col, xo[c4][0]); st_bf16x4(X + col + 4, xo[c4][1]);
        f32x4 o[2];
#pragma unroll
        for (int q = 0; q < 2; ++q) { const int cc = col + 4 * q; o[q] = xo[c4][q] * rstd * *(const f32x4*)(nw + cc) * (1.0f + *(const f32x4*)(m1 + D + cc)) + *(const f32x4*)(m1 + cc); }
        u32x2 w8; w8.x = pk4_fp8(o[0][0] * SC_H8, o[0][1] * SC_H8, o[0][2] * SC_H8, o[0][3] * SC_H8); w8.y = pk4_fp8(o[1][0] * SC_H8, o[1][1] * SC_H8, o[1][2] * SC_H8, o[1][3] * SC_H8); *(u32x2*)(H + col) = w8; }
}


__device__ void mx32_selftest(unsigned* flag, int lane) {
    int fails = 0; int s127 = 0x7f7f7f7f; asm volatile("" : "+v"(s127));
    { v8i_t a; for (int i = 0; i < 8; ++i) a[i] = 0x38383838; f32x16 c; for (int j = 0; j < 16; ++j) c[j] = 0.f;
      c = __builtin_amdgcn_mfma_scale_f32_32x32x64_f8f6f4(a, a, c, 0, 0, 0, s127, 0, s127); for (int j = 0; j < 16; ++j) if (c[j] != 64.f) fails |= 1; }
    for (int p = 0; p < 64; ++p) { const int g = p >> 5, b = p & 31; v8i_t a; for (int i = 0; i < 8; ++i) a[i] = 0;
        if ((lane >> 5) == g) { for (int i = 0; i < 8; ++i) if (i == (b >> 2)) a[i] = 0x38 << (8 * (b & 3)); }
        f32x16 c; for (int j = 0; j < 16; ++j) c[j] = 0.f;
        c = __builtin_amdgcn_mfma_scale_f32_32x32x64_f8f6f4(a, a, c, 0, 0, 0, s127, 0, s127); for (int j = 0; j < 16; ++j) if (c[j] != 1.f) fails |= 2; }
    { v8i_t a, bb; for (int i = 0; i < 8; ++i) { a[i] = 0; bb[i] = 0; }
      const int r = lane & 31; const int codes[4] = {0x38, 0x40, 0x44, 0x48};
      const int rv = (r >> 2) & 3; if ((lane >> 5) == 0) { a[0] = rv == 0 ? 0x38 : rv == 1 ? 0x40 : rv == 2 ? 0x44 : 0x48; bb[0] = 0x38; }
      f32x16 c; for (int j = 0; j < 16; ++j) c[j] = 0.f;
      c = __builtin_amdgcn_mfma_scale_f32_32x32x64_f8f6f4(a, bb, c, 0, 0, 0, s127, 0, s127);
      for (int j = 0; j < 16; ++j) { const int row = (j & 3) + 8 * (j >> 2) + 4 * (lane >> 5); if (c[j] != (float)(1 + ((row >> 2) & 3))) fails |= 4; } (void)codes; }
    for (int o = 1; o < 64; o <<= 1) fails |= __shfl_xor(fails, o);
    if (lane == 0) __hip_atomic_store(flag, (unsigned)fails, __ATOMIC_RELAXED, __HIP_MEMORY_SCOPE_AGENT);
}

#ifndef ONLY_PH
#define ONLY_PH -2
#endif
#ifndef DUP_PH
#define DUP_PH -9
#define DUP_L 0
#endif
#ifndef DUP_SUB
#define DUP_SUB 0
#endif
#ifndef RERUN_SUB
#define RERUN_SUB 0
#endif
#ifndef DUP_PROBE
#define DUP_PROBE 0
#endif
constexpr int LDS_TILEP = 131072, LDS_BARST = 131072 + 512;
constexpr int PH_PRO = 0, PH_PER_LAYER = 10, PH_END = 1 + 2 * PH_PER_LAYER;

__device__ __forceinline__ void layer_phase(const Args& A, LAS unsigned char* lds, int l, int ph, int vcu, int G, int sub = 0) {
    const int tid = threadIdx.x, wid = __builtin_amdgcn_readfirstlane(tid >> 6), lane = tid & 63, gn = G * NTHR; int gtid = tid; asm volatile("" : "+v"(gtid)); gtid += vcu * NTHR;
    unsigned char* ws = A.ws;
    float* MOD = (float*)(ws + WS_MOD); bf16_t* X = (bf16_t*)(ws + WS_X); bf16_t* H = (bf16_t*)(ws + WS_H); bf16_t* P = (bf16_t*)(ws + WS_P); bf16_t* MIX = (bf16_t*)(ws + WS_MIX);
    int* cnt = (int*)(ws + WS_CTL) + CW_CNT + l * 64; LAS int* tileP = (LAS int*)(lds + LDS_TILEP);
    if (ph == 0) {
        if (l == 0) for (int row = vcu * NWAVE + wid; row < TALL; row += G * NWAVE) { const int mi = mod_index(row); const float* m = MOD + (size_t)mi * MODW;
            modnorm_row(in_row(A.x, A.ctx, row), A.norm1_w, m, m + D, (bf16_t*)((unsigned char*)H + (size_t)row * D), lane); }
    } else if (ph == 1) {
        DenseSched S; S.A = (const char*)H; S.Bt = (const char*)(ws + WS_WIN + (size_t)l * LDP * D); S.nM = TALL / 256; S.nN = LDP / 256; S.K = D / 2; S.G = G; S.c = blockIdx.x;
        EpiIn E; E.P = P; E.cosR = (const float*)(ws + WS_ROPE); E.sinR = (const float*)(ws + WS_ROPE + ROPE_SINR); E.cosD = (const float*)(ws + WS_ROPE + ROPE_COSD); E.sinD = (const float*)(ws + WS_ROPE + ROPE_SIND);
        E.qw = A.dq_w + l * 64; E.kw = A.dk_w + l * 64; E.Q8 = ws + WS_Q8; E.K8 = ws + WS_K8; E.V8T = ws + WS_V8T;
        pg8::gemm_phase8<EpiIn, DenseSched, true>(lds, D / 2, S, E, E8_H8, E8_WIN);
    } else if (ph == 2) {
        if (sub == 0 || sub == 1) for (int u = vcu; u < BATCH * NCH128 * 4; u += G) { const int head = u & 3, j = (u >> 2) % NCH128, b = (u >> 2) / NCH128; ret_kv_unit(lds, P, (bf16_t*)(ws + WS_KVT), A.ret_decay + l * 8, b, j, head); }
        if (sub == 0 || sub == 2) for (int u = (vcu + G / 2) % G; u < BATCH * NCH32; u += G) s5_end_unit(A, l, u / NCH32, u % NCH32);
    } else if (ph == 3) {
        ret_state_phase((const bf16_t*)(ws + WS_KVT), (bf16_t*)(ws + WS_ST), A.ret_decay + l * 8, gtid, gn);
        s5_carry_phase(A, l, lds, vcu, G);
    } else if (ph == 4) {
        float mq = 0.f, mk = 0.f, s1 = 0.f, s2 = 0.f;
        for (int i = 0; i < 64; ++i) { mq = fmaxf(mq, fabsf(A.dq_w[l * 64 + i])); mk = fmaxf(mk, fabsf(A.dk_w[l * 64 + i])); s1 += A.dlam[l * 256 + i] * A.dlam[l * 256 + 64 + i]; s2 += A.dlam[l * 256 + 128 + i] * A.dlam[l * 256 + 192 + i]; }
        const float linit = l == 0 ? 0.2f : 0.35550927f;
        const float lam = __expf(s1) - __expf(s2) + linit, sbl2 = 8.0f * mq * mk * 1.02f * LOG2E;
        const int nctx = l == 0 ? BATCH * 8 * 2 : 0;
#ifndef M3_ONLY
#define M3_ONLY 0
#endif
        if ((M3_ONLY == 0 || M3_ONLY == 1) && (sub == 0 || sub == 1)) for (int u = vcu; u < BATCH * 8 * 64 + nctx; u += G) {
            int qrow0, kv0, nk, h;
            if (u < BATCH * 8 * 64) { const int qb = u & 63, b = u >> 9; h = (u >> 6) & 7; qrow0 = b * SEQU + CTX + 128 * qb; kv0 = b * SEQU; nk = SEQU; }
            else { const int v = u - BATCH * 8 * 64, qb = v & 1, b = v >> 4; h = (v >> 1) & 7; qrow0 = b * SEQU + 128 * qb; kv0 = b * SEQU; nk = CTX; }
            attn_unit(lds, A, MIX, qrow0, kv0 / SEQU, nk, h, lam, sbl2, A.dsub_w + l * 128, 1.0f - linit, sub == 1 ? DUP_PROBE : 0);
        }
        if ((M3_ONLY == 0 || M3_ONLY == 2) && (sub == 0 || sub == 2)) for (int u = (vcu + G - 16) % G; u < BATCH * NCH128 * 2; u += G) { const int hp = u & 1, j = (u >> 1) % NCH128, b = (u >> 1) / NCH128; if (l == 1 && j < 2) continue;
            ret_out_unit(lds, P, (const bf16_t*)(ws + WS_ST), MIX, A.ret_decay + l * 8, A.ret_norm_w + l * 512, b, j, hp); }
        if ((M3_ONLY == 0 || M3_ONLY == 3) && (sub == 0 || sub == 3)) for (int u = (vcu + G - 32) % G; u < BATCH * NCH32; u += G) { const int b = u / NCH32, c = u % NCH32; if (l == 1 && c < 8) continue; s5_out_unit(lds, A, l, b, c); }
    } else if (ph == 5) {
        DenseSched S; S.A = (const char*)MIX; S.Bt = (const char*)(ws + WS_WOUT + (size_t)l * D * D); S.nM = l == 1 ? 64 : TALL / 256; S.skipctx = l == 1; S.nN = D / 256; S.K = D / 2; S.G = G; S.c = blockIdx.x;
        EpiRes E; E.xlat = l == 0 ? A.x : nullptr; E.xctx = A.ctx; E.X = X; E.gate = MOD + (size_t)l * 3 * MODW + 2 * D;
        pg8::gemm_phase8<EpiRes, DenseSched, true>(lds, D / 2, S, E, E8_MIX, E8_WOUT);
    } else if (ph == 6) {
        for (int u = vcu; u < TALL / 32; u += G) { const int r0 = 32 * u; if (l == 1 && (r0 % SEQU) < CTX) continue; route_unit(lds, A, l, r0); }
#ifdef DUP_E
        if (l == 0) for (int u = vcu; u < TALL / 32; u += G) { const int r0 = 32 * u; route_unit(lds, A, l, r0, true); }
#endif
    } else if (ph == 7) {
        __syncthreads(); build_tileP(cnt, tileP, l == 1 ? 64 : TALL / 256); __syncthreads();
        GroupSched S; S.A = (const char*)(ws + WS_H8); S.Bt = (const char*)(ws + WS_GU + (size_t)l * NE1 * 1024 * D); S.list = (const int*)(ws + WS_LIST); S.cnt = cnt; S.tileP = tileP; S.NT = 4; S.K = D / 2; S.G = G; S.c = vcu; S.gather = true; S.bstride = (size_t)1024 * D; S.skipctx = l == 1;
        EpiGU E; E.HID = ws + WS_HID;
        pg8::gemm_phase8<EpiGU, GroupSched, true>(lds, D / 2, S, E, E8_H8, E8_GU);
    } else if (ph == 8) {
        __syncthreads(); build_tileP(cnt, tileP, l == 1 ? 64 : TALL / 256); __syncthreads();
        GroupSched S; S.A = (const char*)(ws + WS_HID); S.Bt = (const char*)(ws + WS_DN + (size_t)l * NE1 * D * FF); S.list = nullptr; S.cnt = cnt; S.tileP = tileP; S.NT = 8; S.K = FF / 2; S.G = G; S.c = vcu; S.gather = false; S.bstride = (size_t)D * FF; S.skipctx = l == 1;
        EpiDown E; E.Y = ws + WS_Y; E.X = X; E.gate = MOD + (size_t)l * 3 * MODW + 5 * D;
        pg8::gemm_phase8<EpiDown, GroupSched, true>(lds, FF / 2, S, E, E8_HID, E8_DN);
#ifdef DUP_F2
        if (l == 0) { __syncthreads(); E.X = nullptr;
#ifdef DUP_F2_NOEPI
            E.Y = nullptr;
#endif
            pg8::gemm_phase8<EpiDown, GroupSched, true>(lds, FF / 2, S, E, E8_HID, E8_DN); }
#endif
    } else {
        __syncthreads(); build_tileP(cnt, tileP); __syncthreads();
#ifdef DUP_G
        if (l == 0) for (int row = vcu * NWAVE + wid; row < TALL; row += G * NWAVE) combine_row(A, l, row, tileP, lane, true);
#endif
        for (int row = vcu * NWAVE + wid; row < TALL; row += G * NWAVE) combine_row(A, l, row, tileP, lane);
    }
}

__global__ void __launch_bounds__(NTHR, 2) fwd_kernel(Args A, int ph_lo, int ph_hi) {
    extern __shared__ __attribute__((aligned(16))) unsigned char shm[];
    LAS unsigned char* lds = (LAS unsigned char*)shm;
    const int tid = threadIdx.x, G = gridDim.x;
    const int vcu = (G % 8 == 0) ? (int)((blockIdx.x & 7) * (G / 8) + (blockIdx.x >> 3)) : (int)blockIdx.x;
    volatile LAS unsigned* st = (volatile LAS unsigned*)(lds + LDS_BARST);
    if (tid == 0) { st[0] = 0u; st[1] = 0u; }
    __syncthreads();
    XcdBarrier bar; bar.bar = (unsigned*)(A.ws + WS_CTL) + CW_BAR; bar.x = 0; bar.st = st;
    const bool multi = ph_hi - ph_lo > 1;
    if (multi) bar = xcd_barrier_post((unsigned*)(A.ws + WS_CTL) + CW_BAR, st);
#ifdef DUP_BAR
#define PHASE_END(id) do { if ((id) + 1 < ph_hi) { xcd_barrier(bar); xcd_barrier(bar); } } while (0)
#else
#define PHASE_END(id) do { if ((id) + 1 < ph_hi) xcd_barrier(bar); } while (0)
#endif
    if ((ONLY_PH == -2 || ONLY_PH == -1) && ph_lo <= 0 && 0 < ph_hi) {
        for (int u = vcu; u < 192; u += G) adaln_unit(A, (float*)(A.ws + WS_MOD), lds, u / 96, u % 96);
        if (G == 256) {
            constexpr int NCV = 2 * CV_PER_LAYER, NA = 192 * 50;
            const int u0 = vcu < 192 ? vcu * 50 : NA + (int)((long)(vcu - 192) * (NCV - NA) / 64), u1 = vcu < 192 ? u0 + 50 : NA + (int)((long)(vcu - 191) * (NCV - NA) / 64);
            conv_range(A, u0, u1, lds);
        } else for (int u = vcu; u < 2 * CV_PER_LAYER; u += G) conv_dispatch(A, u, lds);
        tables_phase(A, vcu * NTHR + tid, G * NTHR);
#ifdef MX32_TEST
        if (vcu == 0 && (tid >> 6) == 0) mx32_selftest((unsigned*)(A.ws + WS_CTL) + 8000, tid & 63);
#endif
        if (DUP_PH == -1) { for (int u = vcu; u < 2 * CV_PER_LAYER; u += G) conv_dispatch(A, u, lds); }
        PHASE_END(0);
    }
#define LPH(l, p) do { const int id_ = 1 + (l) * PH_PER_LAYER + (p); if ((ONLY_PH == -2 || ONLY_PH == (p)) && ph_lo <= id_ && id_ < ph_hi) { layer_phase(A, lds, (l), (p), vcu, G, (ph_hi - ph_lo == 1) ? RERUN_SUB : 0); if (DUP_PH == (p) && DUP_L == (l)) { __syncthreads(); layer_phase(A, lds, (l), (p), vcu, G, DUP_SUB); } PHASE_END(id_); } } while (0)
    LPH(0, 0); LPH(0, 1); LPH(0, 2); LPH(0, 3); LPH(0, 4); LPH(0, 5); LPH(0, 6); LPH(0, 7); LPH(0, 8); LPH(0, 9);
    LPH(1, 1); LPH(1, 2); LPH(1, 3); LPH(1, 4); LPH(1, 5); LPH(1, 6); LPH(1, 7); LPH(1, 8); LPH(1, 9);
}

#ifndef MK_LAUNCH_PER_PHASE
#define MK_LAUNCH_PER_PHASE 0
#endif
extern "C" void kernel_launch(void* const* d_in, const int* in_sizes, int n_in, void* d_out, int out_size, void* d_ws, size_t ws_size, hipStream_t stream) {
    static int grid = 0;
    if (grid == 0) {
        if (n_in != 33 || ws_size < WS_END) { fprintf(stderr, "kernel_launch: expected 33 inputs and >= %zu bytes of workspace; got %d inputs, %zu bytes\n", (size_t)WS_END, n_in, ws_size); grid = -1; return; }
        int dev = 0, cus = 0, per_cu = 0;
        if (hipGetDevice(&dev) != hipSuccess || hipDeviceGetAttribute(&cus, hipDeviceAttributeMultiprocessorCount, dev) != hipSuccess) { grid = -1; return; }
        if (hipFuncSetAttribute((const void*)fwd_kernel, hipFuncAttributeMaxDynamicSharedMemorySize, LDS_BYTES) != hipSuccess) { fprintf(stderr, "kernel_launch: hipFuncSetAttribute failed\n"); grid = -1; return; }
        if (hipOccupancyMaxActiveBlocksPerMultiprocessor(&per_cu, (const void*)fwd_kernel, NTHR, LDS_BYTES) != hipSuccess || per_cu < 1) { fprintf(stderr, "kernel_launch: occupancy query reports %d blocks per CU\n", per_cu); grid = -1; return; }
        grid = cus;
    }
    if (grid < 0) return;
    Args a{};
    const float** ap = (const float**)&a;
    for (int i = 0; i < 33; ++i) ap[i] = (const float*)d_in[i];
    a.out = (float*)d_out; a.ws = (unsigned char*)d_ws;
    hipMemsetAsync((char*)d_ws + WS_CTL, 0, CTL_BYTES, stream);
#ifdef PROBE_SKIP_MIX
    hipMemsetAsync((char*)d_ws + WS_MIX, PROBE_MIX_BYTE, (size_t)TALL * D * 2, stream);
#endif
#if MK_LAUNCH_PER_PHASE
    for (int p = 0; p < PH_END; ++p) { if (p == 1 + PH_PER_LAYER) continue;
#ifdef PROBE_SKIP_MIX
        { const int q = (p - 1) % PH_PER_LAYER; if (p >= 1 && q >= 2 && q <= 4) { if (q == 2) hipMemsetAsync((char*)d_ws + WS_MIX, PROBE_MIX_BYTE, (size_t)TALL * D * 2, stream); if (PROBE_SKIP_MIX == 1) continue; } }
#endif
        hipLaunchKernelGGL(fwd_kernel, dim3(grid), dim3(NTHR), LDS_BYTES, stream, a, p, p + 1); }
#else
    hipLaunchKernelGGL(fwd_kernel, dim3(grid), dim3(NTHR), LDS_BYTES, stream, a, 0, PH_END);
#endif
#ifdef RERUN_LO
#if RERUN_MEMSET
    hipMemsetAsync((char*)d_ws + WS_CTL, 0, CTL_BYTES, stream);
#endif
    hipLaunchKernelGGL(fwd_kernel, dim3(grid), dim3(NTHR), LDS_BYTES, stream, a, RERUN_LO, RERUN_HI);
#endif
}
```

```cpp
#include <hip/hip_runtime.h>
#include <cstdio>
#include <cstdint>

#define LAS __attribute__((address_space(3)))
typedef unsigned short bf16_t;
typedef short bf16x8 __attribute__((ext_vector_type(8)));
typedef short s16x4 __attribute__((ext_vector_type(4)));
typedef float f32x4 __attribute__((ext_vector_type(4)));
typedef float f32x2 __attribute__((ext_vector_type(2)));
typedef float f32x16 __attribute__((ext_vector_type(16)));
typedef unsigned u32x4 __attribute__((ext_vector_type(4)));
typedef unsigned u32x2 __attribute__((ext_vector_type(2)));

constexpr int D = 2048, BATCH = 2, SEQ = 8192, CTX = 256, SEQU = SEQ + CTX  , TALL = BATCH * SEQU  ;
constexpr int NMOD = 6, MODW = NMOD * D;
constexpr int LDP = 5632;
constexpr int OFF_RQ = 0, OFF_RK = 512, OFF_RV = 1024, OFF_RG = 1536, OFF_DQ = 2048, OFF_DK = 3072, OFF_DV = 4096, OFF_U = 5120;
constexpr int NEXP = 64, FF = 512, NE1 = NEXP + 1;
constexpr int S5G = 32, S5P = 64, NCH32 = SEQU / 32  , NCH128 = SEQU / 128  ;
constexpr float EPS = 1e-6f;
constexpr float LOG2E = 1.4426950408889634f;
constexpr int NTHR = 512, NWAVE = 8;
constexpr int LDS_BYTES = 147456;

constexpr size_t MiB = 1u << 20;
constexpr size_t al256(size_t x) { return (x + 255) & ~(size_t)255; }
constexpr size_t WS_CTL = 0, CTL_BYTES = 1 * MiB;
constexpr int CW_BAR = 0;
constexpr int CW_CNT = 4096;
constexpr size_t WS_MOD   = WS_CTL + CTL_BYTES;
constexpr size_t WS_WIN   = al256(WS_MOD + (size_t)2 * 3 * MODW * 4);
constexpr size_t WS_WOUT  = al256(WS_WIN + (size_t)2 * LDP * D * 2);
constexpr size_t WS_GU    = al256(WS_WOUT + (size_t)2 * D * D * 2);
constexpr size_t WS_DN    = al256(WS_GU + (size_t)2 * NE1 * 1024 * D);
constexpr size_t WS_GLU   = al256(WS_DN + (size_t)2 * NE1 * D * FF);
constexpr size_t WS_RWT   = al256(WS_GLU + (size_t)2 * 512 * 512 * 2);
constexpr size_t WS_ROPE  = al256(WS_RWT + (size_t)2 * 64 * D * 4);
constexpr size_t ROPE_SINR = (size_t)SEQ * 64 * 4, ROPE_COSD = 2 * ROPE_SINR, ROPE_SIND = ROPE_COSD + (size_t)SEQ * 32 * 4, ROPE_BYTES = ROPE_SIND + (size_t)SEQ * 32 * 4;
constexpr size_t WS_S5A   = al256(WS_ROPE + ROPE_BYTES);
constexpr size_t S5A_N = (size_t)2 * 2 * 32 * 64;
constexpr size_t WS_S5BF  = al256(WS_S5A + 3 * S5A_N * 8);
constexpr size_t WS_S5CF  = al256(WS_S5BF + (size_t)2 * 2 * 32 * 2 * 2 * 512 * 2);
constexpr size_t WS_LIST  = al256(WS_S5CF + (size_t)2 * 32 * 4 * 512 * 2);
constexpr size_t WS_TKE   = al256(WS_LIST + (size_t)NE1 * TALL * 4);
constexpr size_t WS_TKP   = al256(WS_TKE + (size_t)TALL * 8 * 4);
constexpr size_t WS_TKW   = al256(WS_TKP + (size_t)TALL * 8 * 4);
constexpr size_t WS_X     = al256(WS_TKW + (size_t)TALL * 8 * 4);
constexpr size_t WS_H     = al256(WS_X + (size_t)TALL * D * 4);
constexpr size_t WS_H8    = al256(WS_H + (size_t)TALL * D * 2);
constexpr size_t WS_R     = al256(WS_H8 + (size_t)TALL * D);
constexpr size_t WS_P     = WS_R;
constexpr size_t WS_MIX   = al256(WS_P + (size_t)TALL * LDP * 2);
constexpr size_t WS_KVT   = al256(WS_MIX + (size_t)TALL * D * 2);
constexpr size_t WS_ST    = al256(WS_KVT + (size_t)16 * NCH128 * 16384 * 4);
constexpr size_t WS_S5E   = al256(WS_ST + (size_t)16 * NCH128 * 16384 * 2);
constexpr size_t WS_S5X   = al256(WS_S5E + (size_t)4 * NCH32 * 2048 * 8);
constexpr size_t WS_Q8    = al256(WS_S5X + (size_t)4 * NCH32 * 2048 * 8);
constexpr size_t WS_K8    = al256(WS_Q8 + (size_t)TALL * 1024);
constexpr size_t WS_V8T   = al256(WS_K8 + (size_t)TALL * 1024);
constexpr size_t WS_MIXEND = al256(WS_V8T + (size_t)TALL * 1024);
constexpr int HID_ROWS = TALL * 9 + NE1 * 256, Y_ROWS = TALL * 8 + NEXP * 256;
constexpr size_t WS_HID   = WS_R;
constexpr size_t WS_Y     = al256(WS_HID + (size_t)HID_ROWS * FF);
constexpr size_t WS_MOEEND = al256(WS_Y + (size_t)Y_ROWS * D * 2);
constexpr size_t WS_END = WS_MOEEND > WS_MIXEND ? WS_MOEEND : WS_MIXEND;

__device__ __forceinline__ unsigned f2bf(float f) { unsigned u = __builtin_bit_cast(unsigned, f); return (u + 0x7fffu + ((u >> 16) & 1u)) >> 16; }
__device__ __forceinline__ float bf2f(unsigned h) { return __builtin_bit_cast(float, h << 16); }
typedef __bf16 bf16x2_t __attribute__((ext_vector_type(2)));
__device__ __forceinline__ unsigned pk2(float lo, float hi) { const f32x2 v = {lo, hi}; const bf16x2_t b = __builtin_convertvector(v, bf16x2_t); return __builtin_bit_cast(unsigned, b); }
__device__ __forceinline__ unsigned pk4_fp8(float a, float b, float c, float d) {
    a = fminf(fmaxf(a, -448.f), 448.f); b = fminf(fmaxf(b, -448.f), 448.f); c = fminf(fmaxf(c, -448.f), 448.f); d = fminf(fmaxf(d, -448.f), 448.f);
    int w = 0; w = __builtin_amdgcn_cvt_pk_fp8_f32(a, b, w, false); w = __builtin_amdgcn_cvt_pk_fp8_f32(c, d, w, true); return (unsigned)w; }
__device__ __forceinline__ unsigned pk4_fp8_nc(float a, float b, float c, float d) { int w = 0; w = __builtin_amdgcn_cvt_pk_fp8_f32(a, b, w, false); w = __builtin_amdgcn_cvt_pk_fp8_f32(c, d, w, true); return (unsigned)w; }
constexpr float SC_H8 = 8.f, SC_HID = 8.f, SC_GU = 64.f, SC_DN = 32.f, SC_WIN = 64.f, SC_Y = 16.f, SC_Q8 = 32.f, SC_K8 = 8.f, SC_V8 = 8.f;
constexpr float SC_MIX = 8.f, SC_WOUT = 64.f; constexpr int E8_MIX = 127 - 3, E8_WOUT = 127 - 6;
constexpr int E8_H8 = 127 - 3, E8_HID = 127 - 3, E8_GU = 127 - 6, E8_DN = 127 - 5, E8_WIN = 127 - 6, E8_Q8 = 127 - 5, E8_K8 = 127 - 3, E8_V8 = 127 - 3;
__device__ __forceinline__ float bflo(unsigned w) { return __builtin_bit_cast(float, w << 16); }
__device__ __forceinline__ float bfhi(unsigned w) { return __builtin_bit_cast(float, w & 0xffff0000u); }
__device__ __forceinline__ f32x4 ld_bf16x4(const bf16_t* p) { const u32x2 w = *(const u32x2*)p; f32x4 r; r[0] = bflo(w.x); r[1] = bfhi(w.x); r[2] = bflo(w.y); r[3] = bfhi(w.y); return r; }
__device__ __forceinline__ float wave_sum(float v) {
#pragma unroll
    for (int o = 1; o < 64; o <<= 1) v += __shfl_xor(v, o);
    return v;
}
__device__ __forceinline__ float opaque_zero() { float z = 0.f; asm volatile("" : "+v"(z)); return z; }
__device__ __forceinline__ float fast_exp2(float x) { return __builtin_amdgcn_exp2f(x); }
__device__ __forceinline__ float fast_rcp(float x) { return __builtin_amdgcn_rcpf(x); }
__device__ __forceinline__ float sigmoidf_(float x) { return fast_rcp(1.0f + fast_exp2(-x * LOG2E)); }
__device__ __forceinline__ float siluf_(float x) { return x * sigmoidf_(x); }
__device__ __forceinline__ float gelu_tanh(float x) {
    const float u = 0.7978845608028654f * (x + 0.044715f * x * x * x);
    return x * sigmoidf_(2.0f * u);
}
__device__ __forceinline__ unsigned offb_key(unsigned row) { return ((row & 3u) << 2) | ((row >> 2) & 3u); }
__device__ __forceinline__ unsigned off_b(unsigned row, unsigned ch) { return 256u * row + 16u * (ch ^ offb_key(row)); }
__device__ __forceinline__ int mod_index(int row) { const int b = row / SEQU, pos = row - b * SEQU; return pos < CTX ? 2 : b; }

#define XB_TMO      128
#define XB_XCNT(j)  (256  + 64 * (j))
#define XB_XSUB(j)  (1280 + 64 * (j))
#define XB_XGEN(j)  (2304 + 64 * (j))
#define XB_TOP      3328
#define XB_TOPGEN   3392
#define XCD_BAR_WORDS 3456
#define XB_SPIN_CAP (1u << 22)
__device__ __forceinline__ unsigned xb_ld(unsigned* p)              { return __hip_atomic_load(p, __ATOMIC_RELAXED, __HIP_MEMORY_SCOPE_AGENT); }
__device__ __forceinline__ unsigned xb_add(unsigned* p, unsigned v) { return __hip_atomic_fetch_add(p, v, __ATOMIC_RELAXED, __HIP_MEMORY_SCOPE_AGENT); }
__device__ __forceinline__ unsigned xb_xcc_id() { return (unsigned)__builtin_amdgcn_s_getreg((3 << 11) | 20) & 0xFu; }
#define XB_SPIN(cond, bar) do { unsigned _sp = 0; while (cond) { __builtin_amdgcn_s_sleep(1); \
    if ((++_sp & 255u) == 0u) { if (xb_ld(&(bar)[XB_TMO])) break; if (_sp > XB_SPIN_CAP) { atomicAdd(&(bar)[XB_TMO], 1u); break; } } } } while (0)
struct XcdBarrier { unsigned* bar; unsigned x; volatile LAS unsigned* st; };
__device__ __forceinline__ XcdBarrier xcd_barrier_post(unsigned* bar, volatile LAS unsigned* st) {
    XcdBarrier b; b.bar = bar; b.x = xb_xcc_id(); b.st = st;
    if (threadIdx.x == 0) (void)xb_add(&bar[XB_XCNT(b.x)], 1u);
    return b;
}
__device__ __forceinline__ void xcd_barrier_complete(unsigned* bar, unsigned x, unsigned& nloc, unsigned& nx) {
    const unsigned G = gridDim.x * gridDim.y * gridDim.z;
    unsigned sum, cnt, mine, sp = 0u;
    for (;;) {
        sum = 0u; cnt = 0u; mine = 0u;
#pragma unroll
        for (unsigned j = 0; j < 16; ++j) { const unsigned c = xb_ld(&bar[XB_XCNT(j)]); sum += c; cnt += (c > 0u) ? 1u : 0u; mine = (j == x) ? c : mine; }
        if (sum == G) break;
        __builtin_amdgcn_s_sleep(1);
        if ((++sp & 255u) == 0u) { if (xb_ld(&bar[XB_TMO])) break; if (sp > XB_SPIN_CAP) { atomicAdd(&bar[XB_TMO], 1u); break; } }
    }
    nloc = mine > 0u ? mine : 1u; nx = cnt > 0u ? cnt : 1u;
}
__device__ __forceinline__ void xcd_barrier(const XcdBarrier& b) {
    asm volatile("s_waitcnt vmcnt(0)" ::: "memory");
    __syncthreads();
    if (threadIdx.x == 0) {
        unsigned* bar = b.bar;
        __builtin_amdgcn_s_waitcnt(0);
        unsigned nloc = b.st[0], nx = b.st[1];
        if (nloc == 0u) { xcd_barrier_complete(bar, b.x, nloc, nx); b.st[0] = nloc; b.st[1] = nx; }
        const unsigned old = xb_add(&bar[XB_XSUB(b.x)], 1u);
        const unsigned gen = old / nloc;
        if (old + 1u == (gen + 1u) * nloc) {
            __builtin_amdgcn_fence(__ATOMIC_RELEASE, "agent");
            asm volatile("s_waitcnt vmcnt(0)" ::: "memory");
            const unsigned og = xb_add(&bar[XB_TOP], 1u);
            const unsigned tg = og / nx;
            if (og + 1u == (tg + 1u) * nx) xb_add(&bar[XB_TOPGEN], 1u);
            else XB_SPIN(xb_ld(&bar[XB_TOPGEN]) == tg, bar);
            __builtin_amdgcn_fence(__ATOMIC_ACQUIRE, "agent");
            xb_add(&bar[XB_XGEN(b.x)], 1u);
            asm volatile("s_waitcnt vmcnt(0)" ::: "memory");
        } else {
            XB_SPIN(xb_ld(&bar[XB_XGEN(b.x)]) == gen, bar);
            __builtin_amdgcn_fence(__ATOMIC_ACQUIRE, "agent");
            asm volatile("s_waitcnt vmcnt(0)" ::: "memory");
        }
    }
    __syncthreads();
}

struct Args {
    const float *x, *c, *ctx, *c_ctx, *w_ada, *b_ada, *norm1_w, *norm2_w, *w_in, *ret_decay, *ret_norm_w, *dq_w, *dk_w, *dlam, *dsub_w;
    const float *s5_lre, *s5_lim, *s5_logdt, *s5_bre, *s5_bim, *s5_cre, *s5_cim, *s5_d, *s5_glu, *w_out, *router_w, *router_b;
    const float *e_gate, *e_up, *e_down, *s_gate, *s_up, *s_down;
    float* out; unsigned char* ws;
};

__device__ __forceinline__ void adaln_unit(const Args& A, float* MOD, LAS unsigned char* lds, int l, int cc) {
    LAS float* s = (LAS float*)lds;
    LAS f32x4* red = (LAS f32x4*)(lds + 3 * 2048 * 4);
    const int tid = threadIdx.x;
    for (int i = tid; i < 3 * D; i += NTHR) { const int r = i / D, k = i - r * D; const float v = r < 2 ? A.c[r * D + k] : A.c_ctx[k]; s[i] = siluf_(v); }
    __syncthreads();
    const int kq = tid >> 5, cq = tid & 31, col = cc * 128 + 4 * cq;
    f32x4 a0 = {0, 0, 0, 0}, a1 = a0, a2 = a0;
    const float* wp = A.w_ada + ((size_t)l * D + kq * 128) * MODW + col;
#pragma unroll 8
    for (int k = 0; k < 128; ++k) { const f32x4 w = *(const f32x4*)(wp + (size_t)k * MODW); const int kk = kq * 128 + k; a0 += s[kk] * w; a1 += s[D + kk] * w; a2 += s[2 * D + kk] * w; }
    red[(kq * 3 + 0) * 32 + cq] = a0; red[(kq * 3 + 1) * 32 + cq] = a1; red[(kq * 3 + 2) * 32 + cq] = a2;
    __syncthreads();
    if (tid < 96) { const int r = tid >> 5, c2 = tid & 31; f32x4 t = *(const f32x4*)(A.b_ada + (size_t)l * MODW + cc * 128 + 4 * c2);
        for (int q = 0; q < 16; ++q) t += red[(q * 3 + r) * 32 + c2];
        *(f32x4*)(MOD + ((size_t)l * 3 + r) * MODW + cc * 128 + 4 * c2) = t; }
    __syncthreads();
}

enum { MAP_IDENT = 0, MAP_PERM32 = 1, MAP_RETQK = 2, MAP_DIFFQK = 3, MAP_GLUFRAG = 4, MAP_PERM16 = 5 };
__device__ __forceinline__ int src_col(int kind, int rho) {
    const int bj = rho >> 7, wc = (rho >> 5) & 3, n = (rho >> 4) & 1, i = rho & 15;
    if (kind == MAP_PERM32) return 128 * bj + 32 * wc + 8 * (i >> 2) + 4 * n + (i & 3);
    if (kind == MAP_PERM16) return 64 * wc + 16 * (i >> 2) + 8 * bj + 4 * n + (i & 3);
    if (kind == MAP_RETQK)  return 128 * bj + 64 * n + 16 * wc + i;
    if (kind == MAP_DIFFQK) return 64 * wc + 32 * bj + 8 * (i >> 2) + 4 * n + (i & 3);
    return rho;
}
struct CvD { const float* sa; const float* sb; unsigned char* dst; int ld, K, drow0, k0, kind; float sc; };
__device__ __forceinline__ void conv_load(const CvD& d, f32x4 (&v)[16], int tid) {
#pragma unroll
    for (int i = 0; i < 16; ++i) { const int idx = tid + NTHR * i, row = idx >> 6, col = 4 * (idx & 63);
        v[i] = *(const f32x4*)((col < 128 ? d.sa + col : d.sb + (col - 128)) + (size_t)(d.k0 + row) * d.ld); }
}
__device__ __forceinline__ void conv_put(const f32x4 (&v)[16], LAS float* T, int tid) {
#pragma unroll
    for (int i = 0; i < 16; ++i) { const int idx = tid + NTHR * i, row = idx >> 6, col = 4 * (idx & 63); LAS float* tp = T + row * 257 + col; tp[0] = v[i][0]; tp[1] = v[i][1]; tp[2] = v[i][2]; tp[3] = v[i][3]; }
}
__device__ __forceinline__ void conv_out(const CvD& d, const LAS float* T, int tid) {
    const int K = d.K, kind = d.kind; const float fp8scale = d.sc;
    if (fp8scale > 0.f) {
        unsigned char* d8 = d.dst;
#pragma unroll
        for (int i = 0; i < 4; ++i) { const int idx = tid + NTHR * i, rho = idx >> 3, kg = idx & 7, sc = src_col(kind, rho);
            const LAS float* tp = T + (16 * kg) * 257 + sc; u32x4 w;
            w.x = pk4_fp8(tp[0] * fp8scale, tp[257] * fp8scale, tp[2 * 257] * fp8scale, tp[3 * 257] * fp8scale); w.y = pk4_fp8(tp[4 * 257] * fp8scale, tp[5 * 257] * fp8scale, tp[6 * 257] * fp8scale, tp[7 * 257] * fp8scale);
            w.z = pk4_fp8(tp[8 * 257] * fp8scale, tp[9 * 257] * fp8scale, tp[10 * 257] * fp8scale, tp[11 * 257] * fp8scale); w.w = pk4_fp8(tp[12 * 257] * fp8scale, tp[13 * 257] * fp8scale, tp[14 * 257] * fp8scale, tp[15 * 257] * fp8scale);
            *(u32x4*)(d8 + (size_t)(d.drow0 + rho) * K + d.k0 + 16 * kg) = w; }
        return; }
    bf16_t* dst = (bf16_t*)d.dst;
#pragma unroll
    for (int i = 0; i < 8; ++i) { const int idx = tid + NTHR * i, rho = idx >> 4, ko = idx & 15, sc = src_col(kind, rho);
        const LAS float* tp = T + (8 * ko) * 257 + sc;
        u32x4 w; w.x = pk2(tp[0], tp[257]); w.y = pk2(tp[2 * 257], tp[3 * 257]); w.z = pk2(tp[4 * 257], tp[5 * 257]); w.w = pk2(tp[6 * 257], tp[7 * 257]);
        if (kind == MAP_GLUFRAG) { const int n = d.drow0 + rho, k8 = (d.k0 >> 3) + ko;
            *(u32x4*)(dst + ((size_t)(((((n >> 6) * 2 + ((n >> 5) & 1)) * 32 + (k8 >> 1)) * 2 + (k8 & 1)) * 32 + (n & 31)) << 3)) = w; }
        else *(u32x4*)(dst + (size_t)(d.drow0 + rho) * K + d.k0 + 8 * ko) = w; }
}
constexpr int CV_WIN = 352, CV_WOUT = 128, CV_EGU = 64 * 64, CV_EDN = 64 * 32, CV_SGU = 64, CV_SDN = 32, CV_GLU = 8;
constexpr int CV_PER_LAYER = CV_WIN + CV_WOUT + CV_EGU + CV_EDN + CV_SGU + CV_SDN + CV_GLU;
__device__ __forceinline__ CvD conv_desc(const Args& A, int u) {
    const int l = u / CV_PER_LAYER; int v = u - l * CV_PER_LAYER;
    unsigned char* ws = A.ws; CvD d;
    if (v < CV_WIN) { const int nb = v % 22, kb = v / 22; d.kind = nb < 4 ? MAP_RETQK : (nb >= 8 && nb < 16) ? MAP_DIFFQK : MAP_PERM32;
        d.sa = A.w_in + (size_t)l * D * LDP + 256 * nb; d.sb = d.sa + 128; d.ld = LDP; d.dst = ws + WS_WIN + (size_t)l * LDP * D; d.K = D; d.drow0 = 256 * nb; d.k0 = 128 * kb; d.sc = SC_WIN; return d; }
    v -= CV_WIN;
    if (v < CV_WOUT) { const int nb = v & 7, kb = v >> 3; d.sa = A.w_out + (size_t)l * D * D + 256 * nb; d.sb = d.sa + 128; d.ld = D; d.dst = ws + WS_WOUT + (size_t)l * D * D; d.K = D; d.drow0 = 256 * nb; d.k0 = 128 * kb;
        d.kind = MAP_PERM16; d.sc = SC_WOUT; return d; }
    v -= CV_WOUT;
    if (v < CV_EGU) { const int e = v >> 6, r = v & 63, nb = r & 3, kb = r >> 2;
        d.sa = A.e_gate + ((size_t)l * NEXP + e) * D * FF + 128 * nb; d.sb = A.e_up + ((size_t)l * NEXP + e) * D * FF + 128 * nb; d.ld = FF; d.dst = ws + WS_GU + ((size_t)l * NE1 + e) * 1024 * D; d.K = D; d.drow0 = 256 * nb; d.k0 = 128 * kb;
        d.kind = MAP_PERM32; d.sc = SC_GU; return d; }
    v -= CV_EGU;
    if (v < CV_EDN) { const int e = v >> 5, r = v & 31, nb = r & 7, kb = r >> 3; d.sa = A.e_down + ((size_t)l * NEXP + e) * FF * D + 256 * nb; d.sb = d.sa + 128; d.ld = D; d.dst = ws + WS_DN + ((size_t)l * NE1 + e) * D * FF; d.K = FF; d.drow0 = 256 * nb; d.k0 = 128 * kb;
        d.kind = MAP_PERM16; d.sc = SC_DN; return d; }
    v -= CV_EDN;
    if (v < CV_SGU) { const int nb = v & 3, kb = v >> 2;
        d.sa = A.s_gate + (size_t)l * D * FF + 128 * nb; d.sb = A.s_up + (size_t)l * D * FF + 128 * nb; d.ld = FF; d.dst = ws + WS_GU + ((size_t)l * NE1 + NEXP) * 1024 * D; d.K = D; d.drow0 = 256 * nb; d.k0 = 128 * kb;
        d.kind = MAP_PERM32; d.sc = SC_GU; return d; }
    v -= CV_SGU;
    if (v < CV_SDN) { const int nb = v & 7, kb = v >> 3; d.sa = A.s_down + (size_t)l * FF * D + 256 * nb; d.sb = d.sa + 128; d.ld = D; d.dst = ws + WS_DN + ((size_t)l * NE1 + NEXP) * D * FF; d.K = FF; d.drow0 = 256 * nb; d.k0 = 128 * kb;
        d.kind = MAP_PERM16; d.sc = SC_DN; return d; }
    v -= CV_SDN;
    { const int nb = v & 1, kb = v >> 1; d.sa = A.s5_glu + (size_t)l * 512 * 512 + 256 * nb; d.sb = d.sa + 128; d.ld = 512; d.dst = ws + WS_GLU + (size_t)l * 512 * 512 * 2; d.K = 512; d.drow0 = 256 * nb; d.k0 = 128 * kb; d.kind = MAP_GLUFRAG; d.sc = 0.f; }
    return d;
}
__device__ __forceinline__ void conv_range(const Args& A, int u0, int u1, LAS unsigned char* lds) {
    if (u0 >= u1) return;
    LAS float* T = (LAS float*)lds; const int tid = threadIdx.x;
    CvD cur = conv_desc(A, u0); f32x4 v[16]; conv_load(cur, v, tid);
    for (int u = u0; u < u1; ++u) {
        __syncthreads();
        conv_put(v, T, tid);
        __syncthreads();
        CvD nxt = cur;
        if (u + 1 < u1) { nxt = conv_desc(A, u + 1); conv_load(nxt, v, tid); }
        conv_out(cur, T, tid);
        cur = nxt;
    }
    __syncthreads();
}
__device__ __forceinline__ void conv_dispatch(const Args& A, int u, LAS unsigned char* lds) { conv_range(A, u, u + 1, lds); }

__device__ __forceinline__ void cs_rev(double rev, float& c, float& s) {
    const float fr = (float)(rev - __builtin_floor(rev)); c = __builtin_amdgcn_cosf(fr); s = __builtin_amdgcn_sinf(fr);
}
__device__ __forceinline__ void tables_phase(const Args& A, int gtid, int gn) {
    unsigned char* ws = A.ws;
    float* cosR = (float*)(ws + WS_ROPE); float* sinR = (float*)(ws + WS_ROPE + ROPE_SINR); float* cosD = (float*)(ws + WS_ROPE + ROPE_COSD); float* sinD = (float*)(ws + WS_ROPE + ROPE_SIND);
    const double INV2PI = 0.15915494309189535;
    for (int i = gtid; i < SEQ * 64; i += gn) { const int t = i >> 6, j = i & 63, jj = j & 31; const int pos = j < 32 ? (t >> 6) : (t & 63);
        const float f = fast_exp2(-(float)(2 * jj) * (1.0f / 64.0f) * 13.287712379549449f);
        float c, s; cs_rev((double)pos * (double)f * INV2PI, c, s); cosR[i] = c; sinR[i] = s; }
    for (int i = gtid; i < SEQ * 32; i += gn) { const int t = i >> 5, j = i & 31, jj = j & 15; const int pos = j < 16 ? (t >> 6) : (t & 63);
        const float f = fast_exp2(-(float)(2 * jj) * (1.0f / 32.0f) * 13.287712379549449f);
        float c, s; cs_rev((double)pos * (double)f * INV2PI, c, s); cosD[i] = c; sinD[i] = s; }
    float* rwt = (float*)(ws + WS_RWT);
    { unsigned short* rwh = (unsigned short*)rwt; unsigned short* rwl = rwh + (size_t)2 * NEXP * D;
      for (int i = gtid; i < 2 * D * NEXP; i += gn) { const int l = i / (D * NEXP), r = i - l * D * NEXP, k = r >> 6, e = r & 63; const float v = A.router_w[i];
          const unsigned hw = pk2(v, 0.f) & 0xffffu; const float hi = __builtin_bit_cast(float, hw << 16); const unsigned lw = pk2(v - hi, 0.f) & 0xffffu;
          const size_t o = (size_t)l * NEXP * D + ((size_t)(((((e >> 5) * 128 + (k >> 4)) * 2 + ((k >> 3) & 1)) * 32 + (e & 31)) << 3)) + (k & 7);
          rwh[o] = (unsigned short)hw; rwl[o] = (unsigned short)lw; } }
    int* list64 = (int*)(ws + WS_LIST) + (size_t)NEXP * TALL;
    for (int i = gtid; i < TALL; i += gn) list64[i] = i;
    f32x2* SA = (f32x2*)(ws + WS_S5A); bf16_t* BF = (bf16_t*)(ws + WS_S5BF); bf16_t* CF = (bf16_t*)(ws + WS_S5CF);
    for (int i = gtid; i < 2 * 2 * 32 * 64; i += gn) {
        const int p = i & 63, g = (i >> 6) & 31, d = (i >> 11) & 1, l = i >> 12;
        const float dt = fast_exp2(A.s5_logdt[(l * 2 + d) * 32 + g] * LOG2E);
        const float lr = A.s5_lre[i], li = A.s5_lim[i];
        const float mag = fast_exp2(lr * dt * LOG2E);
        float c, s; cs_rev((double)li * (double)dt * INV2PI, c, s);
        const float ar = mag * c, ai = mag * s;
        float pr = ar, pi = ai;
#pragma unroll
        for (int q = 0; q < 4; ++q) { const float nr = pr * pr - pi * pi, ni = 2.f * pr * pi; pr = nr; pi = ni; }
        const float a16r = pr, a16i = pi; const float a32r = pr * pr - pi * pi, a32i = 2.f * pr * pi;
        SA[i] = (f32x2){ar, ai}; SA[S5A_N + i] = (f32x2){a16r, a16i}; SA[2 * S5A_N + i] = (f32x2){a32r, a32i};
        const float den = lr * lr + li * li, nr = ar - 1.0f;
        const float fre = (nr * lr + ai * li) / den, fim = (ai * lr - nr * li) / den;
        const int pb = p >> 5, pl = p & 31;
        const float* bre = A.s5_bre + (((size_t)l * 32 + g) * 64 + p) * 16; const float* bim = A.s5_bim + (((size_t)l * 32 + g) * 64 + p) * 16;
        bf16_t* bf_re = BF + ((((size_t)(l * 2 + d) * 32 + g) * 2 + pb) * 2 + 0) * 512; bf16_t* bf_im = bf_re + 512;
        for (int h = 0; h < 16; ++h) { const float br = bre[h], bi = bim[h]; const int lane = (h >> 3) * 32 + pl, j = h & 7;
            bf_re[lane * 8 + j] = (bf16_t)f2bf(fre * br - fim * bi); bf_im[lane * 8 + j] = (bf16_t)f2bf(fre * bi + fim * br); }
        if (d == 0) {
            for (int reim = 0; reim < 2; ++reim) { const int k = 2 * p + reim, ks = k >> 5, kq = (k >> 3) & 3, j = k & 7;
                for (int hp = 0; hp < 16; ++hp) { const size_t ci = (((size_t)l * 32 + g) * 16 + hp) * 64 + p; const float v = reim ? -A.s5_cim[ci] : A.s5_cre[ci];
                    CF[(((size_t)l * 32 + g) * 4 + ks) * 512 + (kq * 16 + hp) * 8 + j] = (bf16_t)f2bf(v); } }
        }
    }
}

__device__ __forceinline__ const float* in_row(const float* xlat, const float* xctx, int row) {
    const int b = row / SEQU, pos = row - b * SEQU; return pos < CTX ? xctx + ((size_t)b * CTX + pos) * D : xlat + ((size_t)b * SEQ + (pos - CTX)) * D;
}
__device__ __forceinline__ void modnorm_row(const float* xr, const float* nw, const float* sh, const float* sc, bf16_t* hrow, int lane) {
    f32x4 v[8]; float ss = 0.f;
#pragma unroll
    for (int i = 0; i < 8; ++i) { v[i] = *(const f32x4*)(xr + 4 * (lane + 64 * i)); ss += v[i][0] * v[i][0] + v[i][1] * v[i][1] + v[i][2] * v[i][2] + v[i][3] * v[i][3]; }
    ss = wave_sum(ss); const float rstd = __builtin_amdgcn_rsqf(ss * (1.0f / D) + EPS);
#pragma unroll
    for (int i = 0; i < 8; ++i) { const int c = 4 * (lane + 64 * i); const f32x4 w = *(const f32x4*)(nw + c), s1 = *(const f32x4*)(sc + c), s0 = *(const f32x4*)(sh + c);
        const f32x4 o = (v[i] * rstd * w * (1.0f + s1) + s0) * SC_H8; *(unsigned*)((unsigned char*)hrow + c) = pk4_fp8(o[0], o[1], o[2], o[3]); }
}

namespace pg8 {
constexpr int BM = 256, BK = 64, HALF = 128, HTB = HALF * BK * 2, STAGE_BYTES = 8 * HTB, NXCD = 8, WGM = 8;
__device__ __forceinline__ int lds_byte(int r, int c) { const int st = (r >> 4) * 2 + (c >> 5), rr = r & 15, cc = c & 31, ob = rr * 64 + cc * 2; return st * 1024 + (ob ^ (((ob >> 9) & 1) << 5)); }
__device__ __forceinline__ void stage_rc(int b, int& R, int& C) { const int st = b / 1024, sb = b % 1024, swz = sb ^ (((sb >> 9) & 1) << 5); R = (st >> 1) * 16 + swz / 64; C = (st & 1) * 32 + (swz % 64) / 2; }

struct UnitD {
    const char* A;
    const char* B;
    unsigned ao[2][2];
    int pm, pn, e, row0;
};

template <class Epi, class Sched>
__device__ __forceinline__ void gemm_phase(LAS unsigned char* lds, const int K, const Sched& S, const Epi& E) {
    const int tid = threadIdx.x, wid = __builtin_amdgcn_readfirstlane(tid >> 6), lane = tid & 63, wr = wid >> 2, wc = wid & 3, fr = lane & 15, fq = lane >> 4;
    const int nt = K / BK;
    unsigned voffB[2];
#pragma unroll
    for (int i = 0; i < 2; ++i) { int R, C; stage_rc(tid * 16 + i * 8192, R, C); voffB[i] = (unsigned)(R * K + C) * 2u; }
    const size_t kstep = (size_t)(BK * 2);
    const size_t hstep = (size_t)HALF * K * 2;
    const unsigned ldsw = (unsigned)wid * 1024u;
    const int aoff = lds_byte(wr * 64 + fr, fq * 8), boff = lds_byte(wc * 32 + fr, fq * 8);
#define PG8_SA(b, h) (((b) * 2 + (h)) * HTB)
#define PG8_SB(b, h) ((4 + (b) * 2 + (h)) * HTB)
#define PG8_STA(bufoff, U, h, kb) do { _Pragma("unroll") for (int _i = 0; _i < 2; ++_i) \
        __builtin_amdgcn_global_load_lds((const unsigned*)((U).A + (U).ao[h][_i] + (kb)), (LAS unsigned*)(lds + (bufoff) + ldsw + _i * 8192), 16, 0, 0); } while (0)
#define PG8_STB(bufoff, U, h, kb) do { _Pragma("unroll") for (int _i = 0; _i < 2; ++_i) \
        __builtin_amdgcn_global_load_lds((const unsigned*)((U).B + (h) * hstep + voffB[_i] + (kb)), (LAS unsigned*)(lds + (bufoff) + ldsw + _i * 8192), 16, 0, 0); } while (0)
#define PG8_LDA(dst, b, h) do { _Pragma("unroll") for (int m = 0; m < 4; ++m) _Pragma("unroll") for (int k = 0; k < 2; ++k) dst[m][k] = *(const LAS bf16x8*)(lds + PG8_SA(b, h) + aoff + m * 2048 + k * 1024); } while (0)
#define PG8_LDB(dst, b, h) do { _Pragma("unroll") for (int n = 0; n < 2; ++n) _Pragma("unroll") for (int k = 0; k < 2; ++k) dst[n][k] = *(const LAS bf16x8*)(lds + PG8_SB(b, h) + boff + n * 2048 + k * 1024); } while (0)
#define PG8_MMA(ai, bj, At, Bt) do { __builtin_amdgcn_s_setprio(1); _Pragma("unroll") for (int m = 0; m < 4; ++m) _Pragma("unroll") for (int n = 0; n < 2; ++n) _Pragma("unroll") for (int k = 0; k < 2; ++k) \
        acc[ai][bj][m][n] = __builtin_amdgcn_mfma_f32_16x16x32_bf16(Bt[n][k], At[m][k], acc[ai][bj][m][n], 0, 0, 0); __builtin_amdgcn_s_setprio(0); } while (0)
#define PG8_WAIT_V(n) asm volatile("s_waitcnt vmcnt(" #n ")" ::: "memory")
#define PG8_WAIT_L(n) asm volatile("s_waitcnt lgkmcnt(" #n ")" ::: "memory")
#define PG8_BAR __builtin_amdgcn_s_barrier()
#define PG8_SCHED __builtin_amdgcn_sched_barrier(0)
    UnitD cur, nxt; int ui = 0;
    if (!S.next(0, cur)) return;
    f32x4 acc[2][2][4][2];
#pragma unroll
    for (int a = 0; a < 2; ++a)
#pragma unroll
        for (int b = 0; b < 2; ++b)
#pragma unroll
            for (int m = 0; m < 4; ++m)
#pragma unroll
                for (int n = 0; n < 2; ++n) acc[a][b][m][n] = (f32x4){0.f, 0.f, 0.f, 0.f};
    bf16x8 At[4][2], B0[2][2], B1[2][2];
    PG8_STB(PG8_SB(0, 0), cur, 0, 0); PG8_STA(PG8_SA(0, 0), cur, 0, 0); PG8_STB(PG8_SB(0, 1), cur, 1, 0); PG8_STA(PG8_SA(0, 1), cur, 1, 0);
    if (wr == 1) PG8_BAR;
    PG8_WAIT_V(4); PG8_BAR;
    PG8_STB(PG8_SB(1, 0), cur, 0, kstep); PG8_STA(PG8_SA(1, 0), cur, 0, kstep); PG8_STB(PG8_SB(1, 1), cur, 1, kstep);
    PG8_WAIT_V(6); PG8_BAR;
    for (;;) {
        const bool has_next = S.next(ui + 1, nxt);
        if (!has_next) nxt = cur;
        for (int t = 0; t < nt; t += 2) {
            const bool last = (t == nt - 2);
            const size_t k1 = (size_t)(t + 1) * kstep;
            const size_t k2 = last ? (size_t)0 : (size_t)(t + 2) * kstep, k3 = k2 + kstep;
            UnitD w2; w2.A = cur.A; w2.B = last ? nxt.B : cur.B;
            w2.ao[0][0] = last ? nxt.ao[0][0] : cur.ao[0][0]; w2.ao[0][1] = last ? nxt.ao[0][1] : cur.ao[0][1];
            w2.ao[1][0] = last ? nxt.ao[1][0] : cur.ao[1][0]; w2.ao[1][1] = last ? nxt.ao[1][1] : cur.ao[1][1];
            PG8_LDB(B0, 0, 0); PG8_SCHED; PG8_LDA(At, 0, 0); PG8_STA(PG8_SA(1, 1), cur, 1, k1);
            PG8_WAIT_L(8); PG8_BAR; PG8_WAIT_L(0); PG8_MMA(0, 0, At, B0); PG8_BAR; PG8_SCHED;
            PG8_LDB(B1, 0, 1); PG8_STB(PG8_SB(0, 0), w2, 0, k2);
            PG8_BAR; PG8_WAIT_L(0); PG8_MMA(0, 1, At, B1); PG8_BAR;
            PG8_LDA(At, 0, 1); PG8_STA(PG8_SA(0, 0), w2, 0, k2);
            PG8_BAR; PG8_WAIT_L(0); PG8_MMA(1, 0, At, B0); PG8_BAR; PG8_SCHED;
            PG8_STB(PG8_SB(0, 1), w2, 1, k2);
            PG8_WAIT_V(6); PG8_BAR; PG8_MMA(1, 1, At, B1); PG8_BAR;
            PG8_LDB(B0, 1, 0); PG8_SCHED; PG8_LDA(At, 1, 0); PG8_STA(PG8_SA(0, 1), w2, 1, k2);
            PG8_WAIT_L(8); PG8_BAR; PG8_WAIT_L(0); PG8_MMA(0, 0, At, B0); PG8_BAR; PG8_SCHED;
            PG8_LDB(B1, 1, 1); PG8_STB(PG8_SB(1, 0), w2, 0, k3);
            PG8_BAR; PG8_WAIT_L(0); PG8_MMA(0, 1, At, B1); PG8_BAR;
            PG8_LDA(At, 1, 1); PG8_STA(PG8_SA(1, 0), w2, 0, k3);
            PG8_BAR; PG8_WAIT_L(0); PG8_MMA(1, 0, At, B0); PG8_BAR; PG8_SCHED;
            PG8_STB(PG8_SB(1, 1), w2, 1, k3);
            PG8_WAIT_V(6); PG8_BAR; PG8_MMA(1, 1, At, B1); PG8_BAR;
        }
        E(acc, cur, wr, wc, fr, fq);
        if (!has_next) break;
#pragma unroll
        for (int a = 0; a < 2; ++a)
#pragma unroll
            for (int b = 0; b < 2; ++b)
#pragma unroll
                for (int m = 0; m < 4; ++m)
#pragma unroll
                    for (int n = 0; n < 2; ++n) acc[a][b][m][n] = (f32x4){0.f, 0.f, 0.f, 0.f};
        cur = nxt; ++ui;
    }
    PG8_WAIT_V(0);
    if (wr == 0) PG8_BAR;
    PG8_BAR;
#undef PG8_SA
#undef PG8_SB
#undef PG8_STA
#undef PG8_STB
#undef PG8_LDA
#undef PG8_LDB
#undef PG8_MMA
#undef PG8_WAIT_V
#undef PG8_WAIT_L
#undef PG8_BAR
#undef PG8_SCHED
}

typedef int v8i __attribute__((ext_vector_type(8)));
typedef int v4i __attribute__((ext_vector_type(4)));
typedef v4i __attribute__((may_alias)) v4i_a;
template <class Epi, class Sched, bool FP8 = true>
__device__ __forceinline__ void gemm_phase8(LAS unsigned char* lds, const int K, const Sched& S, const Epi& E, int sclA = 127, int sclB = 127) {
    const int tid = threadIdx.x, wid = __builtin_amdgcn_readfirstlane(tid >> 6), lane = tid & 63, wr = wid >> 2, wc = wid & 3, fr = lane & 15, fq = lane >> 4;
    const int nt = K / BK;
    unsigned voffB[2];
#pragma unroll
    for (int i = 0; i < 2; ++i) { int R, C; stage_rc(tid * 16 + i * 8192, R, C); voffB[i] = (unsigned)(R * K + C) * 2u; }
    const size_t kstep = (size_t)(BK * 2);
    const size_t hstep = (size_t)HALF * K * 2;
    const unsigned ldsw = (unsigned)wid * 1024u;
    const int aoff = lds_byte(wr * 64 + fr, fq * 8), boff = lds_byte(wc * 32 + fr, fq * 8);
#define PG8_SA(b, h) (((b) * 2 + (h)) * HTB)
#define PG8_SB(b, h) ((4 + (b) * 2 + (h)) * HTB)
#define PG8_STA(bufoff, U, h, kb) do { _Pragma("unroll") for (int _i = 0; _i < 2; ++_i) \
        __builtin_amdgcn_global_load_lds((const unsigned*)((U).A + (U).ao[h][_i] + (kb)), (LAS unsigned*)(lds + (bufoff) + ldsw + _i * 8192), 16, 0, 0); } while (0)
#define PG8_STB(bufoff, U, h, kb) do { _Pragma("unroll") for (int _i = 0; _i < 2; ++_i) \
        __builtin_amdgcn_global_load_lds((const unsigned*)((U).B + (h) * hstep + voffB[_i] + (kb)), (LAS unsigned*)(lds + (bufoff) + ldsw + _i * 8192), 16, 0, 0); } while (0)
#define PG8_LDA(dst, b, h) do { _Pragma("unroll") for (int m = 0; m < 4; ++m) { dst[m].lo = *(const LAS v4i_a*)(lds + PG8_SA(b, h) + aoff + m * 2048); dst[m].hi = *(const LAS v4i_a*)(lds + PG8_SA(b, h) + aoff + m * 2048 + 1024); } } while (0)
#define PG8_LDB(dst, b, h) do { _Pragma("unroll") for (int n = 0; n < 2; ++n) { dst[n].lo = *(const LAS v4i_a*)(lds + PG8_SB(b, h) + boff + n * 2048); dst[n].hi = *(const LAS v4i_a*)(lds + PG8_SB(b, h) + boff + n * 2048 + 1024); } } while (0)
#define PG8_MMA(ai, bj, At, Bt) do { __builtin_amdgcn_s_setprio(1); _Pragma("unroll") for (int m = 0; m < 4; ++m) _Pragma("unroll") for (int n = 0; n < 2; ++n) { \
        if constexpr (FP8) asm volatile("v_mfma_scale_f32_16x16x128_f8f6f4 %0, %1, %2, %0, %3, %4 op_sel_hi:[0,0,0]" : "+v"(acc[ai][bj][m][n]) : "v"(Bt[n]), "v"(At[m]), "v"(vsclB), "v"(vsclA)); \
        else { acc[ai][bj][m][n] = __builtin_amdgcn_mfma_f32_16x16x32_bf16(__builtin_bit_cast(bf16x8, Bt[n].lo), __builtin_bit_cast(bf16x8, At[m].lo), acc[ai][bj][m][n], 0, 0, 0); \
               acc[ai][bj][m][n] = __builtin_amdgcn_mfma_f32_16x16x32_bf16(__builtin_bit_cast(bf16x8, Bt[n].hi), __builtin_bit_cast(bf16x8, At[m].hi), acc[ai][bj][m][n], 0, 0, 0); } } \
        __builtin_amdgcn_s_setprio(0); } while (0)
#define PG8_WAIT_V(n) asm volatile("s_waitcnt vmcnt(" #n ")" ::: "memory")
#define PG8_WAIT_L(n) asm volatile("s_waitcnt lgkmcnt(" #n ")" ::: "memory")
#define PG8_BAR __builtin_amdgcn_s_barrier()
#define PG8_SCHED __builtin_amdgcn_sched_barrier(0)
    int vsclA = sclA * 0x01010101, vsclB = sclB * 0x01010101;
    asm volatile("" : "+v"(vsclA), "+v"(vsclB));
    UnitD cur, nxt; int ui = 0;
    if (!S.next(0, cur)) return;
    f32x4 acc[2][2][4][2];
#pragma unroll
    for (int a = 0; a < 2; ++a)
#pragma unroll
        for (int b = 0; b < 2; ++b)
#pragma unroll
            for (int m = 0; m < 4; ++m)
#pragma unroll
                for (int n = 0; n < 2; ++n) acc[a][b][m][n] = (f32x4){0.f, 0.f, 0.f, 0.f};
    v8i At[4], B0[2], B1[2];
    PG8_STB(PG8_SB(0, 0), cur, 0, 0); PG8_STA(PG8_SA(0, 0), cur, 0, 0); PG8_STB(PG8_SB(0, 1), cur, 1, 0); PG8_STA(PG8_SA(0, 1), cur, 1, 0);
    if (wr == 1) PG8_BAR;
    PG8_WAIT_V(4); PG8_BAR;
    PG8_STB(PG8_SB(1, 0), cur, 0, kstep); PG8_STA(PG8_SA(1, 0), cur, 0, kstep); PG8_STB(PG8_SB(1, 1), cur, 1, kstep);
    PG8_WAIT_V(6); PG8_BAR;
    for (;;) {
        const bool has_next = S.next(ui + 1, nxt);
        if (!has_next) nxt = cur;
        for (int t = 0; t < nt; t += 2) {
            const bool last = (t == nt - 2);
            const size_t k1 = (size_t)(t + 1) * kstep;
            const size_t k2 = last ? (size_t)0 : (size_t)(t + 2) * kstep, k3 = k2 + kstep;
            UnitD w2; w2.A = cur.A; w2.B = last ? nxt.B : cur.B;
            w2.ao[0][0] = last ? nxt.ao[0][0] : cur.ao[0][0]; w2.ao[0][1] = last ? nxt.ao[0][1] : cur.ao[0][1];
            w2.ao[1][0] = last ? nxt.ao[1][0] : cur.ao[1][0]; w2.ao[1][1] = last ? nxt.ao[1][1] : cur.ao[1][1];
            PG8_LDB(B0, 0, 0); PG8_SCHED; PG8_LDA(At, 0, 0); PG8_STA(PG8_SA(1, 1), cur, 1, k1);
            PG8_WAIT_L(8); PG8_BAR; PG8_WAIT_L(0); PG8_MMA(0, 0, At, B0); PG8_BAR; PG8_SCHED;
            PG8_LDB(B1, 0, 1); PG8_STB(PG8_SB(0, 0), w2, 0, k2);
            PG8_BAR; PG8_WAIT_L(0); PG8_MMA(0, 1, At, B1); PG8_BAR;
            PG8_LDA(At, 0, 1); PG8_STA(PG8_SA(0, 0), w2, 0, k2);
            PG8_BAR; PG8_WAIT_L(0); PG8_MMA(1, 0, At, B0); PG8_BAR; PG8_SCHED;
            PG8_STB(PG8_SB(0, 1), w2, 1, k2);
            PG8_WAIT_V(6); PG8_BAR; PG8_MMA(1, 1, At, B1); PG8_BAR;
            PG8_LDB(B0, 1, 0); PG8_SCHED; PG8_LDA(At, 1, 0); PG8_STA(PG8_SA(0, 1), w2, 1, k2);
            PG8_WAIT_L(8); PG8_BAR; PG8_WAIT_L(0); PG8_MMA(0, 0, At, B0); PG8_BAR; PG8_SCHED;
            PG8_LDB(B1, 1, 1); PG8_STB(PG8_SB(1, 0), w2, 0, k3);
            PG8_BAR; PG8_WAIT_L(0); PG8_MMA(0, 1, At, B1); PG8_BAR;
            PG8_LDA(At, 1, 1); PG8_STA(PG8_SA(1, 0), w2, 0, k3);
            PG8_BAR; PG8_WAIT_L(0); PG8_MMA(1, 0, At, B0); PG8_BAR; PG8_SCHED;
            PG8_STB(PG8_SB(1, 1), w2, 1, k3);
            PG8_WAIT_V(6); PG8_BAR; PG8_MMA(1, 1, At, B1); PG8_BAR;
        }
        if constexpr (FP8) asm volatile("s_nop 15\n\ts_nop 15" ::: "memory");
        E(acc, cur, wr, wc, fr, fq);
        if (!has_next) break;
#pragma unroll
        for (int a = 0; a < 2; ++a)
#pragma unroll
            for (int b = 0; b < 2; ++b)
#pragma unroll
                for (int m = 0; m < 4; ++m)
#pragma unroll
                    for (int n = 0; n < 2; ++n) acc[a][b][m][n] = (f32x4){0.f, 0.f, 0.f, 0.f};
        cur = nxt; ++ui;
    }
    PG8_WAIT_V(0);
    if (wr == 0) PG8_BAR;
    PG8_BAR;
#undef PG8_SA
#undef PG8_SB
#undef PG8_STA
#undef PG8_STB
#undef PG8_LDA
#undef PG8_LDB
#undef PG8_MMA
#undef PG8_WAIT_V
#undef PG8_WAIT_L
#undef PG8_BAR
#undef PG8_SCHED
}

__device__ __forceinline__ void lin_offsets(UnitD& u, int row0, int K) {
#pragma unroll
    for (int i = 0; i < 2; ++i) { int R, C; stage_rc((int)threadIdx.x * 16 + i * 8192, R, C);
        u.ao[0][i] = (unsigned)(((size_t)(row0 + R) * K + C) * 2); u.ao[1][i] = (unsigned)(((size_t)(row0 + HALF + R) * K + C) * 2); }
}
}

using pg8::UnitD;
struct DenseSched {
    const char* A; const char* Bt; int nM, nN, K, G, c; bool skipctx = false;
    __device__ __forceinline__ bool next(int i, UnitD& u) const {
        const int nwg = nM * nN; const long L = (long)i * G + c; if (L >= nwg) return false;
        int wgid = (int)L; { const int q = nwg / 8, r = nwg % 8, xcd = wgid % 8, off = wgid / 8; wgid = (xcd < r ? xcd * (q + 1) : r * (q + 1) + (xcd - r) * q) + off; }
        const int nig = 8 * nN, gid = wgid / nig, fm = gid * 8, gsz = (nM - fm) < 8 ? (nM - fm) : 8;
        int pm = fm + ((wgid % nig) % gsz); const int pn = (wgid % nig) / gsz;
        if (skipctx) pm += 1 + (pm >= 32 ? 1 : 0);
        u.A = A; u.B = Bt + (size_t)pn * 256 * K * 2; pg8::lin_offsets(u, pm * 256, K); u.pm = pm; u.pn = pn; u.e = 0; u.row0 = pm * 256; return true;
    }
};
struct GroupSched {
    const char* A; const char* Bt; const int* list; const int* cnt; const LAS int* tileP; int NT, K, G, c; bool gather; size_t bstride;
    bool skipctx = false;
    __device__ __forceinline__ bool next(int i, UnitD& u) const {
        const int total = tileP[65] * NT; const long L = (long)i * G + c; if (L >= total) return false;
        const int tile = (int)(L / NT), tn = (int)(L % NT);
        int e = 0;
#pragma unroll
        for (int s = 64; s >= 1; s >>= 1) { if (e + s <= 64 && tileP[e + s] <= tile) e += s; }
        const int tm = tile - tileP[e];
        const int srt = skipctx ? tm + 1 + (tm >= 32 ? 1 : 0) : tm;
        u.A = A; u.B = Bt + (size_t)e * bstride + (size_t)tn * 256 * K * 2; u.pm = tm; u.pn = tn; u.e = e;
        if (gather) {
            const int ce = e == NEXP ? TALL : cnt[e]; const int* le = list + (size_t)e * TALL;
#pragma unroll
            for (int p = 0; p < 2; ++p) { int R, C; pg8::stage_rc((int)threadIdx.x * 16 + p * 8192, R, C);
#pragma unroll
                for (int h = 0; h < 2; ++h) { const int idx = tm * 256 + 128 * h + R; const int tok = e == NEXP ? srt * 256 + 128 * h + R : le[idx < ce ? idx : 0]; u.ao[h][p] = (unsigned)(((size_t)tok * K + C) * 2); } }
            u.row0 = 256 * tile;
        } else {
            pg8::lin_offsets(u, 256 * tile, K);
            u.row0 = e == NEXP ? srt * 256 : 256 * tile;
        }
        return true;
    }
};
__device__ __forceinline__ void build_tileP(const int* cnt, LAS int* tileP, int shared_tiles = TALL / 256) {
    if (threadIdx.x == 0) { int s = 0; for (int e = 0; e < NEXP; ++e) { tileP[e] = s; s += (cnt[e] + 255) >> 8; } tileP[64] = s; s += shared_tiles; tileP[65] = s; }
}

__device__ __forceinline__ void st_bf16x4(bf16_t* p, f32x4 v) { u32x2 w; w.x = pk2(v[0], v[1]); w.y = pk2(v[2], v[3]); *(u32x2*)p = w; }
__device__ __forceinline__ void st_bf16x8(bf16_t* p, f32x4 v0, f32x4 v1) { u32x4 w; w.x = pk2(v0[0], v0[1]); w.y = pk2(v0[2], v0[3]); w.z = pk2(v1[0], v1[1]); w.w = pk2(v1[2], v1[3]); *(u32x4*)p = w; }

constexpr float QSCALE = 0.125f * LOG2E;
struct EpiIn {
    bf16_t* P; const float *cosR, *sinR, *cosD, *sinD, *qw, *kw; unsigned char *Q8, *K8, *V8T;
    __device__ __forceinline__ void operator()(const f32x4 (&acc)[2][2][4][2], const UnitD& u, int wr, int wc, int fr, int fq) const {
        const int pn = u.pn, rbase = u.row0 + wr * 64 + fr;
        if (pn < 4) {
            const float scale = pn >= 2 ? 0.08838834764831845f : 1.0f; const int i0 = 16 * wc + 4 * fq;
#pragma unroll
            for (int ai = 0; ai < 2; ++ai)
#pragma unroll
                for (int m = 0; m < 4; ++m) { const int row = rbase + ai * 128 + m * 16, b = row / SEQU, pos = row - b * SEQU; const bool lat = pos >= CTX; const int t = lat ? pos - CTX : 0;
                    f32x4 c = {1.f, 1.f, 1.f, 1.f}, s = {0.f, 0.f, 0.f, 0.f};
                    if (lat) { c = *(const f32x4*)(cosR + (size_t)t * 64 + i0); s = *(const f32x4*)(sinR + (size_t)t * 64 + i0); }
                    c *= scale; s *= scale;
#pragma unroll
                    for (int bj = 0; bj < 2; ++bj) { const f32x4 x1 = acc[ai][bj][m][0], x2 = acc[ai][bj][m][1]; bf16_t* op = P + (size_t)row * LDP + 256 * pn + 128 * bj + i0;
                        st_bf16x4(op, x1 * c - x2 * s); st_bf16x4(op + 64, x1 * s + x2 * c); } }
        } else if (pn >= 8 && pn < 16) {
            const bool isq = pn < 12; const float* w = isq ? qw : kw; const int sh = 4 * (pn - (isq ? 8 : 12)) + wc;
            unsigned char* dst8 = Q8 + 64 * sh;
            const float os = isq ? QSCALE * SC_Q8 : SC_K8;
            f32x4 wv[2][2];
#pragma unroll
            for (int bj = 0; bj < 2; ++bj)
#pragma unroll
                for (int n = 0; n < 2; ++n) wv[bj][n] = *(const f32x4*)(w + 32 * bj + 8 * fq + 4 * n) * os;
#pragma unroll
            for (int ai = 0; ai < 2; ++ai)
#pragma unroll
                for (int m = 0; m < 4; ++m) { const int row = rbase + ai * 128 + m * 16, b = row / SEQU, pos = row - b * SEQU; const bool lat = pos >= CTX; const int t = lat ? pos - CTX : 0;
                    float ss = 0.f;
#pragma unroll
                    for (int bj = 0; bj < 2; ++bj)
#pragma unroll
                        for (int n = 0; n < 2; ++n) { const f32x4 v = acc[ai][bj][m][n]; ss += v[0] * v[0] + v[1] * v[1] + v[2] * v[2] + v[3] * v[3]; }
                    ss += __shfl_xor(ss, 16); ss += __shfl_xor(ss, 32);
                    const float rinv = __builtin_amdgcn_rsqf(ss * (1.0f / 64.0f) + EPS);
                    u32x2 w1, w2;
#pragma unroll
                    for (int n = 0; n < 2; ++n) { const int i0 = 8 * fq + 4 * n;
                        f32x4 c = {1.f, 1.f, 1.f, 1.f}, s = {0.f, 0.f, 0.f, 0.f};
                        if (lat) { c = *(const f32x4*)(cosD + (size_t)t * 32 + i0); s = *(const f32x4*)(sinD + (size_t)t * 32 + i0); }
                        const f32x4 x1 = acc[ai][0][m][n] * rinv * wv[0][n], x2 = acc[ai][1][m][n] * rinv * wv[1][n];
                        const f32x4 o1 = x1 * c - x2 * s, o2 = x1 * s + x2 * c;
                        const unsigned a1 = pk4_fp8(o1[0], o1[1], o1[2], o1[3]), a2 = pk4_fp8(o2[0], o2[1], o2[2], o2[3]);
                        if (n == 0) { w1.x = a1; w2.x = a2; } else { w1.y = a1; w2.y = a2; } }
                    unsigned char* op = isq ? dst8 + (size_t)row * 1024 + 8 * fq : K8 + ((((size_t)(b * 8 + (sh >> 1)) * SEQU + pos) << 7) + 64 * (sh & 1) + 8 * fq);
                    *(u32x2*)op = w1; *(u32x2*)(op + 32) = w2; }
        } else if (pn >= 16 && pn < 20) {
            const int lane = fr + 16 * fq, cq = lane & 3;
#pragma unroll
            for (int ai = 0; ai < 2; ++ai)
#pragma unroll
                for (int m = 0; m < 4; ++m) { const int row = rbase + ai * 128 + m * 16, b = row / SEQU, pos = row - b * SEQU, t = pos >> 6, kk4 = pos & 60;
                    const int off = 32 * ((kk4 >> 2) & 1) + 16 * (kk4 >> 5) + 4 * ((kk4 >> 3) & 3);
#pragma unroll
                    for (int bj = 0; bj < 2; ++bj) { const int head = 2 * (pn - 16) + bj;
#pragma unroll
                        for (int n = 0; n < 2; ++n) { const f32x4 v = acc[ai][bj][m][n] * SC_V8; const unsigned W = pk4_fp8(v[0], v[1], v[2], v[3]);
                            const unsigned w0 = __shfl(W, (lane & ~3) + 0), w1 = __shfl(W, (lane & ~3) + 1), w2 = __shfl(W, (lane & ~3) + 2), w3 = __shfl(W, (lane & ~3) + 3);
                            const unsigned sft = 8 * cq; const unsigned R = ((w0 >> sft) & 0xffu) | (((w1 >> sft) & 0xffu) << 8) | (((w2 >> sft) & 0xffu) << 16) | (((w3 >> sft) & 0xffu) << 24);
                            const int dv = 32 * wc + 8 * fq + 4 * n + cq;
                            *(unsigned*)(V8T + ((((size_t)(b * 8 + head) * (SEQU / 64) + t) * 128 + dv) << 6) + off) = R; } } }
        } else {
            const bool gate = (pn == 6 || pn == 7);
#pragma unroll
            for (int ai = 0; ai < 2; ++ai)
#pragma unroll
                for (int m = 0; m < 4; ++m) { const int row = rbase + ai * 128 + m * 16;
#pragma unroll
                    for (int bj = 0; bj < 2; ++bj) { f32x4 v0 = acc[ai][bj][m][0], v1 = acc[ai][bj][m][1];
                        if (gate) {
#pragma unroll
                            for (int j = 0; j < 4; ++j) { v0[j] = siluf_(v0[j]); v1[j] = siluf_(v1[j]); } }
                        st_bf16x8(P + (size_t)row * LDP + 256 * pn + 128 * bj + 32 * wc + 8 * fq, v0, v1); } }
        }
    }
};
struct EpiRes {
    const float *xlat, *xctx; bf16_t* X; const float* gate;
    __device__ __forceinline__ void operator()(const f32x4 (&acc)[2][2][4][2], const UnitD& u, int wr, int wc, int fr, int fq) const {
        const int mi = mod_index(u.row0); const float* g = gate + (size_t)mi * MODW;
#pragma unroll
        for (int ai = 0; ai < 2; ++ai)
#pragma unroll
            for (int m = 0; m < 4; ++m) { const int row = u.row0 + ai * 128 + wr * 64 + m * 16 + fr; const float* sp = xlat ? in_row(xlat, xctx, row) : nullptr; bf16_t* dp = X + (size_t)row * D;
#pragma unroll
                for (int bj = 0; bj < 2; ++bj) { const int col = 256 * u.pn + 64 * wc + 16 * fq + 8 * bj;
                    f32x4 s0, s1;
                    if (sp) { s0 = *(const f32x4*)(sp + col); s1 = *(const f32x4*)(sp + col + 4); }
                    else { const u32x4 w = *(const u32x4*)(dp + col); s0[0] = bflo(w.x); s0[1] = bfhi(w.x); s0[2] = bflo(w.y); s0[3] = bfhi(w.y); s1[0] = bflo(w.z); s1[1] = bfhi(w.z); s1[2] = bflo(w.w); s1[3] = bfhi(w.w); }
                    const f32x4 o0 = s0 + *(const f32x4*)(g + col) * acc[ai][bj][m][0], o1 = s1 + *(const f32x4*)(g + col + 4) * acc[ai][bj][m][1];
                    u32x4 ow; ow.x = pk2(o0[0], o0[1]); ow.y = pk2(o0[2], o0[3]); ow.z = pk2(o1[0], o1[1]); ow.w = pk2(o1[2], o1[3]); *(u32x4*)(dp + col) = ow; } }
    }
};
struct EpiGU {
    unsigned char* HID;
    __device__ __forceinline__ void operator()(const f32x4 (&acc)[2][2][4][2], const UnitD& u, int wr, int wc, int fr, int fq) const {
#pragma unroll
        for (int ai = 0; ai < 2; ++ai)
#pragma unroll
            for (int m = 0; m < 4; ++m) { const int row = u.row0 + ai * 128 + wr * 64 + m * 16 + fr; f32x4 h[2];
#pragma unroll
                for (int n = 0; n < 2; ++n)
#pragma unroll
                    for (int j = 0; j < 4; ++j) h[n][j] = siluf_(acc[ai][0][m][n][j]) * acc[ai][1][m][n][j] * SC_HID;
                u32x2 w; w.x = pk4_fp8(h[0][0], h[0][1], h[0][2], h[0][3]); w.y = pk4_fp8(h[1][0], h[1][1], h[1][2], h[1][3]);
                *(u32x2*)(HID + (size_t)row * FF + 128 * u.pn + 32 * wc + 8 * fq) = w; }
    }
};
struct EpiDown {
    unsigned char* Y; bf16_t* X; const float* gate;
    __device__ __forceinline__ void operator()(const f32x4 (&acc)[2][2][4][2], const UnitD& u, int wr, int wc, int fr, int fq) const {
        if (u.e == NEXP) {
            if (!X) return;
            const int mi = mod_index(u.row0); const float* g = gate + (size_t)mi * MODW;
#pragma unroll
            for (int ai = 0; ai < 2; ++ai)
#pragma unroll
                for (int m = 0; m < 4; ++m) { bf16_t* dp = X + (size_t)(u.row0 + ai * 128 + wr * 64 + m * 16 + fr) * D;
#pragma unroll
                    for (int bj = 0; bj < 2; ++bj) { const int col = 256 * u.pn + 64 * wc + 16 * fq + 8 * bj;
                        const u32x4 w = *(const u32x4*)(dp + col); f32x4 s0, s1; s0[0] = bflo(w.x); s0[1] = bfhi(w.x); s0[2] = bflo(w.y); s0[3] = bfhi(w.y); s1[0] = bflo(w.z); s1[1] = bfhi(w.z); s1[2] = bflo(w.w); s1[3] = bfhi(w.w);
                        const f32x4 o0 = s0 + *(const f32x4*)(g + col) * acc[ai][bj][m][0], o1 = s1 + *(const f32x4*)(g + col + 4) * acc[ai][bj][m][1];
                        u32x4 ow; ow.x = pk2(o0[0], o0[1]); ow.y = pk2(o0[2], o0[3]); ow.z = pk2(o1[0], o1[1]); ow.w = pk2(o1[2], o1[3]); *(u32x4*)(dp + col) = ow; } }
        } else {
            if (!Y) { asm volatile("" :: "v"(acc[0][0][0][0][0]), "v"(acc[1][1][3][1][3])); return; }
#pragma unroll
            for (int ai = 0; ai < 2; ++ai)
#pragma unroll
                for (int m = 0; m < 4; ++m) { unsigned char* yp = Y + (size_t)(u.row0 + ai * 128 + wr * 64 + m * 16 + fr) * D + 256 * u.pn + 64 * wc + 16 * fq;
                    const f32x4 v0 = acc[ai][0][m][0] * SC_Y, v1 = acc[ai][0][m][1] * SC_Y, v2 = acc[ai][1][m][0] * SC_Y, v3 = acc[ai][1][m][1] * SC_Y; u32x4 w;
                    w.x = pk4_fp8(v0[0], v0[1], v0[2], v0[3]); w.y = pk4_fp8(v1[0], v1[1], v1[2], v1[3]); w.z = pk4_fp8(v2[0], v2[1], v2[2], v2[3]); w.w = pk4_fp8(v3[0], v3[1], v3[2], v3[3]);
                    *(u32x4*)yp = w; }
        }
    }
};

typedef bf16x8 __attribute__((may_alias)) bf16x8_a;
__device__ __forceinline__ f32x16 mfma32(bf16x8 a, bf16x8 b, f32x16 c) { return __builtin_amdgcn_mfma_f32_32x32x16_bf16(a, b, c, 0, 0, 0); }
__device__ __forceinline__ bf16x8 ld_tr2(const LAS unsigned char* p0, const LAS unsigned char* p1) {
    const s16x4 a = __builtin_amdgcn_ds_read_tr16_b64_v4i16((LAS s16x4*)p0), b = __builtin_amdgcn_ds_read_tr16_b64_v4i16((LAS s16x4*)p1);
    bf16x8 r; r[0] = a[0]; r[1] = a[1]; r[2] = a[2]; r[3] = a[3]; r[4] = b[0]; r[5] = b[1]; r[6] = b[2]; r[7] = b[3]; return r;
}
__device__ __forceinline__ unsigned tr_addr(unsigned lane, unsigned rowbase, unsigned cb) {
    const unsigned blk = (lane >> 4) & 1, q = (lane & 15) >> 2, p = lane & 3; return off_b(rowbase + q, 4 * cb + 2 * blk + (p >> 1)) + 8 * (p & 1);
}
__device__ __forceinline__ bf16x8 pack8(const f32x16& v, int s) {
    u32x4 w; w.x = pk2(v[8 * s + 0], v[8 * s + 1]); w.y = pk2(v[8 * s + 2], v[8 * s + 3]); w.z = pk2(v[8 * s + 4], v[8 * s + 5]); w.w = pk2(v[8 * s + 6], v[8 * s + 7]);
    return __builtin_bit_cast(bf16x8, w);
}
__device__ __forceinline__ void stage_offb(LAS unsigned char* img, const bf16_t* g, int ldg, int rows, int tid) {
    const int wid = __builtin_amdgcn_readfirstlane(tid >> 6);
    for (int r0 = 0; r0 < rows; r0 += 32) { const unsigned p = (unsigned)(r0 * 16 + tid), row = p >> 4, chs = p & 15, ch = chs ^ offb_key(row);
        __builtin_amdgcn_global_load_lds((const unsigned*)(g + (size_t)row * ldg + 8 * ch), (LAS unsigned*)(img + r0 * 256 + wid * 1024), 16, 0, 0); }
}
typedef int v8i_t __attribute__((ext_vector_type(8)));
typedef int v4i_t __attribute__((ext_vector_type(4)));
typedef v4i_t __attribute__((may_alias)) v4i_ta;
constexpr int ATT_STG = 8192, ATT_VOF = 65536;
__device__ __forceinline__ void attn_unit(LAS unsigned char* lds, const Args& A, bf16_t* MIX, int qrow0, int b, int nkeys, int head, float lam, float sbl2, const float* subw, float outscale, const int probe = 0) {
    const int tid = threadIdx.x, wid = __builtin_amdgcn_readfirstlane(tid >> 6), lane = tid & 63, br = wid >> 2, qq = wid & 3, l31 = lane & 31, hh = lane >> 5;
    const int qrow = qrow0 + 32 * qq + l31;
    const unsigned char* q8 = A.ws + WS_Q8 + (size_t)qrow * 1024 + head * 128 + br * 64 + 32 * hh;
    v8i_t Qf; Qf.lo = *(const v4i_t*)q8; Qf.hi = *(const v4i_t*)(q8 + 16);
    f32x16 O[4]; const float oz = opaque_zero();
#pragma unroll
    for (int i = 0; i < 4; ++i)
#pragma unroll
        for (int j = 0; j < 16; ++j) O[i][j] = oz;
    const float c565 = opaque_zero() + 56.5f; f32x16 CB; f32x4 Ol;
#pragma unroll
    for (int j = 0; j < 16; ++j) CB[j] = c565;
#pragma unroll
    for (int j = 0; j < 4; ++j) Ol[j] = oz;
    v8i_t Aones;
#pragma unroll
    for (int i = 0; i < 8; ++i) Aones[i] = (lane & 15) == ((lane >> 4) & 1) ? 0x50505050 : 0;
    const int ntile = nkeys / 64;
    const unsigned ksw = (l31 >> 1) & 7, vsw = (l31 >> 2) & 7;
    const unsigned ka0 = l31 * 128 + 16 * ((4 * br + 2 * hh) ^ ksw), ka1 = l31 * 128 + 16 * ((4 * br + 2 * hh + 1) ^ ksw);
    unsigned va0 = ATT_VOF + (l31 >> 1) * 128 + 16 * ((4 * (l31 & 1) + 2 * hh) ^ vsw), va1 = ATT_VOF + (l31 >> 1) * 128 + 16 * ((4 * (l31 & 1) + 2 * hh + 1) ^ vsw);
    asm volatile("" : "+v"(va0), "+v"(va1));
    const int sP = 127 * 0x01010101, sK = sP, sV = sP, sQ = (E8_Q8 + 3 + E8_K8 - 127) * 0x01010101;
    __syncthreads();
    const unsigned ksrc = (unsigned)((tid >> 3) * 128 + 16 * ((tid & 7) ^ ((tid >> 4) & 7)));
    const unsigned char* kgb = A.ws + WS_K8 + ((size_t)(b * 8 + head) * SEQU << 7);
    const unsigned char* vgb = A.ws + WS_V8T + ((size_t)(b * 8 + head) * (SEQU / 64) << 13);
    const unsigned dmaw = (unsigned)(size_t)(lds + wid * 1024);
#define ATT_DMA(gbase, voff, la) do { unsigned m0s_; asm volatile("s_mov_b32 %0, m0\n\ts_mov_b32 m0, %1\n\ts_nop 0\n\tglobal_load_lds_dwordx4 %2, %3\n\ts_mov_b32 m0, %0\n\ts_nop 0" : "=&s"(m0s_) : "s"(la), "v"(voff), "s"(gbase) : "memory"); } while (0)
#define ATT_DMAK(stg, t_) ATT_DMA(kgb + (size_t)min((t_), ntile - 1) * 8192, ksrc, dmaw + (unsigned)(stg))
#define ATT_DMAV(stg, t_) ATT_DMA(vgb + (size_t)min((t_), ntile - 1) * 8192, ksrc, dmaw + (unsigned)((stg) + ATT_VOF))
#define ATT_WAITV(n) asm volatile("s_waitcnt vmcnt(" #n ")" ::: "memory")
    ATT_DMAK(3 * ATT_STG, 0);
    ATT_DMAK(7 * ATT_STG, 1);
    ATT_DMAK(0, 2); ATT_DMAV(0, 0);
    ATT_DMAK(ATT_STG, 3); ATT_DMAV(ATT_STG, 1);
    ATT_DMAK(2 * ATT_STG, 4); ATT_DMAV(2 * ATT_STG, 2);
    { u32x4 z; z.x = 0; z.y = 0; z.z = 0; z.w = 0; *(LAS u32x4*)(lds + 7 * ATT_STG + ATT_VOF + 16 * tid) = z; }
    ATT_WAITV(0);
    __syncthreads();
    f32x16 Sa, Sb; v8i_t FA, FB, FC, FD;
    { v8i_t Kf; Kf.lo = *(const LAS v4i_ta*)(lds + 3 * ATT_STG + ka0); Kf.hi = *(const LAS v4i_ta*)(lds + 3 * ATT_STG + ka1);
      Sa = __builtin_amdgcn_mfma_scale_f32_32x32x64_f8f6f4(Kf, Qf, CB, 0, 0, 0, sK, 0, sQ);
      Kf.lo = *(const LAS v4i_ta*)(lds + 3 * ATT_STG + 4096 + ka0); Kf.hi = *(const LAS v4i_ta*)(lds + 3 * ATT_STG + 4096 + ka1);
      Sb = __builtin_amdgcn_mfma_scale_f32_32x32x64_f8f6f4(Kf, Qf, CB, 0, 0, 0, sK, 0, sQ);
      FA.lo = *(const LAS v4i_ta*)(lds + 7 * ATT_STG + va0); FA.hi = *(const LAS v4i_ta*)(lds + 7 * ATT_STG + va1);
      FB.lo = *(const LAS v4i_ta*)(lds + 7 * ATT_STG + 2048 + va0); FB.hi = *(const LAS v4i_ta*)(lds + 7 * ATT_STG + 2048 + va1); }
    v8i_t PfP;
#pragma unroll
    for (int i = 0; i < 8; ++i) PfP[i] = 0;
    __syncthreads();
#define ATT_PACK(S, r0, dst) if (probe & 2) { asm volatile("" :: "v"(S[(r0)]), "v"(S[(r0) + 3])); dst = PfP[0] + (r0); } else { unsigned w = 0; _Pragma("unroll") for (int c = 0; c < 4; ++c) w = __builtin_amdgcn_cvt_pk_u8_f32(__builtin_amdgcn_fmed3f(S[(r0) + c], 0.0f, hi), c, w); dst = (int)w; }
#define ATT_LDV(dst, base, dvb) if (probe & 4) { dst = Qf; } else { dst.lo = *(const LAS v4i_ta*)(base + (dvb) * 2048 + va0); dst.hi = *(const LAS v4i_ta*)(base + (dvb) * 2048 + va1); }
#define ATT_LDK(dst, kb) if (probe & 4) { dst = Qf; } else { dst.lo = *(const LAS v4i_ta*)(rd + (kb) * 4096 + ka0); dst.hi = *(const LAS v4i_ta*)(rd + (kb) * 4096 + ka1); }
#define ATT_MFMA(D, A_, B_, C_, sa, sb) if (probe & 32) { asm volatile("" :: "v"(A_)); D = __builtin_amdgcn_mfma_scale_f32_32x32x64_f8f6f4(Qf, B_, C_, 0, 0, 0, sa, 0, sb); asm volatile("" : "+v"(D)); } else if (!(probe & 1)) { D = __builtin_amdgcn_mfma_scale_f32_32x32x64_f8f6f4(A_, B_, C_, 0, 0, 0, sa, 0, sb); asm volatile("" : "+v"(D)); } else { asm volatile("" :: "v"(A_), "v"(B_)); }
#define ATT_SB __builtin_amdgcn_sched_barrier(0)
#define ATT_INTERVAL(I, F0, F1, F2, F3, BAR) { \
        LAS unsigned char* rd = lds + (((I) + 7) & 7) * ATT_STG; LAS unsigned char* pf = lds + ((I) & 7) * ATT_STG; \
        const float hi = __builtin_bit_cast(float, __builtin_amdgcn_readfirstlane((I) < ntile ? 0x42fc0000 : 0));     \
        v8i_t PfN; \
        ATT_SB; \
        ATT_LDK(F2, 0); \
        if (!(probe & 1)) { Ol = __builtin_amdgcn_mfma_scale_f32_16x16x128_f8f6f4(Aones, PfP, Ol, 0, 0, 0, sV, 0, sP); asm volatile("" : "+v"(Ol)); } else { asm volatile("" :: "v"(Aones), "v"(PfP)); } \
        ATT_PACK(Sa, 0, PfN[0]); ATT_PACK(Sa, 4, PfN[1]); \
        ATT_SB; \
        ATT_LDV(F3, rd, 2); \
        ATT_MFMA(O[0], F0, PfP, O[0], sV, sP); \
        ATT_PACK(Sa, 8, PfN[2]); ATT_PACK(Sa, 12, PfN[3]); \
        ATT_SB; \
        ATT_MFMA(O[1], F1, PfP, O[1], sV, sP); \
        if (!(probe & 8)) ATT_DMAK((((I) + 3) & 7) * ATT_STG, (I) + 5);     \
        ATT_LDK(F0, 1); \
        ATT_PACK(Sb, 0, PfN[4]); ATT_PACK(Sb, 4, PfN[5]); \
        ATT_SB; \
        ATT_MFMA(Sa, F2, Qf, CB, sK, sQ); \
        ATT_LDV(F1, rd, 3); \
        ATT_PACK(Sb, 8, PfN[6]); ATT_PACK(Sb, 12, PfN[7]); \
        ATT_SB; \
        ATT_MFMA(O[2], F3, PfP, O[2], sV, sP); \
        if (!(probe & 8)) ATT_DMAV((((I) + 3) & 7) * ATT_STG, (I) + 3); \
        ATT_LDV(F2, pf, 0); \
        ATT_SB; \
        ATT_MFMA(Sb, F0, Qf, CB, sK, sQ); \
        ATT_LDV(F3, pf, 1); \
        ATT_SB; \
        ATT_MFMA(O[3], F1, PfP, O[3], sV, sP); \
        ATT_SB; \
        PfP = PfN; \
        if (BAR) { asm volatile("s_waitcnt vmcnt(2) lgkmcnt(4)" ::: "memory");     \
            if (!(probe & 16)) { __builtin_amdgcn_s_barrier(); asm volatile("" ::: "memory"); } } \
        else asm volatile("" ::: "memory");     }
#pragma unroll 1
    for (int i = 0; i <= ntile; i += 8) {
        ATT_INTERVAL(i, FA, FB, FC, FD, 0);
        ATT_INTERVAL(i + 1, FC, FD, FA, FB, 1);
        ATT_INTERVAL(i + 2, FA, FB, FC, FD, 0);
        ATT_INTERVAL(i + 3, FC, FD, FA, FB, 1);
        ATT_INTERVAL(i + 4, FA, FB, FC, FD, 0);
        ATT_INTERVAL(i + 5, FC, FD, FA, FB, 1);
        ATT_INTERVAL(i + 6, FA, FB, FC, FD, 0);
        ATT_INTERVAL(i + 7, FC, FD, FA, FB, 1);
    }
    ATT_WAITV(0);
#undef ATT_INTERVAL
#undef ATT_MFMA
#undef ATT_DMAK
#undef ATT_DMAV
#undef ATT_WAITV
#undef ATT_PACK
#undef ATT_LDV
#undef ATT_LDK
#undef ATT_SB
    if (probe) { _Pragma("unroll") for (int i = 0; i < 4; ++i) asm volatile("" :: "v"(O[i])); asm volatile("" :: "v"(Ol), "v"(Sa), "v"(Sb), "v"(PfP), "v"(FA), "v"(FB)); __syncthreads(); return; }
    const float ls0 = __shfl(Ol[0], lane & 15), ls1 = __shfl(Ol[1], lane & 15); const float lsum = (lane & 16) ? ls1 : ls0;
    const float inv = fast_rcp(lsum);
    __syncthreads();
    LAS float* ex = (LAS float*)lds + qq * 4096;
    if (br == 1) { const float f = lam * inv;
#pragma unroll
        for (int dvb = 0; dvb < 4; ++dvb)
#pragma unroll
            for (int j = 0; j < 16; ++j) ex[(dvb * 16 + j) * 64 + lane] = O[dvb][j] * f; }
    __syncthreads();
    if (br == 0) { float ss = 0.f;
#pragma unroll
        for (int dvb = 0; dvb < 4; ++dvb)
#pragma unroll
            for (int j = 0; j < 16; ++j) {
#ifdef ATT_NOEX
                const float v = O[dvb][j] * inv;
#else
                const float v = O[dvb][j] * inv - ex[(dvb * 16 + j) * 64 + lane];
#endif
                O[dvb][j] = v; ss += v * v; }
        ss += __shfl_xor(ss, 32);
        const float rinv = __builtin_amdgcn_rsqf(ss * (1.0f / 128.0f) + EPS) * outscale;
        LAS unsigned char* ot = lds + 65536 + qq * 8704;
#pragma unroll
        for (int dvb = 0; dvb < 4; ++dvb)
#pragma unroll
            for (int a = 0; a < 4; ++a) { const int dv = 32 * dvb + 8 * a + 4 * hh; const f32x4 w = *(const f32x4*)(subw + dv);
                u32x2 o; o.x = pk2(O[dvb][4 * a] * rinv * w[0], O[dvb][4 * a + 1] * rinv * w[1]); o.y = pk2(O[dvb][4 * a + 2] * rinv * w[2], O[dvb][4 * a + 3] * rinv * w[3]);
                *(LAS u32x2*)(ot + l31 * 272 + 2 * dv) = o; }
        unsigned char* op = (unsigned char*)MIX + (size_t)(qrow0 + 32 * qq) * D + 512 + head * 128 + 8 * (lane & 15);
#pragma unroll
        for (int i = 0; i < 8; ++i) { const int r = 4 * i + (lane >> 4); const u32x4 v = *(const LAS u32x4*)(ot + r * 272 + 16 * (lane & 15)); u32x2 o;
            o.x = pk4_fp8(bflo(v.x) * SC_MIX, bfhi(v.x) * SC_MIX, bflo(v.y) * SC_MIX, bfhi(v.y) * SC_MIX); o.y = pk4_fp8(bflo(v.z) * SC_MIX, bfhi(v.z) * SC_MIX, bflo(v.w) * SC_MIX, bfhi(v.w) * SC_MIX);
            *(u32x2*)(op + (size_t)r * D) = o; } }
    __syncthreads();
}

__device__ __forceinline__ float log2_gamma(float logit) { return -__builtin_log2f(1.0f + fast_exp2(-logit * LOG2E)); }
__device__ __forceinline__ bf16x8 scale8(bf16x8 v, const float (&f)[8]) {
    const u32x4 w = __builtin_bit_cast(u32x4, v); u32x4 o;
    o.x = pk2(bflo(w.x) * f[0], bfhi(w.x) * f[1]); o.y = pk2(bflo(w.y) * f[2], bfhi(w.y) * f[3]); o.z = pk2(bflo(w.z) * f[4], bfhi(w.z) * f[5]); o.w = pk2(bflo(w.w) * f[6], bfhi(w.w) * f[7]);
    return __builtin_bit_cast(bf16x8, o);
}
__device__ __forceinline__ bf16x8 scale8s(bf16x8 v, float f) {
    const u32x4 w = __builtin_bit_cast(u32x4, v); u32x4 o;
    o.x = pk2(bflo(w.x) * f, bfhi(w.x) * f); o.y = pk2(bflo(w.y) * f, bfhi(w.y) * f); o.z = pk2(bflo(w.z) * f, bfhi(w.z) * f); o.w = pk2(bflo(w.w) * f, bfhi(w.w) * f);
    return __builtin_bit_cast(bf16x8, o);
}
__device__ __forceinline__ void ret_kv_unit(LAS unsigned char* lds, const bf16_t* P, bf16_t* KVT, const float* decay_logit  , int b, int j, int head) {
    const int tid = threadIdx.x, wid = __builtin_amdgcn_readfirstlane(tid >> 6), lane = tid & 63, eb = wid & 3, dir = wid >> 2, l31 = lane & 31, hh = lane >> 5;
    const int rbase = b * SEQU + 128 * j;
    LAS unsigned char* vimg = lds; LAS unsigned char* kimg = lds + 32768;
    __syncthreads();
    stage_offb(vimg, P + (size_t)rbase * LDP + OFF_RV + head * 128, LDP, 128, tid);
    stage_offb(kimg, P + (size_t)rbase * LDP + OFF_RK + head * 128, LDP, 128, tid);
    const float l2g = log2_gamma(decay_logit[dir * 4 + head]);
    asm volatile("s_waitcnt vmcnt(0)" ::: "memory"); __syncthreads();
    f32x16 acc[4];
#pragma unroll
    for (int i = 0; i < 4; ++i)
#pragma unroll
        for (int q = 0; q < 16; ++q) acc[i][q] = 0.f;
#pragma unroll 2
    for (int ks = 0; ks < 8; ++ks) {
        const unsigned rb = 16 * ks + 8 * hh;
        bf16x8 vf = ld_tr2(vimg + tr_addr(lane, rb, eb), vimg + tr_addr(lane, rb + 4, eb));
        float f[8];
#pragma unroll
        for (int q = 0; q < 8; ++q) { const int i = (int)rb + q; f[q] = fast_exp2(l2g * (float)(dir == 0 ? 127 - i : i)); }
        vf = scale8(vf, f);
#pragma unroll
        for (int db = 0; db < 4; ++db) { const bf16x8 kf = ld_tr2(kimg + tr_addr(lane, rb, db), kimg + tr_addr(lane, rb + 4, db)); acc[db] = mfma32(vf, kf, acc[db]); }
    }
    bf16_t* out = KVT + ((((size_t)(b * 4 + head) * 2 + dir) * NCH128 + j) << 14);
#pragma unroll
    for (int db = 0; db < 4; ++db)
#pragma unroll
        for (int q = 0; q < 16; ++q) { const int e = 32 * eb + (q & 3) + 8 * (q >> 2) + 4 * hh; const float v = acc[db][q], vn = __shfl_xor(v, 1);
            if ((lane & 1) == 0) *(unsigned*)(out + e * 128 + 32 * db + l31) = pk2(v, vn); }
    __syncthreads();
}
__device__ __forceinline__ void ret_state_phase(const bf16_t* KVT, bf16_t* ST, const float* decay_logit, int gtid, int gn) {
    for (int id = gtid; id < 16 * 8192; id += gn) {
        const int seq = id >> 13, el = (id & 8191) * 2, dir = seq & 1, head = (seq >> 1) & 3;
        const float G = fast_exp2(128.0f * log2_gamma(decay_logit[dir * 4 + head]));
        const bf16_t* kv = KVT + ((size_t)seq * NCH128 << 14) + el; bf16_t* st = ST + ((size_t)seq * NCH128 << 14) + el;
        float s0 = 0.f, s1 = 0.f;
        for (int sb = 0; sb < NCH128; sb += 22) {
            unsigned kk[22]; int jj[22];
#pragma unroll
            for (int q = 0; q < 22; ++q) { const int s = sb + q; jj[q] = dir == 0 ? s : (s == 0 ? 1 : s == 1 ? 0 : 67 - s); kk[q] = *(const unsigned*)(kv + ((size_t)jj[q] << 14)); }
#pragma unroll
            for (int q = 0; q < 22; ++q) { *(unsigned*)(st + ((size_t)jj[q] << 14)) = pk2(s0, s1); s0 = s0 * G + bflo(kk[q]); s1 = s1 * G + bfhi(kk[q]); }
        }
    }
}
__device__ __forceinline__ void ret_out_unit(LAS unsigned char* lds, const bf16_t* P, const bf16_t* ST, bf16_t* MIX, const float* decay_logit, const float* normw, int b, int j, int hp) {
    const int tid = threadIdx.x, wid = __builtin_amdgcn_readfirstlane(tid >> 6), lane = tid & 63, hsel = wid >> 2, qq = wid & 3, l31 = lane & 31, hh = lane >> 5;
    const int head = 2 * hp + hsel, rbase = b * SEQU + 128 * j, qi = 32 * qq + l31, qrow = rbase + qi;
    LAS unsigned char* vimg = lds + hsel * 32768; LAS unsigned char* kimg = lds + 65536 + hsel * 32768;
    __syncthreads();
    stage_offb(lds, P + (size_t)rbase * LDP + OFF_RV + (2 * hp) * 128, LDP, 128, tid);
    stage_offb(lds + 32768, P + (size_t)rbase * LDP + OFF_RV + (2 * hp + 1) * 128, LDP, 128, tid);
    stage_offb(lds + 65536, P + (size_t)rbase * LDP + OFF_RK + (2 * hp) * 128, LDP, 128, tid);
    stage_offb(lds + 98304, P + (size_t)rbase * LDP + OFF_RK + (2 * hp + 1) * 128, LDP, 128, tid);
    const float l2f = log2_gamma(decay_logit[head]), l2b = log2_gamma(decay_logit[4 + head]);
    bf16x8 Qf[8];
#pragma unroll
    for (int ks = 0; ks < 8; ++ks) Qf[ks] = *(const bf16x8*)(P + (size_t)qrow * LDP + OFF_RQ + head * 128 + 16 * ks + 8 * hh);
    f32x16 O[4];
#pragma unroll
    for (int i = 0; i < 4; ++i)
#pragma unroll
        for (int q = 0; q < 16; ++q) O[i][q] = 0.f;
    asm volatile("s_waitcnt vmcnt(0)" ::: "memory"); __syncthreads();
    for (int kb = 0; kb < 4; ++kb) {
        f32x16 S; const float z0 = opaque_zero();
#pragma unroll
        for (int q = 0; q < 16; ++q) S[q] = z0;
#pragma unroll
        for (int ks = 0; ks < 8; ++ks) { const bf16x8 kf = *(const LAS bf16x8_a*)(kimg + off_b(32 * kb + l31, 2 * ks + hh)); S = mfma32(kf, Qf[ks], S); }
#pragma unroll
        for (int q = 0; q < 16; ++q) { const int ik = 32 * kb + (q & 3) + 8 * (q >> 2) + 4 * hh, dlt = qi - ik;
            const float m = (dlt >= 0 ? fast_exp2(l2f * (float)dlt) : 0.f) + (dlt <= 0 ? fast_exp2(l2b * (float)(-dlt)) : 0.f); S[q] *= m; }
#pragma unroll
        for (int s = 0; s < 2; ++s) { const bf16x8 pf = pack8(S, s); const unsigned rb = 32 * kb + 16 * s + 4 * hh;
#pragma unroll
            for (int eb = 0; eb < 4; ++eb) { const bf16x8 vf = ld_tr2(vimg + tr_addr(lane, rb, eb), vimg + tr_addr(lane, rb + 8, eb)); O[eb] = mfma32(vf, pf, O[eb]); } }
    }
    __syncthreads();
#pragma unroll
    for (int t = 0; t < 4; ++t) stage_offb(lds + t * 32768, ST + ((((size_t)(b * 4 + 2 * hp + (t >> 1)) * 2 + (t & 1)) * NCH128 + j) << 14), 128, 128, tid);
    asm volatile("s_waitcnt vmcnt(0)" ::: "memory"); __syncthreads();
#pragma unroll
    for (int dir = 0; dir < 2; ++dir) {
        const float qd = dir == 0 ? fast_exp2(l2f * (float)(qi + 1)) : fast_exp2(l2b * (float)(128 - qi));
        const LAS unsigned char* simg = lds + (hsel * 2 + dir) * 32768;
#pragma unroll
        for (int ks = 0; ks < 8; ++ks) { const bf16x8 qs = scale8s(Qf[ks], qd);
#pragma unroll
            for (int eb = 0; eb < 4; ++eb) { const bf16x8 sf = *(const LAS bf16x8_a*)(simg + off_b(32 * eb + l31, 2 * ks + hh)); O[eb] = mfma32(sf, qs, O[eb]); } }
    }
    float sm = 0.f;
#pragma unroll
    for (int eb = 0; eb < 4; ++eb)
#pragma unroll
        for (int q = 0; q < 16; ++q) sm += O[eb][q];
    sm += __shfl_xor(sm, 32); const float mu = sm * (1.0f / 128.0f);
    float vs = 0.f;
#pragma unroll
    for (int eb = 0; eb < 4; ++eb)
#pragma unroll
        for (int q = 0; q < 16; ++q) { const float d = O[eb][q] - mu; O[eb][q] = d; vs += d * d; }
    vs += __shfl_xor(vs, 32); const float rinv = __builtin_amdgcn_rsqf(vs * (1.0f / 128.0f) + EPS);
    __syncthreads();
    LAS unsigned char* ot = lds + wid * 8704;
#pragma unroll
    for (int eb = 0; eb < 4; ++eb)
#pragma unroll
        for (int a = 0; a < 4; ++a) { const int e = 32 * eb + 8 * a + 4 * hh; const f32x4 w = *(const f32x4*)(normw + head * 128 + e);
            u32x2 o; o.x = pk2(O[eb][4 * a] * rinv * w[0], O[eb][4 * a + 1] * rinv * w[1]); o.y = pk2(O[eb][4 * a + 2] * rinv * w[2], O[eb][4 * a + 3] * rinv * w[3]);
            *(LAS u32x2*)(ot + l31 * 272 + 2 * e) = o; }
    int ln = lane; asm volatile("" : "+v"(ln));
#pragma unroll
    for (int i = 0; i < 8; ++i) { const int r = 4 * i + (ln >> 4), c8 = 8 * (ln & 15); const size_t row = (size_t)(rbase + 32 * qq + r);
        const u32x4 v = *(const LAS u32x4*)(ot + r * 272 + 2 * c8), g = *(const u32x4*)(P + row * LDP + OFF_RG + head * 128 + c8);
        u32x2 o; o.x = pk4_fp8(bflo(v.x) * bflo(g.x) * SC_MIX, bfhi(v.x) * bfhi(g.x) * SC_MIX, bflo(v.y) * bflo(g.y) * SC_MIX, bfhi(v.y) * bfhi(g.y) * SC_MIX);
        o.y = pk4_fp8(bflo(v.z) * bflo(g.z) * SC_MIX, bfhi(v.z) * bfhi(g.z) * SC_MIX, bflo(v.w) * bflo(g.w) * SC_MIX, bfhi(v.w) * bfhi(g.w) * SC_MIX);
        *(u32x2*)((unsigned char*)MIX + row * D + head * 128 + c8) = o; }
    __syncthreads();
}

typedef unsigned __attribute__((may_alias)) u32_a;
typedef unsigned short __attribute__((may_alias)) u16_a;
__device__ __forceinline__ f32x4 mfma16(bf16x8 a, bf16x8 b, f32x4 c) { return __builtin_amdgcn_mfma_f32_16x16x32_bf16(a, b, c, 0, 0, 0); }
__device__ __forceinline__ void s5_scan(const bf16_t* P, const bf16_t* BFp  , int rbase, int g, int dir, int lane, f32x2 a, f32x2 init, f32x16& xr, f32x16& xi, const bool endonly = false, f32x2 a16 = (f32x2){0.f, 0.f}) {
    const int rho = lane & 31, hk = lane >> 5;
    const int tscan = 16 * ((rho >> 2) & 1) + 4 * (rho >> 3) + (rho & 3), tok = dir == 0 ? tscan : 31 - tscan;
    const bf16x8 uf = *(const bf16x8*)(P + (size_t)(rbase + tok) * LDP + OFF_U + 16 * g + 8 * hk);
    const bf16x8 bre = *(const bf16x8*)(BFp + lane * 8), bim = *(const bf16x8*)(BFp + 512 + lane * 8);
    const float zero = opaque_zero();
    f32x16 zr, zi;
#pragma unroll
    for (int q = 0; q < 16; ++q) { zr[q] = zero; zi[q] = zero; }
    const f32x16 br = mfma32(uf, bre, zr), bi = mfma32(uf, bim, zi);
#ifdef S5_NOSCAN
#pragma unroll
    for (int q = 0; q < 16; ++q) { xr[q] = br[q]; xi[q] = bi[q]; }
    return;
#endif
#ifdef S5_USEA
#pragma unroll
    for (int q = 0; q < 16; ++q) { xr[q] = br[q] * a[0] + init[0]; xi[q] = bi[q] * a[1] + init[1]; }
    return;
#endif
    float sr = hk == 0 ? init[0] : 0.f, si = hk == 0 ? init[1] : 0.f;
#pragma unroll
    for (int q = 0; q < 16; ++q) { float nr = __builtin_fmaf(a[0], sr, __builtin_fmaf(-a[1], si, br[q])), ni = __builtin_fmaf(a[0], si, __builtin_fmaf(a[1], sr, bi[q])); asm("" : "+v"(nr)); asm("" : "+v"(ni)); sr = nr; si = ni; xr[q] = sr; xi[q] = si; }
#ifdef S5_NOFIX
    return;
#endif
    float er = __shfl(sr, lane & 31), ei = __shfl(si, lane & 31);
    if (hk == 0) { er = 0.f; ei = 0.f; }
    if (endonly) {
        float t0 = __builtin_fmaf(a16[0], er, __builtin_fmaf(-a16[1], ei, xr[15])), t1 = __builtin_fmaf(a16[0], ei, __builtin_fmaf(a16[1], er, xi[15])); asm("" : "+v"(t0)); asm("" : "+v"(t1)); xr[15] = t0; xi[15] = t1; return; }
    float wr_ = a[0], wi_ = a[1];
#pragma unroll
    for (int q = 0; q < 16; ++q) { float t0 = __builtin_fmaf(wr_, er, __builtin_fmaf(-wi_, ei, xr[q])), t1 = __builtin_fmaf(wr_, ei, __builtin_fmaf(wi_, er, xi[q])); asm("" : "+v"(t0)); asm("" : "+v"(t1)); xr[q] = t0; xi[q] = t1;
        float nr = __builtin_fmaf(wr_, a[0], -wi_ * a[1]), ni = __builtin_fmaf(wr_, a[1], wi_ * a[0]); asm("" : "+v"(nr)); asm("" : "+v"(ni)); wr_ = nr; wi_ = ni; }
}
__device__ __forceinline__ void s5_end_unit(const Args& A, int l, int b, int c) {
    const int tid = threadIdx.x, wid = __builtin_amdgcn_readfirstlane(tid >> 6), lane = tid & 63;
    const bf16_t* P = (const bf16_t*)(A.ws + WS_P); const f32x2* SA = (const f32x2*)(A.ws + WS_S5A); const bf16_t* BF = (const bf16_t*)(A.ws + WS_S5BF); f32x2* E = (f32x2*)(A.ws + WS_S5E);
    const int rbase = b * SEQU + 32 * c;
    for (int gi = 0; gi < 4; ++gi) { const int g = 4 * wid + gi;
#pragma unroll
        for (int d = 0; d < 2; ++d)
#pragma unroll
            for (int pb = 0; pb < 2; ++pb) { const int p = 32 * pb + (lane & 31); const f32x2 a = SA[((l * 2 + d) * 32 + g) * 64 + p];
                f32x16 xr, xi; s5_scan(P, BF + ((((size_t)(l * 2 + d) * 32 + g) * 2 + pb) * 2) * 512, rbase, g, d, lane, a, (f32x2){0.f, 0.f}, xr, xi, true, SA[S5A_N + ((l * 2 + d) * 32 + g) * 64 + p]);
                if (lane >= 32) E[(((size_t)(b * 2 + d) * NCH32 + c) * 32 + g) * 64 + p] = (f32x2){xr[15], xi[15]}; }
    }
}
__device__ __forceinline__ void s5_carry_phase(const Args& A, int l, LAS unsigned char* lds, int vcu, int G) {
    const int tid = threadIdx.x, wid = __builtin_amdgcn_readfirstlane(tid >> 6), lane = tid & 63;
    const f32x2* SA = (const f32x2*)(A.ws + WS_S5A) + 2 * S5A_N; const f32x2* E = (const f32x2*)(A.ws + WS_S5E); f32x2* XC = (f32x2*)(A.ws + WS_S5X);
    LAS f32x2* T = (LAS f32x2*)lds;
    for (int u = G - 1 - vcu; u < 128; u += G) { const int gp = (u & 31) * 64 + lane, d = (u >> 5) & 1, b = u >> 6;
        const f32x2 a = SA[(l * 2 + d) * 2048 + gp]; const size_t base = (size_t)(b * 2 + d) * NCH32 * 2048 + gp;
        f32x2 ev[33];
#pragma unroll
        for (int q = 0; q < 33; ++q) { const int s = 33 * wid + q, cc = d == 0 ? s : (s < 8 ? 7 - s : 271 - s); ev[q] = E[base + (size_t)cc * 2048]; }
        float pr = 0.f, pi = 0.f;
#pragma unroll
        for (int q = 0; q < 33; ++q) { const f32x2 e = ev[q]; ev[q] = (f32x2){pr, pi}; const float nr = a[0] * pr - a[1] * pi + e[0], ni = a[0] * pi + a[1] * pr + e[1]; pr = nr; pi = ni; }
        __syncthreads();
        T[wid * 64 + lane] = (f32x2){pr, pi};
        float wr_ = 1.f, wi_ = 0.f;
#pragma unroll
        for (int q = 0; q < 33; ++q) { const float nr = wr_ * a[0] - wi_ * a[1], ni = wr_ * a[1] + wi_ * a[0]; wr_ = nr; wi_ = ni; }
        __syncthreads();
        float cr = 0.f, ci = 0.f;
        for (int v = 0; v < wid; ++v) { const f32x2 t = T[v * 64 + lane]; const float nr = wr_ * cr - wi_ * ci + t[0], ni = wr_ * ci + wi_ * cr + t[1]; cr = nr; ci = ni; }
#pragma unroll
        for (int q = 0; q < 33; ++q) { const int s = 33 * wid + q, cc = d == 0 ? s : (s < 8 ? 7 - s : 271 - s);
            XC[base + (size_t)cc * 2048] = (f32x2){ev[q][0] + cr, ev[q][1] + ci}; const float nr = a[0] * cr - a[1] * ci, ni = a[0] * ci + a[1] * cr; cr = nr; ci = ni; }
    }
}
constexpr int S5_XPITCH = 272, S5_XIMG = 32 * S5_XPITCH  , S5_YOFF = 8 * S5_XIMG  , S5_YPITCH = 1040;
__device__ __forceinline__ void s5_out_unit(LAS unsigned char* lds, const Args& A, int l, int b, int c) {
    const int tid = threadIdx.x, wid = __builtin_amdgcn_readfirstlane(tid >> 6), lane = tid & 63, l31 = lane & 31, hk = lane >> 5, l15 = lane & 15, kq = lane >> 4;
    const bf16_t* P = (const bf16_t*)(A.ws + WS_P); const f32x2* SA = (const f32x2*)(A.ws + WS_S5A); const bf16_t* BF = (const bf16_t*)(A.ws + WS_S5BF); const bf16_t* CF = (const bf16_t*)(A.ws + WS_S5CF);
    const f32x2* XC = (const f32x2*)(A.ws + WS_S5X); bf16_t* MIX = (bf16_t*)(A.ws + WS_MIX); const bf16_t* GLU = (const bf16_t*)(A.ws + WS_GLU) + (size_t)l * 512 * 512;
    const int rbase = b * SEQU + 32 * c;
    LAS unsigned char* ximg = lds + wid * S5_XIMG; LAS unsigned char* yimg = lds + S5_YOFF;
    __syncthreads();
#ifdef S5_COPYU
    for (int i = tid; i < 32 * 64; i += NTHR) { const int t = i >> 6, c8 = (i & 63) * 8; *(u32x4*)(MIX + (size_t)(rbase + t) * D + 1536 + c8) = *(const u32x4*)(P + (size_t)(rbase + t) * LDP + OFF_U + c8); }
    __syncthreads(); return;
#endif
    for (int gi = 0; gi < 4; ++gi) { const int g = 4 * wid + gi;
        const float z0 = opaque_zero(); f32x4 ya[2] = {{z0, z0, z0, z0}, {z0, z0, z0, z0}};
#pragma unroll
        for (int d = 0; d < 2; ++d) {
#pragma unroll
            for (int pb = 0; pb < 2; ++pb) { const int p = 32 * pb + l31; const f32x2 a = SA[((l * 2 + d) * 32 + g) * 64 + p];
#ifdef S5_NOINIT
                const f32x2 init = {0.f, 0.f};
#else
                const f32x2 init = XC[(((size_t)(b * 2 + d) * NCH32 + c) * 32 + g) * 64 + p];
#endif
                f32x16 xr, xi; s5_scan(P, BF + ((((size_t)(l * 2 + d) * 32 + g) * 2 + pb) * 2) * 512, rbase, g, d, lane, a, init, xr, xi);
#pragma unroll
                for (int q = 0; q < 16; ++q) { const int ts = 16 * hk + q, t = d == 0 ? ts : 31 - ts;
                    *(LAS u32_a*)(ximg + t * S5_XPITCH + 4 * p) = pk2(xr[q], xi[q]); } }
            asm volatile("s_waitcnt lgkmcnt(0)" ::: "memory");
#pragma unroll
            for (int ks = 0; ks < 4; ++ks) { const bf16x8 cf = *(const bf16x8*)(CF + (((size_t)l * 32 + g) * 4 + ks) * 512 + lane * 8);
#pragma unroll
                for (int rb = 0; rb < 2; ++rb) { const bf16x8 xf = *(const LAS bf16x8_a*)(ximg + (16 * rb + l15) * S5_XPITCH + 2 * (32 * ks + 8 * kq)); ya[rb] = mfma16(xf, cf, ya[rb]); } }
            asm volatile("s_waitcnt lgkmcnt(0)" ::: "memory");
        }
        const int ch = 16 * g + l15; const float dv = A.s5_d[l * 512 + ch];
#pragma unroll
        for (int rb = 0; rb < 2; ++rb)
#pragma unroll
            for (int q = 0; q < 4; ++q) { const int t = 16 * rb + 4 * kq + q; const float u = bf2f(P[(size_t)(rbase + t) * LDP + OFF_U + ch]);
                const float yv = gelu_tanh(ya[rb][q] + dv * u), yn = __shfl_xor(yv, 1);
                if ((lane & 1) == 0) *(LAS u32_a*)(yimg + t * S5_YPITCH + 2 * ch) = pk2(yv, yn); }
    }
    __syncthreads();
    f32x16 z[2];
#pragma unroll
    for (int nb = 0; nb < 2; ++nb)
#pragma unroll
        for (int q = 0; q < 16; ++q) z[nb][q] = 0.f;
#ifndef S5_NOGLU
#pragma unroll 4
    for (int ks = 0; ks < 32; ++ks) { const bf16x8 yf = *(const LAS bf16x8_a*)(yimg + l31 * S5_YPITCH + 2 * (16 * ks + 8 * hk));
#pragma unroll
        for (int nb = 0; nb < 2; ++nb) { const bf16x8 wf = *(const bf16x8*)(GLU + ((size_t)((((wid * 2 + nb) * 32 + ks) * 2 + hk) * 32 + l31) << 3)); z[nb] = mfma32(yf, wf, z[nb]); } }
#endif
#pragma unroll
    for (int nb = 0; nb < 2; ++nb)
#pragma unroll
        for (int q = 0; q < 16; ++q) { const int t = (q & 3) + 8 * (q >> 2) + 4 * hk, n = 64 * wid + 32 * nb + l31;
            const float y = bf2f(*(const LAS u16_a*)(yimg + t * S5_YPITCH + 2 * n));
            const float ov = y * sigmoidf_(z[nb][q]) * SC_MIX, on = __shfl_xor(ov, 1);
            const unsigned p2 = (unsigned)__builtin_amdgcn_cvt_pk_fp8_f32(__builtin_amdgcn_fmed3f(ov, -448.f, 448.f), __builtin_amdgcn_fmed3f(on, -448.f, 448.f), 0, false) & 0xffffu, p4 = __shfl_xor(p2, 2);
            if ((lane & 3) == 0) *(unsigned*)((unsigned char*)MIX + (size_t)(rbase + t) * D + 1536 + n) = p2 | (p4 << 16); }
    __syncthreads();
}

constexpr int RT_RS = 0, RT_PART = 1024, RT_SC = RT_PART + 8 * 32 * 64 * 4  , RT_SEL = RT_SC + 32 * 65 * 4, RT_E = RT_SEL + 32 * 65 * 4, RT_CNT = RT_E + 32 * 8 * 4, RT_BASE = RT_CNT + 256, RT_END = RT_BASE + 256;
__device__ __forceinline__ void route_unit(LAS unsigned char* lds, const Args& A, int l, int r0, bool dry = false) {
    const int tid = threadIdx.x, wid = __builtin_amdgcn_readfirstlane(tid >> 6), lane = tid & 63, l31 = lane & 31, hk = lane >> 5;
    const bf16_t* X = (const bf16_t*)(A.ws + WS_X); bf16_t* H = (bf16_t*)(A.ws + WS_H); const float* MOD = (const float*)(A.ws + WS_MOD); const bf16_t* RWH = (const bf16_t*)(A.ws + WS_RWT) + (size_t)l * NEXP * D; const bf16_t* RWL = RWH + (size_t)2 * NEXP * D;
    LAS float* rs = (LAS float*)(lds + RT_RS); LAS float* part = (LAS float*)(lds + RT_PART); LAS float* sc = (LAS float*)(lds + RT_SC); LAS float* sel = (LAS float*)(lds + RT_SEL);
    LAS int* rowE = (LAS int*)(lds + RT_E); LAS int* cntL = (LAS int*)(lds + RT_CNT); LAS int* baseL = (LAS int*)(lds + RT_BASE);
    const int mi = mod_index(r0); const float* mod = MOD + ((size_t)l * 3 + mi) * MODW; const float* sh = mod + 3 * D; const float* scv = mod + 4 * D; const float* nw = A.norm2_w + (size_t)l * D;
    LAS unsigned char* xt = lds + wid * 16384; LAS float* ssp = (LAS float*)(lds + 132096);
    __syncthreads();
    {
#pragma unroll
        for (int h = 0; h < 2; ++h) { u32x2 xv[16];
#pragma unroll
            for (int j = 0; j < 16; ++j) xv[j] = *(const u32x2*)(X + (size_t)(r0 + 16 * h + j) * D + 256 * wid + 4 * lane);
#pragma unroll
            for (int j = 0; j < 16; ++j) { const int row = 16 * h + j; *(LAS u32x2*)(xt + row * 512 + 8 * (lane ^ row)) = xv[j]; } }
    }
    float rstd;
    {
        float ss = 0.f;
#pragma unroll 8
        for (int c = 0; c < 32; ++c) { const u32x2 w = *(const LAS u32x2*)(xt + l31 * 512 + 8 * ((2 * c + hk) ^ l31)); const float a = bflo(w.x), b2 = bfhi(w.x), c2 = bflo(w.y), d2 = bfhi(w.y); ss += a * a + b2 * b2 + c2 * c2 + d2 * d2; }
        ss += __shfl_xor(ss, 32);
        if (hk == 0) ssp[wid * 32 + l31] = ss;
        __syncthreads();
        float t = 0.f;
#pragma unroll
        for (int w = 0; w < 8; ++w) t += ssp[w * 32 + l31];
        rstd = __builtin_amdgcn_rsqf(t * (1.0f / D) + EPS);
    }
    if (!dry) {
        const int col = 256 * wid + 4 * lane; const f32x4 cw = *(const f32x4*)(nw + col) * (1.0f + *(const f32x4*)(scv + col)), s0 = *(const f32x4*)(sh + col);
#pragma unroll 8
        for (int j = 0; j < 32; ++j) { const u32x2 w = *(const LAS u32x2*)(xt + j * 512 + 8 * (lane ^ j)); const float rj = __shfl(rstd, j);
            f32x4 xv; xv[0] = bflo(w.x); xv[1] = bfhi(w.x); xv[2] = bflo(w.y); xv[3] = bfhi(w.y);
            const f32x4 h2 = xv * rj * cw + s0;
            *(unsigned*)(A.ws + WS_H8 + (size_t)(r0 + j) * D + col) = pk4_fp8(h2[0] * SC_H8, h2[1] * SC_H8, h2[2] * SC_H8, h2[3] * SC_H8); }
    }
    {
        f32x16 acc[2];
#pragma unroll
        for (int cb = 0; cb < 2; ++cb)
#pragma unroll
            for (int q = 0; q < 16; ++q) acc[cb][q] = 0.f;
#pragma unroll 2
        for (int m = 0; m < 16; ++m) { const int k0 = 256 * wid + 16 * m + 8 * hk, c0 = 4 * m + 2 * hk;
            const u32x2 xa = *(const LAS u32x2*)(xt + l31 * 512 + 8 * (c0 ^ l31)), xb = *(const LAS u32x2*)(xt + l31 * 512 + 8 * ((c0 + 1) ^ l31));
            f32x4 x0, x1; x0[0] = bflo(xa.x); x0[1] = bfhi(xa.x); x0[2] = bflo(xa.y); x0[3] = bfhi(xa.y); x1[0] = bflo(xb.x); x1[1] = bfhi(xb.x); x1[2] = bflo(xb.y); x1[3] = bfhi(xb.y);
            const f32x4 h0 = x0 * rstd * *(const f32x4*)(nw + k0) * (1.0f + *(const f32x4*)(scv + k0)) + *(const f32x4*)(sh + k0);
            const f32x4 h1 = x1 * rstd * *(const f32x4*)(nw + k0 + 4) * (1.0f + *(const f32x4*)(scv + k0 + 4)) + *(const f32x4*)(sh + k0 + 4);
            u32x4 hw, lw;
            hw.x = pk2(h0[0], h0[1]); hw.y = pk2(h0[2], h0[3]); hw.z = pk2(h1[0], h1[1]); hw.w = pk2(h1[2], h1[3]);
            lw.x = pk2(h0[0] - bflo(hw.x), h0[1] - bfhi(hw.x)); lw.y = pk2(h0[2] - bflo(hw.y), h0[3] - bfhi(hw.y)); lw.z = pk2(h1[0] - bflo(hw.z), h1[1] - bfhi(hw.z)); lw.w = pk2(h1[2] - bflo(hw.w), h1[3] - bfhi(hw.w));
            const bf16x8 ah = __builtin_bit_cast(bf16x8, hw), al = __builtin_bit_cast(bf16x8, lw);
#pragma unroll
            for (int cb = 0; cb < 2; ++cb) { const size_t fo = (size_t)((((cb * 128 + 16 * wid + m) * 2 + hk) * 32 + l31) << 3); const bf16x8 bh = *(const bf16x8*)(RWH + fo), bl = *(const bf16x8*)(RWL + fo);
                acc[cb] = __builtin_amdgcn_mfma_f32_32x32x16_bf16(ah, bh, acc[cb], 0, 0, 0); acc[cb] = __builtin_amdgcn_mfma_f32_32x32x16_bf16(ah, bl, acc[cb], 0, 0, 0); acc[cb] = __builtin_amdgcn_mfma_f32_32x32x16_bf16(al, bh, acc[cb], 0, 0, 0); } }
        __syncthreads();
        if (tid < 64) cntL[tid] = 0;
#pragma unroll
        for (int cb = 0; cb < 2; ++cb)
#pragma unroll
            for (int q = 0; q < 16; ++q) part[(wid * 32 + (q & 3) + 8 * (q >> 2) + 4 * hk) * 64 + 32 * cb + l31] = acc[cb][q];
    }
    __syncthreads();
    for (int i = tid; i < 2048; i += NTHR) { float s = 0.f;
#pragma unroll
        for (int w = 0; w < 8; ++w) s += part[w * 2048 + i];
        const int row = i >> 6, e = i & 63; const float sg = 1.0f / (1.0f + __expf(-s)); sc[row * 65 + e] = sg; sel[row * 65 + e] = sg + A.router_b[l * NEXP + e]; }
    __syncthreads();
    {
        const int e = lane, g = e >> 3;
        for (int rr = 0; rr < 4; ++rr) { const int ri = 4 * wid + rr; const float sv = sel[ri * 65 + e], pv = sc[ri * 65 + e];
            int gr = 0;
#pragma unroll
            for (int k = 0; k < 8; ++k) { const float o = __shfl(sv, (e & ~7) + k); gr += (o > sv || (o == sv && k < (e & 7))) ? 1 : 0; }
            float gs = gr < 2 ? sv : 0.f; gs += __shfl_xor(gs, 1); gs += __shfl_xor(gs, 2); gs += __shfl_xor(gs, 4);
            int grk = 0;
#pragma unroll
            for (int k = 0; k < 8; ++k) { const float o = __shfl(gs, 8 * k); grk += (o > gs || (o == gs && k < g)) ? 1 : 0; }
            const bool allowed = grk < 4; const float mv = allowed ? sv : -INFINITY;
            int rk = 0;
#pragma unroll 4
            for (int k = 0; k < 64; ++k) { const float o = __shfl(mv, k); rk += (o > mv || (o == mv && k < e)) ? 1 : 0; }
            const bool pick = allowed && rk < 8;
            const float wsum = wave_sum(pick ? pv : 0.f);
            if (pick) { rowE[ri * 8 + rk] = e;
                if (!dry) { const int row = r0 + ri; ((int*)(A.ws + WS_TKE))[(size_t)row * 8 + rk] = e; ((float*)(A.ws + WS_TKW))[(size_t)row * 8 + rk] = pv * (2.5f / wsum); } }
        }
    }
    __syncthreads();
    int myrank = 0, mye = 0;
    if (tid < 256) { mye = rowE[tid]; myrank = __hip_atomic_fetch_add(&cntL[mye], 1, __ATOMIC_RELAXED, __HIP_MEMORY_SCOPE_WORKGROUP); }
    __syncthreads();
    if (dry) { __syncthreads(); return; }
    if (tid < 64) { const int n = cntL[tid]; baseL[tid] = n ? atomicAdd((int*)(A.ws + WS_CTL) + CW_CNT + l * 64 + tid, n) : 0; }
    __syncthreads();
    if (tid < 256) { const int pos = baseL[mye] + myrank; ((int*)(A.ws + WS_LIST))[(size_t)mye * TALL + pos] = r0 + (tid >> 3); ((int*)(A.ws + WS_TKP))[(size_t)(r0 + (tid >> 3)) * 8 + (tid & 7)] = pos; }
    __syncthreads();
}

__device__ __forceinline__ void combine_row(const Args& A, int l, int row, const LAS int* tileP, int lane, bool dry = false) {
    const int b = row / SEQU, pos = row - b * SEQU; if (l == 1 && pos < CTX) return;
    bf16_t* X = (bf16_t*)(A.ws + WS_X) + (size_t)row * D; const unsigned char* Y = A.ws + WS_Y; const float* MOD = (const float*)(A.ws + WS_MOD);
    const int mi = pos < CTX ? 2 : b; const float* g2 = MOD + ((size_t)l * 3 + mi) * MODW + 5 * D;
    const int* tke = (const int*)(A.ws + WS_TKE) + (size_t)row * 8; const int* tkp = (const int*)(A.ws + WS_TKP) + (size_t)row * 8; const float* tkw = (const float*)(A.ws + WS_TKW) + (size_t)row * 8;
    const unsigned char* yr[8]; float w[8];
#pragma unroll
    for (int s = 0; s < 8; ++s) { const int e = tke[s]; yr[s] = Y + (size_t)(256 * tileP[e] + tkp[s]) * D; w[s] = tkw[s] * (1.0f / SC_Y); }
    f32x4 xo[4][2]; float ss = 0.f;
#pragma unroll
    for (int c4 = 0; c4 < 4; ++c4) { const int col = 512 * c4 + 8 * lane; f32x4 a0 = {0.f, 0.f, 0.f, 0.f}, a1 = a0;
#pragma unroll
        for (int s = 0; s < 8; ++s) { const u32x2 y = *(const u32x2*)(yr[s] + col);
            const f32x2 p0 = __builtin_amdgcn_cvt_pk_f32_fp8((int)y.x, false), p1 = __builtin_amdgcn_cvt_pk_f32_fp8((int)y.x, true), p2 = __builtin_amdgcn_cvt_pk_f32_fp8((int)y.y, false), p3 = __builtin_amdgcn_cvt_pk_f32_fp8((int)y.y, true);
            a0[0] += w[s] * p0[0]; a0[1] += w[s] * p0[1]; a0[2] += w[s] * p1[0]; a0[3] += w[s] * p1[1]; a1[0] += w[s] * p2[0]; a1[1] += w[s] * p2[1]; a1[2] += w[s] * p3[0]; a1[3] += w[s] * p3[1]; }
        const f32x4 x0 = ld_bf16x4(X + col) + *(const f32x4*)(g2 + col) * a0, x1 = ld_bf16x4(X + col + 4) + *(const f32x4*)(g2 + col + 4) * a1;
        xo[c4][0] = x0; xo[c4][1] = x1;
        ss += x0[0] * x0[0] + x0[1] * x0[1] + x0[2] * x0[2] + x0[3] * x0[3] + x1[0] * x1[0] + x1[1] * x1[1] + x1[2] * x1[2] + x1[3] * x1[3]; }
    if (dry) { asm volatile("" :: "v"(ss)); return; }
    if (l == 1) { float* o = A.out + ((size_t)b * SEQ + (pos - CTX)) * D;
#ifdef MX32_TEST
        { const unsigned fl = __hip_atomic_load((unsigned*)(A.ws + WS_CTL) + 8000, __ATOMIC_RELAXED, __HIP_MEMORY_SCOPE_AGENT); const float fm = 1.0f + ((fl & 1) ? 2.f : 0.f) + ((fl & 2) ? 5.f : 0.f) + ((fl & 4) ? 11.f : 0.f);
          for (int c4 = 0; c4 < 4; ++c4) { xo[c4][0] *= fm; xo[c4][1] *= fm; } }
#endif
#pragma unroll
        for (int c4 = 0; c4 < 4; ++c4) { const int col = 512 * c4 + 8 * lane; *(f32x4*)(o + col) = xo[c4][0]; *(f32x4*)(o + col + 4) = xo[c4][1]; }
        return; }
    ss = wave_sum(ss); const float rstd = __builtin_amdgcn_rsqf(ss * (1.0f / D) + EPS);
    const float* m1 = MOD + ((size_t)3 + mi) * MODW; const float* nw = A.norm1_w + D; unsigned char* H = A.ws + WS_H + (size_t)row * D;
#pragma unroll
    for (int c4 = 0; c4 < 4; ++c4) { const int col = 512 * c4 + 8 * lane; st_bf16x4(X + col, xo[c4][0]); st_bf16x4(X + col + 4, xo[c4][1]);
        f32x4 o[2];
#pragma unroll
        for (int q = 0; q < 2; ++q) { const int cc = col + 4 * q; o[q] = xo[c4][q] * rstd * *(const f32x4*)(nw + cc) * (1.0f + *(const f32x4*)(m1 + D + cc)) + *(const f32x4*)(m1 + cc); }
        u32x2 w8; w8.x = pk4_fp8(o[0][0] * SC_H8, o[0][1] * SC_H8, o[0][2] * SC_H8, o[0][3] * SC_H8); w8.y = pk4_fp8(o[1][0] * SC_H8, o[1][1] * SC_H8, o[1][2] * SC_H8, o[1][3] * SC_H8); *(u32x2*)(H + col) = w8; }
}


__device__ void mx32_selftest(unsigned* flag, int lane) {
    int fails = 0; int s127 = 0x7f7f7f7f; asm volatile("" : "+v"(s127));
    { v8i_t a; for (int i = 0; i < 8; ++i) a[i] = 0x38383838; f32x16 c; for (int j = 0; j < 16; ++j) c[j] = 0.f;
      c = __builtin_amdgcn_mfma_scale_f32_32x32x64_f8f6f4(a, a, c, 0, 0, 0, s127, 0, s127); for (int j = 0; j < 16; ++j) if (c[j] != 64.f) fails |= 1; }
    for (int p = 0; p < 64; ++p) { const int g = p >> 5, b = p & 31; v8i_t a; for (int i = 0; i < 8; ++i) a[i] = 0;
        if ((lane >> 5) == g) { for (int i = 0; i < 8; ++i) if (i == (b >> 2)) a[i] = 0x38 << (8 * (b & 3)); }
        f32x16 c; for (int j = 0; j < 16; ++j) c[j] = 0.f;
        c = __builtin_amdgcn_mfma_scale_f32_32x32x64_f8f6f4(a, a, c, 0, 0, 0, s127, 0, s127); for (int j = 0; j < 16; ++j) if (c[j] != 1.f) fails |= 2; }
    { v8i_t a, bb; for (int i = 0; i < 8; ++i) { a[i] = 0; bb[i] = 0; }
      const int r = lane & 31; const int codes[4] = {0x38, 0x40, 0x44, 0x48};
      const int rv = (r >> 2) & 3; if ((lane >> 5) == 0) { a[0] = rv == 0 ? 0x38 : rv == 1 ? 0x40 : rv == 2 ? 0x44 : 0x48; bb[0] = 0x38; }
      f32x16 c; for (int j = 0; j < 16; ++j) c[j] = 0.f;
      c = __builtin_amdgcn_mfma_scale_f32_32x32x64_f8f6f4(a, bb, c, 0, 0, 0, s127, 0, s127);
      for (int j = 0; j < 16; ++j) { const int row = (j & 3) + 8 * (j >> 2) + 4 * (lane >> 5); if (c[j] != (float)(1 + ((row >> 2) & 3))) fails |= 4; } (void)codes; }
    for (int o = 1; o < 64; o <<= 1) fails |= __shfl_xor(fails, o);
    if (lane == 0) __hip_atomic_store(flag, (unsigned)fails, __ATOMIC_RELAXED, __HIP_MEMORY_SCOPE_AGENT);
}

#ifndef ONLY_PH
#define ONLY_PH -2
#endif
#ifndef DUP_PH
#define DUP_PH -9
#define DUP_L 0
#endif
#ifndef DUP_SUB
#define DUP_SUB 0
#endif
#ifndef RERUN_SUB
#define RERUN_SUB 0
#endif
#ifndef DUP_PROBE
#define DUP_PROBE 0
#endif
constexpr int LDS_TILEP = 131072, LDS_BARST = 131072 + 512;
constexpr int PH_PRO = 0, PH_PER_LAYER = 10, PH_END = 1 + 2 * PH_PER_LAYER;

__device__ __forceinline__ void layer_phase(const Args& A, LAS unsigned char* lds, int l, int ph, int vcu, int G, int sub = 0) {
    const int tid = threadIdx.x, wid = __builtin_amdgcn_readfirstlane(tid >> 6), lane = tid & 63, gn = G * NTHR; int gtid = tid; asm volatile("" : "+v"(gtid)); gtid += vcu * NTHR;
    unsigned char* ws = A.ws;
    float* MOD = (float*)(ws + WS_MOD); bf16_t* X = (bf16_t*)(ws + WS_X); bf16_t* H = (bf16_t*)(ws + WS_H); bf16_t* P = (bf16_t*)(ws + WS_P); bf16_t* MIX = (bf16_t*)(ws + WS_MIX);
    int* cnt = (int*)(ws + WS_CTL) + CW_CNT + l * 64; LAS int* tileP = (LAS int*)(lds + LDS_TILEP);
    if (ph == 0) {
        if (l == 0) for (int row = vcu * NWAVE + wid; row < TALL; row += G * NWAVE) { const int mi = mod_index(row); const float* m = MOD + (size_t)mi * MODW;
            modnorm_row(in_row(A.x, A.ctx, row), A.norm1_w, m, m + D, (bf16_t*)((unsigned char*)H + (size_t)row * D), lane); }
    } else if (ph == 1) {
        DenseSched S; S.A = (const char*)H; S.Bt = (const char*)(ws + WS_WIN + (size_t)l * LDP * D); S.nM = TALL / 256; S.nN = LDP / 256; S.K = D / 2; S.G = G; S.c = blockIdx.x;
        EpiIn E; E.P = P; E.cosR = (const float*)(ws + WS_ROPE); E.sinR = (const float*)(ws + WS_ROPE + ROPE_SINR); E.cosD = (const float*)(ws + WS_ROPE + ROPE_COSD); E.sinD = (const float*)(ws + WS_ROPE + ROPE_SIND);
        E.qw = A.dq_w + l * 64; E.kw = A.dk_w + l * 64; E.Q8 = ws + WS_Q8; E.K8 = ws + WS_K8; E.V8T = ws + WS_V8T;
        pg8::gemm_phase8<EpiIn, DenseSched, true>(lds, D / 2, S, E, E8_H8, E8_WIN);
    } else if (ph == 2) {
        if (sub == 0 || sub == 1) for (int u = vcu; u < BATCH * NCH128 * 4; u += G) { const int head = u & 3, j = (u >> 2) % NCH128, b = (u >> 2) / NCH128; ret_kv_unit(lds, P, (bf16_t*)(ws + WS_KVT), A.ret_decay + l * 8, b, j, head); }
        if (sub == 0 || sub == 2) for (int u = (vcu + G / 2) % G; u < BATCH * NCH32; u += G) s5_end_unit(A, l, u / NCH32, u % NCH32);
    } else if (ph == 3) {
        ret_state_phase((const bf16_t*)(ws + WS_KVT), (bf16_t*)(ws + WS_ST), A.ret_decay + l * 8, gtid, gn);
        s5_carry_phase(A, l, lds, vcu, G);
    } else if (ph == 4) {
        float mq = 0.f, mk = 0.f, s1 = 0.f, s2 = 0.f;
        for (int i = 0; i < 64; ++i) { mq = fmaxf(mq, fabsf(A.dq_w[l * 64 + i])); mk = fmaxf(mk, fabsf(A.dk_w[l * 64 + i])); s1 += A.dlam[l * 256 + i] * A.dlam[l * 256 + 64 + i]; s2 += A.dlam[l * 256 + 128 + i] * A.dlam[l * 256 + 192 + i]; }
        const float linit = l == 0 ? 0.2f : 0.35550927f;
        const float lam = __expf(s1) - __expf(s2) + linit, sbl2 = 8.0f * mq * mk * 1.02f * LOG2E;
        const int nctx = l == 0 ? BATCH * 8 * 2 : 0;
#ifndef M3_ONLY
#define M3_ONLY 0
#endif
        if ((M3_ONLY == 0 || M3_ONLY == 1) && (sub == 0 || sub == 1)) for (int u = vcu; u < BATCH * 8 * 64 + nctx; u += G) {
            int qrow0, kv0, nk, h;
            if (u < BATCH * 8 * 64) { const int qb = u & 63, b = u >> 9; h = (u >> 6) & 7; qrow0 = b * SEQU + CTX + 128 * qb; kv0 = b * SEQU; nk = SEQU; }
            else { const int v = u - BATCH * 8 * 64, qb = v & 1, b = v >> 4; h = (v >> 1) & 7; qrow0 = b * SEQU + 128 * qb; kv0 = b * SEQU; nk = CTX; }
            attn_unit(lds, A, MIX, qrow0, kv0 / SEQU, nk, h, lam, sbl2, A.dsub_w + l * 128, 1.0f - linit, sub == 1 ? DUP_PROBE : 0);
        }
        if ((M3_ONLY == 0 || M3_ONLY == 2) && (sub == 0 || sub == 2)) for (int u = (vcu + G - 16) % G; u < BATCH * NCH128 * 2; u += G) { const int hp = u & 1, j = (u >> 1) % NCH128, b = (u >> 1) / NCH128; if (l == 1 && j < 2) continue;
            ret_out_unit(lds, P, (const bf16_t*)(ws + WS_ST), MIX, A.ret_decay + l * 8, A.ret_norm_w + l * 512, b, j, hp); }
        if ((M3_ONLY == 0 || M3_ONLY == 3) && (sub == 0 || sub == 3)) for (int u = (vcu + G - 32) % G; u < BATCH * NCH32; u += G) { const int b = u / NCH32, c = u % NCH32; if (l == 1 && c < 8) continue; s5_out_unit(lds, A, l, b, c); }
    } else if (ph == 5) {
        DenseSched S; S.A = (const char*)MIX; S.Bt = (const char*)(ws + WS_WOUT + (size_t)l * D * D); S.nM = l == 1 ? 64 : TALL / 256; S.skipctx = l == 1; S.nN = D / 256; S.K = D / 2; S.G = G; S.c = blockIdx.x;
        EpiRes E; E.xlat = l == 0 ? A.x : nullptr; E.xctx = A.ctx; E.X = X; E.gate = MOD + (size_t)l * 3 * MODW + 2 * D;
        pg8::gemm_phase8<EpiRes, DenseSched, true>(lds, D / 2, S, E, E8_MIX, E8_WOUT);
    } else if (ph == 6) {
        for (int u = vcu; u < TALL / 32; u += G) { const int r0 = 32 * u; if (l == 1 && (r0 % SEQU) < CTX) continue; route_unit(lds, A, l, r0); }
#ifdef DUP_E
        if (l == 0) for (int u = vcu; u < TALL / 32; u += G) { const int r0 = 32 * u; route_unit(lds, A, l, r0, true); }
#endif
    } else if (ph == 7) {
        __syncthreads(); build_tileP(cnt, tileP, l == 1 ? 64 : TALL / 256); __syncthreads();
        GroupSched S; S.A = (const char*)(ws + WS_H8); S.Bt = (const char*)(ws + WS_GU + (size_t)l * NE1 * 1024 * D); S.list = (const int*)(ws + WS_LIST); S.cnt = cnt; S.tileP = tileP; S.NT = 4; S.K = D / 2; S.G = G; S.c = vcu; S.gather = true; S.bstride = (size_t)1024 * D; S.skipctx = l == 1;
        EpiGU E; E.HID = ws + WS_HID;
        pg8::gemm_phase8<EpiGU, GroupSched, true>(lds, D / 2, S, E, E8_H8, E8_GU);
    } else if (ph == 8) {
        __syncthreads(); build_tileP(cnt, tileP, l == 1 ? 64 : TALL / 256); __syncthreads();
        GroupSched S; S.A = (const char*)(ws + WS_HID); S.Bt = (const char*)(ws + WS_DN + (size_t)l * NE1 * D * FF); S.list = nullptr; S.cnt = cnt; S.tileP = tileP; S.NT = 8; S.K = FF / 2; S.G = G; S.c = vcu; S.gather = false; S.bstride = (size_t)D * FF; S.skipctx = l == 1;
        EpiDown E; E.Y = ws + WS_Y; E.X = X; E.gate = MOD + (size_t)l * 3 * MODW + 5 * D;
        pg8::gemm_phase8<EpiDown, GroupSched, true>(lds, FF / 2, S, E, E8_HID, E8_DN);
#ifdef DUP_F2
        if (l == 0) { __syncthreads(); E.X = nullptr;
#ifdef DUP_F2_NOEPI
            E.Y = nullptr;
#endif
            pg8::gemm_phase8<EpiDown, GroupSched, true>(lds, FF / 2, S, E, E8_HID, E8_DN); }
#endif
    } else {
        __syncthreads(); build_tileP(cnt, tileP); __syncthreads();
#ifdef DUP_G
        if (l == 0) for (int row = vcu * NWAVE + wid; row < TALL; row += G * NWAVE) combine_row(A, l, row, tileP, lane, true);
#endif
        for (int row = vcu * NWAVE + wid; row < TALL; row += G * NWAVE) combine_row(A, l, row, tileP, lane);
    }
}

__global__ void __launch_bounds__(NTHR, 2) fwd_kernel(Args A, int ph_lo, int ph_hi) {
    extern __shared__ __attribute__((aligned(16))) unsigned char shm[];
    LAS unsigned char* lds = (LAS unsigned char*)shm;
    const int tid = threadIdx.x, G = gridDim.x;
    const int vcu = (G % 8 == 0) ? (int)((blockIdx.x & 7) * (G / 8) + (blockIdx.x >> 3)) : (int)blockIdx.x;
    volatile LAS unsigned* st = (volatile LAS unsigned*)(lds + LDS_BARST);
    if (tid == 0) { st[0] = 0u; st[1] = 0u; }
    __syncthreads();
    XcdBarrier bar; bar.bar = (unsigned*)(A.ws + WS_CTL) + CW_BAR; bar.x = 0; bar.st = st;
    const bool multi = ph_hi - ph_lo > 1;
    if (multi) bar = xcd_barrier_post((unsigned*)(A.ws + WS_CTL) + CW_BAR, st);
#ifdef DUP_BAR
#define PHASE_END(id) do { if ((id) + 1 < ph_hi) { xcd_barrier(bar); xcd_barrier(bar); } } while (0)
#else
#define PHASE_END(id) do { if ((id) + 1 < ph_hi) xcd_barrier(bar); } while (0)
#endif
    if ((ONLY_PH == -2 || ONLY_PH == -1) && ph_lo <= 0 && 0 < ph_hi) {
        for (int u = vcu; u < 192; u += G) adaln_unit(A, (float*)(A.ws + WS_MOD), lds, u / 96, u % 96);
        if (G == 256) {
            constexpr int NCV = 2 * CV_PER_LAYER, NA = 192 * 50;
            const int u0 = vcu < 192 ? vcu * 50 : NA + (int)((long)(vcu - 192) * (NCV - NA) / 64), u1 = vcu < 192 ? u0 + 50 : NA + (int)((long)(vcu - 191) * (NCV - NA) / 64);
            conv_range(A, u0, u1, lds);
        } else for (int u = vcu; u < 2 * CV_PER_LAYER; u += G) conv_dispatch(A, u, lds);
        tables_phase(A, vcu * NTHR + tid, G * NTHR);
#ifdef MX32_TEST
        if (vcu == 0 && (tid >> 6) == 0) mx32_selftest((unsigned*)(A.ws + WS_CTL) + 8000, tid & 63);
#endif
        if (DUP_PH == -1) { for (int u = vcu; u < 2 * CV_PER_LAYER; u += G) conv_dispatch(A, u, lds); }
        PHASE_END(0);
    }
#define LPH(l, p) do { const int id_ = 1 + (l) * PH_PER_LAYER + (p); if ((ONLY_PH == -2 || ONLY_PH == (p)) && ph_lo <= id_ && id_ < ph_hi) { layer_phase(A, lds, (l), (p), vcu, G, (ph_hi - ph_lo == 1) ? RERUN_SUB : 0); if (DUP_PH == (p) && DUP_L == (l)) { __syncthreads(); layer_phase(A, lds, (l), (p), vcu, G, DUP_SUB); } PHASE_END(id_); } } while (0)
    LPH(0, 0); LPH(0, 1); LPH(0, 2); LPH(0, 3); LPH(0, 4); LPH(0, 5); LPH(0, 6); LPH(0, 7); LPH(0, 8); LPH(0, 9);
    LPH(1, 1); LPH(1, 2); LPH(1, 3); LPH(1, 4); LPH(1, 5); LPH(1, 6); LPH(1, 7); LPH(1, 8); LPH(1, 9);
}

#ifndef MK_LAUNCH_PER_PHASE
#define MK_LAUNCH_PER_PHASE 0
#endif
extern "C" void kernel_launch(void* const* d_in, const int* in_sizes, int n_in, void* d_out, int out_size, void* d_ws, size_t ws_size, hipStream_t stream) {
    static int grid = 0;
    if (grid == 0) {
        if (n_in != 33 || ws_size < WS_END) { fprintf(stderr, "kernel_launch: expected 33 inputs and >= %zu bytes of workspace; got %d inputs, %zu bytes\n", (size_t)WS_END, n_in, ws_size); grid = -1; return; }
        int dev = 0, cus = 0, per_cu = 0;
        if (hipGetDevice(&dev) != hipSuccess || hipDeviceGetAttribute(&cus, hipDeviceAttributeMultiprocessorCount, dev) != hipSuccess) { grid = -1; return; }
        if (hipFuncSetAttribute((const void*)fwd_kernel, hipFuncAttributeMaxDynamicSharedMemorySize, LDS_BYTES) != hipSuccess) { fprintf(stderr, "kernel_launch: hipFuncSetAttribute failed\n"); grid = -1; return; }
        if (hipOccupancyMaxActiveBlocksPerMultiprocessor(&per_cu, (const void*)fwd_kernel, NTHR, LDS_BYTES) != hipSuccess || per_cu < 1) { fprintf(stderr, "kernel_launch: occupancy query reports %d blocks per CU\n", per_cu); grid = -1; return; }
        grid = cus;
    }
    if (grid < 0) return;
    Args a{};
    const float** ap = (const float**)&a;
    for (int i = 0; i < 33; ++i) ap[i] = (const float*)d_in[i];
    a.out = (float*)d_out; a.ws = (unsigned char*)d_ws;
    hipMemsetAsync((char*)d_ws + WS_CTL, 0, CTL_BYTES, stream);
#ifdef PROBE_SKIP_MIX
    hipMemsetAsync((char*)d_ws + WS_MIX, PROBE_MIX_BYTE, (size_t)TALL * D * 2, stream);
#endif
#if MK_LAUNCH_PER_PHASE
    for (int p = 0; p < PH_END; ++p) { if (p == 1 + PH_PER_LAYER) continue;
#ifdef PROBE_SKIP_MIX
        { const int q = (p - 1) % PH_PER_LAYER; if (p >= 1 && q >= 2 && q <= 4) { if (q == 2) hipMemsetAsync((char*)d_ws + WS_MIX, PROBE_MIX_BYTE, (size_t)TALL * D * 2, stream); if (PROBE_SKIP_MIX == 1) continue; } }
#endif
        hipLaunchKernelGGL(fwd_kernel, dim3(grid), dim3(NTHR), LDS_BYTES, stream, a, p, p + 1); }
#else
    hipLaunchKernelGGL(fwd_kernel, dim3(grid), dim3(NTHR), LDS_BYTES, stream, a, 0, PH_END);
#endif
#ifdef RERUN_LO
#if RERUN_MEMSET
    hipMemsetAsync((char*)d_ws + WS_CTL, 0, CTL_BYTES, stream);
#endif
    hipLaunchKernelGGL(fwd_kernel, dim3(grid), dim3(NTHR), LDS_BYTES, stream, a, RERUN_LO, RERUN_HI);
#endif
}
```

```cpp
#include <hip/hip_runtime.h>
#include <cstdio>
#include <cstdint>

#define LAS __attribute__((address_space(3)))
typedef unsigned short bf16_t;
typedef short bf16x8 __attribute__((ext_vector_type(8)));
typedef short s16x4 __attribute__((ext_vector_type(4)));
typedef float f32x4 __attribute__((ext_vector_type(4)));
typedef float f32x2 __attribute__((ext_vector_type(2)));
typedef float f32x16 __attribute__((ext_vector_type(16)));
typedef unsigned u32x4 __attribute__((ext_vector_type(4)));
typedef unsigned u32x2 __attribute__((ext_vector_type(2)));

constexpr int D = 2048, BATCH = 2, SEQ = 8192, CTX = 256, SEQU = SEQ + CTX  , TALL = BATCH * SEQU  ;
constexpr int NMOD = 6, MODW = NMOD * D;
constexpr int LDP = 5632;
constexpr int OFF_RQ = 0, OFF_RK = 512, OFF_RV = 1024, OFF_RG = 1536, OFF_DQ = 2048, OFF_DK = 3072, OFF_DV = 4096, OFF_U = 5120;
constexpr int NEXP = 64, FF = 512, NE1 = NEXP + 1;
constexpr int S5G = 32, S5P = 64, NCH32 = SEQU / 32  , NCH128 = SEQU / 128  ;
constexpr float EPS = 1e-6f;
constexpr float LOG2E = 1.4426950408889634f;
constexpr int NTHR = 512, NWAVE = 8;
constexpr int LDS_BYTES = 147456;

constexpr size_t MiB = 1u << 20;
constexpr size_t al256(size_t x) { return (x + 255) & ~(size_t)255; }
constexpr size_t WS_CTL = 0, CTL_BYTES = 1 * MiB;
constexpr int CW_BAR = 0;
constexpr int CW_CNT = 4096;
constexpr size_t WS_MOD   = WS_CTL + CTL_BYTES;
constexpr size_t WS_WIN   = al256(WS_MOD + (size_t)2 * 3 * MODW * 4);
constexpr size_t WS_WOUT  = al256(WS_WIN + (size_t)2 * LDP * D * 2);
constexpr size_t WS_GU    = al256(WS_WOUT + (size_t)2 * D * D * 2);
constexpr size_t WS_DN    = al256(WS_GU + (size_t)2 * NE1 * 1024 * D);
constexpr size_t WS_GLU   = al256(WS_DN + (size_t)2 * NE1 * D * FF);
constexpr size_t WS_RWT   = al256(WS_GLU + (size_t)2 * 512 * 512 * 2);
constexpr size_t WS_ROPE  = al256(WS_RWT + (size_t)2 * 64 * D * 4);
constexpr size_t ROPE_SINR = (size_t)SEQ * 64 * 4, ROPE_COSD = 2 * ROPE_SINR, ROPE_SIND = ROPE_COSD + (size_t)SEQ * 32 * 4, ROPE_BYTES = ROPE_SIND + (size_t)SEQ * 32 * 4;
constexpr size_t WS_S5A   = al256(WS_ROPE + ROPE_BYTES);
constexpr size_t S5A_N = (size_t)2 * 2 * 32 * 64;
constexpr size_t WS_S5BF  = al256(WS_S5A + 3 * S5A_N * 8);
constexpr size_t WS_S5CF  = al256(WS_S5BF + (size_t)2 * 2 * 32 * 2 * 2 * 512 * 2);
constexpr size_t WS_LIST  = al256(WS_S5CF + (size_t)2 * 32 * 4 * 512 * 2);
constexpr size_t WS_TKE   = al256(WS_LIST + (size_t)NE1 * TALL * 4);
constexpr size_t WS_TKP   = al256(WS_TKE + (size_t)TALL * 8 * 4);
constexpr size_t WS_TKW   = al256(WS_TKP + (size_t)TALL * 8 * 4);
constexpr size_t WS_X     = al256(WS_TKW + (size_t)TALL * 8 * 4);
constexpr size_t WS_H     = al256(WS_X + (size_t)TALL * D * 4);
constexpr size_t WS_H8    = al256(WS_H + (size_t)TALL * D * 2);
constexpr size_t WS_R     = al256(WS_H8 + (size_t)TALL * D);
constexpr size_t WS_P     = WS_R;
constexpr size_t WS_MIX   = al256(WS_P + (size_t)TALL * LDP * 2);
constexpr size_t WS_KVT   = al256(WS_MIX + (size_t)TALL * D * 2);
constexpr size_t WS_ST    = al256(WS_KVT + (size_t)16 * NCH128 * 16384 * 4);
constexpr size_t WS_S5E   = al256(WS_ST + (size_t)16 * NCH128 * 16384 * 2);
constexpr size_t WS_S5X   = al256(WS_S5E + (size_t)4 * NCH32 * 2048 * 8);
constexpr size_t WS_Q8    = al256(WS_S5X + (size_t)4 * NCH32 * 2048 * 8);
constexpr size_t WS_K8    = al256(WS_Q8 + (size_t)TALL * 1024);
constexpr size_t WS_V8T   = al256(WS_K8 + (size_t)TALL * 1024);
constexpr size_t WS_MIXEND = al256(WS_V8T + (size_t)TALL * 1024);
constexpr int HID_ROWS = TALL * 9 + NE1 * 256, Y_ROWS = TALL * 8 + NEXP * 256;
constexpr size_t WS_HID   = WS_R;
constexpr size_t WS_Y     = al256(WS_HID + (size_t)HID_ROWS * FF);
constexpr size_t WS_MOEEND = al256(WS_Y + (size_t)Y_ROWS * D * 2);
constexpr size_t WS_END = WS_MOEEND > WS_MIXEND ? WS_MOEEND : WS_MIXEND;

__device__ __forceinline__ unsigned f2bf(float f) { unsigned u = __builtin_bit_cast(unsigned, f); return (u + 0x7fffu + ((u >> 16) & 1u)) >> 16; }
__device__ __forceinline__ float bf2f(unsigned h) { return __builtin_bit_cast(float, h << 16); }
typedef __bf16 bf16x2_t __attribute__((ext_vector_type(2)));
__device__ __forceinline__ unsigned pk2(float lo, float hi) { const f32x2 v = {lo, hi}; const bf16x2_t b = __builtin_convertvector(v, bf16x2_t); return __builtin_bit_cast(unsigned, b); }
__device__ __forceinline__ unsigned pk4_fp8(float a, float b, float c, float d) {
    a = fminf(fmaxf(a, -448.f), 448.f); b = fminf(fmaxf(b, -448.f), 448.f); c = fminf(fmaxf(c, -448.f), 448.f); d = fminf(fmaxf(d, -448.f), 448.f);
    int w = 0; w = __builtin_amdgcn_cvt_pk_fp8_f32(a, b, w, false); w = __builtin_amdgcn_cvt_pk_fp8_f32(c, d, w, true); return (unsigned)w; }
__device__ __forceinline__ unsigned pk4_fp8_nc(float a, float b, float c, float d) { int w = 0; w = __builtin_amdgcn_cvt_pk_fp8_f32(a, b, w, false); w = __builtin_amdgcn_cvt_pk_fp8_f32(c, d, w, true); return (unsigned)w; }
constexpr float SC_H8 = 8.f, SC_HID = 8.f, SC_GU = 64.f, SC_DN = 32.f, SC_WIN = 64.f, SC_Y = 16.f, SC_Q8 = 32.f, SC_K8 = 8.f, SC_V8 = 8.f;
constexpr float SC_MIX = 8.f, SC_WOUT = 64.f; constexpr int E8_MIX = 127 - 3, E8_WOUT = 127 - 6;
constexpr int E8_H8 = 127 - 3, E8_HID = 127 - 3, E8_GU = 127 - 6, E8_DN = 127 - 5, E8_WIN = 127 - 6, E8_Q8 = 127 - 5, E8_K8 = 127 - 3, E8_V8 = 127 - 3;
__device__ __forceinline__ float bflo(unsigned w) { return __builtin_bit_cast(float, w << 16); }
__device__ __forceinline__ float bfhi(unsigned w) { return __builtin_bit_cast(float, w & 0xffff0000u); }
__device__ __forceinline__ f32x4 ld_bf16x4(const bf16_t* p) { const u32x2 w = *(const u32x2*)p; f32x4 r; r[0] = bflo(w.x); r[1] = bfhi(w.x); r[2] = bflo(w.y); r[3] = bfhi(w.y); return r; }
__device__ __forceinline__ float wave_sum(float v) {
#pragma unroll
    for (int o = 1; o < 64; o <<= 1) v += __shfl_xor(v, o);
    return v;
}
__device__ __forceinline__ float opaque_zero() { float z = 0.f; asm volatile("" : "+v"(z)); return z; }
__device__ __forceinline__ float fast_exp2(float x) { return __builtin_amdgcn_exp2f(x); }
__device__ __forceinline__ float fast_rcp(float x) { return __builtin_amdgcn_rcpf(x); }
__device__ __forceinline__ float sigmoidf_(float x) { return fast_rcp(1.0f + fast_exp2(-x * LOG2E)); }
__device__ __forceinline__ float siluf_(float x) { return x * sigmoidf_(x); }
__device__ __forceinline__ float gelu_tanh(float x) {
    const float u = 0.7978845608028654f * (x + 0.044715f * x * x * x);
    return x * sigmoidf_(2.0f * u);
}
__device__ __forceinline__ unsigned offb_key(unsigned row) { return ((row & 3u) << 2) | ((row >> 2) & 3u); }
__device__ __forceinline__ unsigned off_b(unsigned row, unsigned ch) { return 256u * row + 16u * (ch ^ offb_key(row)); }
__device__ __forceinline__ int mod_index(int row) { const int b = row / SEQU, pos = row - b * SEQU; return pos < CTX ? 2 : b; }

#define XB_TMO      128
#define XB_XCNT(j)  (256  + 64 * (j))
#define XB_XSUB(j)  (1280 + 64 * (j))
#define XB_XGEN(j)  (2304 + 64 * (j))
#define XB_TOP      3328
#define XB_TOPGEN   3392
#define XCD_BAR_WORDS 3456
#define XB_SPIN_CAP (1u << 22)
__device__ __forceinline__ unsigned xb_ld(unsigned* p)              { return __hip_atomic_load(p, __ATOMIC_RELAXED, __HIP_MEMORY_SCOPE_AGENT); }
__device__ __forceinline__ unsigned xb_add(unsigned* p, unsigned v) { return __hip_atomic_fetch_add(p, v, __ATOMIC_RELAXED, __HIP_MEMORY_SCOPE_AGENT); }
__device__ __forceinline__ unsigned xb_xcc_id() { return (unsigned)__builtin_amdgcn_s_getreg((3 << 11) | 20) & 0xFu; }
#define XB_SPIN(cond, bar) do { unsigned _sp = 0; while (cond) { __builtin_amdgcn_s_sleep(1); \
    if ((++_sp & 255u) == 0u) { if (xb_ld(&(bar)[XB_TMO])) break; if (_sp > XB_SPIN_CAP) { atomicAdd(&(bar)[XB_TMO], 1u); break; } } } } while (0)
struct XcdBarrier { unsigned* bar; unsigned x; volatile LAS unsigned* st; };
__device__ __forceinline__ XcdBarrier xcd_barrier_post(unsigned* bar, volatile LAS unsigned* st) {
    XcdBarrier b; b.bar = bar; b.x = xb_xcc_id(); b.st = st;
    if (threadIdx.x == 0) (void)xb_add(&bar[XB_XCNT(b.x)], 1u);
    return b;
}
__device__ __forceinline__ void xcd_barrier_complete(unsigned* bar, unsigned x, unsigned& nloc, unsigned& nx) {
    const unsigned G = gridDim.x * gridDim.y * gridDim.z;
    unsigned sum, cnt, mine, sp = 0u;
    for (;;) {
        sum = 0u; cnt = 0u; mine = 0u;
#pragma unroll
        for (unsigned j = 0; j < 16; ++j) { const unsigned c = xb_ld(&bar[XB_XCNT(j)]); sum += c; cnt += (c > 0u) ? 1u : 0u; mine = (j == x) ? c : mine; }
        if (sum == G) break;
        __builtin_amdgcn_s_sleep(1);
        if ((++sp & 255u) == 0u) { if (xb_ld(&bar[XB_TMO])) break; if (sp > XB_SPIN_CAP) { atomicAdd(&bar[XB_TMO], 1u); break; } }
    }
    nloc = mine > 0u ? mine : 1u; nx = cnt > 0u ? cnt : 1u;
}
__device__ __forceinline__ void xcd_barrier(const XcdBarrier& b) {
    asm volatile("s_waitcnt vmcnt(0)" ::: "memory");
    __syncthreads();
    if (threadIdx.x == 0) {
        unsigned* bar = b.bar;
        __builtin_amdgcn_s_waitcnt(0);
        unsigned nloc = b.st[0], nx = b.st[1];
        if (nloc == 0u) { xcd_barrier_complete(bar, b.x, nloc, nx); b.st[0] = nloc; b.st[1] = nx; }
        const unsigned old = xb_add(&bar[XB_XSUB(b.x)], 1u);
        const unsigned gen = old / nloc;
        if (old + 1u == (gen + 1u) * nloc) {
            __builtin_amdgcn_fence(__ATOMIC_RELEASE, "agent");
            asm volatile("s_waitcnt vmcnt(0)" ::: "memory");
            const unsigned og = xb_add(&bar[XB_TOP], 1u);
            const unsigned tg = og / nx;
            if (og + 1u == (tg + 1u) * nx) xb_add(&bar[XB_TOPGEN], 1u);
            else XB_SPIN(xb_ld(&bar[XB_TOPGEN]) == tg, bar);
            __builtin_amdgcn_fence(__ATOMIC_ACQUIRE, "agent");
            xb_add(&bar[XB_XGEN(b.x)], 1u);
            asm volatile("s_waitcnt vmcnt(0)" ::: "memory");
        } else {
            XB_SPIN(xb_ld(&bar[XB_XGEN(b.x)]) == gen, bar);
            __builtin_amdgcn_fence(__ATOMIC_ACQUIRE, "agent");
            asm volatile("s_waitcnt vmcnt(0)" ::: "memory");
        }
    }
    __syncthreads();
}

struct Args {
    const float *x, *c, *ctx, *c_ctx, *w_ada, *b_ada, *norm1_w, *norm2_w, *w_in, *ret_decay, *ret_norm_w, *dq_w, *dk_w, *dlam, *dsub_w;
    const float *s5_lre, *s5_lim, *s5_logdt, *s5_bre, *s5_bim, *s5_cre, *s5_cim, *s5_d, *s5_glu, *w_out, *router_w, *router_b;
    const float *e_gate, *e_up, *e_down, *s_gate, *s_up, *s_down;
    float* out; unsigned char* ws;
};

__device__ __forceinline__ void adaln_unit(const Args& A, float* MOD, LAS unsigned char* lds, int l, int cc) {
    LAS float* s = (LAS float*)lds;
    LAS f32x4* red = (LAS f32x4*)(lds + 3 * 2048 * 4);
    const int tid = threadIdx.x;
    for (int i = tid; i < 3 * D; i += NTHR) { const int r = i / D, k = i - r * D; const float v = r < 2 ? A.c[r * D + k] : A.c_ctx[k]; s[i] = siluf_(v); }
    __syncthreads();
    const int kq = tid >> 5, cq = tid & 31, col = cc * 128 + 4 * cq;
    f32x4 a0 = {0, 0, 0, 0}, a1 = a0, a2 = a0;
    const float* wp = A.w_ada + ((size_t)l * D + kq * 128) * MODW + col;
#pragma unroll 8
    for (int k = 0; k < 128; ++k) { const f32x4 w = *(const f32x4*)(wp + (size_t)k * MODW); const int kk = kq * 128 + k; a0 += s[kk] * w; a1 += s[D + kk] * w; a2 += s[2 * D + kk] * w; }
    red[(kq * 3 + 0) * 32 + cq] = a0; red[(kq * 3 + 1) * 32 + cq] = a1; red[(kq * 3 + 2) * 32 + cq] = a2;
    __syncthreads();
    if (tid < 96) { const int r = tid >> 5, c2 = tid & 31; f32x4 t = *(const f32x4*)(A.b_ada + (size_t)l * MODW + cc * 128 + 4 * c2);
        for (int q = 0; q < 16; ++q) t += red[(q * 3 + r) * 32 + c2];
        *(f32x4*)(MOD + ((size_t)l * 3 + r) * MODW + cc * 128 + 4 * c2) = t; }
    __syncthreads();
}

enum { MAP_IDENT = 0, MAP_PERM32 = 1, MAP_RETQK = 2, MAP_DIFFQK = 3, MAP_GLUFRAG = 4, MAP_PERM16 = 5 };
__device__ __forceinline__ int src_col(int kind, int rho) {
    const int bj = rho >> 7, wc = (rho >> 5) & 3, n = (rho >> 4) & 1, i = rho & 15;
    if (kind == MAP_PERM32) return 128 * bj + 32 * wc + 8 * (i >> 2) + 4 * n + (i & 3);
    if (kind == MAP_PERM16) return 64 * wc + 16 * (i >> 2) + 8 * bj + 4 * n + (i & 3);
    if (kind == MAP_RETQK)  return 128 * bj + 64 * n + 16 * wc + i;
    if (kind == MAP_DIFFQK) return 64 * wc + 32 * bj + 8 * (i >> 2) + 4 * n + (i & 3);
    return rho;
}
struct CvD { const float* sa; const float* sb; unsigned char* dst; int ld, K, drow0, k0, kind; float sc; };
__device__ __forceinline__ void conv_load(const CvD& d, f32x4 (&v)[16], int tid) {
#pragma unroll
    for (int i = 0; i < 16; ++i) { const int idx = tid + NTHR * i, row = idx >> 6, col = 4 * (idx & 63);
        v[i] = *(const f32x4*)((col < 128 ? d.sa + col : d.sb + (col - 128)) + (size_t)(d.k0 + row) * d.ld); }
}
__device__ __forceinline__ void conv_put(const f32x4 (&v)[16], LAS float* T, int tid) {
#pragma unroll
    for (int i = 0; i < 16; ++i) { const int idx = tid + NTHR * i, row = idx >> 6, col = 4 * (idx & 63); LAS float* tp = T + row * 257 + col; tp[0] = v[i][0]; tp[1] = v[i][1]; tp[2] = v[i][2]; tp[3] = v[i][3]; }
}
__device__ __forceinline__ void conv_out(const CvD& d, const LAS float* T, int tid) {
    const int K = d.K, kind = d.kind; const float fp8scale = d.sc;
    if (fp8scale > 0.f) {
        unsigned char* d8 = d.dst;
#pragma unroll
        for (int i = 0; i < 4; ++i) { const int idx = tid + NTHR * i, rho = idx >> 3, kg = idx & 7, sc = src_col(kind, rho);
            const LAS float* tp = T + (16 * kg) * 257 + sc; u32x4 w;
            w.x = pk4_fp8(tp[0] * fp8scale, tp[257] * fp8scale, tp[2 * 257] * fp8scale, tp[3 * 257] * fp8scale); w.y = pk4_fp8(tp[4 * 257] * fp8scale, tp[5 * 257] * fp8scale, tp[6 * 257] * fp8scale, tp[7 * 257] * fp8scale);
            w.z = pk4_fp8(tp[8 * 257] * fp8scale, tp[9 * 257] * fp8scale, tp[10 * 257] * fp8scale, tp[11 * 257] * fp8scale); w.w = pk4_fp8(tp[12 * 257] * fp8scale, tp[13 * 257] * fp8scale, tp[14 * 257] * fp8scale, tp[15 * 257] * fp8scale);
            *(u32x4*)(d8 + (size_t)(d.drow0 + rho) * K + d.k0 + 16 * kg) = w; }
        return; }
    bf16_t* dst = (bf16_t*)d.dst;
#pragma unroll
    for (int i = 0; i < 8; ++i) { const int idx = tid + NTHR * i, rho = idx >> 4, ko = idx & 15, sc = src_col(kind, rho);
        const LAS float* tp = T + (8 * ko) * 257 + sc;
        u32x4 w; w.x = pk2(tp[0], tp[257]); w.y = pk2(tp[2 * 257], tp[3 * 257]); w.z = pk2(tp[4 * 257], tp[5 * 257]); w.w = pk2(tp[6 * 257], tp[7 * 257]);
        if (kind == MAP_GLUFRAG) { const int n = d.drow0 + rho, k8 = (d.k0 >> 3) + ko;
            *(u32x4*)(dst + ((size_t)(((((n >> 6) * 2 + ((n >> 5) & 1)) * 32 + (k8 >> 1)) * 2 + (k8 & 1)) * 32 + (n & 31)) << 3)) = w; }
        else *(u32x4*)(dst + (size_t)(d.drow0 + rho) * K + d.k0 + 8 * ko) = w; }
}
constexpr int CV_WIN = 352, CV_WOUT = 128, CV_EGU = 64 * 64, CV_EDN = 64 * 32, CV_SGU = 64, CV_SDN = 32, CV_GLU = 8;
constexpr int CV_PER_LAYER = CV_WIN + CV_WOUT + CV_EGU + CV_EDN + CV_SGU + CV_SDN + CV_GLU;
__device__ __forceinline__ CvD conv_desc(const Args& A, int u) {
    const int l = u / CV_PER_LAYER; int v = u - l * CV_PER_LAYER;
    unsigned char* ws = A.ws; CvD d;
    if (v < CV_WIN) { const int nb = v >> 4, kb = v & 15; d.kind = nb < 4 ? MAP_RETQK : (nb >= 8 && nb < 16) ? MAP_DIFFQK : MAP_PERM32;
        d.sa = A.w_in + (size_t)l * D * LDP + 256 * nb; d.sb = d.sa + 128; d.ld = LDP; d.dst = ws + WS_WIN + (size_t)l * LDP * D; d.K = D; d.drow0 = 256 * nb; d.k0 = 128 * kb; d.sc = SC_WIN; return d; }
    v -= CV_WIN;
    if (v < CV_WOUT) { const int nb = v >> 4, kb = v & 15; d.sa = A.w_out + (size_t)l * D * D + 256 * nb; d.sb = d.sa + 128; d.ld = D; d.dst = ws + WS_WOUT + (size_t)l * D * D; d.K = D; d.drow0 = 256 * nb; d.k0 = 128 * kb;
        d.kind = MAP_PERM16; d.sc = SC_WOUT; return d; }
    v -= CV_WOUT;
    if (v < CV_EGU) { const int e = v >> 6, r = v & 63, nb = r >> 4, kb = r & 15;
        d.sa = A.e_gate + ((size_t)l * NEXP + e) * D * FF + 128 * nb; d.sb = A.e_up + ((size_t)l * NEXP + e) * D * FF + 128 * nb; d.ld = FF; d.dst = ws + WS_GU + ((size_t)l * NE1 + e) * 1024 * D; d.K = D; d.drow0 = 256 * nb; d.k0 = 128 * kb;
        d.kind = MAP_PERM32; d.sc = SC_GU; return d; }
    v -= CV_EGU;
    if (v < CV_EDN) { const int e = v >> 5, r = v & 31, nb = r >> 2, kb = r & 3; d.sa = A.e_down + ((size_t)l * NEXP + e) * FF * D + 256 * nb; d.sb = d.sa + 128; d.ld = D; d.dst = ws + WS_DN + ((size_t)l * NE1 + e) * D * FF; d.K = FF; d.drow0 = 256 * nb; d.k0 = 128 * kb;
        d.kind = MAP_PERM16; d.sc = SC_DN; return d; }
    v -= CV_EDN;
    if (v < CV_SGU) { const int nb = v >> 4, kb = v & 15;
        d.sa = A.s_gate + (size_t)l * D * FF + 128 * nb; d.sb = A.s_up + (size_t)l * D * FF + 128 * nb; d.ld = FF; d.dst = ws + WS_GU + ((size_t)l * NE1 + NEXP) * 1024 * D; d.K = D; d.drow0 = 256 * nb; d.k0 = 128 * kb;
        d.kind = MAP_PERM32; d.sc = SC_GU; return d; }
    v -= CV_SGU;
    if (v < CV_SDN) { const int nb = v >> 2, kb = v & 3; d.sa = A.s_down + (size_t)l * FF * D + 256 * nb; d.sb = d.sa + 128; d.ld = D; d.dst = ws + WS_DN + ((size_t)l * NE1 + NEXP) * D * FF; d.K = FF; d.drow0 = 256 * nb; d.k0 = 128 * kb;
        d.kind = MAP_PERM16; d.sc = SC_DN; return d; }
    v -= CV_SDN;
    { const int nb = v >> 2, kb = v & 3; d.sa = A.s5_glu + (size_t)l * 512 * 512 + 256 * nb; d.sb = d.sa + 128; d.ld = 512; d.dst = ws + WS_GLU + (size_t)l * 512 * 512 * 2; d.K = 512; d.drow0 = 256 * nb; d.k0 = 128 * kb; d.kind = MAP_GLUFRAG; d.sc = 0.f; }
    return d;
}
__device__ __forceinline__ void conv_range(const Args& A, int u0, int u1, LAS unsigned char* lds) {
    if (u0 >= u1) return;
    LAS float* T = (LAS float*)lds; const int tid = threadIdx.x;
    CvD cur = conv_desc(A, u0); f32x4 v[16]; conv_load(cur, v, tid);
    for (int u = u0; u < u1; ++u) {
        __syncthreads();
        conv_put(v, T, tid);
        __syncthreads();
        CvD nxt = cur;
        if (u + 1 < u1) { nxt = conv_desc(A, u + 1); conv_load(nxt, v, tid); }
        conv_out(cur, T, tid);
        cur = nxt;
    }
    __syncthreads();
}
__device__ __forceinline__ void conv_dispatch(const Args& A, int u, LAS unsigned char* lds) { conv_range(A, u, u + 1, lds); }

__device__ __forceinline__ void cs_rev(double rev, float& c, float& s) {
    const float fr = (float)(rev - __builtin_floor(rev)); c = __builtin_amdgcn_cosf(fr); s = __builtin_amdgcn_sinf(fr);
}
__device__ __forceinline__ void tables_phase(const Args& A, int gtid, int gn) {
    unsigned char* ws = A.ws;
    float* cosR = (float*)(ws + WS_ROPE); float* sinR = (float*)(ws + WS_ROPE + ROPE_SINR); float* cosD = (float*)(ws + WS_ROPE + ROPE_COSD); float* sinD = (float*)(ws + WS_ROPE + ROPE_SIND);
    const double INV2PI = 0.15915494309189535;
    for (int i = gtid; i < SEQ * 64; i += gn) { const int t = i >> 6, j = i & 63, jj = j & 31; const int pos = j < 32 ? (t >> 6) : (t & 63);
        const float f = fast_exp2(-(float)(2 * jj) * (1.0f / 64.0f) * 13.287712379549449f);
        float c, s; cs_rev((double)pos * (double)f * INV2PI, c, s); cosR[i] = c; sinR[i] = s; }
    for (int i = gtid; i < SEQ * 32; i += gn) { const int t = i >> 5, j = i & 31, jj = j & 15; const int pos = j < 16 ? (t >> 6) : (t & 63);
        const float f = fast_exp2(-(float)(2 * jj) * (1.0f / 32.0f) * 13.287712379549449f);
        float c, s; cs_rev((double)pos * (double)f * INV2PI, c, s); cosD[i] = c; sinD[i] = s; }
    float* rwt = (float*)(ws + WS_RWT);
    { unsigned short* rwh = (unsigned short*)rwt; unsigned short* rwl = rwh + (size_t)2 * NEXP * D;
      for (int i = gtid; i < 2 * D * NEXP; i += gn) { const int l = i / (D * NEXP), r = i - l * D * NEXP, k = r >> 6, e = r & 63; const float v = A.router_w[i];
          const unsigned hw = pk2(v, 0.f) & 0xffffu; const float hi = __builtin_bit_cast(float, hw << 16); const unsigned lw = pk2(v - hi, 0.f) & 0xffffu;
          const size_t o = (size_t)l * NEXP * D + ((size_t)(((((e >> 5) * 128 + (k >> 4)) * 2 + ((k >> 3) & 1)) * 32 + (e & 31)) << 3)) + (k & 7);
          rwh[o] = (unsigned short)hw; rwl[o] = (unsigned short)lw; } }
    int* list64 = (int*)(ws + WS_LIST) + (size_t)NEXP * TALL;
    for (int i = gtid; i < TALL; i += gn) list64[i] = i;
    f32x2* SA = (f32x2*)(ws + WS_S5A); bf16_t* BF = (bf16_t*)(ws + WS_S5BF); bf16_t* CF = (bf16_t*)(ws + WS_S5CF);
    for (int i = gtid; i < 2 * 2 * 32 * 64; i += gn) {
        const int p = i & 63, g = (i >> 6) & 31, d = (i >> 11) & 1, l = i >> 12;
        const float dt = fast_exp2(A.s5_logdt[(l * 2 + d) * 32 + g] * LOG2E);
        const float lr = A.s5_lre[i], li = A.s5_lim[i];
        const float mag = fast_exp2(lr * dt * LOG2E);
        float c, s; cs_rev((double)li * (double)dt * INV2PI, c, s);
        const float ar = mag * c, ai = mag * s;
        float pr = ar, pi = ai;
#pragma unroll
        for (int q = 0; q < 4; ++q) { const float nr = pr * pr - pi * pi, ni = 2.f * pr * pi; pr = nr; pi = ni; }
        const float a16r = pr, a16i = pi; const float a32r = pr * pr - pi * pi, a32i = 2.f * pr * pi;
        SA[i] = (f32x2){ar, ai}; SA[S5A_N + i] = (f32x2){a16r, a16i}; SA[2 * S5A_N + i] = (f32x2){a32r, a32i};
        const float den = lr * lr + li * li, nr = ar - 1.0f;
        const float fre = (nr * lr + ai * li) / den, fim = (ai * lr - nr * li) / den;
        const int pb = p >> 5, pl = p & 31;
        const float* bre = A.s5_bre + (((size_t)l * 32 + g) * 64 + p) * 16; const float* bim = A.s5_bim + (((size_t)l * 32 + g) * 64 + p) * 16;
        bf16_t* bf_re = BF + ((((size_t)(l * 2 + d) * 32 + g) * 2 + pb) * 2 + 0) * 512; bf16_t* bf_im = bf_re + 512;
        for (int h = 0; h < 16; ++h) { const float br = bre[h], bi = bim[h]; const int lane = (h >> 3) * 32 + pl, j = h & 7;
            bf_re[lane * 8 + j] = (bf16_t)f2bf(fre * br - fim * bi); bf_im[lane * 8 + j] = (bf16_t)f2bf(fre * bi + fim * br); }
        if (d == 0) {
            for (int reim = 0; reim < 2; ++reim) { const int k = 2 * p + reim, ks = k >> 5, kq = (k >> 3) & 3, j = k & 7;
                for (int hp = 0; hp < 16; ++hp) { const size_t ci = (((size_t)l * 32 + g) * 16 + hp) * 64 + p; const float v = reim ? -A.s5_cim[ci] : A.s5_cre[ci];
                    CF[(((size_t)l * 32 + g) * 4 + ks) * 512 + (kq * 16 + hp) * 8 + j] = (bf16_t)f2bf(v); } }
        }
    }
}

__device__ __forceinline__ const float* in_row(const float* xlat, const float* xctx, int row) {
    const int b = row / SEQU, pos = row - b * SEQU; return pos < CTX ? xctx + ((size_t)b * CTX + pos) * D : xlat + ((size_t)b * SEQ + (pos - CTX)) * D;
}
__device__ __forceinline__ void modnorm_row(const float* xr, const float* nw, const float* sh, const float* sc, bf16_t* hrow, int lane) {
    f32x4 v[8]; float ss = 0.f;
#pragma unroll
    for (int i = 0; i < 8; ++i) { v[i] = *(const f32x4*)(xr + 4 * (lane + 64 * i)); ss += v[i][0] * v[i][0] + v[i][1] * v[i][1] + v[i][2] * v[i][2] + v[i][3] * v[i][3]; }
    ss = wave_sum(ss); const float rstd = __builtin_amdgcn_rsqf(ss * (1.0f / D) + EPS);
#pragma unroll
    for (int i = 0; i < 8; ++i) { const int c = 4 * (lane + 64 * i); const f32x4 w = *(const f32x4*)(nw + c), s1 = *(const f32x4*)(sc + c), s0 = *(const f32x4*)(sh + c);
        const f32x4 o = (v[i] * rstd * w * (1.0f + s1) + s0) * SC_H8; *(unsigned*)((unsigned char*)hrow + c) = pk4_fp8(o[0], o[1], o[2], o[3]); }
}

namespace pg8 {
constexpr int BM = 256, BK = 64, HALF = 128, HTB = HALF * BK * 2, STAGE_BYTES = 8 * HTB, NXCD = 8, WGM = 8;
__device__ __forceinline__ int lds_byte(int r, int c) { const int st = (r >> 4) * 2 + (c >> 5), rr = r & 15, cc = c & 31, ob = rr * 64 + cc * 2; return st * 1024 + (ob ^ (((ob >> 9) & 1) << 5)); }
__device__ __forceinline__ void stage_rc(int b, int& R, int& C) { const int st = b / 1024, sb = b % 1024, swz = sb ^ (((sb >> 9) & 1) << 5); R = (st >> 1) * 16 + swz / 64; C = (st & 1) * 32 + (swz % 64) / 2; }

struct UnitD {
    const char* A;
    const char* B;
    unsigned ao[2][2];
    int pm, pn, e, row0;
};

template <class Epi, class Sched>
__device__ __forceinline__ void gemm_phase(LAS unsigned char* lds, const int K, const Sched& S, const Epi& E) {
    const int tid = threadIdx.x, wid = __builtin_amdgcn_readfirstlane(tid >> 6), lane = tid & 63, wr = wid >> 2, wc = wid & 3, fr = lane & 15, fq = lane >> 4;
    const int nt = K / BK;
    unsigned voffB[2];
#pragma unroll
    for (int i = 0; i < 2; ++i) { int R, C; stage_rc(tid * 16 + i * 8192, R, C); voffB[i] = (unsigned)(R * K + C) * 2u; }
    const size_t kstep = (size_t)(BK * 2);
    const size_t hstep = (size_t)HALF * K * 2;
    const unsigned ldsw = (unsigned)wid * 1024u;
    const int aoff = lds_byte(wr * 64 + fr, fq * 8), boff = lds_byte(wc * 32 + fr, fq * 8);
#define PG8_SA(b, h) (((b) * 2 + (h)) * HTB)
#define PG8_SB(b, h) ((4 + (b) * 2 + (h)) * HTB)
#define PG8_STA(bufoff, U, h, kb) do { _Pragma("unroll") for (int _i = 0; _i < 2; ++_i) \
        __builtin_amdgcn_global_load_lds((const unsigned*)((U).A + (U).ao[h][_i] + (kb)), (LAS unsigned*)(lds + (bufoff) + ldsw + _i * 8192), 16, 0, 0); } while (0)
#define PG8_STB(bufoff, U, h, kb) do { _Pragma("unroll") for (int _i = 0; _i < 2; ++_i) \
        __builtin_amdgcn_global_load_lds((const unsigned*)((U).B + (h) * hstep + voffB[_i] + (kb)), (LAS unsigned*)(lds + (bufoff) + ldsw + _i * 8192), 16, 0, 0); } while (0)
#define PG8_LDA(dst, b, h) do { _Pragma("unroll") for (int m = 0; m < 4; ++m) _Pragma("unroll") for (int k = 0; k < 2; ++k) dst[m][k] = *(const LAS bf16x8*)(lds + PG8_SA(b, h) + aoff + m * 2048 + k * 1024); } while (0)
#define PG8_LDB(dst, b, h) do { _Pragma("unroll") for (int n = 0; n < 2; ++n) _Pragma("unroll") for (int k = 0; k < 2; ++k) dst[n][k] = *(const LAS bf16x8*)(lds + PG8_SB(b, h) + boff + n * 2048 + k * 1024); } while (0)
#define PG8_MMA(ai, bj, At, Bt) do { __builtin_amdgcn_s_setprio(1); _Pragma("unroll") for (int m = 0; m < 4; ++m) _Pragma("unroll") for (int n = 0; n < 2; ++n) _Pragma("unroll") for (int k = 0; k < 2; ++k) \
        acc[ai][bj][m][n] = __builtin_amdgcn_mfma_f32_16x16x32_bf16(Bt[n][k], At[m][k], acc[ai][bj][m][n], 0, 0, 0); __builtin_amdgcn_s_setprio(0); } while (0)
#define PG8_WAIT_V(n) asm volatile("s_waitcnt vmcnt(" #n ")" ::: "memory")
#define PG8_WAIT_L(n) asm volatile("s_waitcnt lgkmcnt(" #n ")" ::: "memory")
#define PG8_BAR __builtin_amdgcn_s_barrier()
#define PG8_SCHED __builtin_amdgcn_sched_barrier(0)
    UnitD cur, nxt; int ui = 0;
    if (!S.next(0, cur)) return;
    f32x4 acc[2][2][4][2];
#pragma unroll
    for (int a = 0; a < 2; ++a)
#pragma unroll
        for (int b = 0; b < 2; ++b)
#pragma unroll
            for (int m = 0; m < 4; ++m)
#pragma unroll
                for (int n = 0; n < 2; ++n) acc[a][b][m][n] = (f32x4){0.f, 0.f, 0.f, 0.f};
    bf16x8 At[4][2], B0[2][2], B1[2][2];
    PG8_STB(PG8_SB(0, 0), cur, 0, 0); PG8_STA(PG8_SA(0, 0), cur, 0, 0); PG8_STB(PG8_SB(0, 1), cur, 1, 0); PG8_STA(PG8_SA(0, 1), cur, 1, 0);
    if (wr == 1) PG8_BAR;
    PG8_WAIT_V(4); PG8_BAR;
    PG8_STB(PG8_SB(1, 0), cur, 0, kstep); PG8_STA(PG8_SA(1, 0), cur, 0, kstep); PG8_STB(PG8_SB(1, 1), cur, 1, kstep);
    PG8_WAIT_V(6); PG8_BAR;
    for (;;) {
        const bool has_next = S.next(ui + 1, nxt);
        if (!has_next) nxt = cur;
        for (int t = 0; t < nt; t += 2) {
            const bool last = (t == nt - 2);
            const size_t k1 = (size_t)(t + 1) * kstep;
            const size_t k2 = last ? (size_t)0 : (size_t)(t + 2) * kstep, k3 = k2 + kstep;
            UnitD w2; w2.A = cur.A; w2.B = last ? nxt.B : cur.B;
            w2.ao[0][0] = last ? nxt.ao[0][0] : cur.ao[0][0]; w2.ao[0][1] = last ? nxt.ao[0][1] : cur.ao[0][1];
            w2.ao[1][0] = last ? nxt.ao[1][0] : cur.ao[1][0]; w2.ao[1][1] = last ? nxt.ao[1][1] : cur.ao[1][1];
            PG8_LDB(B0, 0, 0); PG8_SCHED; PG8_LDA(At, 0, 0); PG8_STA(PG8_SA(1, 1), cur, 1, k1);
            PG8_WAIT_L(8); PG8_BAR; PG8_WAIT_L(0); PG8_MMA(0, 0, At, B0); PG8_BAR; PG8_SCHED;
            PG8_LDB(B1, 0, 1); PG8_STB(PG8_SB(0, 0), w2, 0, k2);
            PG8_BAR; PG8_WAIT_L(0); PG8_MMA(0, 1, At, B1); PG8_BAR;
            PG8_LDA(At, 0, 1); PG8_STA(PG8_SA(0, 0), w2, 0, k2);
            PG8_BAR; PG8_WAIT_L(0); PG8_MMA(1, 0, At, B0); PG8_BAR; PG8_SCHED;
            PG8_STB(PG8_SB(0, 1), w2, 1, k2);
            PG8_WAIT_V(6); PG8_BAR; PG8_MMA(1, 1, At, B1); PG8_BAR;
            PG8_LDB(B0, 1, 0); PG8_SCHED; PG8_LDA(At, 1, 0); PG8_STA(PG8_SA(0, 1), w2, 1, k2);
            PG8_WAIT_L(8); PG8_BAR; PG8_WAIT_L(0); PG8_MMA(0, 0, At, B0); PG8_BAR; PG8_SCHED;
            PG8_LDB(B1, 1, 1); PG8_STB(PG8_SB(1, 0), w2, 0, k3);
            PG8_BAR; PG8_WAIT_L(0); PG8_MMA(0, 1, At, B1); PG8_BAR;
            PG8_LDA(At, 1, 1); PG8_STA(PG8_SA(1, 0), w2, 0, k3);
            PG8_BAR; PG8_WAIT_L(0); PG8_MMA(1, 0, At, B0); PG8_BAR; PG8_SCHED;
            PG8_STB(PG8_SB(1, 1), w2, 1, k3);
            PG8_WAIT_V(6); PG8_BAR; PG8_MMA(1, 1, At, B1); PG8_BAR;
        }
        E(acc, cur, wr, wc, fr, fq);
        if (!has_next) break;
#pragma unroll
        for (int a = 0; a < 2; ++a)
#pragma unroll
            for (int b = 0; b < 2; ++b)
#pragma unroll
                for (int m = 0; m < 4; ++m)
#pragma unroll
                    for (int n = 0; n < 2; ++n) acc[a][b][m][n] = (f32x4){0.f, 0.f, 0.f, 0.f};
        cur = nxt; ++ui;
    }
    PG8_WAIT_V(0);
    if (wr == 0) PG8_BAR;
    PG8_BAR;
#undef PG8_SA
#undef PG8_SB
#undef PG8_STA
#undef PG8_STB
#undef PG8_LDA
#undef PG8_LDB
#undef PG8_MMA
#undef PG8_WAIT_V
#undef PG8_WAIT_L
#undef PG8_BAR
#undef PG8_SCHED
}

typedef int v8i __attribute__((ext_vector_type(8)));
typedef int v4i __attribute__((ext_vector_type(4)));
typedef v4i __attribute__((may_alias)) v4i_a;
template <class Epi, class Sched, bool FP8 = true>
__device__ __forceinline__ void gemm_phase8(LAS unsigned char* lds, const int K, const Sched& S, const Epi& E, int sclA = 127, int sclB = 127) {
    const int tid = threadIdx.x, wid = __builtin_amdgcn_readfirstlane(tid >> 6), lane = tid & 63, wr = wid >> 2, wc = wid & 3, fr = lane & 15, fq = lane >> 4;
    const int nt = K / BK;
    unsigned voffB[2];
#pragma unroll
    for (int i = 0; i < 2; ++i) { int R, C; stage_rc(tid * 16 + i * 8192, R, C); voffB[i] = (unsigned)(R * K + C) * 2u; }
    const size_t kstep = (size_t)(BK * 2);
    const size_t hstep = (size_t)HALF * K * 2;
    const unsigned ldsw = (unsigned)wid * 1024u;
    const int aoff = lds_byte(wr * 64 + fr, fq * 8), boff = lds_byte(wc * 32 + fr, fq * 8);
#define PG8_SA(b, h) (((b) * 2 + (h)) * HTB)
#define PG8_SB(b, h) ((4 + (b) * 2 + (h)) * HTB)
#define PG8_STA(bufoff, U, h, kb) do { _Pragma("unroll") for (int _i = 0; _i < 2; ++_i) \
        __builtin_amdgcn_global_load_lds((const unsigned*)((U).A + (U).ao[h][_i] + (kb)), (LAS unsigned*)(lds + (bufoff) + ldsw + _i * 8192), 16, 0, 0); } while (0)
#define PG8_STB(bufoff, U, h, kb) do { _Pragma("unroll") for (int _i = 0; _i < 2; ++_i) \
        __builtin_amdgcn_global_load_lds((const unsigned*)((U).B + (h) * hstep + voffB[_i] + (kb)), (LAS unsigned*)(lds + (bufoff) + ldsw + _i * 8192), 16, 0, 0); } while (0)
#define PG8_LDA(dst, b, h) do { _Pragma("unroll") for (int m = 0; m < 4; ++m) { dst[m].lo = *(const LAS v4i_a*)(lds + PG8_SA(b, h) + aoff + m * 2048); dst[m].hi = *(const LAS v4i_a*)(lds + PG8_SA(b, h) + aoff + m * 2048 + 1024); } } while (0)
#define PG8_LDB(dst, b, h) do { _Pragma("unroll") for (int n = 0; n < 2; ++n) { dst[n].lo = *(const LAS v4i_a*)(lds + PG8_SB(b, h) + boff + n * 2048); dst[n].hi = *(const LAS v4i_a*)(lds + PG8_SB(b, h) + boff + n * 2048 + 1024); } } while (0)
#define PG8_MMA(ai, bj, At, Bt) do { __builtin_amdgcn_s_setprio(1); _Pragma("unroll") for (int m = 0; m < 4; ++m) _Pragma("unroll") for (int n = 0; n < 2; ++n) { \
        if constexpr (FP8) asm volatile("v_mfma_scale_f32_16x16x128_f8f6f4 %0, %1, %2, %0, %3, %4 op_sel_hi:[0,0,0]" : "+v"(acc[ai][bj][m][n]) : "v"(Bt[n]), "v"(At[m]), "v"(vsclB), "v"(vsclA)); \
        else { acc[ai][bj][m][n] = __builtin_amdgcn_mfma_f32_16x16x32_bf16(__builtin_bit_cast(bf16x8, Bt[n].lo), __builtin_bit_cast(bf16x8, At[m].lo), acc[ai][bj][m][n], 0, 0, 0); \
               acc[ai][bj][m][n] = __builtin_amdgcn_mfma_f32_16x16x32_bf16(__builtin_bit_cast(bf16x8, Bt[n].hi), __builtin_bit_cast(bf16x8, At[m].hi), acc[ai][bj][m][n], 0, 0, 0); } } \
        __builtin_amdgcn_s_setprio(0); } while (0)
#define PG8_WAIT_V(n) asm volatile("s_waitcnt vmcnt(" #n ")" ::: "memory")
#define PG8_WAIT_L(n) asm volatile("s_waitcnt lgkmcnt(" #n ")" ::: "memory")
#define PG8_BAR __builtin_amdgcn_s_barrier()
#define PG8_SCHED __builtin_amdgcn_sched_barrier(0)
    int vsclA = sclA * 0x01010101, vsclB = sclB * 0x01010101;
    asm volatile("" : "+v"(vsclA), "+v"(vsclB));
    UnitD cur, nxt; int ui = 0;
    if (!S.next(0, cur)) return;
    f32x4 acc[2][2][4][2];
#pragma unroll
    for (int a = 0; a < 2; ++a)
#pragma unroll
        for (int b = 0; b < 2; ++b)
#pragma unroll
            for (int m = 0; m < 4; ++m)
#pragma unroll
                for (int n = 0; n < 2; ++n) acc[a][b][m][n] = (f32x4){0.f, 0.f, 0.f, 0.f};
    v8i At[4], B0[2], B1[2];
    PG8_STB(PG8_SB(0, 0), cur, 0, 0); PG8_STA(PG8_SA(0, 0), cur, 0, 0); PG8_STB(PG8_SB(0, 1), cur, 1, 0); PG8_STA(PG8_SA(0, 1), cur, 1, 0);
    if (wr == 1) PG8_BAR;
    PG8_WAIT_V(4); PG8_BAR;
    PG8_STB(PG8_SB(1, 0), cur, 0, kstep); PG8_STA(PG8_SA(1, 0), cur, 0, kstep); PG8_STB(PG8_SB(1, 1), cur, 1, kstep);
    PG8_WAIT_V(6); PG8_BAR;
    for (;;) {
        const bool has_next = S.next(ui + 1, nxt);
        if (!has_next) nxt = cur;
        for (int t = 0; t < nt; t += 2) {
            const bool last = (t == nt - 2);
            const size_t k1 = (size_t)(t + 1) * kstep;
            const size_t k2 = last ? (size_t)0 : (size_t)(t + 2) * kstep, k3 = k2 + kstep;
            UnitD w2; w2.A = cur.A; w2.B = last ? nxt.B : cur.B;
            w2.ao[0][0] = last ? nxt.ao[0][0] : cur.ao[0][0]; w2.ao[0][1] = last ? nxt.ao[0][1] : cur.ao[0][1];
            w2.ao[1][0] = last ? nxt.ao[1][0] : cur.ao[1][0]; w2.ao[1][1] = last ? nxt.ao[1][1] : cur.ao[1][1];
            PG8_LDB(B0, 0, 0); PG8_SCHED; PG8_LDA(At, 0, 0); PG8_STA(PG8_SA(1, 1), cur, 1, k1);
            PG8_WAIT_L(8); PG8_BAR; PG8_WAIT_L(0); PG8_MMA(0, 0, At, B0); PG8_BAR; PG8_SCHED;
            PG8_LDB(B1, 0, 1); PG8_STB(PG8_SB(0, 0), w2, 0, k2);
            PG8_BAR; PG8_WAIT_L(0); PG8_MMA(0, 1, At, B1); PG8_BAR;
            PG8_LDA(At, 0, 1); PG8_STA(PG8_SA(0, 0), w2, 0, k2);
            PG8_BAR; PG8_WAIT_L(0); PG8_MMA(1, 0, At, B0); PG8_BAR; PG8_SCHED;
            PG8_STB(PG8_SB(0, 1), w2, 1, k2);
            PG8_WAIT_V(6); PG8_BAR; PG8_MMA(1, 1, At, B1); PG8_BAR;
            PG8_LDB(B0, 1, 0); PG8_SCHED; PG8_LDA(At, 1, 0); PG8_STA(PG8_SA(0, 1), w2, 1, k2);
            PG8_WAIT_L(8); PG8_BAR; PG8_WAIT_L(0); PG8_MMA(0, 0, At, B0); PG8_BAR; PG8_SCHED;
            PG8_LDB(B1, 1, 1); PG8_STB(PG8_SB(1, 0), w2, 0, k3);
            PG8_BAR; PG8_WAIT_L(0); PG8_MMA(0, 1, At, B1); PG8_BAR;
            PG8_LDA(At, 1, 1); PG8_STA(PG8_SA(1, 0), w2, 0, k3);
            PG8_BAR; PG8_WAIT_L(0); PG8_MMA(1, 0, At, B0); PG8_BAR; PG8_SCHED;
            PG8_STB(PG8_SB(1, 1), w2, 1, k3);
            PG8_WAIT_V(6); PG8_BAR; PG8_MMA(1, 1, At, B1); PG8_BAR;
        }
        if constexpr (FP8) asm volatile("s_nop 15\n\ts_nop 15" ::: "memory");
        E(acc, cur, wr, wc, fr, fq);
        if (!has_next) break;
#pragma unroll
        for (int a = 0; a < 2; ++a)
#pragma unroll
            for (int b = 0; b < 2; ++b)
#pragma unroll
                for (int m = 0; m < 4; ++m)
#pragma unroll
                    for (int n = 0; n < 2; ++n) acc[a][b][m][n] = (f32x4){0.f, 0.f, 0.f, 0.f};
        cur = nxt; ++ui;
    }
    PG8_WAIT_V(0);
    if (wr == 0) PG8_BAR;
    PG8_BAR;
#undef PG8_SA
#undef PG8_SB
#undef PG8_STA
#undef PG8_STB
#undef PG8_LDA
#undef PG8_LDB
#undef PG8_MMA
#undef PG8_WAIT_V
#undef PG8_WAIT_L
#undef PG8_BAR
#undef PG8_SCHED
}

__device__ __forceinline__ void lin_offsets(UnitD& u, int row0, int K) {
#pragma unroll
    for (int i = 0; i < 2; ++i) { int R, C; stage_rc((int)threadIdx.x * 16 + i * 8192, R, C);
        u.ao[0][i] = (unsigned)(((size_t)(row0 + R) * K + C) * 2); u.ao[1][i] = (unsigned)(((size_t)(row0 + HALF + R) * K + C) * 2); }
}
}

using pg8::UnitD;
struct DenseSched {
    const char* A; const char* Bt; int nM, nN, K, G, c; bool skipctx = false;
    __device__ __forceinline__ bool next(int i, UnitD& u) const {
        const int nwg = nM * nN; const long L = (long)i * G + c; if (L >= nwg) return false;
        int wgid = (int)L; { const int q = nwg / 8, r = nwg % 8, xcd = wgid % 8, off = wgid / 8; wgid = (xcd < r ? xcd * (q + 1) : r * (q + 1) + (xcd - r) * q) + off; }
        const int nig = 8 * nN, gid = wgid / nig, fm = gid * 8, gsz = (nM - fm) < 8 ? (nM - fm) : 8;
        int pm = fm + ((wgid % nig) % gsz); const int pn = (wgid % nig) / gsz;
        if (skipctx) pm += 1 + (pm >= 32 ? 1 : 0);
        u.A = A; u.B = Bt + (size_t)pn * 256 * K * 2; pg8::lin_offsets(u, pm * 256, K); u.pm = pm; u.pn = pn; u.e = 0; u.row0 = pm * 256; return true;
    }
};
struct GroupSched {
    const char* A; const char* Bt; const int* list; const int* cnt; const LAS int* tileP; int NT, K, G, c; bool gather; size_t bstride;
    bool skipctx = false;
    __device__ __forceinline__ bool next(int i, UnitD& u) const {
        const int total = tileP[65] * NT; const long L = (long)i * G + c; if (L >= total) return false;
        const int tile = (int)(L / NT), tn = (int)(L % NT);
        int e = 0;
#pragma unroll
        for (int s = 64; s >= 1; s >>= 1) { if (e + s <= 64 && tileP[e + s] <= tile) e += s; }
        const int tm = tile - tileP[e];
        const int srt = skipctx ? tm + 1 + (tm >= 32 ? 1 : 0) : tm;
        u.A = A; u.B = Bt + (size_t)e * bstride + (size_t)tn * 256 * K * 2; u.pm = tm; u.pn = tn; u.e = e;
        if (gather) {
            const int ce = e == NEXP ? TALL : cnt[e]; const int* le = list + (size_t)e * TALL;
#pragma unroll
            for (int p = 0; p < 2; ++p) { int R, C; pg8::stage_rc((int)threadIdx.x * 16 + p * 8192, R, C);
#pragma unroll
                for (int h = 0; h < 2; ++h) { const int idx = tm * 256 + 128 * h + R; const int tok = e == NEXP ? srt * 256 + 128 * h + R : le[idx < ce ? idx : 0]; u.ao[h][p] = (unsigned)(((size_t)tok * K + C) * 2); } }
            u.row0 = 256 * tile;
        } else {
            pg8::lin_offsets(u, 256 * tile, K);
            u.row0 = e == NEXP ? srt * 256 : 256 * tile;
        }
        return true;
    }
};
__device__ __forceinline__ void build_tileP(const int* cnt, LAS int* tileP, int shared_tiles = TALL / 256) {
    if (threadIdx.x == 0) { int s = 0; for (int e = 0; e < NEXP; ++e) { tileP[e] = s; s += (cnt[e] + 255) >> 8; } tileP[64] = s; s += shared_tiles; tileP[65] = s; }
}

__device__ __forceinline__ void st_bf16x4(bf16_t* p, f32x4 v) { u32x2 w; w.x = pk2(v[0], v[1]); w.y = pk2(v[2], v[3]); *(u32x2*)p = w; }
__device__ __forceinline__ void st_bf16x8(bf16_t* p, f32x4 v0, f32x4 v1) { u32x4 w; w.x = pk2(v0[0], v0[1]); w.y = pk2(v0[2], v0[3]); w.z = pk2(v1[0], v1[1]); w.w = pk2(v1[2], v1[3]); *(u32x4*)p = w; }

constexpr float QSCALE = 0.125f * LOG2E;
struct EpiIn {
    bf16_t* P; const float *cosR, *sinR, *cosD, *sinD, *qw, *kw; unsigned char *Q8, *K8, *V8T;
    __device__ __forceinline__ void operator()(const f32x4 (&acc)[2][2][4][2], const UnitD& u, int wr, int wc, int fr, int fq) const {
        const int pn = u.pn, rbase = u.row0 + wr * 64 + fr;
        if (pn < 4) {
            const float scale = pn >= 2 ? 0.08838834764831845f : 1.0f; const int i0 = 16 * wc + 4 * fq;
#pragma unroll
            for (int ai = 0; ai < 2; ++ai)
#pragma unroll
                for (int m = 0; m < 4; ++m) { const int row = rbase + ai * 128 + m * 16, b = row / SEQU, pos = row - b * SEQU; const bool lat = pos >= CTX; const int t = lat ? pos - CTX : 0;
                    f32x4 c = {1.f, 1.f, 1.f, 1.f}, s = {0.f, 0.f, 0.f, 0.f};
                    if (lat) { c = *(const f32x4*)(cosR + (size_t)t * 64 + i0); s = *(const f32x4*)(sinR + (size_t)t * 64 + i0); }
                    c *= scale; s *= scale;
#pragma unroll
                    for (int bj = 0; bj < 2; ++bj) { const f32x4 x1 = acc[ai][bj][m][0], x2 = acc[ai][bj][m][1]; bf16_t* op = P + (size_t)row * LDP + 256 * pn + 128 * bj + i0;
                        st_bf16x4(op, x1 * c - x2 * s); st_bf16x4(op + 64, x1 * s + x2 * c); } }
        } else if (pn >= 8 && pn < 16) {
            const bool isq = pn < 12; const float* w = isq ? qw : kw; const int sh = 4 * (pn - (isq ? 8 : 12)) + wc;
            unsigned char* dst8 = Q8 + 64 * sh;
            const float os = isq ? QSCALE * SC_Q8 : SC_K8;
            f32x4 wv[2][2];
#pragma unroll
            for (int bj = 0; bj < 2; ++bj)
#pragma unroll
                for (int n = 0; n < 2; ++n) wv[bj][n] = *(const f32x4*)(w + 32 * bj + 8 * fq + 4 * n) * os;
#pragma unroll
            for (int ai = 0; ai < 2; ++ai)
#pragma unroll
                for (int m = 0; m < 4; ++m) { const int row = rbase + ai * 128 + m * 16, b = row / SEQU, pos = row - b * SEQU; const bool lat = pos >= CTX; const int t = lat ? pos - CTX : 0;
                    float ss = 0.f;
#pragma unroll
                    for (int bj = 0; bj < 2; ++bj)
#pragma unroll
                        for (int n = 0; n < 2; ++n) { const f32x4 v = acc[ai][bj][m][n]; ss += v[0] * v[0] + v[1] * v[1] + v[2] * v[2] + v[3] * v[3]; }
                    ss += __shfl_xor(ss, 16); ss += __shfl_xor(ss, 32);
                    const float rinv = __builtin_amdgcn_rsqf(ss * (1.0f / 64.0f) + EPS);
                    u32x2 w1, w2;
#pragma unroll
                    for (int n = 0; n < 2; ++n) { const int i0 = 8 * fq + 4 * n;
                        f32x4 c = {1.f, 1.f, 1.f, 1.f}, s = {0.f, 0.f, 0.f, 0.f};
                        if (lat) { c = *(const f32x4*)(cosD + (size_t)t * 32 + i0); s = *(const f32x4*)(sinD + (size_t)t * 32 + i0); }
                        const f32x4 x1 = acc[ai][0][m][n] * rinv * wv[0][n], x2 = acc[ai][1][m][n] * rinv * wv[1][n];
                        const f32x4 o1 = x1 * c - x2 * s, o2 = x1 * s + x2 * c;
                        const unsigned a1 = pk4_fp8(o1[0], o1[1], o1[2], o1[3]), a2 = pk4_fp8(o2[0], o2[1], o2[2], o2[3]);
                        if (n == 0) { w1.x = a1; w2.x = a2; } else { w1.y = a1; w2.y = a2; } }
                    unsigned char* op = isq ? dst8 + (size_t)row * 1024 + 8 * fq : K8 + ((((size_t)(b * 8 + (sh >> 1)) * SEQU + pos) << 7) + 64 * (sh & 1) + 8 * fq);
                    *(u32x2*)op = w1; *(u32x2*)(op + 32) = w2; }
        } else if (pn >= 16 && pn < 20) {
            const int lane = fr + 16 * fq, cq = lane & 3;
#pragma unroll
            for (int ai = 0; ai < 2; ++ai)
#pragma unroll
                for (int m = 0; m < 4; ++m) { const int row = rbase + ai * 128 + m * 16, b = row / SEQU, pos = row - b * SEQU, t = pos >> 6, kk4 = pos & 60;
                    const int off = 32 * ((kk4 >> 2) & 1) + 16 * (kk4 >> 5) + 4 * ((kk4 >> 3) & 3);
#pragma unroll
                    for (int bj = 0; bj < 2; ++bj) { const int head = 2 * (pn - 16) + bj;
#pragma unroll
                        for (int n = 0; n < 2; ++n) { const f32x4 v = acc[ai][bj][m][n] * SC_V8; const unsigned W = pk4_fp8(v[0], v[1], v[2], v[3]);
                            const unsigned w0 = __shfl(W, (lane & ~3) + 0), w1 = __shfl(W, (lane & ~3) + 1), w2 = __shfl(W, (lane & ~3) + 2), w3 = __shfl(W, (lane & ~3) + 3);
                            const unsigned sft = 8 * cq; const unsigned R = ((w0 >> sft) & 0xffu) | (((w1 >> sft) & 0xffu) << 8) | (((w2 >> sft) & 0xffu) << 16) | (((w3 >> sft) & 0xffu) << 24);
                            const int dv = 32 * wc + 8 * fq + 4 * n + cq;
                            *(unsigned*)(V8T + ((((size_t)(b * 8 + head) * (SEQU / 64) + t) * 128 + dv) << 6) + off) = R; } } }
        } else {
            const bool gate = (pn == 6 || pn == 7);
#pragma unroll
            for (int ai = 0; ai < 2; ++ai)
#pragma unroll
                for (int m = 0; m < 4; ++m) { const int row = rbase + ai * 128 + m * 16;
#pragma unroll
                    for (int bj = 0; bj < 2; ++bj) { f32x4 v0 = acc[ai][bj][m][0], v1 = acc[ai][bj][m][1];
                        if (gate) {
#pragma unroll
                            for (int j = 0; j < 4; ++j) { v0[j] = siluf_(v0[j]); v1[j] = siluf_(v1[j]); } }
                        st_bf16x8(P + (size_t)row * LDP + 256 * pn + 128 * bj + 32 * wc + 8 * fq, v0, v1); } }
        }
    }
};
struct EpiRes {
    const float *xlat, *xctx; bf16_t* X; const float* gate;
    __device__ __forceinline__ void operator()(const f32x4 (&acc)[2][2][4][2], const UnitD& u, int wr, int wc, int fr, int fq) const {
        const int mi = mod_index(u.row0); const float* g = gate + (size_t)mi * MODW;
#pragma unroll
        for (int ai = 0; ai < 2; ++ai)
#pragma unroll
            for (int m = 0; m < 4; ++m) { const int row = u.row0 + ai * 128 + wr * 64 + m * 16 + fr; const float* sp = xlat ? in_row(xlat, xctx, row) : nullptr; bf16_t* dp = X + (size_t)row * D;
#pragma unroll
                for (int bj = 0; bj < 2; ++bj) { const int col = 256 * u.pn + 64 * wc + 16 * fq + 8 * bj;
                    f32x4 s0, s1;
                    if (sp) { s0 = *(const f32x4*)(sp + col); s1 = *(const f32x4*)(sp + col + 4); }
                    else { const u32x4 w = *(const u32x4*)(dp + col); s0[0] = bflo(w.x); s0[1] = bfhi(w.x); s0[2] = bflo(w.y); s0[3] = bfhi(w.y); s1[0] = bflo(w.z); s1[1] = bfhi(w.z); s1[2] = bflo(w.w); s1[3] = bfhi(w.w); }
                    const f32x4 o0 = s0 + *(const f32x4*)(g + col) * acc[ai][bj][m][0], o1 = s1 + *(const f32x4*)(g + col + 4) * acc[ai][bj][m][1];
                    u32x4 ow; ow.x = pk2(o0[0], o0[1]); ow.y = pk2(o0[2], o0[3]); ow.z = pk2(o1[0], o1[1]); ow.w = pk2(o1[2], o1[3]); *(u32x4*)(dp + col) = ow; } }
    }
};
struct EpiGU {
    unsigned char* HID;
    __device__ __forceinline__ void operator()(const f32x4 (&acc)[2][2][4][2], const UnitD& u, int wr, int wc, int fr, int fq) const {
#pragma unroll
        for (int ai = 0; ai < 2; ++ai)
#pragma unroll
            for (int m = 0; m < 4; ++m) { const int row = u.row0 + ai * 128 + wr * 64 + m * 16 + fr; f32x4 h[2];
#pragma unroll
                for (int n = 0; n < 2; ++n)
#pragma unroll
                    for (int j = 0; j < 4; ++j) h[n][j] = siluf_(acc[ai][0][m][n][j]) * acc[ai][1][m][n][j] * SC_HID;
                u32x2 w; w.x = pk4_fp8(h[0][0], h[0][1], h[0][2], h[0][3]); w.y = pk4_fp8(h[1][0], h[1][1], h[1][2], h[1][3]);
                *(u32x2*)(HID + (size_t)row * FF + 128 * u.pn + 32 * wc + 8 * fq) = w; }
    }
};
struct EpiDown {
    unsigned char* Y; bf16_t* X; const float* gate;
    __device__ __forceinline__ void operator()(const f32x4 (&acc)[2][2][4][2], const UnitD& u, int wr, int wc, int fr, int fq) const {
        if (u.e == NEXP) {
            if (!X) return;
            const int mi = mod_index(u.row0); const float* g = gate + (size_t)mi * MODW;
#pragma unroll
            for (int ai = 0; ai < 2; ++ai)
#pragma unroll
                for (int m = 0; m < 4; ++m) { bf16_t* dp = X + (size_t)(u.row0 + ai * 128 + wr * 64 + m * 16 + fr) * D;
#pragma unroll
                    for (int bj = 0; bj < 2; ++bj) { const int col = 256 * u.pn + 64 * wc + 16 * fq + 8 * bj;
                        const u32x4 w = *(const u32x4*)(dp + col); f32x4 s0, s1; s0[0] = bflo(w.x); s0[1] = bfhi(w.x); s0[2] = bflo(w.y); s0[3] = bfhi(w.y); s1[0] = bflo(w.z); s1[1] = bfhi(w.z); s1[2] = bflo(w.w); s1[3] = bfhi(w.w);
                        const f32x4 o0 = s0 + *(const f32x4*)(g + col) * acc[ai][bj][m][0], o1 = s1 + *(const f32x4*)(g + col + 4) * acc[ai][bj][m][1];
                        u32x4 ow; ow.x = pk2(o0[0], o0[1]); ow.y = pk2(o0[2], o0[3]); ow.z = pk2(o1[0], o1[1]); ow.w = pk2(o1[2], o1[3]); *(u32x4*)(dp + col) = ow; } }
        } else {
            if (!Y) { asm volatile("" :: "v"(acc[0][0][0][0][0]), "v"(acc[1][1][3][1][3])); return; }
#pragma unroll
            for (int ai = 0; ai < 2; ++ai)
#pragma unroll
                for (int m = 0; m < 4; ++m) { unsigned char* yp = Y + (size_t)(u.row0 + ai * 128 + wr * 64 + m * 16 + fr) * D + 256 * u.pn + 64 * wc + 16 * fq;
                    const f32x4 v0 = acc[ai][0][m][0] * SC_Y, v1 = acc[ai][0][m][1] * SC_Y, v2 = acc[ai][1][m][0] * SC_Y, v3 = acc[ai][1][m][1] * SC_Y; u32x4 w;
                    w.x = pk4_fp8(v0[0], v0[1], v0[2], v0[3]); w.y = pk4_fp8(v1[0], v1[1], v1[2], v1[3]); w.z = pk4_fp8(v2[0], v2[1], v2[2], v2[3]); w.w = pk4_fp8(v3[0], v3[1], v3[2], v3[3]);
                    *(u32x4*)yp = w; }
        }
    }
};

typedef bf16x8 __attribute__((may_alias)) bf16x8_a;
__device__ __forceinline__ f32x16 mfma32(bf16x8 a, bf16x8 b, f32x16 c) { return __builtin_amdgcn_mfma_f32_32x32x16_bf16(a, b, c, 0, 0, 0); }
__device__ __forceinline__ bf16x8 ld_tr2(const LAS unsigned char* p0, const LAS unsigned char* p1) {
    const s16x4 a = __builtin_amdgcn_ds_read_tr16_b64_v4i16((LAS s16x4*)p0), b = __builtin_amdgcn_ds_read_tr16_b64_v4i16((LAS s16x4*)p1);
    bf16x8 r; r[0] = a[0]; r[1] = a[1]; r[2] = a[2]; r[3] = a[3]; r[4] = b[0]; r[5] = b[1]; r[6] = b[2]; r[7] = b[3]; return r;
}
__device__ __forceinline__ unsigned tr_addr(unsigned lane, unsigned rowbase, unsigned cb) {
    const unsigned blk = (lane >> 4) & 1, q = (lane & 15) >> 2, p = lane & 3; return off_b(rowbase + q, 4 * cb + 2 * blk + (p >> 1)) + 8 * (p & 1);
}
__device__ __forceinline__ bf16x8 pack8(const f32x16& v, int s) {
    u32x4 w; w.x = pk2(v[8 * s + 0], v[8 * s + 1]); w.y = pk2(v[8 * s + 2], v[8 * s + 3]); w.z = pk2(v[8 * s + 4], v[8 * s + 5]); w.w = pk2(v[8 * s + 6], v[8 * s + 7]);
    return __builtin_bit_cast(bf16x8, w);
}
__device__ __forceinline__ void stage_offb(LAS unsigned char* img, const bf16_t* g, int ldg, int rows, int tid) {
    const int wid = __builtin_amdgcn_readfirstlane(tid >> 6);
    for (int r0 = 0; r0 < rows; r0 += 32) { const unsigned p = (unsigned)(r0 * 16 + tid), row = p >> 4, chs = p & 15, ch = chs ^ offb_key(row);
        __builtin_amdgcn_global_load_lds((const unsigned*)(g + (size_t)row * ldg + 8 * ch), (LAS unsigned*)(img + r0 * 256 + wid * 1024), 16, 0, 0); }
}
typedef int v8i_t __attribute__((ext_vector_type(8)));
typedef int v4i_t __attribute__((ext_vector_type(4)));
typedef v4i_t __attribute__((may_alias)) v4i_ta;
constexpr int ATT_STG = 8192, ATT_VOF = 65536;
__device__ __forceinline__ void attn_unit(LAS unsigned char* lds, const Args& A, bf16_t* MIX, int qrow0, int b, int nkeys, int head, float lam, float sbl2, const float* subw, float outscale, const int probe = 0) {
    const int tid = threadIdx.x, wid = __builtin_amdgcn_readfirstlane(tid >> 6), lane = tid & 63, br = wid >> 2, qq = wid & 3, l31 = lane & 31, hh = lane >> 5;
    const int qrow = qrow0 + 32 * qq + l31;
    const unsigned char* q8 = A.ws + WS_Q8 + (size_t)qrow * 1024 + head * 128 + br * 64 + 32 * hh;
    v8i_t Qf; Qf.lo = *(const v4i_t*)q8; Qf.hi = *(const v4i_t*)(q8 + 16);
    f32x16 O[4]; const float oz = opaque_zero();
#pragma unroll
    for (int i = 0; i < 4; ++i)
#pragma unroll
        for (int j = 0; j < 16; ++j) O[i][j] = oz;
    const float c565 = opaque_zero() + 56.5f; f32x16 CB; f32x4 Ol;
#pragma unroll
    for (int j = 0; j < 16; ++j) CB[j] = c565;
#pragma unroll
    for (int j = 0; j < 4; ++j) Ol[j] = oz;
    v8i_t Aones;
#pragma unroll
    for (int i = 0; i < 8; ++i) Aones[i] = (lane & 15) == ((lane >> 4) & 1) ? 0x50505050 : 0;
    const int ntile = nkeys / 64;
    const unsigned ksw = (l31 >> 1) & 7, vsw = (l31 >> 2) & 7;
    const unsigned ka0 = l31 * 128 + 16 * ((4 * br + 2 * hh) ^ ksw), ka1 = l31 * 128 + 16 * ((4 * br + 2 * hh + 1) ^ ksw);
    unsigned va0 = ATT_VOF + (l31 >> 1) * 128 + 16 * ((4 * (l31 & 1) + 2 * hh) ^ vsw), va1 = ATT_VOF + (l31 >> 1) * 128 + 16 * ((4 * (l31 & 1) + 2 * hh + 1) ^ vsw);
    asm volatile("" : "+v"(va0), "+v"(va1));
    const int sP = 127 * 0x01010101, sK = sP, sV = sP, sQ = (E8_Q8 + 3 + E8_K8 - 127) * 0x01010101;
    __syncthreads();
    const unsigned ksrc = (unsigned)((tid >> 3) * 128 + 16 * ((tid & 7) ^ ((tid >> 4) & 7)));
    const unsigned char* kgb = A.ws + WS_K8 + ((size_t)(b * 8 + head) * SEQU << 7);
    const unsigned char* vgb = A.ws + WS_V8T + ((size_t)(b * 8 + head) * (SEQU / 64) << 13);
    const unsigned dmaw = (unsigned)(size_t)(lds + wid * 1024);
#define ATT_DMA(gbase, voff, la) do { unsigned m0s_; asm volatile("s_mov_b32 %0, m0\n\ts_mov_b32 m0, %1\n\ts_nop 0\n\tglobal_load_lds_dwordx4 %2, %3\n\ts_mov_b32 m0, %0\n\ts_nop 0" : "=&s"(m0s_) : "s"(la), "v"(voff), "s"(gbase) : "memory"); } while (0)
#define ATT_DMAK(stg, t_) ATT_DMA(kgb + (size_t)min((t_), ntile - 1) * 8192, ksrc, dmaw + (unsigned)(stg))
#define ATT_DMAV(stg, t_) ATT_DMA(vgb + (size_t)min((t_), ntile - 1) * 8192, ksrc, dmaw + (unsigned)((stg) + ATT_VOF))
#define ATT_WAITV(n) asm volatile("s_waitcnt vmcnt(" #n ")" ::: "memory")
    ATT_DMAK(3 * ATT_STG, 0);
    ATT_DMAK(7 * ATT_STG, 1);
    ATT_DMAK(0, 2); ATT_DMAV(0, 0);
    ATT_DMAK(ATT_STG, 3); ATT_DMAV(ATT_STG, 1);
    ATT_DMAK(2 * ATT_STG, 4); ATT_DMAV(2 * ATT_STG, 2);
    { u32x4 z; z.x = 0; z.y = 0; z.z = 0; z.w = 0; *(LAS u32x4*)(lds + 7 * ATT_STG + ATT_VOF + 16 * tid) = z; }
    ATT_WAITV(0);
    __syncthreads();
    f32x16 Sa, Sb; v8i_t FA, FB, FC, FD;
    { v8i_t Kf; Kf.lo = *(const LAS v4i_ta*)(lds + 3 * ATT_STG + ka0); Kf.hi = *(const LAS v4i_ta*)(lds + 3 * ATT_STG + ka1);
      Sa = __builtin_amdgcn_mfma_scale_f32_32x32x64_f8f6f4(Kf, Qf, CB, 0, 0, 0, sK, 0, sQ);
      Kf.lo = *(const LAS v4i_ta*)(lds + 3 * ATT_STG + 4096 + ka0); Kf.hi = *(const LAS v4i_ta*)(lds + 3 * ATT_STG + 4096 + ka1);
      Sb = __builtin_amdgcn_mfma_scale_f32_32x32x64_f8f6f4(Kf, Qf, CB, 0, 0, 0, sK, 0, sQ);
      FA.lo = *(const LAS v4i_ta*)(lds + 7 * ATT_STG + va0); FA.hi = *(const LAS v4i_ta*)(lds + 7 * ATT_STG + va1);
      FB.lo = *(const LAS v4i_ta*)(lds + 7 * ATT_STG + 2048 + va0); FB.hi = *(const LAS v4i_ta*)(lds + 7 * ATT_STG + 2048 + va1); }
    v8i_t PfP;
#pragma unroll
    for (int i = 0; i < 8; ++i) PfP[i] = 0;
    __syncthreads();
#define ATT_PACK(S, r0, dst) if (probe & 2) { asm volatile("" :: "v"(S[(r0)]), "v"(S[(r0) + 3])); dst = PfP[0] + (r0); } else { unsigned w = 0; _Pragma("unroll") for (int c = 0; c < 4; ++c) w = __builtin_amdgcn_cvt_pk_u8_f32(__builtin_amdgcn_fmed3f(S[(r0) + c], 0.0f, hi), c, w); dst = (int)w; }
#define ATT_LDV(dst, base, dvb) if (probe & 4) { dst = Qf; } else { dst.lo = *(const LAS v4i_ta*)(base + (dvb) * 2048 + va0); dst.hi = *(const LAS v4i_ta*)(base + (dvb) * 2048 + va1); }
#define ATT_LDK(dst, kb) if (probe & 4) { dst = Qf; } else { dst.lo = *(const LAS v4i_ta*)(rd + (kb) * 4096 + ka0); dst.hi = *(const LAS v4i_ta*)(rd + (kb) * 4096 + ka1); }
#define ATT_MFMA(D, A_, B_, C_, sa, sb) if (probe & 32) { asm volatile("" :: "v"(A_)); D = __builtin_amdgcn_mfma_scale_f32_32x32x64_f8f6f4(Qf, B_, C_, 0, 0, 0, sa, 0, sb); asm volatile("" : "+v"(D)); } else if (!(probe & 1)) { D = __builtin_amdgcn_mfma_scale_f32_32x32x64_f8f6f4(A_, B_, C_, 0, 0, 0, sa, 0, sb); asm volatile("" : "+v"(D)); } else { asm volatile("" :: "v"(A_), "v"(B_)); }
#define ATT_SB __builtin_amdgcn_sched_barrier(0)
#define ATT_INTERVAL(I, F0, F1, F2, F3, BAR) { \
        LAS unsigned char* rd = lds + (((I) + 7) & 7) * ATT_STG; LAS unsigned char* pf = lds + ((I) & 7) * ATT_STG; \
        const float hi = __builtin_bit_cast(float, __builtin_amdgcn_readfirstlane((I) < ntile ? 0x42fc0000 : 0));     \
        v8i_t PfN; \
        ATT_SB; \
        ATT_LDK(F2, 0); \
        if (!(probe & 1)) { Ol = __builtin_amdgcn_mfma_scale_f32_16x16x128_f8f6f4(Aones, PfP, Ol, 0, 0, 0, sV, 0, sP); asm volatile("" : "+v"(Ol)); } else { asm volatile("" :: "v"(Aones), "v"(PfP)); } \
        ATT_PACK(Sa, 0, PfN[0]); ATT_PACK(Sa, 4, PfN[1]); \
        ATT_SB; \
        ATT_LDV(F3, rd, 2); \
        ATT_MFMA(O[0], F0, PfP, O[0], sV, sP); \
        ATT_PACK(Sa, 8, PfN[2]); ATT_PACK(Sa, 12, PfN[3]); \
        ATT_SB; \
        ATT_MFMA(O[1], F1, PfP, O[1], sV, sP); \
        if (!(probe & 8)) ATT_DMAK((((I) + 3) & 7) * ATT_STG, (I) + 5);     \
        ATT_LDK(F0, 1); \
        ATT_PACK(Sb, 0, PfN[4]); ATT_PACK(Sb, 4, PfN[5]); \
        ATT_SB; \
        ATT_MFMA(Sa, F2, Qf, CB, sK, sQ); \
        ATT_LDV(F1, rd, 3); \
        ATT_PACK(Sb, 8, PfN[6]); ATT_PACK(Sb, 12, PfN[7]); \
        ATT_SB; \
        ATT_MFMA(O[2], F3, PfP, O[2], sV, sP); \
        if (!(probe & 8)) ATT_DMAV((((I) + 3) & 7) * ATT_STG, (I) + 3); \
        ATT_LDV(F2, pf, 0); \
        ATT_SB; \
        ATT_MFMA(Sb, F0, Qf, CB, sK, sQ); \
        ATT_LDV(F3, pf, 1); \
        ATT_SB; \
        ATT_MFMA(O[3], F1, PfP, O[3], sV, sP); \
        ATT_SB; \
        PfP = PfN; \
        if (BAR) { asm volatile("s_waitcnt vmcnt(2) lgkmcnt(4)" ::: "memory");     \
            if (!(probe & 16)) { __builtin_amdgcn_s_barrier(); asm volatile("" ::: "memory"); } } \
        else asm volatile("" ::: "memory");     }
#pragma unroll 1
    for (int i = 0; i <= ntile; i += 8) {
        ATT_INTERVAL(i, FA, FB, FC, FD, 0);
        ATT_INTERVAL(i + 1, FC, FD, FA, FB, 1);
        ATT_INTERVAL(i + 2, FA, FB, FC, FD, 0);
        ATT_INTERVAL(i + 3, FC, FD, FA, FB, 1);
        ATT_INTERVAL(i + 4, FA, FB, FC, FD, 0);
        ATT_INTERVAL(i + 5, FC, FD, FA, FB, 1);
        ATT_INTERVAL(i + 6, FA, FB, FC, FD, 0);
        ATT_INTERVAL(i + 7, FC, FD, FA, FB, 1);
    }
    ATT_WAITV(0);
#undef ATT_INTERVAL
#undef ATT_MFMA
#undef ATT_DMAK
#undef ATT_DMAV
#undef ATT_WAITV
#undef ATT_PACK
#undef ATT_LDV
#undef ATT_LDK
#undef ATT_SB
    if (probe) { _Pragma("unroll") for (int i = 0; i < 4; ++i) asm volatile("" :: "v"(O[i])); asm volatile("" :: "v"(Ol), "v"(Sa), "v"(Sb), "v"(PfP), "v"(FA), "v"(FB)); __syncthreads(); return; }
    const float ls0 = __shfl(Ol[0], lane & 15), ls1 = __shfl(Ol[1], lane & 15); const float lsum = (lane & 16) ? ls1 : ls0;
    const float inv = fast_rcp(lsum);
    __syncthreads();
    LAS float* ex = (LAS float*)lds + qq * 4096;
    if (br == 1) { const float f = lam * inv;
#pragma unroll
        for (int dvb = 0; dvb < 4; ++dvb)
#pragma unroll
            for (int j = 0; j < 16; ++j) ex[(dvb * 16 + j) * 64 + lane] = O[dvb][j] * f; }
    __syncthreads();
    if (br == 0) { float ss = 0.f;
#pragma unroll
        for (int dvb = 0; dvb < 4; ++dvb)
#pragma unroll
            for (int j = 0; j < 16; ++j) {
#ifdef ATT_NOEX
                const float v = O[dvb][j] * inv;
#else
                const float v = O[dvb][j] * inv - ex[(dvb * 16 + j) * 64 + lane];
#endif
                O[dvb][j] = v; ss += v * v; }
        ss += __shfl_xor(ss, 32);
        const float rinv = __builtin_amdgcn_rsqf(ss * (1.0f / 128.0f) + EPS) * outscale;
        LAS unsigned char* ot = lds + 65536 + qq * 8704;
#pragma unroll
        for (int dvb = 0; dvb < 4; ++dvb)
#pragma unroll
            for (int a = 0; a < 4; ++a) { const int dv = 32 * dvb + 8 * a + 4 * hh; const f32x4 w = *(const f32x4*)(subw + dv);
                u32x2 o; o.x = pk2(O[dvb][4 * a] * rinv * w[0], O[dvb][4 * a + 1] * rinv * w[1]); o.y = pk2(O[dvb][4 * a + 2] * rinv * w[2], O[dvb][4 * a + 3] * rinv * w[3]);
                *(LAS u32x2*)(ot + l31 * 272 + 2 * dv) = o; }
        unsigned char* op = (unsigned char*)MIX + (size_t)(qrow0 + 32 * qq) * D + 512 + head * 128 + 8 * (lane & 15);
#pragma unroll
        for (int i = 0; i < 8; ++i) { const int r = 4 * i + (lane >> 4); const u32x4 v = *(const LAS u32x4*)(ot + r * 272 + 16 * (lane & 15)); u32x2 o;
            o.x = pk4_fp8(bflo(v.x) * SC_MIX, bfhi(v.x) * SC_MIX, bflo(v.y) * SC_MIX, bfhi(v.y) * SC_MIX); o.y = pk4_fp8(bflo(v.z) * SC_MIX, bfhi(v.z) * SC_MIX, bflo(v.w) * SC_MIX, bfhi(v.w) * SC_MIX);
            *(u32x2*)(op + (size_t)r * D) = o; } }
    __syncthreads();
}

__device__ __forceinline__ float log2_gamma(float logit) { return -__builtin_log2f(1.0f + fast_exp2(-logit * LOG2E)); }
__device__ __forceinline__ bf16x8 scale8(bf16x8 v, const float (&f)[8]) {
    const u32x4 w = __builtin_bit_cast(u32x4, v); u32x4 o;
    o.x = pk2(bflo(w.x) * f[0], bfhi(w.x) * f[1]); o.y = pk2(bflo(w.y) * f[2], bfhi(w.y) * f[3]); o.z = pk2(bflo(w.z) * f[4], bfhi(w.z) * f[5]); o.w = pk2(bflo(w.w) * f[6], bfhi(w.w) * f[7]);
    return __builtin_bit_cast(bf16x8, o);
}
__device__ __forceinline__ bf16x8 scale8s(bf16x8 v, float f) {
    const u32x4 w = __builtin_bit_cast(u32x4, v); u32x4 o;
    o.x = pk2(bflo(w.x) * f, bfhi(w.x) * f); o.y = pk2(bflo(w.y) * f, bfhi(w.y) * f); o.z = pk2(bflo(w.z) * f, bfhi(w.z) * f); o.w = pk2(bflo(w.w) * f, bfhi(w.w) * f);
    return __builtin_bit_cast(bf16x8, o);
}
__device__ __forceinline__ void ret_kv_unit(LAS unsigned char* lds, const bf16_t* P, bf16_t* KVT, const float* decay_logit  , int b, int j, int head) {
    const int tid = threadIdx.x, wid = __builtin_amdgcn_readfirstlane(tid >> 6), lane = tid & 63, eb = wid & 3, dir = wid >> 2, l31 = lane & 31, hh = lane >> 5;
    const int rbase = b * SEQU + 128 * j;
    LAS unsigned char* vimg = lds; LAS unsigned char* kimg = lds + 32768;
    __syncthreads();
    stage_offb(vimg, P + (size_t)rbase * LDP + OFF_RV + head * 128, LDP, 128, tid);
    stage_offb(kimg, P + (size_t)rbase * LDP + OFF_RK + head * 128, LDP, 128, tid);
    const float l2g = log2_gamma(decay_logit[dir * 4 + head]);
    asm volatile("s_waitcnt vmcnt(0)" ::: "memory"); __syncthreads();
    f32x16 acc[4];
#pragma unroll
    for (int i = 0; i < 4; ++i)
#pragma unroll
        for (int q = 0; q < 16; ++q) acc[i][q] = 0.f;
#pragma unroll 2
    for (int ks = 0; ks < 8; ++ks) {
        const unsigned rb = 16 * ks + 8 * hh;
        bf16x8 vf = ld_tr2(vimg + tr_addr(lane, rb, eb), vimg + tr_addr(lane, rb + 4, eb));
        float f[8];
#pragma unroll
        for (int q = 0; q < 8; ++q) { const int i = (int)rb + q; f[q] = fast_exp2(l2g * (float)(dir == 0 ? 127 - i : i)); }
        vf = scale8(vf, f);
#pragma unroll
        for (int db = 0; db < 4; ++db) { const bf16x8 kf = ld_tr2(kimg + tr_addr(lane, rb, db), kimg + tr_addr(lane, rb + 4, db)); acc[db] = mfma32(vf, kf, acc[db]); }
    }
    bf16_t* out = KVT + ((((size_t)(b * 4 + head) * 2 + dir) * NCH128 + j) << 14);
#pragma unroll
    for (int db = 0; db < 4; ++db)
#pragma unroll
        for (int q = 0; q < 16; ++q) { const int e = 32 * eb + (q & 3) + 8 * (q >> 2) + 4 * hh; const float v = acc[db][q], vn = __shfl_xor(v, 1);
            if ((lane & 1) == 0) *(unsigned*)(out + e * 128 + 32 * db + l31) = pk2(v, vn); }
    __syncthreads();
}
__device__ __forceinline__ void ret_state_phase(const bf16_t* KVT, bf16_t* ST, const float* decay_logit, int gtid, int gn) {
    for (int id = gtid; id < 16 * 8192; id += gn) {
        const int seq = id >> 13, el = (id & 8191) * 2, dir = seq & 1, head = (seq >> 1) & 3;
        const float G = fast_exp2(128.0f * log2_gamma(decay_logit[dir * 4 + head]));
        const bf16_t* kv = KVT + ((size_t)seq * NCH128 << 14) + el; bf16_t* st = ST + ((size_t)seq * NCH128 << 14) + el;
        float s0 = 0.f, s1 = 0.f;
        for (int sb = 0; sb < NCH128; sb += 22) {
            unsigned kk[22]; int jj[22];
#pragma unroll
            for (int q = 0; q < 22; ++q) { const int s = sb + q; jj[q] = dir == 0 ? s : (s == 0 ? 1 : s == 1 ? 0 : 67 - s); kk[q] = *(const unsigned*)(kv + ((size_t)jj[q] << 14)); }
#pragma unroll
            for (int q = 0; q < 22; ++q) { *(unsigned*)(st + ((size_t)jj[q] << 14)) = pk2(s0, s1); s0 = s0 * G + bflo(kk[q]); s1 = s1 * G + bfhi(kk[q]); }
        }
    }
}
__device__ __forceinline__ void ret_out_unit(LAS unsigned char* lds, const bf16_t* P, const bf16_t* ST, bf16_t* MIX, const float* decay_logit, const float* normw, int b, int j, int hp) {
    const int tid = threadIdx.x, wid = __builtin_amdgcn_readfirstlane(tid >> 6), lane = tid & 63, hsel = wid >> 2, qq = wid & 3, l31 = lane & 31, hh = lane >> 5;
    const int head = 2 * hp + hsel, rbase = b * SEQU + 128 * j, qi = 32 * qq + l31, qrow = rbase + qi;
    LAS unsigned char* vimg = lds + hsel * 32768; LAS unsigned char* kimg = lds + 65536 + hsel * 32768;
    __syncthreads();
    stage_offb(lds, P + (size_t)rbase * LDP + OFF_RV + (2 * hp) * 128, LDP, 128, tid);
    stage_offb(lds + 32768, P + (size_t)rbase * LDP + OFF_RV + (2 * hp + 1) * 128, LDP, 128, tid);
    stage_offb(lds + 65536, P + (size_t)rbase * LDP + OFF_RK + (2 * hp) * 128, LDP, 128, tid);
    stage_offb(lds + 98304, P + (size_t)rbase * LDP + OFF_RK + (2 * hp + 1) * 128, LDP, 128, tid);
    const float l2f = log2_gamma(decay_logit[head]), l2b = log2_gamma(decay_logit[4 + head]);
    bf16x8 Qf[8];
#pragma unroll
    for (int ks = 0; ks < 8; ++ks) Qf[ks] = *(const bf16x8*)(P + (size_t)qrow * LDP + OFF_RQ + head * 128 + 16 * ks + 8 * hh);
    f32x16 O[4];
#pragma unroll
    for (int i = 0; i < 4; ++i)
#pragma unroll
        for (int q = 0; q < 16; ++q) O[i][q] = 0.f;
    asm volatile("s_waitcnt vmcnt(0)" ::: "memory"); __syncthreads();
    for (int kb = 0; kb < 4; ++kb) {
        f32x16 S; const float z0 = opaque_zero();
#pragma unroll
        for (int q = 0; q < 16; ++q) S[q] = z0;
#pragma unroll
        for (int ks = 0; ks < 8; ++ks) { const bf16x8 kf = *(const LAS bf16x8_a*)(kimg + off_b(32 * kb + l31, 2 * ks + hh)); S = mfma32(kf, Qf[ks], S); }
#pragma unroll
        for (int q = 0; q < 16; ++q) { const int ik = 32 * kb + (q & 3) + 8 * (q >> 2) + 4 * hh, dlt = qi - ik;
            const float m = (dlt >= 0 ? fast_exp2(l2f * (float)dlt) : 0.f) + (dlt <= 0 ? fast_exp2(l2b * (float)(-dlt)) : 0.f); S[q] *= m; }
#pragma unroll
        for (int s = 0; s < 2; ++s) { const bf16x8 pf = pack8(S, s); const unsigned rb = 32 * kb + 16 * s + 4 * hh;
#pragma unroll
            for (int eb = 0; eb < 4; ++eb) { const bf16x8 vf = ld_tr2(vimg + tr_addr(lane, rb, eb), vimg + tr_addr(lane, rb + 8, eb)); O[eb] = mfma32(vf, pf, O[eb]); } }
    }
    __syncthreads();
#pragma unroll
    for (int t = 0; t < 4; ++t) stage_offb(lds + t * 32768, ST + ((((size_t)(b * 4 + 2 * hp + (t >> 1)) * 2 + (t & 1)) * NCH128 + j) << 14), 128, 128, tid);
    asm volatile("s_waitcnt vmcnt(0)" ::: "memory"); __syncthreads();
#pragma unroll
    for (int dir = 0; dir < 2; ++dir) {
        const float qd = dir == 0 ? fast_exp2(l2f * (float)(qi + 1)) : fast_exp2(l2b * (float)(128 - qi));
        const LAS unsigned char* simg = lds + (hsel * 2 + dir) * 32768;
#pragma unroll
        for (int ks = 0; ks < 8; ++ks) { const bf16x8 qs = scale8s(Qf[ks], qd);
#pragma unroll
            for (int eb = 0; eb < 4; ++eb) { const bf16x8 sf = *(const LAS bf16x8_a*)(simg + off_b(32 * eb + l31, 2 * ks + hh)); O[eb] = mfma32(sf, qs, O[eb]); } }
    }
    float sm = 0.f;
#pragma unroll
    for (int eb = 0; eb < 4; ++eb)
#pragma unroll
        for (int q = 0; q < 16; ++q) sm += O[eb][q];
    sm += __shfl_xor(sm, 32); const float mu = sm * (1.0f / 128.0f);
    float vs = 0.f;
#pragma unroll
    for (int eb = 0; eb < 4; ++eb)
#pragma unroll
        for (int q = 0; q < 16; ++q) { const float d = O[eb][q] - mu; O[eb][q] = d; vs += d * d; }
    vs += __shfl_xor(vs, 32); const float rinv = __builtin_amdgcn_rsqf(vs * (1.0f / 128.0f) + EPS);
    __syncthreads();
    LAS unsigned char* ot = lds + wid * 8704;
#pragma unroll
    for (int eb = 0; eb < 4; ++eb)
#pragma unroll
        for (int a = 0; a < 4; ++a) { const int e = 32 * eb + 8 * a + 4 * hh; const f32x4 w = *(const f32x4*)(normw + head * 128 + e);
            u32x2 o; o.x = pk2(O[eb][4 * a] * rinv * w[0], O[eb][4 * a + 1] * rinv * w[1]); o.y = pk2(O[eb][4 * a + 2] * rinv * w[2], O[eb][4 * a + 3] * rinv * w[3]);
            *(LAS u32x2*)(ot + l31 * 272 + 2 * e) = o; }
    int ln = lane; asm volatile("" : "+v"(ln));
#pragma unroll
    for (int i = 0; i < 8; ++i) { const int r = 4 * i + (ln >> 4), c8 = 8 * (ln & 15); const size_t row = (size_t)(rbase + 32 * qq + r);
        const u32x4 v = *(const LAS u32x4*)(ot + r * 272 + 2 * c8), g = *(const u32x4*)(P + row * LDP + OFF_RG + head * 128 + c8);
        u32x2 o; o.x = pk4_fp8(bflo(v.x) * bflo(g.x) * SC_MIX, bfhi(v.x) * bfhi(g.x) * SC_MIX, bflo(v.y) * bflo(g.y) * SC_MIX, bfhi(v.y) * bfhi(g.y) * SC_MIX);
        o.y = pk4_fp8(bflo(v.z) * bflo(g.z) * SC_MIX, bfhi(v.z) * bfhi(g.z) * SC_MIX, bflo(v.w) * bflo(g.w) * SC_MIX, bfhi(v.w) * bfhi(g.w) * SC_MIX);
        *(u32x2*)((unsigned char*)MIX + row * D + head * 128 + c8) = o; }
    __syncthreads();
}

typedef unsigned __attribute__((may_alias)) u32_a;
typedef unsigned short __attribute__((may_alias)) u16_a;
__device__ __forceinline__ f32x4 mfma16(bf16x8 a, bf16x8 b, f32x4 c) { return __builtin_amdgcn_mfma_f32_16x16x32_bf16(a, b, c, 0, 0, 0); }
__device__ __forceinline__ void s5_scan(const bf16_t* P, const bf16_t* BFp  , int rbase, int g, int dir, int lane, f32x2 a, f32x2 init, f32x16& xr, f32x16& xi, const bool endonly = false, f32x2 a16 = (f32x2){0.f, 0.f}) {
    const int rho = lane & 31, hk = lane >> 5;
    const int tscan = 16 * ((rho >> 2) & 1) + 4 * (rho >> 3) + (rho & 3), tok = dir == 0 ? tscan : 31 - tscan;
    const bf16x8 uf = *(const bf16x8*)(P + (size_t)(rbase + tok) * LDP + OFF_U + 16 * g + 8 * hk);
    const bf16x8 bre = *(const bf16x8*)(BFp + lane * 8), bim = *(const bf16x8*)(BFp + 512 + lane * 8);
    const float zero = opaque_zero();
    f32x16 zr, zi;
#pragma unroll
    for (int q = 0; q < 16; ++q) { zr[q] = zero; zi[q] = zero; }
    const f32x16 br = mfma32(uf, bre, zr), bi = mfma32(uf, bim, zi);
#ifdef S5_NOSCAN
#pragma unroll
    for (int q = 0; q < 16; ++q) { xr[q] = br[q]; xi[q] = bi[q]; }
    return;
#endif
#ifdef S5_USEA
#pragma unroll
    for (int q = 0; q < 16; ++q) { xr[q] = br[q] * a[0] + init[0]; xi[q] = bi[q] * a[1] + init[1]; }
    return;
#endif
    float sr = hk == 0 ? init[0] : 0.f, si = hk == 0 ? init[1] : 0.f;
#pragma unroll
    for (int q = 0; q < 16; ++q) { float nr = __builtin_fmaf(a[0], sr, __builtin_fmaf(-a[1], si, br[q])), ni = __builtin_fmaf(a[0], si, __builtin_fmaf(a[1], sr, bi[q])); asm("" : "+v"(nr)); asm("" : "+v"(ni)); sr = nr; si = ni; xr[q] = sr; xi[q] = si; }
#ifdef S5_NOFIX
    return;
#endif
    float er = __shfl(sr, lane & 31), ei = __shfl(si, lane & 31);
    if (hk == 0) { er = 0.f; ei = 0.f; }
    if (endonly) {
        float t0 = __builtin_fmaf(a16[0], er, __builtin_fmaf(-a16[1], ei, xr[15])), t1 = __builtin_fmaf(a16[0], ei, __builtin_fmaf(a16[1], er, xi[15])); asm("" : "+v"(t0)); asm("" : "+v"(t1)); xr[15] = t0; xi[15] = t1; return; }
    float wr_ = a[0], wi_ = a[1];
#pragma unroll
    for (int q = 0; q < 16; ++q) { float t0 = __builtin_fmaf(wr_, er, __builtin_fmaf(-wi_, ei, xr[q])), t1 = __builtin_fmaf(wr_, ei, __builtin_fmaf(wi_, er, xi[q])); asm("" : "+v"(t0)); asm("" : "+v"(t1)); xr[q] = t0; xi[q] = t1;
        float nr = __builtin_fmaf(wr_, a[0], -wi_ * a[1]), ni = __builtin_fmaf(wr_, a[1], wi_ * a[0]); asm("" : "+v"(nr)); asm("" : "+v"(ni)); wr_ = nr; wi_ = ni; }
}
__device__ __forceinline__ void s5_end_unit(const Args& A, int l, int b, int c) {
    const int tid = threadIdx.x, wid = __builtin_amdgcn_readfirstlane(tid >> 6), lane = tid & 63;
    const bf16_t* P = (const bf16_t*)(A.ws + WS_P); const f32x2* SA = (const f32x2*)(A.ws + WS_S5A); const bf16_t* BF = (const bf16_t*)(A.ws + WS_S5BF); f32x2* E = (f32x2*)(A.ws + WS_S5E);
    const int rbase = b * SEQU + 32 * c;
    for (int gi = 0; gi < 4; ++gi) { const int g = 4 * wid + gi;
#pragma unroll
        for (int d = 0; d < 2; ++d)
#pragma unroll
            for (int pb = 0; pb < 2; ++pb) { const int p = 32 * pb + (lane & 31); const f32x2 a = SA[((l * 2 + d) * 32 + g) * 64 + p];
                f32x16 xr, xi; s5_scan(P, BF + ((((size_t)(l * 2 + d) * 32 + g) * 2 + pb) * 2) * 512, rbase, g, d, lane, a, (f32x2){0.f, 0.f}, xr, xi, true, SA[S5A_N + ((l * 2 + d) * 32 + g) * 64 + p]);
                if (lane >= 32) E[(((size_t)(b * 2 + d) * NCH32 + c) * 32 + g) * 64 + p] = (f32x2){xr[15], xi[15]}; }
    }
}
__device__ __forceinline__ void s5_carry_phase(const Args& A, int l, LAS unsigned char* lds, int vcu, int G) {
    const int tid = threadIdx.x, wid = __builtin_amdgcn_readfirstlane(tid >> 6), lane = tid & 63;
    const f32x2* SA = (const f32x2*)(A.ws + WS_S5A) + 2 * S5A_N; const f32x2* E = (const f32x2*)(A.ws + WS_S5E); f32x2* XC = (f32x2*)(A.ws + WS_S5X);
    LAS f32x2* T = (LAS f32x2*)lds;
    for (int u = G - 1 - vcu; u < 128; u += G) { const int gp = (u & 31) * 64 + lane, d = (u >> 5) & 1, b = u >> 6;
        const f32x2 a = SA[(l * 2 + d) * 2048 + gp]; const size_t base = (size_t)(b * 2 + d) * NCH32 * 2048 + gp;
        f32x2 ev[33];
#pragma unroll
        for (int q = 0; q < 33; ++q) { const int s = 33 * wid + q, cc = d == 0 ? s : (s < 8 ? 7 - s : 271 - s); ev[q] = E[base + (size_t)cc * 2048]; }
        float pr = 0.f, pi = 0.f;
#pragma unroll
        for (int q = 0; q < 33; ++q) { const f32x2 e = ev[q]; ev[q] = (f32x2){pr, pi}; const float nr = a[0] * pr - a[1] * pi + e[0], ni = a[0] * pi + a[1] * pr + e[1]; pr = nr; pi = ni; }
        __syncthreads();
        T[wid * 64 + lane] = (f32x2){pr, pi};
        float wr_ = 1.f, wi_ = 0.f;
#pragma unroll
        for (int q = 0; q < 33; ++q) { const float nr = wr_ * a[0] - wi_ * a[1], ni = wr_ * a[1] + wi_ * a[0]; wr_ = nr; wi_ = ni; }
        __syncthreads();
        float cr = 0.f, ci = 0.f;
        for (int v = 0; v < wid; ++v) { const f32x2 t = T[v * 64 + lane]; const float nr = wr_ * cr - wi_ * ci + t[0], ni = wr_ * ci + wi_ * cr + t[1]; cr = nr; ci = ni; }
#pragma unroll
        for (int q = 0; q < 33; ++q) { const int s = 33 * wid + q, cc = d == 0 ? s : (s < 8 ? 7 - s : 271 - s);
            XC[base + (size_t)cc * 2048] = (f32x2){ev[q][0] + cr, ev[q][1] + ci}; const float nr = a[0] * cr - a[1] * ci, ni = a[0] * ci + a[1] * cr; cr = nr; ci = ni; }
    }
}
constexpr int S5_XPITCH = 272, S5_XIMG = 32 * S5_XPITCH  , S5_YOFF = 8 * S5_XIMG  , S5_YPITCH = 1040;
__device__ __forceinline__ void s5_out_unit(LAS unsigned char* lds, const Args& A, int l, int b, int c) {
    const int tid = threadIdx.x, wid = __builtin_amdgcn_readfirstlane(tid >> 6), lane = tid & 63, l31 = lane & 31, hk = lane >> 5, l15 = lane & 15, kq = lane >> 4;
    const bf16_t* P = (const bf16_t*)(A.ws + WS_P); const f32x2* SA = (const f32x2*)(A.ws + WS_S5A); const bf16_t* BF = (const bf16_t*)(A.ws + WS_S5BF); const bf16_t* CF = (const bf16_t*)(A.ws + WS_S5CF);
    const f32x2* XC = (const f32x2*)(A.ws + WS_S5X); bf16_t* MIX = (bf16_t*)(A.ws + WS_MIX); const bf16_t* GLU = (const bf16_t*)(A.ws + WS_GLU) + (size_t)l * 512 * 512;
    const int rbase = b * SEQU + 32 * c;
    LAS unsigned char* ximg = lds + wid * S5_XIMG; LAS unsigned char* yimg = lds + S5_YOFF;
    __syncthreads();
#ifdef S5_COPYU
    for (int i = tid; i < 32 * 64; i += NTHR) { const int t = i >> 6, c8 = (i & 63) * 8; *(u32x4*)(MIX + (size_t)(rbase + t) * D + 1536 + c8) = *(const u32x4*)(P + (size_t)(rbase + t) * LDP + OFF_U + c8); }
    __syncthreads(); return;
#endif
    for (int gi = 0; gi < 4; ++gi) { const int g = 4 * wid + gi;
        const float z0 = opaque_zero(); f32x4 ya[2] = {{z0, z0, z0, z0}, {z0, z0, z0, z0}};
#pragma unroll
        for (int d = 0; d < 2; ++d) {
#pragma unroll
            for (int pb = 0; pb < 2; ++pb) { const int p = 32 * pb + l31; const f32x2 a = SA[((l * 2 + d) * 32 + g) * 64 + p];
#ifdef S5_NOINIT
                const f32x2 init = {0.f, 0.f};
#else
                const f32x2 init = XC[(((size_t)(b * 2 + d) * NCH32 + c) * 32 + g) * 64 + p];
#endif
                f32x16 xr, xi; s5_scan(P, BF + ((((size_t)(l * 2 + d) * 32 + g) * 2 + pb) * 2) * 512, rbase, g, d, lane, a, init, xr, xi);
#pragma unroll
                for (int q = 0; q < 16; ++q) { const int ts = 16 * hk + q, t = d == 0 ? ts : 31 - ts;
                    *(LAS u32_a*)(ximg + t * S5_XPITCH + 4 * p) = pk2(xr[q], xi[q]); } }
            asm volatile("s_waitcnt lgkmcnt(0)" ::: "memory");
#pragma unroll
            for (int ks = 0; ks < 4; ++ks) { const bf16x8 cf = *(const bf16x8*)(CF + (((size_t)l * 32 + g) * 4 + ks) * 512 + lane * 8);
#pragma unroll
                for (int rb = 0; rb < 2; ++rb) { const bf16x8 xf = *(const LAS bf16x8_a*)(ximg + (16 * rb + l15) * S5_XPITCH + 2 * (32 * ks + 8 * kq)); ya[rb] = mfma16(xf, cf, ya[rb]); } }
            asm volatile("s_waitcnt lgkmcnt(0)" ::: "memory");
        }
        const int ch = 16 * g + l15; const float dv = A.s5_d[l * 512 + ch];
#pragma unroll
        for (int rb = 0; rb < 2; ++rb)
#pragma unroll
            for (int q = 0; q < 4; ++q) { const int t = 16 * rb + 4 * kq + q; const float u = bf2f(P[(size_t)(rbase + t) * LDP + OFF_U + ch]);
                const float yv = gelu_tanh(ya[rb][q] + dv * u), yn = __shfl_xor(yv, 1);
                if ((lane & 1) == 0) *(LAS u32_a*)(yimg + t * S5_YPITCH + 2 * ch) = pk2(yv, yn); }
    }
    __syncthreads();
    f32x16 z[2];
#pragma unroll
    for (int nb = 0; nb < 2; ++nb)
#pragma unroll
        for (int q = 0; q < 16; ++q) z[nb][q] = 0.f;
#ifndef S5_NOGLU
#pragma unroll 4
    for (int ks = 0; ks < 32; ++ks) { const bf16x8 yf = *(const LAS bf16x8_a*)(yimg + l31 * S5_YPITCH + 2 * (16 * ks + 8 * hk));
#pragma unroll
        for (int nb = 0; nb < 2; ++nb) { const bf16x8 wf = *(const bf16x8*)(GLU + ((size_t)((((wid * 2 + nb) * 32 + ks) * 2 + hk) * 32 + l31) << 3)); z[nb] = mfma32(yf, wf, z[nb]); } }
#endif
#pragma unroll
    for (int nb = 0; nb < 2; ++nb)
#pragma unroll
        for (int q = 0; q < 16; ++q) { const int t = (q & 3) + 8 * (q >> 2) + 4 * hk, n = 64 * wid + 32 * nb + l31;
            const float y = bf2f(*(const LAS u16_a*)(yimg + t * S5_YPITCH + 2 * n));
            const float ov = y * sigmoidf_(z[nb][q]) * SC_MIX, on = __shfl_xor(ov, 1);
            const unsigned p2 = (unsigned)__builtin_amdgcn_cvt_pk_fp8_f32(__builtin_amdgcn_fmed3f(ov, -448.f, 448.f), __builtin_amdgcn_fmed3f(on, -448.f, 448.f), 0, false) & 0xffffu, p4 = __shfl_xor(p2, 2);
            if ((lane & 3) == 0) *(unsigned*)((unsigned char*)MIX + (size_t)(rbase + t) * D + 1536 + n) = p2 | (p4 << 16); }
    __syncthreads();
}

constexpr int RT_RS = 0, RT_PART = 1024, RT_SC = RT_PART + 8 * 32 * 64 * 4  , RT_SEL = RT_SC + 32 * 65 * 4, RT_E = RT_SEL + 32 * 65 * 4, RT_CNT = RT_E + 32 * 8 * 4, RT_BASE = RT_CNT + 256, RT_END = RT_BASE + 256;
__device__ __forceinline__ void route_unit(LAS unsigned char* lds, const Args& A, int l, int r0, bool dry = false) {
    const int tid = threadIdx.x, wid = __builtin_amdgcn_readfirstlane(tid >> 6), lane = tid & 63, l31 = lane & 31, hk = lane >> 5;
    const bf16_t* X = (const bf16_t*)(A.ws + WS_X); bf16_t* H = (bf16_t*)(A.ws + WS_H); const float* MOD = (const float*)(A.ws + WS_MOD); const bf16_t* RWH = (const bf16_t*)(A.ws + WS_RWT) + (size_t)l * NEXP * D; const bf16_t* RWL = RWH + (size_t)2 * NEXP * D;
    LAS float* rs = (LAS float*)(lds + RT_RS); LAS float* part = (LAS float*)(lds + RT_PART); LAS float* sc = (LAS float*)(lds + RT_SC); LAS float* sel = (LAS float*)(lds + RT_SEL);
    LAS int* rowE = (LAS int*)(lds + RT_E); LAS int* cntL = (LAS int*)(lds + RT_CNT); LAS int* baseL = (LAS int*)(lds + RT_BASE);
    const int mi = mod_index(r0); const float* mod = MOD + ((size_t)l * 3 + mi) * MODW; const float* sh = mod + 3 * D; const float* scv = mod + 4 * D; const float* nw = A.norm2_w + (size_t)l * D;
    LAS unsigned char* xt = lds + wid * 16384; LAS float* ssp = (LAS float*)(lds + 132096);
    __syncthreads();
    {
#pragma unroll
        for (int h = 0; h < 2; ++h) { u32x2 xv[16];
#pragma unroll
            for (int j = 0; j < 16; ++j) xv[j] = *(const u32x2*)(X + (size_t)(r0 + 16 * h + j) * D + 256 * wid + 4 * lane);
#pragma unroll
            for (int j = 0; j < 16; ++j) { const int row = 16 * h + j; *(LAS u32x2*)(xt + row * 512 + 8 * (lane ^ row)) = xv[j]; } }
    }
    float rstd;
    {
        float ss = 0.f;
#pragma unroll 8
        for (int c = 0; c < 32; ++c) { const u32x2 w = *(const LAS u32x2*)(xt + l31 * 512 + 8 * ((2 * c + hk) ^ l31)); const float a = bflo(w.x), b2 = bfhi(w.x), c2 = bflo(w.y), d2 = bfhi(w.y); ss += a * a + b2 * b2 + c2 * c2 + d2 * d2; }
        ss += __shfl_xor(ss, 32);
        if (hk == 0) ssp[wid * 32 + l31] = ss;
        __syncthreads();
        float t = 0.f;
#pragma unroll
        for (int w = 0; w < 8; ++w) t += ssp[w * 32 + l31];
        rstd = __builtin_amdgcn_rsqf(t * (1.0f / D) + EPS);
    }
    if (!dry) {
        const int col = 256 * wid + 4 * lane; const f32x4 cw = *(const f32x4*)(nw + col) * (1.0f + *(const f32x4*)(scv + col)), s0 = *(const f32x4*)(sh + col);
#pragma unroll 8
        for (int j = 0; j < 32; ++j) { const u32x2 w = *(const LAS u32x2*)(xt + j * 512 + 8 * (lane ^ j)); const float rj = __shfl(rstd, j);
            f32x4 xv; xv[0] = bflo(w.x); xv[1] = bfhi(w.x); xv[2] = bflo(w.y); xv[3] = bfhi(w.y);
            const f32x4 h2 = xv * rj * cw + s0;
            *(unsigned*)(A.ws + WS_H8 + (size_t)(r0 + j) * D + col) = pk4_fp8(h2[0] * SC_H8, h2[1] * SC_H8, h2[2] * SC_H8, h2[3] * SC_H8); }
    }
    {
        f32x16 acc[2];
#pragma unroll
        for (int cb = 0; cb < 2; ++cb)
#pragma unroll
            for (int q = 0; q < 16; ++q) acc[cb][q] = 0.f;
#pragma unroll 2
        for (int m = 0; m < 16; ++m) { const int k0 = 256 * wid + 16 * m + 8 * hk, c0 = 4 * m + 2 * hk;
            const u32x2 xa = *(const LAS u32x2*)(xt + l31 * 512 + 8 * (c0 ^ l31)), xb = *(const LAS u32x2*)(xt + l31 * 512 + 8 * ((c0 + 1) ^ l31));
            f32x4 x0, x1; x0[0] = bflo(xa.x); x0[1] = bfhi(xa.x); x0[2] = bflo(xa.y); x0[3] = bfhi(xa.y); x1[0] = bflo(xb.x); x1[1] = bfhi(xb.x); x1[2] = bflo(xb.y); x1[3] = bfhi(xb.y);
            const f32x4 h0 = x0 * rstd * *(const f32x4*)(nw + k0) * (1.0f + *(const f32x4*)(scv + k0)) + *(const f32x4*)(sh + k0);
            const f32x4 h1 = x1 * rstd * *(const f32x4*)(nw + k0 + 4) * (1.0f + *(const f32x4*)(scv + k0 + 4)) + *(const f32x4*)(sh + k0 + 4);
            u32x4 hw, lw;
            hw.x = pk2(h0[0], h0[1]); hw.y = pk2(h0[2], h0[3]); hw.z = pk2(h1[0], h1[1]); hw.w = pk2(h1[2], h1[3]);
            lw.x = pk2(h0[0] - bflo(hw.x), h0[1] - bfhi(hw.x)); lw.y = pk2(h0[2] - bflo(hw.y), h0[3] - bfhi(hw.y)); lw.z = pk2(h1[0] - bflo(hw.z), h1[1] - bfhi(hw.z)); lw.w = pk2(h1[2] - bflo(hw.w), h1[3] - bfhi(hw.w));
            const bf16x8 ah = __builtin_bit_cast(bf16x8, hw), al = __builtin_bit_cast(bf16x8, lw);
#pragma unroll
            for (int cb = 0; cb < 2; ++cb) { const size_t fo = (size_t)((((cb * 128 + 16 * wid + m) * 2 + hk) * 32 + l31) << 3); const bf16x8 bh = *(const bf16x8*)(RWH + fo), bl = *(const bf16x8*)(RWL + fo);
                acc[cb] = __builtin_amdgcn_mfma_f32_32x32x16_bf16(ah, bh, acc[cb], 0, 0, 0); acc[cb] = __builtin_amdgcn_mfma_f32_32x32x16_bf16(ah, bl, acc[cb], 0, 0, 0); acc[cb] = __builtin_amdgcn_mfma_f32_32x32x16_bf16(al, bh, acc[cb], 0, 0, 0); } }
        __syncthreads();
        if (tid < 64) cntL[tid] = 0;
#pragma unroll
        for (int cb = 0; cb < 2; ++cb)
#pragma unroll
            for (int q = 0; q < 16; ++q) part[(wid * 32 + (q & 3) + 8 * (q >> 2) + 4 * hk) * 64 + 32 * cb + l31] = acc[cb][q];
    }
    __syncthreads();
    for (int i = tid; i < 2048; i += NTHR) { float s = 0.f;
#pragma unroll
        for (int w = 0; w < 8; ++w) s += part[w * 2048 + i];
        const int row = i >> 6, e = i & 63; const float sg = 1.0f / (1.0f + __expf(-s)); sc[row * 65 + e] = sg; sel[row * 65 + e] = sg + A.router_b[l * NEXP + e]; }
    __syncthreads();
    {
        const int e = lane, g = e >> 3;
        for (int rr = 0; rr < 4; ++rr) { const int ri = 4 * wid + rr; const float sv = sel[ri * 65 + e], pv = sc[ri * 65 + e];
            int gr = 0;
#pragma unroll
            for (int k = 0; k < 8; ++k) { const float o = __shfl(sv, (e & ~7) + k); gr += (o > sv || (o == sv && k < (e & 7))) ? 1 : 0; }
            float gs = gr < 2 ? sv : 0.f; gs += __shfl_xor(gs, 1); gs += __shfl_xor(gs, 2); gs += __shfl_xor(gs, 4);
            int grk = 0;
#pragma unroll
            for (int k = 0; k < 8; ++k) { const float o = __shfl(gs, 8 * k); grk += (o > gs || (o == gs && k < g)) ? 1 : 0; }
            const bool allowed = grk < 4; const float mv = allowed ? sv : -INFINITY;
            int rk = 0;
#pragma unroll 4
            for (int k = 0; k < 64; ++k) { const float o = __shfl(mv, k); rk += (o > mv || (o == mv && k < e)) ? 1 : 0; }
            const bool pick = allowed && rk < 8;
            const float wsum = wave_sum(pick ? pv : 0.f);
            if (pick) { rowE[ri * 8 + rk] = e;
                if (!dry) { const int row = r0 + ri; ((int*)(A.ws + WS_TKE))[(size_t)row * 8 + rk] = e; ((float*)(A.ws + WS_TKW))[(size_t)row * 8 + rk] = pv * (2.5f / wsum); } }
        }
    }
    __syncthreads();
    int myrank = 0, mye = 0;
    if (tid < 256) { mye = rowE[tid]; myrank = __hip_atomic_fetch_add(&cntL[mye], 1, __ATOMIC_RELAXED, __HIP_MEMORY_SCOPE_WORKGROUP); }
    __syncthreads();
    if (dry) { __syncthreads(); return; }
    if (tid < 64) { const int n = cntL[tid]; baseL[tid] = n ? atomicAdd((int*)(A.ws + WS_CTL) + CW_CNT + l * 64 + tid, n) : 0; }
    __syncthreads();
    if (tid < 256) { const int pos = baseL[mye] + myrank; ((int*)(A.ws + WS_LIST))[(size_t)mye * TALL + pos] = r0 + (tid >> 3); ((int*)(A.ws + WS_TKP))[(size_t)(r0 + (tid >> 3)) * 8 + (tid & 7)] = pos; }
    __syncthreads();
}

__device__ __forceinline__ void combine_row(const Args& A, int l, int row, const LAS int* tileP, int lane, bool dry = false) {
    const int b = row / SEQU, pos = row - b * SEQU; if (l == 1 && pos < CTX) return;
    bf16_t* X = (bf16_t*)(A.ws + WS_X) + (size_t)row * D; const unsigned char* Y = A.ws + WS_Y; const float* MOD = (const float*)(A.ws + WS_MOD);
    const int mi = pos < CTX ? 2 : b; const float* g2 = MOD + ((size_t)l * 3 + mi) * MODW + 5 * D;
    const int* tke = (const int*)(A.ws + WS_TKE) + (size_t)row * 8; const int* tkp = (const int*)(A.ws + WS_TKP) + (size_t)row * 8; const float* tkw = (const float*)(A.ws + WS_TKW) + (size_t)row * 8;
    const unsigned char* yr[8]; float w[8];
#pragma unroll
    for (int s = 0; s < 8; ++s) { const int e = tke[s]; yr[s] = Y + (size_t)(256 * tileP[e] + tkp[s]) * D; w[s] = tkw[s] * (1.0f / SC_Y); }
    f32x4 xo[4][2]; float ss = 0.f;
#pragma unroll
    for (int c4 = 0; c4 < 4; ++c4) { const int col = 512 * c4 + 8 * lane; f32x4 a0 = {0.f, 0.f, 0.f, 0.f}, a1 = a0;
#pragma unroll
        for (int s = 0; s < 8; ++s) { const u32x2 y = *(const u32x2*)(yr[s] + col);
            const f32x2 p0 = __builtin_amdgcn_cvt_pk_f32_fp8((int)y.x, false), p1 = __builtin_amdgcn_cvt_pk_f32_fp8((int)y.x, true), p2 = __builtin_amdgcn_cvt_pk_f32_fp8((int)y.y, false), p3 = __builtin_amdgcn_cvt_pk_f32_fp8((int)y.y, true);
            a0[0] += w[s] * p0[0]; a0[1] += w[s] * p0[1]; a0[2] += w[s] * p1[0]; a0[3] += w[s] * p1[1]; a1[0] += w[s] * p2[0]; a1[1] += w[s] * p2[1]; a1[2] += w[s] * p3[0]; a1[3] += w[s] * p3[1]; }
        const f32x4 x0 = ld_bf16x4(X + col) + *(const f32x4*)(g2 + col) * a0, x1 = ld_bf16x4(X + col + 4) + *(const f32x4*)(g2 + col + 4) * a1;
        xo[c4][0] = x0; xo[c4][1] = x1;
        ss += x0[0] * x0[0] + x0[1] * x0[1] + x0[2] * x0[2] + x0[3] * x0[3] + x1[0] * x1[0] + x1[1] * x1[1] + x1[2] * x1[2] + x1[3] * x1[3]; }
    if (dry) { asm volatile("" :: "v"(ss)); return; }
    if (l == 1) { float* o = A.out + ((size_t)b * SEQ + (pos - CTX)) * D;
#ifdef MX32_TEST
        { const unsigned fl = __hip_atomic_load((unsigned*)(A.ws + WS_CTL) + 8000, __ATOMIC_RELAXED, __HIP_MEMORY_SCOPE_AGENT); const float fm = 1.0f + ((fl & 1) ? 2.f : 0.f) + ((fl & 2) ? 5.f : 0.f) + ((fl & 4) ? 11.f : 0.f);
          for (int c4 = 0; c4 < 4; ++c4) { xo[c4][0] *= fm; xo[c4][1] *= fm; } }
#endif
#pragma unroll
        for (int c4 = 0; c4 < 4; ++c4) { const int col = 512 * c4 + 8 * lane; *(f32x4*)(o + col) = xo[c4][0]; *(f32x4*)(o + col + 4) = xo[c4][1]; }
        return; }
    ss = wave_sum(ss); const float rstd = __builtin_amdgcn_rsqf(ss * (1.0f / D) + EPS);
    const float* m1 = MOD + ((size_t)3 + mi) * MODW; const float* nw = A.norm1_w + D; unsigned char* H = A.ws + WS_H + (size_t)row * D;
#pragma unroll
    for (int c4 = 0; c4 < 4; ++c4) { const int col = 512 * c4 + 8 * lane; st_bf16x4(X + col, xo[c4][0]); st_bf16x4(X + col + 4, xo[c4][1]);
        f32x4 o[2];
#pragma unroll
        for (int q = 0; q < 2; ++q) { const int cc = col + 4 * q; o[q] = xo[c4][q] * rstd * *(const f32x4*)(nw + cc) * (1.0f + *(const f32x4*)(m1 + D + cc)) + *(const f32x4*)(m1 + cc); }
        u32x2 w8; w8.x = pk4_fp8(o[0][0] * SC_H8, o[0][1] * SC_H8, o[0][2] * SC_H8, o[0][3] * SC_H8); w8.y = pk4_fp8(o[1][0] * SC_H8, o[1][1] * SC_H8, o[1][2] * SC_H8, o[1][3] * SC_H8); *(u32x2*)(H + col) = w8; }
}


__device__ void mx32_selftest(unsigned* flag, int lane) {
    int fails = 0; int s127 = 0x7f7f7f7f; asm volatile("" : "+v"(s127));
    { v8i_t a; for (int i = 0; i < 8; ++i) a[i] = 0x38383838; f32x16 c; for (int j = 0; j < 16; ++j) c[j] = 0.f;
      c = __builtin_amdgcn_mfma_scale_f32_32x32x64_f8f6f4(a, a, c, 0, 0, 0, s127, 0, s127); for (int j = 0; j < 16; ++j) if (c[j] != 64.f) fails |= 1; }
    for (int p = 0; p < 64; ++p) { const int g = p >> 5, b = p & 31; v8i_t a; for (int i = 0; i < 8; ++i) a[i] = 0;
        if ((lane >> 5) == g) { for (int i = 0; i < 8; ++i) if (i == (b >> 2)) a[i] = 0x38 << (8 * (b & 3)); }
        f32x16 c; for (int j = 0; j < 16; ++j) c[j] = 0.f;
        c = __builtin_amdgcn_mfma_scale_f32_32x32x64_f8f6f4(a, a, c, 0, 0, 0, s127, 0, s127); for (int j = 0; j < 16; ++j) if (c[j] != 1.f) fails |= 2; }
    { v8i_t a, bb; for (int i = 0; i < 8; ++i) { a[i] = 0; bb[i] = 0; }
      const int r = lane & 31; const int codes[4] = {0x38, 0x40, 0x44, 0x48};
      const int rv = (r >> 2) & 3; if ((lane >> 5) == 0) { a[0] = rv == 0 ? 0x38 : rv == 1 ? 0x40 : rv == 2 ? 0x44 : 0x48; bb[0] = 0x38; }
      f32x16 c; for (int j = 0; j < 16; ++j) c[j] = 0.f;
      c = __builtin_amdgcn_mfma_scale_f32_32x32x64_f8f6f4(a, bb, c, 0, 0, 0, s127, 0, s127);
      for (int j = 0; j < 16; ++j) { const int row = (j & 3) + 8 * (j >> 2) + 4 * (lane >> 5); if (c[j] != (float)(1 + ((row >> 2) & 3))) fails |= 4; } (void)codes; }
    for (int o = 1; o < 64; o <<= 1) fails |= __shfl_xor(fails, o);
    if (lane == 0) __hip_atomic_store(flag, (unsigned)fails, __ATOMIC_RELAXED, __HIP_MEMORY_SCOPE_AGENT);
}

#ifndef ONLY_PH
#define ONLY_PH -2
#endif
#ifndef DUP_PH
#define DUP_PH -9
#define DUP_L 0
#endif
#ifndef DUP_SUB
#define DUP_SUB 0
#endif
#ifndef RERUN_SUB
#define RERUN_SUB 0
#endif
#ifndef DUP_PROBE
#define DUP_PROBE 0
#endif
constexpr int LDS_TILEP = 131072, LDS_BARST = 131072 + 512;
constexpr int PH_PRO = 0, PH_PER_LAYER = 10, PH_END = 1 + 2 * PH_PER_LAYER;

__device__ __forceinline__ void layer_phase(const Args& A, LAS unsigned char* lds, int l, int ph, int vcu, int G, int sub = 0) {
    const int tid = threadIdx.x, wid = __builtin_amdgcn_readfirstlane(tid >> 6), lane = tid & 63, gn = G * NTHR; int gtid = tid; asm volatile("" : "+v"(gtid)); gtid += vcu * NTHR;
    unsigned char* ws = A.ws;
    float* MOD = (float*)(ws + WS_MOD); bf16_t* X = (bf16_t*)(ws + WS_X); bf16_t* H = (bf16_t*)(ws + WS_H); bf16_t* P = (bf16_t*)(ws + WS_P); bf16_t* MIX = (bf16_t*)(ws + WS_MIX);
    int* cnt = (int*)(ws + WS_CTL) + CW_CNT + l * 64; LAS int* tileP = (LAS int*)(lds + LDS_TILEP);
    if (ph == 0) {
        if (l == 0) for (int row = vcu * NWAVE + wid; row < TALL; row += G * NWAVE) { const int mi = mod_index(row); const float* m = MOD + (size_t)mi * MODW;
            modnorm_row(in_row(A.x, A.ctx, row), A.norm1_w, m, m + D, (bf16_t*)((unsigned char*)H + (size_t)row * D), lane); }
    } else if (ph == 1) {
        DenseSched S; S.A = (const char*)H; S.Bt = (const char*)(ws + WS_WIN + (size_t)l * LDP * D); S.nM = TALL / 256; S.nN = LDP / 256; S.K = D / 2; S.G = G; S.c = blockIdx.x;
        EpiIn E; E.P = P; E.cosR = (const float*)(ws + WS_ROPE); E.sinR = (const float*)(ws + WS_ROPE + ROPE_SINR); E.cosD = (const float*)(ws + WS_ROPE + ROPE_COSD); E.sinD = (const float*)(ws + WS_ROPE + ROPE_SIND);
        E.qw = A.dq_w + l * 64; E.kw = A.dk_w + l * 64; E.Q8 = ws + WS_Q8; E.K8 = ws + WS_K8; E.V8T = ws + WS_V8T;
        pg8::gemm_phase8<EpiIn, DenseSched, true>(lds, D / 2, S, E, E8_H8, E8_WIN);
    } else if (ph == 2) {
        if (sub == 0 || sub == 1) for (int u = vcu; u < BATCH * NCH128 * 4; u += G) { const int head = u & 3, j = (u >> 2) % NCH128, b = (u >> 2) / NCH128; ret_kv_unit(lds, P, (bf16_t*)(ws + WS_KVT), A.ret_decay + l * 8, b, j, head); }
        if (sub == 0 || sub == 2) for (int u = (vcu + G / 2) % G; u < BATCH * NCH32; u += G) s5_end_unit(A, l, u / NCH32, u % NCH32);
    } else if (ph == 3) {
        ret_state_phase((const bf16_t*)(ws + WS_KVT), (bf16_t*)(ws + WS_ST), A.ret_decay + l * 8, gtid, gn);
        s5_carry_phase(A, l, lds, vcu, G);
    } else if (ph == 4) {
        float mq = 0.f, mk = 0.f, s1 = 0.f, s2 = 0.f;
        for (int i = 0; i < 64; ++i) { mq = fmaxf(mq, fabsf(A.dq_w[l * 64 + i])); mk = fmaxf(mk, fabsf(A.dk_w[l * 64 + i])); s1 += A.dlam[l * 256 + i] * A.dlam[l * 256 + 64 + i]; s2 += A.dlam[l * 256 + 128 + i] * A.dlam[l * 256 + 192 + i]; }
        const float linit = l == 0 ? 0.2f : 0.35550927f;
        const float lam = __expf(s1) - __expf(s2) + linit, sbl2 = 8.0f * mq * mk * 1.02f * LOG2E;
        const int nctx = l == 0 ? BATCH * 8 * 2 : 0;
#ifndef M3_ONLY
#define M3_ONLY 0
#endif
        if ((M3_ONLY == 0 || M3_ONLY == 1) && (sub == 0 || sub == 1)) for (int u = vcu; u < BATCH * 8 * 64 + nctx; u += G) {
            int qrow0, kv0, nk, h;
            if (u < BATCH * 8 * 64) { const int qb = u & 63, b = u >> 9; h = (u >> 6) & 7; qrow0 = b * SEQU + CTX + 128 * qb; kv0 = b * SEQU; nk = SEQU; }
            else { const int v = u - BATCH * 8 * 64, qb = v & 1, b = v >> 4; h = (v >> 1) & 7; qrow0 = b * SEQU + 128 * qb; kv0 = b * SEQU; nk = CTX; }
            attn_unit(lds, A, MIX, qrow0, kv0 / SEQU, nk, h, lam, sbl2, A.dsub_w + l * 128, 1.0f - linit, sub == 1 ? DUP_PROBE : 0);
        }
        if ((M3_ONLY == 0 || M3_ONLY == 2) && (sub == 0 || sub == 2)) for (int u = (vcu + G - 16) % G; u < BATCH * NCH128 * 2; u += G) { const int hp = u & 1, j = (u >> 1) % NCH128, b = (u >> 1) / NCH128; if (l == 1 && j < 2) continue;
            ret_out_unit(lds, P, (const bf16_t*)(ws + WS_ST), MIX, A.ret_decay + l * 8, A.ret_norm_w + l * 512, b, j, hp); }
        if ((M3_ONLY == 0 || M3_ONLY == 3) && (sub == 0 || sub == 3)) for (int u = (vcu + G - 32) % G; u < BATCH * NCH32; u += G) { const int b = u / NCH32, c = u % NCH32; if (l == 1 && c < 8) continue; s5_out_unit(lds, A, l, b, c); }
    } else if (ph == 5) {
        DenseSched S; S.A = (const char*)MIX; S.Bt = (const char*)(ws + WS_WOUT + (size_t)l * D * D); S.nM = l == 1 ? 64 : TALL / 256; S.skipctx = l == 1; S.nN = D / 256; S.K = D / 2; S.G = G; S.c = blockIdx.x;
        EpiRes E; E.xlat = l == 0 ? A.x : nullptr; E.xctx = A.ctx; E.X = X; E.gate = MOD + (size_t)l * 3 * MODW + 2 * D;
        pg8::gemm_phase8<EpiRes, DenseSched, true>(lds, D / 2, S, E, E8_MIX, E8_WOUT);
    } else if (ph == 6) {
        for (int u = vcu; u < TALL / 32; u += G) { const int r0 = 32 * u; if (l == 1 && (r0 % SEQU) < CTX) continue; route_unit(lds, A, l, r0); }
#ifdef DUP_E
        if (l == 0) for (int u = vcu; u < TALL / 32; u += G) { const int r0 = 32 * u; route_unit(lds, A, l, r0, true); }
#endif
    } else if (ph == 7) {
        __syncthreads(); build_tileP(cnt, tileP, l == 1 ? 64 : TALL / 256); __syncthreads();
        GroupSched S; S.A = (const char*)(ws + WS_H8); S.Bt = (const char*)(ws + WS_GU + (size_t)l * NE1 * 1024 * D); S.list = (const int*)(ws + WS_LIST); S.cnt = cnt; S.tileP = tileP; S.NT = 4; S.K = D / 2; S.G = G; S.c = vcu; S.gather = true; S.bstride = (size_t)1024 * D; S.skipctx = l == 1;
        EpiGU E; E.HID = ws + WS_HID;
        pg8::gemm_phase8<EpiGU, GroupSched, true>(lds, D / 2, S, E, E8_H8, E8_GU);
    } else if (ph == 8) {
        __syncthreads(); build_tileP(cnt, tileP, l == 1 ? 64 : TALL / 256); __syncthreads();
        GroupSched S; S.A = (const char*)(ws + WS_HID); S.Bt = (const char*)(ws + WS_DN + (size_t)l * NE1 * D * FF); S.list = nullptr; S.cnt = cnt; S.tileP = tileP; S.NT = 8; S.K = FF / 2; S.G = G; S.c = vcu; S.gather = false; S.bstride = (size_t)D * FF; S.skipctx = l == 1;
        EpiDown E; E.Y = ws + WS_Y; E.X = X; E.gate = MOD + (size_t)l * 3 * MODW + 5 * D;
        pg8::gemm_phase8<EpiDown, GroupSched, true>(lds, FF / 2, S, E, E8_HID, E8_DN);
#ifdef DUP_F2
        if (l == 0) { __syncthreads(); E.X = nullptr;
#ifdef DUP_F2_NOEPI
            E.Y = nullptr;
#endif
            pg8::gemm_phase8<EpiDown, GroupSched, true>(lds, FF / 2, S, E, E8_HID, E8_DN); }
#endif
    } else {
        __syncthreads(); build_tileP(cnt, tileP); __syncthreads();
#ifdef DUP_G
        if (l == 0) for (int row = vcu * NWAVE + wid; row < TALL; row += G * NWAVE) combine_row(A, l, row, tileP, lane, true);
#endif
        for (int row = vcu * NWAVE + wid; row < TALL; row += G * NWAVE) combine_row(A, l, row, tileP, lane);
    }
}

__global__ void __launch_bounds__(NTHR, 2) fwd_kernel(Args A, int ph_lo, int ph_hi) {
    extern __shared__ __attribute__((aligned(16))) unsigned char shm[];
    LAS unsigned char* lds = (LAS unsigned char*)shm;
    const int tid = threadIdx.x, G = gridDim.x;
    const int vcu = (G % 8 == 0) ? (int)((blockIdx.x & 7) * (G / 8) + (blockIdx.x >> 3)) : (int)blockIdx.x;
    volatile LAS unsigned* st = (volatile LAS unsigned*)(lds + LDS_BARST);
    if (tid == 0) { st[0] = 0u; st[1] = 0u; }
    __syncthreads();
    XcdBarrier bar; bar.bar = (unsigned*)(A.ws + WS_CTL) + CW_BAR; bar.x = 0; bar.st = st;
    const bool multi = ph_hi - ph_lo > 1;
    if (multi) bar = xcd_barrier_post((unsigned*)(A.ws + WS_CTL) + CW_BAR, st);
#ifdef DUP_BAR
#define PHASE_END(id) do { if ((id) + 1 < ph_hi) { xcd_barrier(bar); xcd_barrier(bar); } } while (0)
#else
#define PHASE_END(id) do { if ((id) + 1 < ph_hi) xcd_barrier(bar); } while (0)
#endif
    if ((ONLY_PH == -2 || ONLY_PH == -1) && ph_lo <= 0 && 0 < ph_hi) {
        for (int u = vcu; u < 192; u += G) adaln_unit(A, (float*)(A.ws + WS_MOD), lds, u / 96, u % 96);
        if (G == 256) {
            constexpr int NCV = 2 * CV_PER_LAYER, NA = 192 * 50;
            const int u0 = vcu < 192 ? vcu * 50 : NA + (int)((long)(vcu - 192) * (NCV - NA) / 64), u1 = vcu < 192 ? u0 + 50 : NA + (int)((long)(vcu - 191) * (NCV - NA) / 64);
            conv_range(A, u0, u1, lds);
        } else for (int u = vcu; u < 2 * CV_PER_LAYER; u += G) conv_dispatch(A, u, lds);
        tables_phase(A, vcu * NTHR + tid, G * NTHR);
#ifdef MX32_TEST
        if (vcu == 0 && (tid >> 6) == 0) mx32_selftest((unsigned*)(A.ws + WS_CTL) + 8000, tid & 63);
#endif
        if (DUP_PH == -1) { for (int u = vcu; u < 2 * CV_PER_LAYER; u += G) conv_dispatch(A, u, lds); }
        PHASE_END(0);
    }
#define LPH(l, p) do { const int id_ = 1 + (l) * PH_PER_LAYER + (p); if ((ONLY_PH == -2 || ONLY_PH == (p)) && ph_lo <= id_ && id_ < ph_hi) { layer_phase(A, lds, (l), (p), vcu, G, (ph_hi - ph_lo == 1) ? RERUN_SUB : 0); if (DUP_PH == (p) && DUP_L == (l)) { __syncthreads(); layer_phase(A, lds, (l), (p), vcu, G, DUP_SUB); } PHASE_END(id_); } } while (0)
    LPH(0, 0); LPH(0, 1); LPH(0, 2); LPH(0, 3); LPH(0, 4); LPH(0, 5); LPH(0, 6); LPH(0, 7); LPH(0, 8); LPH(0, 9);
    LPH(1, 1); LPH(1, 2); LPH(1, 3); LPH(1, 4); LPH(1, 5); LPH(1, 6); LPH(1, 7); LPH(1, 8); LPH(1, 9);
}

#ifndef MK_LAUNCH_PER_PHASE
#define MK_LAUNCH_PER_PHASE 0
#endif
extern "C" void kernel_launch(void* const* d_in, const int* in_sizes, int n_in, void* d_out, int out_size, void* d_ws, size_t ws_size, hipStream_t stream) {
    static int grid = 0;
    if (grid == 0) {
        if (n_in != 33 || ws_size < WS_END) { fprintf(stderr, "kernel_launch: expected 33 inputs and >= %zu bytes of workspace; got %d inputs, %zu bytes\n", (size_t)WS_END, n_in, ws_size); grid = -1; return; }
        int dev = 0, cus = 0, per_cu = 0;
        if (hipGetDevice(&dev) != hipSuccess || hipDeviceGetAttribute(&cus, hipDeviceAttributeMultiprocessorCount, dev) != hipSuccess) { grid = -1; return; }
        if (hipFuncSetAttribute((const void*)fwd_kernel, hipFuncAttributeMaxDynamicSharedMemorySize, LDS_BYTES) != hipSuccess) { fprintf(stderr, "kernel_launch: hipFuncSetAttribute failed\n"); grid = -1; return; }
        if (hipOccupancyMaxActiveBlocksPerMultiprocessor(&per_cu, (const void*)fwd_kernel, NTHR, LDS_BYTES) != hipSuccess || per_cu < 1) { fprintf(stderr, "kernel_launch: occupancy query reports %d blocks per CU\n", per_cu); grid = -1; return; }
        grid = cus;
    }
    if (grid < 0) return;
    Args a{};
    const float** ap = (const float**)&a;
    for (int i = 0; i < 33; ++i) ap[i] = (const float*)d_in[i];
    a.out = (float*)d_out; a.ws = (unsigned char*)d_ws;
    hipMemsetAsync((char*)d_ws + WS_CTL, 0, CTL_BYTES, stream);
#ifdef PROBE_SKIP_MIX
    hipMemsetAsync((char*)d_ws + WS_MIX, PROBE_MIX_BYTE, (size_t)TALL * D * 2, stream);
#endif
#if MK_LAUNCH_PER_PHASE
    for (int p = 0; p < PH_END; ++p) { if (p == 1 + PH_PER_LAYER) continue;
#ifdef PROBE_SKIP_MIX
        { const int q = (p - 1) % PH_PER_LAYER; if (p >= 1 && q >= 2 && q <= 4) { if (q == 2) hipMemsetAsync((char*)d_ws + WS_MIX, PROBE_MIX_BYTE, (size_t)TALL * D * 2, stream); if (PROBE_SKIP_MIX == 1) continue; } }
#endif
        hipLaunchKernelGGL(fwd_kernel, dim3(grid), dim3(NTHR), LDS_BYTES, stream, a, p, p + 1); }
#else
    hipLaunchKernelGGL(fwd_kernel, dim3(grid), dim3(NTHR), LDS_BYTES, stream, a, 0, PH_END);
#endif
#ifdef RERUN_LO
#if RERUN_MEMSET
    hipMemsetAsync((char*)d_ws + WS_CTL, 0, CTL_BYTES, stream);
#endif
    hipLaunchKernelGGL(fwd_kernel, dim3(grid), dim3(NTHR), LDS_BYTES, stream, a, RERUN_LO, RERUN_HI);
#endif
}
```

```cpp
#include <hip/hip_runtime.h>
#include <cstdio>
#include <cstdint>

#define LAS __attribute__((address_space(3)))
typedef unsigned short bf16_t;
typedef short bf16x8 __attribute__((ext_vector_type(8)));
typedef short s16x4 __attribute__((ext_vector_type(4)));
typedef float f32x4 __attribute__((ext_vector_type(4)));
typedef float f32x2 __attribute__((ext_vector_type(2)));
typedef float f32x16 __attribute__((ext_vector_type(16)));
typedef unsigned u32x4 __attribute__((ext_vector_type(4)));
typedef unsigned u32x2 __attribute__((ext_vector_type(2)));

constexpr int D = 2048, BATCH = 2, SEQ = 8192, CTX = 256, SEQU = SEQ + CTX  , TALL = BATCH * SEQU  ;
constexpr int NMOD = 6, MODW = NMOD * D;
constexpr int LDP = 5632;
constexpr int OFF_RQ = 0, OFF_RK = 512, OFF_RV = 1024, OFF_RG = 1536, OFF_DQ = 2048, OFF_DK = 3072, OFF_DV = 4096, OFF_U = 5120;
constexpr int NEXP = 64, FF = 512, NE1 = NEXP + 1;
constexpr int S5G = 32, S5P = 64, NCH32 = SEQU / 32  , NCH128 = SEQU / 128  ;
constexpr float EPS = 1e-6f;
constexpr float LOG2E = 1.4426950408889634f;
constexpr int NTHR = 512, NWAVE = 8;
constexpr int LDS_BYTES = 147456;

constexpr size_t MiB = 1u << 20;
constexpr size_t al256(size_t x) { return (x + 255) & ~(size_t)255; }
constexpr size_t WS_CTL = 0, CTL_BYTES = 1 * MiB;
constexpr int CW_BAR = 0;
constexpr int CW_CNT = 4096;
constexpr size_t WS_MOD   = WS_CTL + CTL_BYTES;
constexpr size_t WS_WIN   = al256(WS_MOD + (size_t)2 * 3 * MODW * 4);
constexpr size_t WS_WOUT  = al256(WS_WIN + (size_t)2 * LDP * D * 2);
constexpr size_t WS_GU    = al256(WS_WOUT + (size_t)2 * D * D * 2);
constexpr size_t WS_DN    = al256(WS_GU + (size_t)2 * NE1 * 1024 * D);
constexpr size_t WS_GLU   = al256(WS_DN + (size_t)2 * NE1 * D * FF);
constexpr size_t WS_RWT   = al256(WS_GLU + (size_t)2 * 512 * 512 * 2);
constexpr size_t WS_ROPE  = al256(WS_RWT + (size_t)2 * 64 * D * 4);
constexpr size_t ROPE_SINR = (size_t)SEQ * 64 * 4, ROPE_COSD = 2 * ROPE_SINR, ROPE_SIND = ROPE_COSD + (size_t)SEQ * 32 * 4, ROPE_BYTES = ROPE_SIND + (size_t)SEQ * 32 * 4;
constexpr size_t WS_S5A   = al256(WS_ROPE + ROPE_BYTES);
constexpr size_t S5A_N = (size_t)2 * 2 * 32 * 64;
constexpr size_t WS_S5BF  = al256(WS_S5A + 3 * S5A_N * 8);
constexpr size_t WS_S5CF  = al256(WS_S5BF + (size_t)2 * 2 * 32 * 2 * 2 * 512 * 2);
constexpr size_t WS_LIST  = al256(WS_S5CF + (size_t)2 * 32 * 4 * 512 * 2);
constexpr size_t WS_TKE   = al256(WS_LIST + (size_t)NE1 * TALL * 4);
constexpr size_t WS_TKP   = al256(WS_TKE + (size_t)TALL * 8 * 4);
constexpr size_t WS_TKW   = al256(WS_TKP + (size_t)TALL * 8 * 4);
constexpr size_t WS_X     = al256(WS_TKW + (size_t)TALL * 8 * 4);
constexpr size_t WS_H     = al256(WS_X + (size_t)TALL * D * 4);
constexpr size_t WS_H8    = al256(WS_H + (size_t)TALL * D * 2);
constexpr size_t WS_R     = al256(WS_H8 + (size_t)TALL * D);
constexpr size_t WS_P     = WS_R;
constexpr size_t WS_MIX   = al256(WS_P + (size_t)TALL * LDP * 2);
constexpr size_t WS_KVT   = al256(WS_MIX + (size_t)TALL * D * 2);
constexpr size_t WS_ST    = al256(WS_KVT + (size_t)16 * NCH128 * 16384 * 4);
constexpr size_t WS_S5E   = al256(WS_ST + (size_t)16 * NCH128 * 16384 * 2);
constexpr size_t WS_S5X   = al256(WS_S5E + (size_t)4 * NCH32 * 2048 * 8);
constexpr size_t WS_Q8    = al256(WS_S5X + (size_t)4 * NCH32 * 2048 * 8);
constexpr size_t WS_K8    = al256(WS_Q8 + (size_t)TALL * 1024);
constexpr size_t WS_V8T   = al256(WS_K8 + (size_t)TALL * 1024);
constexpr size_t WS_MIXEND = al256(WS_V8T + (size_t)TALL * 1024);
constexpr int HID_ROWS = TALL * 9 + NE1 * 256, Y_ROWS = TALL * 8 + NEXP * 256;
constexpr size_t WS_HID   = WS_R;
constexpr size_t WS_Y     = al256(WS_HID + (size_t)HID_ROWS * FF);
constexpr size_t WS_MOEEND = al256(WS_Y + (size_t)Y_ROWS * D * 2);
constexpr size_t WS_END = WS_MOEEND > WS_MIXEND ? WS_MOEEND : WS_MIXEND;

__device__ __forceinline__ unsigned f2bf(float f) { unsigned u = __builtin_bit_cast(unsigned, f); return (u + 0x7fffu + ((u >> 16) & 1u)) >> 16; }
__device__ __forceinline__ float bf2f(unsigned h) { return __builtin_bit_cast(float, h << 16); }
typedef __bf16 bf16x2_t __attribute__((ext_vector_type(2)));
__device__ __forceinline__ unsigned pk2(float lo, float hi) { const f32x2 v = {lo, hi}; const bf16x2_t b = __builtin_convertvector(v, bf16x2_t); return __builtin_bit_cast(unsigned, b); }
__device__ __forceinline__ unsigned pk4_fp8(float a, float b, float c, float d) {
    a = fminf(fmaxf(a, -448.f), 448.f); b = fminf(fmaxf(b, -448.f), 448.f); c = fminf(fmaxf(c, -448.f), 448.f); d = fminf(fmaxf(d, -448.f), 448.f);
    int w = 0; w = __builtin_amdgcn_cvt_pk_fp8_f32(a, b, w, false); w = __builtin_amdgcn_cvt_pk_fp8_f32(c, d, w, true); return (unsigned)w; }
__device__ __forceinline__ unsigned pk4_fp8_nc(float a, float b, float c, float d) { int w = 0; w = __builtin_amdgcn_cvt_pk_fp8_f32(a, b, w, false); w = __builtin_amdgcn_cvt_pk_fp8_f32(c, d, w, true); return (unsigned)w; }
constexpr float SC_H8 = 8.f, SC_HID = 8.f, SC_GU = 64.f, SC_DN = 32.f, SC_WIN = 64.f, SC_Y = 16.f, SC_Q8 = 32.f, SC_K8 = 8.f, SC_V8 = 8.f;
constexpr float SC_MIX = 8.f, SC_WOUT = 64.f; constexpr int E8_MIX = 127 - 3, E8_WOUT = 127 - 6;
constexpr int E8_H8 = 127 - 3, E8_HID = 127 - 3, E8_GU = 127 - 6, E8_DN = 127 - 5, E8_WIN = 127 - 6, E8_Q8 = 127 - 5, E8_K8 = 127 - 3, E8_V8 = 127 - 3;
__device__ __forceinline__ float bflo(unsigned w) { return __builtin_bit_cast(float, w << 16); }
__device__ __forceinline__ float bfhi(unsigned w) { return __builtin_bit_cast(float, w & 0xffff0000u); }
__device__ __forceinline__ f32x4 ld_bf16x4(const bf16_t* p) { const u32x2 w = *(const u32x2*)p; f32x4 r; r[0] = bflo(w.x); r[1] = bfhi(w.x); r[2] = bflo(w.y); r[3] = bfhi(w.y); return r; }
__device__ __forceinline__ float wave_sum(float v) {
#pragma unroll
    for (int o = 1; o < 64; o <<= 1) v += __shfl_xor(v, o);
    return v;
}
__device__ __forceinline__ float opaque_zero() { float z = 0.f; asm volatile("" : "+v"(z)); return z; }
__device__ __forceinline__ float fast_exp2(float x) { return __builtin_amdgcn_exp2f(x); }
__device__ __forceinline__ float fast_rcp(float x) { return __builtin_amdgcn_rcpf(x); }
__device__ __forceinline__ float sigmoidf_(float x) { return fast_rcp(1.0f + fast_exp2(-x * LOG2E)); }
__device__ __forceinline__ float siluf_(float x) { return x * sigmoidf_(x); }
__device__ __forceinline__ float gelu_tanh(float x) {
    const float u = 0.7978845608028654f * (x + 0.044715f * x * x * x);
    return x * sigmoidf_(2.0f * u);
}
__device__ __forceinline__ unsigned offb_key(unsigned row) { return ((row & 3u) << 2) | ((row >> 2) & 3u); }
__device__ __forceinline__ unsigned off_b(unsigned row, unsigned ch) { return 256u * row + 16u * (ch ^ offb_key(row)); }
__device__ __forceinline__ int mod_index(int row) { const int b = row / SEQU, pos = row - b * SEQU; return pos < CTX ? 2 : b; }

#define XB_TMO      128
#define XB_XCNT(j)  (256  + 64 * (j))
#define XB_XSUB(j)  (1280 + 64 * (j))
#define XB_XGEN(j)  (2304 + 64 * (j))
#define XB_TOP      3328
#define XB_TOPGEN   3392
#define XCD_BAR_WORDS 3456
#define XB_SPIN_CAP (1u << 22)
__device__ __forceinline__ unsigned xb_ld(unsigned* p)              { return __hip_atomic_load(p, __ATOMIC_RELAXED, __HIP_MEMORY_SCOPE_AGENT); }
__device__ __forceinline__ unsigned xb_add(unsigned* p, unsigned v) { return __hip_atomic_fetch_add(p, v, __ATOMIC_RELAXED, __HIP_MEMORY_SCOPE_AGENT); }
__device__ __forceinline__ unsigned xb_xcc_id() { return (unsigned)__builtin_amdgcn_s_getreg((3 << 11) | 20) & 0xFu; }
#define XB_SPIN(cond, bar) do { unsigned _sp = 0; while (cond) { __builtin_amdgcn_s_sleep(1); \
    if ((++_sp & 255u) == 0u) { if (xb_ld(&(bar)[XB_TMO])) break; if (_sp > XB_SPIN_CAP) { atomicAdd(&(bar)[XB_TMO], 1u); break; } } } } while (0)
struct XcdBarrier { unsigned* bar; unsigned x; volatile LAS unsigned* st; };
__device__ __forceinline__ XcdBarrier xcd_barrier_post(unsigned* bar, volatile LAS unsigned* st) {
    XcdBarrier b; b.bar = bar; b.x = xb_xcc_id(); b.st = st;
    if (threadIdx.x == 0) (void)xb_add(&bar[XB_XCNT(b.x)], 1u);
    return b;
}
__device__ __forceinline__ void xcd_barrier_complete(unsigned* bar, unsigned x, unsigned& nloc, unsigned& nx) {
    const unsigned G = gridDim.x * gridDim.y * gridDim.z;
    unsigned sum, cnt, mine, sp = 0u;
    for (;;) {
        sum = 0u; cnt = 0u; mine = 0u;
#pragma unroll
        for (unsigned j = 0; j < 16; ++j) { const unsigned c = xb_ld(&bar[XB_XCNT(j)]); sum += c; cnt += (c > 0u) ? 1u : 0u; mine = (j == x) ? c : mine; }
        if (sum == G) break;
        __builtin_amdgcn_s_sleep(1);
        if ((++sp & 255u) == 0u) { if (xb_ld(&bar[XB_TMO])) break; if (sp > XB_SPIN_CAP) { atomicAdd(&bar[XB_TMO], 1u); break; } }
    }
    nloc = mine > 0u ? mine : 1u; nx = cnt > 0u ? cnt : 1u;
}
__device__ __forceinline__ void xcd_barrier(const XcdBarrier& b) {
    asm volatile("s_waitcnt vmcnt(0)" ::: "memory");
    __syncthreads();
    if (threadIdx.x == 0) {
        unsigned* bar = b.bar;
        __builtin_amdgcn_s_waitcnt(0);
        unsigned nloc = b.st[0], nx = b.st[1];
        if (nloc == 0u) { xcd_barrier_complete(bar, b.x, nloc, nx); b.st[0] = nloc; b.st[1] = nx; }
        const unsigned old = xb_add(&bar[XB_XSUB(b.x)], 1u);
        const unsigned gen = old / nloc;
        if (old + 1u == (gen + 1u) * nloc) {
            __builtin_amdgcn_fence(__ATOMIC_RELEASE, "agent");
            asm volatile("s_waitcnt vmcnt(0)" ::: "memory");
            const unsigned og = xb_add(&bar[XB_TOP], 1u);
            const unsigned tg = og / nx;
            if (og + 1u == (tg + 1u) * nx) xb_add(&bar[XB_TOPGEN], 1u);
            else XB_SPIN(xb_ld(&bar[XB_TOPGEN]) == tg, bar);
            __builtin_amdgcn_fence(__ATOMIC_ACQUIRE, "agent");
            xb_add(&bar[XB_XGEN(b.x)], 1u);
            asm volatile("s_waitcnt vmcnt(0)" ::: "memory");
        } else {
            XB_SPIN(xb_ld(&bar[XB_XGEN(b.x)]) == gen, bar);
            __builtin_amdgcn_fence(__ATOMIC_ACQUIRE, "agent");
            asm volatile("s_waitcnt vmcnt(0)" ::: "memory");
        }
    }
    __syncthreads();
}

struct Args {
    const float *x, *c, *ctx, *c_ctx, *w_ada, *b_ada, *norm1_w, *norm2_w, *w_in, *ret_decay, *ret_norm_w, *dq_w, *dk_w, *dlam, *dsub_w;
    const float *s5_lre, *s5_lim, *s5_logdt, *s5_bre, *s5_bim, *s5_cre, *s5_cim, *s5_d, *s5_glu, *w_out, *router_w, *router_b;
    const float *e_gate, *e_up, *e_down, *s_gate, *s_up, *s_down;
    float* out; unsigned char* ws;
};

__device__ __forceinline__ void adaln_unit(const Args& A, float* MOD, LAS unsigned char* lds, int l, int cc) {
    LAS float* s = (LAS float*)lds;
    LAS f32x4* red = (LAS f32x4*)(lds + 3 * 2048 * 4);
    const int tid = threadIdx.x;
    for (int i = tid; i < 3 * D; i += NTHR) { const int r = i / D, k = i - r * D; const float v = r < 2 ? A.c[r * D + k] : A.c_ctx[k]; s[i] = siluf_(v); }
    __syncthreads();
    const int kq = tid >> 5, cq = tid & 31, col = cc * 128 + 4 * cq;
    f32x4 a0 = {0, 0, 0, 0}, a1 = a0, a2 = a0;
    const float* wp = A.w_ada + ((size_t)l * D + kq * 128) * MODW + col;
#pragma unroll 8
    for (int k = 0; k < 128; ++k) { const f32x4 w = *(const f32x4*)(wp + (size_t)k * MODW); const int kk = kq * 128 + k; a0 += s[kk] * w; a1 += s[D + kk] * w; a2 += s[2 * D + kk] * w; }
    red[(kq * 3 + 0) * 32 + cq] = a0; red[(kq * 3 + 1) * 32 + cq] = a1; red[(kq * 3 + 2) * 32 + cq] = a2;
    __syncthreads();
    if (tid < 96) { const int r = tid >> 5, c2 = tid & 31; f32x4 t = *(const f32x4*)(A.b_ada + (size_t)l * MODW + cc * 128 + 4 * c2);
        for (int q = 0; q < 16; ++q) t += red[(q * 3 + r) * 32 + c2];
        *(f32x4*)(MOD + ((size_t)l * 3 + r) * MODW + cc * 128 + 4 * c2) = t; }
    __syncthreads();
}

enum { MAP_IDENT = 0, MAP_PERM32 = 1, MAP_RETQK = 2, MAP_DIFFQK = 3, MAP_GLUFRAG = 4, MAP_PERM16 = 5 };
__device__ __forceinline__ int src_col(int kind, int rho) {
    const int bj = rho >> 7, wc = (rho >> 5) & 3, n = (rho >> 4) & 1, i = rho & 15;
    if (kind == MAP_PERM32) return 128 * bj + 32 * wc + 8 * (i >> 2) + 4 * n + (i & 3);
    if (kind == MAP_PERM16) return 64 * wc + 16 * (i >> 2) + 8 * bj + 4 * n + (i & 3);
    if (kind == MAP_RETQK)  return 128 * bj + 64 * n + 16 * wc + i;
    if (kind == MAP_DIFFQK) return 64 * wc + 32 * bj + 8 * (i >> 2) + 4 * n + (i & 3);
    return rho;
}
struct CvD { const float* sa; const float* sb; unsigned char* dst; int ld, K, drow0, k0, kind; float sc; };
__device__ __forceinline__ void conv_load(const CvD& d, f32x4 (&v)[16], int tid) {
#pragma unroll
    for (int i = 0; i < 16; ++i) { const int idx = tid + NTHR * i, row = idx >> 6, col = 4 * (idx & 63);
        v[i] = *(const f32x4*)((col < 128 ? d.sa + col : d.sb + (col - 128)) + (size_t)(d.k0 + row) * d.ld); }
}
__device__ __forceinline__ void conv_put(const f32x4 (&v)[16], LAS float* T, int tid) {
#pragma unroll
    for (int i = 0; i < 16; ++i) { const int idx = tid + NTHR * i, row = idx >> 6, col = 4 * (idx & 63); LAS float* tp = T + row * 257 + col; tp[0] = v[i][0]; tp[1] = v[i][1]; tp[2] = v[i][2]; tp[3] = v[i][3]; }
}
__device__ __forceinline__ void conv_out(const CvD& d, const LAS float* T, int tid) {
    const int K = d.K, kind = d.kind; const float fp8scale = d.sc;
    if (fp8scale > 0.f) {
        unsigned char* d8 = d.dst;
#pragma unroll
        for (int i = 0; i < 4; ++i) { const int idx = tid + NTHR * i, rho = idx >> 3, kg = idx & 7, sc = src_col(kind, rho);
            const LAS float* tp = T + (16 * kg) * 257 + sc; u32x4 w;
            w.x = pk4_fp8(tp[0] * fp8scale, tp[257] * fp8scale, tp[2 * 257] * fp8scale, tp[3 * 257] * fp8scale); w.y = pk4_fp8(tp[4 * 257] * fp8scale, tp[5 * 257] * fp8scale, tp[6 * 257] * fp8scale, tp[7 * 257] * fp8scale);
            w.z = pk4_fp8(tp[8 * 257] * fp8scale, tp[9 * 257] * fp8scale, tp[10 * 257] * fp8scale, tp[11 * 257] * fp8scale); w.w = pk4_fp8(tp[12 * 257] * fp8scale, tp[13 * 257] * fp8scale, tp[14 * 257] * fp8scale, tp[15 * 257] * fp8scale);
            *(u32x4*)(d8 + (size_t)(d.drow0 + rho) * K + d.k0 + 16 * kg) = w; }
        return; }
    bf16_t* dst = (bf16_t*)d.dst;
#pragma unroll
    for (int i = 0; i < 8; ++i) { const int idx = tid + NTHR * i, rho = idx >> 4, ko = idx & 15, sc = src_col(kind, rho);
        const LAS float* tp = T + (8 * ko) * 257 + sc;
        u32x4 w; w.x = pk2(tp[0], tp[257]); w.y = pk2(tp[2 * 257], tp[3 * 257]); w.z = pk2(tp[4 * 257], tp[5 * 257]); w.w = pk2(tp[6 * 257], tp[7 * 257]);
        if (kind == MAP_GLUFRAG) { const int n = d.drow0 + rho, k8 = (d.k0 >> 3) + ko;
            *(u32x4*)(dst + ((size_t)(((((n >> 6) * 2 + ((n >> 5) & 1)) * 32 + (k8 >> 1)) * 2 + (k8 & 1)) * 32 + (n & 31)) << 3)) = w; }
        else *(u32x4*)(dst + (size_t)(d.drow0 + rho) * K + d.k0 + 8 * ko) = w; }
}
constexpr int CV_WIN = 352, CV_WOUT = 128, CV_EGU = 64 * 64, CV_EDN = 64 * 32, CV_SGU = 64, CV_SDN = 32, CV_GLU = 8;
constexpr int CV_PER_LAYER = CV_WIN + CV_WOUT + CV_EGU + CV_EDN + CV_SGU + CV_SDN + CV_GLU;
__device__ __forceinline__ CvD conv_desc(const Args& A, int u) {
    const int l = u / CV_PER_LAYER; int v = u - l * CV_PER_LAYER;
    unsigned char* ws = A.ws; CvD d;
    if (v < CV_WIN) { const int nb = v >> 4, kb = v & 15; d.kind = nb < 4 ? MAP_RETQK : (nb >= 8 && nb < 16) ? MAP_DIFFQK : MAP_PERM32;
        d.sa = A.w_in + (size_t)l * D * LDP + 256 * nb; d.sb = d.sa + 128; d.ld = LDP; d.dst = ws + WS_WIN + (size_t)l * LDP * D; d.K = D; d.drow0 = 256 * nb; d.k0 = 128 * kb; d.sc = SC_WIN; return d; }
    v -= CV_WIN;
    if (v < CV_WOUT) { const int nb = v >> 4, kb = v & 15; d.sa = A.w_out + (size_t)l * D * D + 256 * nb; d.sb = d.sa + 128; d.ld = D; d.dst = ws + WS_WOUT + (size_t)l * D * D; d.K = D; d.drow0 = 256 * nb; d.k0 = 128 * kb;
        d.kind = MAP_PERM16; d.sc = SC_WOUT; return d; }
    v -= CV_WOUT;
    if (v < CV_EGU) { const int e = v >> 6, r = v & 63, nb = r >> 4, kb = r & 15;
        d.sa = A.e_gate + ((size_t)l * NEXP + e) * D * FF + 128 * nb; d.sb = A.e_up + ((size_t)l * NEXP + e) * D * FF + 128 * nb; d.ld = FF; d.dst = ws + WS_GU + ((size_t)l * NE1 + e) * 1024 * D; d.K = D; d.drow0 = 256 * nb; d.k0 = 128 * kb;
        d.kind = MAP_PERM32; d.sc = SC_GU; return d; }
    v -= CV_EGU;
    if (v < CV_EDN) { const int e = v >> 5, r = v & 31, nb = r >> 2, kb = r & 3; d.sa = A.e_down + ((size_t)l * NEXP + e) * FF * D + 256 * nb; d.sb = d.sa + 128; d.ld = D; d.dst = ws + WS_DN + ((size_t)l * NE1 + e) * D * FF; d.K = FF; d.drow0 = 256 * nb; d.k0 = 128 * kb;
        d.kind = MAP_PERM16; d.sc = SC_DN; return d; }
    v -= CV_EDN;
    if (v < CV_SGU) { const int nb = v >> 4, kb = v & 15;
        d.sa = A.s_gate + (size_t)l * D * FF + 128 * nb; d.sb = A.s_up + (size_t)l * D * FF + 128 * nb; d.ld = FF; d.dst = ws + WS_GU + ((size_t)l * NE1 + NEXP) * 1024 * D; d.K = D; d.drow0 = 256 * nb; d.k0 = 128 * kb;
        d.kind = MAP_PERM32; d.sc = SC_GU; return d; }
    v -= CV_SGU;
    if (v < CV_SDN) { const int nb = v >> 2, kb = v & 3; d.sa = A.s_down + (size_t)l * FF * D + 256 * nb; d.sb = d.sa + 128; d.ld = D; d.dst = ws + WS_DN + ((size_t)l * NE1 + NEXP) * D * FF; d.K = FF; d.drow0 = 256 * nb; d.k0 = 128 * kb;
        d.kind = MAP_PERM16; d.sc = SC_DN; return d; }
    v -= CV_SDN;
    { const int nb = v >> 2, kb = v & 3; d.sa = A.s5_glu + (size_t)l * 512 * 512 + 256 * nb; d.sb = d.sa + 128; d.ld = 512; d.dst = ws + WS_GLU + (size_t)l * 512 * 512 * 2; d.K = 512; d.drow0 = 256 * nb; d.k0 = 128 * kb; d.kind = MAP_GLUFRAG; d.sc = 0.f; }
    return d;
}
__device__ __forceinline__ void conv_range(const Args& A, int u0, int u1, LAS unsigned char* lds) {
    if (u0 >= u1) return;
    LAS float* T = (LAS float*)lds; const int tid = threadIdx.x;
    CvD cur = conv_desc(A, u0); f32x4 v[16]; conv_load(cur, v, tid);
    for (int u = u0; u < u1; ++u) {
        __syncthreads();
        conv_put(v, T, tid);
        __syncthreads();
        CvD nxt = cur;
        if (u + 1 < u1) { nxt = conv_desc(A, u + 1); conv_load(nxt, v, tid); }
        conv_out(cur, T, tid);
        cur = nxt;
    }
    __syncthreads();
}
__device__ __forceinline__ void conv_dispatch(const Args& A, int u, LAS unsigned char* lds) { conv_range(A, u, u + 1, lds); }

__device__ __forceinline__ void cs_rev(double rev, float& c, float& s) {
    const float fr = (float)(rev - __builtin_floor(rev)); c = __builtin_amdgcn_cosf(fr); s = __builtin_amdgcn_sinf(fr);
}
__device__ __forceinline__ void tables_phase(const Args& A, int gtid, int gn) {
    unsigned char* ws = A.ws;
    float* cosR = (float*)(ws + WS_ROPE); float* sinR = (float*)(ws + WS_ROPE + ROPE_SINR); float* cosD = (float*)(ws + WS_ROPE + ROPE_COSD); float* sinD = (float*)(ws + WS_ROPE + ROPE_SIND);
    const double INV2PI = 0.15915494309189535;
    for (int i = gtid; i < SEQ * 64; i += gn) { const int t = i >> 6, j = i & 63, jj = j & 31; const int pos = j < 32 ? (t >> 6) : (t & 63);
        const float f = fast_exp2(-(float)(2 * jj) * (1.0f / 64.0f) * 13.287712379549449f);
        float c, s; cs_rev((double)pos * (double)f * INV2PI, c, s); cosR[i] = c; sinR[i] = s; }
    for (int i = gtid; i < SEQ * 32; i += gn) { const int t = i >> 5, j = i & 31, jj = j & 15; const int pos = j < 16 ? (t >> 6) : (t & 63);
        const float f = fast_exp2(-(float)(2 * jj) * (1.0f / 32.0f) * 13.287712379549449f);
        float c, s; cs_rev((double)pos * (double)f * INV2PI, c, s); cosD[i] = c; sinD[i] = s; }
    float* rwt = (float*)(ws + WS_RWT);
    { unsigned short* rwh = (unsigned short*)rwt; unsigned short* rwl = rwh + (size_t)2 * NEXP * D;
      for (int i = gtid; i < 2 * D * NEXP; i += gn) { const int l = i / (D * NEXP), r = i - l * D * NEXP, k = r >> 6, e = r & 63; const float v = A.router_w[i];
          const unsigned hw = pk2(v, 0.f) & 0xffffu; const float hi = __builtin_bit_cast(float, hw << 16); const unsigned lw = pk2(v - hi, 0.f) & 0xffffu;
          const size_t o = (size_t)l * NEXP * D + ((size_t)(((((e >> 5) * 128 + (k >> 4)) * 2 + ((k >> 3) & 1)) * 32 + (e & 31)) << 3)) + (k & 7);
          rwh[o] = (unsigned short)hw; rwl[o] = (unsigned short)lw; } }
    int* list64 = (int*)(ws + WS_LIST) + (size_t)NEXP * TALL;
    for (int i = gtid; i < TALL; i += gn) list64[i] = i;
    f32x2* SA = (f32x2*)(ws + WS_S5A); bf16_t* BF = (bf16_t*)(ws + WS_S5BF); bf16_t* CF = (bf16_t*)(ws + WS_S5CF);
    for (int i = gtid; i < 2 * 2 * 32 * 64; i += gn) {
        const int p = i & 63, g = (i >> 6) & 31, d = (i >> 11) & 1, l = i >> 12;
        const float dt = fast_exp2(A.s5_logdt[(l * 2 + d) * 32 + g] * LOG2E);
        const float lr = A.s5_lre[i], li = A.s5_lim[i];
        const float mag = fast_exp2(lr * dt * LOG2E);
        float c, s; cs_rev((double)li * (double)dt * INV2PI, c, s);
        const float ar = mag * c, ai = mag * s;
        float pr = ar, pi = ai;
#pragma unroll
        for (int q = 0; q < 4; ++q) { const float nr = pr * pr - pi * pi, ni = 2.f * pr * pi; pr = nr; pi = ni; }
        const float a16r = pr, a16i = pi; const float a32r = pr * pr - pi * pi, a32i = 2.f * pr * pi;
        SA[i] = (f32x2){ar, ai}; SA[S5A_N + i] = (f32x2){a16r, a16i}; SA[2 * S5A_N + i] = (f32x2){a32r, a32i};
        const float den = lr * lr + li * li, nr = ar - 1.0f;
        const float fre = (nr * lr + ai * li) / den, fim = (ai * lr - nr * li) / den;
        const int pb = p >> 5, pl = p & 31;
        const float* bre = A.s5_bre + (((size_t)l * 32 + g) * 64 + p) * 16; const float* bim = A.s5_bim + (((size_t)l * 32 + g) * 64 + p) * 16;
        bf16_t* bf_re = BF + ((((size_t)(l * 2 + d) * 32 + g) * 2 + pb) * 2 + 0) * 512; bf16_t* bf_im = bf_re + 512;
        for (int h = 0; h < 16; ++h) { const float br = bre[h], bi = bim[h]; const int lane = (h >> 3) * 32 + pl, j = h & 7;
            bf_re[lane * 8 + j] = (bf16_t)f2bf(fre * br - fim * bi); bf_im[lane * 8 + j] = (bf16_t)f2bf(fre * bi + fim * br); }
        if (d == 0) {
            for (int reim = 0; reim < 2; ++reim) { const int k = 2 * p + reim, ks = k >> 5, kq = (k >> 3) & 3, j = k & 7;
                for (int hp = 0; hp < 16; ++hp) { const size_t ci = (((size_t)l * 32 + g) * 16 + hp) * 64 + p; const float v = reim ? -A.s5_cim[ci] : A.s5_cre[ci];
                    CF[(((size_t)l * 32 + g) * 4 + ks) * 512 + (kq * 16 + hp) * 8 + j] = (bf16_t)f2bf(v); } }
        }
    }
}

__device__ __forceinline__ const float* in_row(const float* xlat, const float* xctx, int row) {
    const int b = row / SEQU, pos = row - b * SEQU; return pos < CTX ? xctx + ((size_t)b * CTX + pos) * D : xlat + ((size_t)b * SEQ + (pos - CTX)) * D;
}
__device__ __forceinline__ void modnorm_row(const float* xr, const float* nw, const float* sh, const float* sc, bf16_t* hrow, int lane) {
    f32x4 v[8]; float ss = 0.f;
#pragma unroll
    for (int i = 0; i < 8; ++i) { v[i] = *(const f32x4*)(xr + 4 * (lane + 64 * i)); ss += v[i][0] * v[i][0] + v[i][1] * v[i][1] + v[i][2] * v[i][2] + v[i][3] * v[i][3]; }
    ss = wave_sum(ss); const float rstd = __builtin_amdgcn_rsqf(ss * (1.0f / D) + EPS);
#pragma unroll
    for (int i = 0; i < 8; ++i) { const int c = 4 * (lane + 64 * i); const f32x4 w = *(const f32x4*)(nw + c), s1 = *(const f32x4*)(sc + c), s0 = *(const f32x4*)(sh + c);
        const f32x4 o = (v[i] * rstd * w * (1.0f + s1) + s0) * SC_H8; *(unsigned*)((unsigned char*)hrow + c) = pk4_fp8(o[0], o[1], o[2], o[3]); }
}

namespace pg8 {
constexpr int BM = 256, BK = 64, HALF = 128, HTB = HALF * BK * 2, STAGE_BYTES = 8 * HTB, NXCD = 8, WGM = 8;
__device__ __forceinline__ int lds_byte(int r, int c) { const int st = (r >> 4) * 2 + (c >> 5), rr = r & 15, cc = c & 31, ob = rr * 64 + cc * 2; return st * 1024 + (ob ^ (((ob >> 9) & 1) << 5)); }
__device__ __forceinline__ void stage_rc(int b, int& R, int& C) { const int st = b / 1024, sb = b % 1024, swz = sb ^ (((sb >> 9) & 1) << 5); R = (st >> 1) * 16 + swz / 64; C = (st & 1) * 32 + (swz % 64) / 2; }

struct UnitD {
    const char* A;
    const char* B;
    unsigned ao[2][2];
    int pm, pn, e, row0;
};

template <class Epi, class Sched>
__device__ __forceinline__ void gemm_phase(LAS unsigned char* lds, const int K, const Sched& S, const Epi& E) {
    const int tid = threadIdx.x, wid = __builtin_amdgcn_readfirstlane(tid >> 6), lane = tid & 63, wr = wid >> 2, wc = wid & 3, fr = lane & 15, fq = lane >> 4;
    const int nt = K / BK;
    unsigned voffB[2];
#pragma unroll
    for (int i = 0; i < 2; ++i) { int R, C; stage_rc(tid * 16 + i * 8192, R, C); voffB[i] = (unsigned)(R * K + C) * 2u; }
    const size_t kstep = (size_t)(BK * 2);
    const size_t hstep = (size_t)HALF * K * 2;
    const unsigned ldsw = (unsigned)wid * 1024u;
    const int aoff = lds_byte(wr * 64 + fr, fq * 8), boff = lds_byte(wc * 32 + fr, fq * 8);
#define PG8_SA(b, h) (((b) * 2 + (h)) * HTB)
#define PG8_SB(b, h) ((4 + (b) * 2 + (h)) * HTB)
#define PG8_STA(bufoff, U, h, kb) do { _Pragma("unroll") for (int _i = 0; _i < 2; ++_i) \
        __builtin_amdgcn_global_load_lds((const unsigned*)((U).A + (U).ao[h][_i] + (kb)), (LAS unsigned*)(lds + (bufoff) + ldsw + _i * 8192), 16, 0, 0); } while (0)
#define PG8_STB(bufoff, U, h, kb) do { _Pragma("unroll") for (int _i = 0; _i < 2; ++_i) \
        __builtin_amdgcn_global_load_lds((const unsigned*)((U).B + (h) * hstep + voffB[_i] + (kb)), (LAS unsigned*)(lds + (bufoff) + ldsw + _i * 8192), 16, 0, 0); } while (0)
#define PG8_LDA(dst, b, h) do { _Pragma("unroll") for (int m = 0; m < 4; ++m) _Pragma("unroll") for (int k = 0; k < 2; ++k) dst[m][k] = *(const LAS bf16x8*)(lds + PG8_SA(b, h) + aoff + m * 2048 + k * 1024); } while (0)
#define PG8_LDB(dst, b, h) do { _Pragma("unroll") for (int n = 0; n < 2; ++n) _Pragma("unroll") for (int k = 0; k < 2; ++k) dst[n][k] = *(const LAS bf16x8*)(lds + PG8_SB(b, h) + boff + n * 2048 + k * 1024); } while (0)
#define PG8_MMA(ai, bj, At, Bt) do { __builtin_amdgcn_s_setprio(1); _Pragma("unroll") for (int m = 0; m < 4; ++m) _Pragma("unroll") for (int n = 0; n < 2; ++n) _Pragma("unroll") for (int k = 0; k < 2; ++k) \
        acc[ai][bj][m][n] = __builtin_amdgcn_mfma_f32_16x16x32_bf16(Bt[n][k], At[m][k], acc[ai][bj][m][n], 0, 0, 0); __builtin_amdgcn_s_setprio(0); } while (0)
#define PG8_WAIT_V(n) asm volatile("s_waitcnt vmcnt(" #n ")" ::: "memory")
#define PG8_WAIT_L(n) asm volatile("s_waitcnt lgkmcnt(" #n ")" ::: "memory")
#define PG8_BAR __builtin_amdgcn_s_barrier()
#define PG8_SCHED __builtin_amdgcn_sched_barrier(0)
    UnitD cur, nxt; int ui = 0;
    if (!S.next(0, cur)) return;
    f32x4 acc[2][2][4][2];
#pragma unroll
    for (int a = 0; a < 2; ++a)
#pragma unroll
        for (int b = 0; b < 2; ++b)
#pragma unroll
            for (int m = 0; m < 4; ++m)
#pragma unroll
                for (int n = 0; n < 2; ++n) acc[a][b][m][n] = (f32x4){0.f, 0.f, 0.f, 0.f};
    bf16x8 At[4][2], B0[2][2], B1[2][2];
    PG8_STB(PG8_SB(0, 0), cur, 0, 0); PG8_STA(PG8_SA(0, 0), cur, 0, 0); PG8_STB(PG8_SB(0, 1), cur, 1, 0); PG8_STA(PG8_SA(0, 1), cur, 1, 0);
    if (wr == 1) PG8_BAR;
    PG8_WAIT_V(4); PG8_BAR;
    PG8_STB(PG8_SB(1, 0), cur, 0, kstep); PG8_STA(PG8_SA(1, 0), cur, 0, kstep); PG8_STB(PG8_SB(1, 1), cur, 1, kstep);
    PG8_WAIT_V(6); PG8_BAR;
    for (;;) {
        const bool has_next = S.next(ui + 1, nxt);
        if (!has_next) nxt = cur;
        for (int t = 0; t < nt; t += 2) {
            const bool last = (t == nt - 2);
            const size_t k1 = (size_t)(t + 1) * kstep;
            const size_t k2 = last ? (size_t)0 : (size_t)(t + 2) * kstep, k3 = k2 + kstep;
            UnitD w2; w2.A = cur.A; w2.B = last ? nxt.B : cur.B;
            w2.ao[0][0] = last ? nxt.ao[0][0] : cur.ao[0][0]; w2.ao[0][1] = last ? nxt.ao[0][1] : cur.ao[0][1];
            w2.ao[1][0] = last ? nxt.ao[1][0] : cur.ao[1][0]; w2.ao[1][1] = last ? nxt.ao[1][1] : cur.ao[1][1];
            PG8_LDB(B0, 0, 0); PG8_SCHED; PG8_LDA(At, 0, 0); PG8_STA(PG8_SA(1, 1), cur, 1, k1);
            PG8_WAIT_L(8); PG8_BAR; PG8_WAIT_L(0); PG8_MMA(0, 0, At, B0); PG8_BAR; PG8_SCHED;
            PG8_LDB(B1, 0, 1); PG8_STB(PG8_SB(0, 0), w2, 0, k2);
            PG8_BAR; PG8_WAIT_L(0); PG8_MMA(0, 1, At, B1); PG8_BAR;
            PG8_LDA(At, 0, 1); PG8_STA(PG8_SA(0, 0), w2, 0, k2);
            PG8_BAR; PG8_WAIT_L(0); PG8_MMA(1, 0, At, B0); PG8_BAR; PG8_SCHED;
            PG8_STB(PG8_SB(0, 1), w2, 1, k2);
            PG8_WAIT_V(6); PG8_BAR; PG8_MMA(1, 1, At, B1); PG8_BAR;
            PG8_LDB(B0, 1, 0); PG8_SCHED; PG8_LDA(At, 1, 0); PG8_STA(PG8_SA(0, 1), w2, 1, k2);
            PG8_WAIT_L(8); PG8_BAR; PG8_WAIT_L(0); PG8_MMA(0, 0, At, B0); PG8_BAR; PG8_SCHED;
            PG8_LDB(B1, 1, 1); PG8_STB(PG8_SB(1, 0), w2, 0, k3);
            PG8_BAR; PG8_WAIT_L(0); PG8_MMA(0, 1, At, B1); PG8_BAR;
            PG8_LDA(At, 1, 1); PG8_STA(PG8_SA(1, 0), w2, 0, k3);
            PG8_BAR; PG8_WAIT_L(0); PG8_MMA(1, 0, At, B0); PG8_BAR; PG8_SCHED;
            PG8_STB(PG8_SB(1, 1), w2, 1, k3);
            PG8_WAIT_V(6); PG8_BAR; PG8_MMA(1, 1, At, B1); PG8_BAR;
        }
        E(acc, cur, wr, wc, fr, fq);
        if (!has_next) break;
#pragma unroll
        for (int a = 0; a < 2; ++a)
#pragma unroll
            for (int b = 0; b < 2; ++b)
#pragma unroll
                for (int m = 0; m < 4; ++m)
#pragma unroll
                    for (int n = 0; n < 2; ++n) acc[a][b][m][n] = (f32x4){0.f, 0.f, 0.f, 0.f};
        cur = nxt; ++ui;
    }
    PG8_WAIT_V(0);
    if (wr == 0) PG8_BAR;
    PG8_BAR;
#undef PG8_SA
#undef PG8_SB
#undef PG8_STA
#undef PG8_STB
#undef PG8_LDA
#undef PG8_LDB
#undef PG8_MMA
#undef PG8_WAIT_V
#undef PG8_WAIT_L
#undef PG8_BAR
#undef PG8_SCHED
}

typedef int v8i __attribute__((ext_vector_type(8)));
typedef int v4i __attribute__((ext_vector_type(4)));
typedef v4i __attribute__((may_alias)) v4i_a;
template <class Epi, class Sched, bool FP8 = true>
__device__ __forceinline__ void gemm_phase8(LAS unsigned char* lds, const int K, const Sched& S, const Epi& E, int sclA = 127, int sclB = 127) {
    const int tid = threadIdx.x, wid = __builtin_amdgcn_readfirstlane(tid >> 6), lane = tid & 63, wr = wid >> 2, wc = wid & 3, fr = lane & 15, fq = lane >> 4;
    const int nt = K / BK;
    unsigned voffB[2];
#pragma unroll
    for (int i = 0; i < 2; ++i) { int R, C; stage_rc(tid * 16 + i * 8192, R, C); voffB[i] = (unsigned)(R * K + C) * 2u; }
    const size_t kstep = (size_t)(BK * 2);
    const size_t hstep = (size_t)HALF * K * 2;
    const unsigned ldsw = (unsigned)wid * 1024u;
    const int aoff = lds_byte(wr * 64 + fr, fq * 8), boff = lds_byte(wc * 32 + fr, fq * 8);
#define PG8_SA(b, h) (((b) * 2 + (h)) * HTB)
#define PG8_SB(b, h) ((4 + (b) * 2 + (h)) * HTB)
#define PG8_STA(bufoff, U, h, kb) do { _Pragma("unroll") for (int _i = 0; _i < 2; ++_i) \
        __builtin_amdgcn_global_load_lds((const unsigned*)((U).A + (U).ao[h][_i] + (kb)), (LAS unsigned*)(lds + (bufoff) + ldsw + _i * 8192), 16, 0, 0); } while (0)
#define PG8_STB(bufoff, U, h, kb) do { _Pragma("unroll") for (int _i = 0; _i < 2; ++_i) \
        __builtin_amdgcn_global_load_lds((const unsigned*)((U).B + (h) * hstep + voffB[_i] + (kb)), (LAS unsigned*)(lds + (bufoff) + ldsw + _i * 8192), 16, 0, 0); } while (0)
#define PG8_LDA(dst, b, h) do { _Pragma("unroll") for (int m = 0; m < 4; ++m) { dst[m].lo = *(const LAS v4i_a*)(lds + PG8_SA(b, h) + aoff + m * 2048); dst[m].hi = *(const LAS v4i_a*)(lds + PG8_SA(b, h) + aoff + m * 2048 + 1024); } } while (0)
#define PG8_LDB(dst, b, h) do { _Pragma("unroll") for (int n = 0; n < 2; ++n) { dst[n].lo = *(const LAS v4i_a*)(lds + PG8_SB(b, h) + boff + n * 2048); dst[n].hi = *(const LAS v4i_a*)(lds + PG8_SB(b, h) + boff + n * 2048 + 1024); } } while (0)
#define PG8_MMA(ai, bj, At, Bt) do { __builtin_amdgcn_s_setprio(1); _Pragma("unroll") for (int m = 0; m < 4; ++m) _Pragma("unroll") for (int n = 0; n < 2; ++n) { \
        if constexpr (FP8) asm volatile("v_mfma_scale_f32_16x16x128_f8f6f4 %0, %1, %2, %0, %3, %4 op_sel_hi:[0,0,0]" : "+v"(acc[ai][bj][m][n]) : "v"(Bt[n]), "v"(At[m]), "v"(vsclB), "v"(vsclA)); \
        else { acc[ai][bj][m][n] = __builtin_amdgcn_mfma_f32_16x16x32_bf16(__builtin_bit_cast(bf16x8, Bt[n].lo), __builtin_bit_cast(bf16x8, At[m].lo), acc[ai][bj][m][n], 0, 0, 0); \
               acc[ai][bj][m][n] = __builtin_amdgcn_mfma_f32_16x16x32_bf16(__builtin_bit_cast(bf16x8, Bt[n].hi), __builtin_bit_cast(bf16x8, At[m].hi), acc[ai][bj][m][n], 0, 0, 0); } } \
        __builtin_amdgcn_s_setprio(0); } while (0)
#define PG8_WAIT_V(n) asm volatile("s_waitcnt vmcnt(" #n ")" ::: "memory")
#define PG8_WAIT_L(n) asm volatile("s_waitcnt lgkmcnt(" #n ")" ::: "memory")
#define PG8_BAR __builtin_amdgcn_s_barrier()
#define PG8_SCHED __builtin_amdgcn_sched_barrier(0)
    int vsclA = sclA * 0x01010101, vsclB = sclB * 0x01010101;
    asm volatile("" : "+v"(vsclA), "+v"(vsclB));
    UnitD cur, nxt; int ui = 0;
    if (!S.next(0, cur)) return;
    f32x4 acc[2][2][4][2];
#pragma unroll
    for (int a = 0; a < 2; ++a)
#pragma unroll
        for (int b = 0; b < 2; ++b)
#pragma unroll
            for (int m = 0; m < 4; ++m)
#pragma unroll
                for (int n = 0; n < 2; ++n) acc[a][b][m][n] = (f32x4){0.f, 0.f, 0.f, 0.f};
    v8i At[4], B0[2], B1[2];
    PG8_STB(PG8_SB(0, 0), cur, 0, 0); PG8_STA(PG8_SA(0, 0), cur, 0, 0); PG8_STB(PG8_SB(0, 1), cur, 1, 0); PG8_STA(PG8_SA(0, 1), cur, 1, 0);
    if (wr == 1) PG8_BAR;
    PG8_WAIT_V(4); PG8_BAR;
    PG8_STB(PG8_SB(1, 0), cur, 0, kstep); PG8_STA(PG8_SA(1, 0), cur, 0, kstep); PG8_STB(PG8_SB(1, 1), cur, 1, kstep);
    PG8_WAIT_V(6); PG8_BAR;
    for (;;) {
        const bool has_next = S.next(ui + 1, nxt);
        if (!has_next) nxt = cur;
        for (int t = 0; t < nt; t += 2) {
            const bool last = (t == nt - 2);
            const size_t k1 = (size_t)(t + 1) * kstep;
            const size_t k2 = last ? (size_t)0 : (size_t)(t + 2) * kstep, k3 = k2 + kstep;
            UnitD w2; w2.A = cur.A; w2.B = last ? nxt.B : cur.B;
            w2.ao[0][0] = last ? nxt.ao[0][0] : cur.ao[0][0]; w2.ao[0][1] = last ? nxt.ao[0][1] : cur.ao[0][1];
            w2.ao[1][0] = last ? nxt.ao[1][0] : cur.ao[1][0]; w2.ao[1][1] = last ? nxt.ao[1][1] : cur.ao[1][1];
            PG8_LDB(B0, 0, 0); PG8_SCHED; PG8_LDA(At, 0, 0); PG8_STA(PG8_SA(1, 1), cur, 1, k1);
            PG8_WAIT_L(8); PG8_BAR; PG8_WAIT_L(0); PG8_MMA(0, 0, At, B0); PG8_BAR; PG8_SCHED;
            PG8_LDB(B1, 0, 1); PG8_STB(PG8_SB(0, 0), w2, 0, k2);
            PG8_BAR; PG8_WAIT_L(0); PG8_MMA(0, 1, At, B1); PG8_BAR;
            PG8_LDA(At, 0, 1); PG8_STA(PG8_SA(0, 0), w2, 0, k2);
            PG8_BAR; PG8_WAIT_L(0); PG8_MMA(1, 0, At, B0); PG8_BAR; PG8_SCHED;
            PG8_STB(PG8_SB(0, 1), w2, 1, k2);
            PG8_WAIT_V(6); PG8_BAR; PG8_MMA(1, 1, At, B1); PG8_BAR;
            PG8_LDB(B0, 1, 0); PG8_SCHED; PG8_LDA(At, 1, 0); PG8_STA(PG8_SA(0, 1), w2, 1, k2);
            PG8_WAIT_L(8); PG8_BAR; PG8_WAIT_L(0); PG8_MMA(0, 0, At, B0); PG8_BAR; PG8_SCHED;
            PG8_LDB(B1, 1, 1); PG8_STB(PG8_SB(1, 0), w2, 0, k3);
            PG8_BAR; PG8_WAIT_L(0); PG8_MMA(0, 1, At, B1); PG8_BAR;
            PG8_LDA(At, 1, 1); PG8_STA(PG8_SA(1, 0), w2, 0, k3);
            PG8_BAR; PG8_WAIT_L(0); PG8_MMA(1, 0, At, B0); PG8_BAR; PG8_SCHED;
            PG8_STB(PG8_SB(1, 1), w2, 1, k3);
            PG8_WAIT_V(6); PG8_BAR; PG8_MMA(1, 1, At, B1); PG8_BAR;
        }
        if constexpr (FP8) asm volatile("s_nop 15\n\ts_nop 15" ::: "memory");
        E(acc, cur, wr, wc, fr, fq);
        if (!has_next) break;
#pragma unroll
        for (int a = 0; a < 2; ++a)
#pragma unroll
            for (int b = 0; b < 2; ++b)
#pragma unroll
                for (int m = 0; m < 4; ++m)
#pragma unroll
                    for (int n = 0; n < 2; ++n) acc[a][b][m][n] = (f32x4){0.f, 0.f, 0.f, 0.f};
        cur = nxt; ++ui;
    }
    PG8_WAIT_V(0);
    if (wr == 0) PG8_BAR;
    PG8_BAR;
#undef PG8_SA
#undef PG8_SB
#undef PG8_STA
#undef PG8_STB
#undef PG8_LDA
#undef PG8_LDB
#undef PG8_MMA
#undef PG8_WAIT_V
#undef PG8_WAIT_L
#undef PG8_BAR
#undef PG8_SCHED
}

__device__ __forceinline__ void lin_offsets(UnitD& u, int row0, int K) {
#pragma unroll
    for (int i = 0; i < 2; ++i) { int R, C; stage_rc((int)threadIdx.x * 16 + i * 8192, R, C);
        u.ao[0][i] = (unsigned)(((size_t)(row0 + R) * K + C) * 2); u.ao[1][i] = (unsigned)(((size_t)(row0 + HALF + R) * K + C) * 2); }
}
}

using pg8::UnitD;
struct DenseSched {
    const char* A; const char* Bt; int nM, nN, K, G, c; bool skipctx = false;
    __device__ __forceinline__ bool next(int i, UnitD& u) const {
        const int nwg = nM * nN; const long L = (long)i * G + c; if (L >= nwg) return false;
        int wgid = (int)L; { const int q = nwg / 8, r = nwg % 8, xcd = wgid % 8, off = wgid / 8; wgid = (xcd < r ? xcd * (q + 1) : r * (q + 1) + (xcd - r) * q) + off; }
        const int nig = 8 * nN, gid = wgid / nig, fm = gid * 8, gsz = (nM - fm) < 8 ? (nM - fm) : 8;
        int pm = fm + ((wgid % nig) % gsz); const int pn = (wgid % nig) / gsz;
        if (skipctx) pm += 1 + (pm >= 32 ? 1 : 0);
        u.A = A; u.B = Bt + (size_t)pn * 256 * K * 2; pg8::lin_offsets(u, pm * 256, K); u.pm = pm; u.pn = pn; u.e = 0; u.row0 = pm * 256; return true;
    }
};
struct GroupSched {
    const char* A; const char* Bt; const int* list; const int* cnt; const LAS int* tileP; int NT, K, G, c; bool gather; size_t bstride;
    bool skipctx = false;
    __device__ __forceinline__ bool next(int i, UnitD& u) const {
        const int total = tileP[65] * NT; const long L = (long)i * G + c; if (L >= total) return false;
        const int tile = (int)(L / NT), tn = (int)(L % NT);
        int e = 0;
#pragma unroll
        for (int s = 64; s >= 1; s >>= 1) { if (e + s <= 64 && tileP[e + s] <= tile) e += s; }
        const int tm = tile - tileP[e];
        const int srt = skipctx ? tm + 1 + (tm >= 32 ? 1 : 0) : tm;
        u.A = A; u.B = Bt + (size_t)e * bstride + (size_t)tn * 256 * K * 2; u.pm = tm; u.pn = tn; u.e = e;
        if (gather) {
            const int ce = e == NEXP ? TALL : cnt[e]; const int* le = list + (size_t)e * TALL;
#pragma unroll
            for (int p = 0; p < 2; ++p) { int R, C; pg8::stage_rc((int)threadIdx.x * 16 + p * 8192, R, C);
#pragma unroll
                for (int h = 0; h < 2; ++h) { const int idx = tm * 256 + 128 * h + R; const int tok = e == NEXP ? srt * 256 + 128 * h + R : le[idx < ce ? idx : 0]; u.ao[h][p] = (unsigned)(((size_t)tok * K + C) * 2); } }
            u.row0 = 256 * tile;
        } else {
            pg8::lin_offsets(u, 256 * tile, K);
            u.row0 = e == NEXP ? srt * 256 : 256 * tile;
        }
        return true;
    }
};
__device__ __forceinline__ void build_tileP(const int* cnt, LAS int* tileP, int shared_tiles = TALL / 256) {
    if (threadIdx.x == 0) { int s = 0; for (int e = 0; e < NEXP; ++e) { tileP[e] = s; s += (cnt[e] + 255) >> 8; } tileP[64] = s; s += shared_tiles; tileP[65] = s; }
}

__device__ __forceinline__ void st_bf16x4(bf16_t* p, f32x4 v) { u32x2 w; w.x = pk2(v[0], v[1]); w.y = pk2(v[2], v[3]); *(u32x2*)p = w; }
__device__ __forceinline__ void st_bf16x8(bf16_t* p, f32x4 v0, f32x4 v1) { u32x4 w; w.x = pk2(v0[0], v0[1]); w.y = pk2(v0[2], v0[3]); w.z = pk2(v1[0], v1[1]); w.w = pk2(v1[2], v1[3]); *(u32x4*)p = w; }

constexpr float QSCALE = 0.125f * LOG2E;
struct EpiIn {
    bf16_t* P; const float *cosR, *sinR, *cosD, *sinD, *qw, *kw; unsigned char *Q8, *K8, *V8T;
    __device__ __forceinline__ void operator()(const f32x4 (&acc)[2][2][4][2], const UnitD& u, int wr, int wc, int fr, int fq) const {
        const int pn = u.pn, rbase = u.row0 + wr * 64 + fr;
        if (pn < 4) {
            const float scale = pn >= 2 ? 0.08838834764831845f : 1.0f; const int i0 = 16 * wc + 4 * fq;
#pragma unroll
            for (int ai = 0; ai < 2; ++ai)
#pragma unroll
                for (int m = 0; m < 4; ++m) { const int row = rbase + ai * 128 + m * 16, b = row / SEQU, pos = row - b * SEQU; const bool lat = pos >= CTX; const int t = lat ? pos - CTX : 0;
                    f32x4 c = {1.f, 1.f, 1.f, 1.f}, s = {0.f, 0.f, 0.f, 0.f};
                    if (lat) { c = *(const f32x4*)(cosR + (size_t)t * 64 + i0); s = *(const f32x4*)(sinR + (size_t)t * 64 + i0); }
                    c *= scale; s *= scale;
#pragma unroll
                    for (int bj = 0; bj < 2; ++bj) { const f32x4 x1 = acc[ai][bj][m][0], x2 = acc[ai][bj][m][1]; bf16_t* op = P + (size_t)row * LDP + 256 * pn + 128 * bj + i0;
                        st_bf16x4(op, x1 * c - x2 * s); st_bf16x4(op + 64, x1 * s + x2 * c); } }
        } else if (pn >= 8 && pn < 16) {
            const bool isq = pn < 12; const float* w = isq ? qw : kw; const int sh = 4 * (pn - (isq ? 8 : 12)) + wc;
            unsigned char* dst8 = Q8 + 64 * sh;
            const float os = isq ? QSCALE * SC_Q8 : SC_K8;
            f32x4 wv[2][2];
#pragma unroll
            for (int bj = 0; bj < 2; ++bj)
#pragma unroll
                for (int n = 0; n < 2; ++n) wv[bj][n] = *(const f32x4*)(w + 32 * bj + 8 * fq + 4 * n) * os;
#pragma unroll
            for (int ai = 0; ai < 2; ++ai)
#pragma unroll
                for (int m = 0; m < 4; ++m) { const int row = rbase + ai * 128 + m * 16, b = row / SEQU, pos = row - b * SEQU; const bool lat = pos >= CTX; const int t = lat ? pos - CTX : 0;
                    float ss = 0.f;
#pragma unroll
                    for (int bj = 0; bj < 2; ++bj)
#pragma unroll
                        for (int n = 0; n < 2; ++n) { const f32x4 v = acc[ai][bj][m][n]; ss += v[0] * v[0] + v[1] * v[1] + v[2] * v[2] + v[3] * v[3]; }
                    ss += __shfl_xor(ss, 16); ss += __shfl_xor(ss, 32);
                    const float rinv = __builtin_amdgcn_rsqf(ss * (1.0f / 64.0f) + EPS);
                    u32x2 w1, w2;
#pragma unroll
                    for (int n = 0; n < 2; ++n) { const int i0 = 8 * fq + 4 * n;
                        f32x4 c = {1.f, 1.f, 1.f, 1.f}, s = {0.f, 0.f, 0.f, 0.f};
                        if (lat) { c = *(const f32x4*)(cosD + (size_t)t * 32 + i0); s = *(const f32x4*)(sinD + (size_t)t * 32 + i0); }
                        const f32x4 x1 = acc[ai][0][m][n] * rinv * wv[0][n], x2 = acc[ai][1][m][n] * rinv * wv[1][n];
                        const f32x4 o1 = x1 * c - x2 * s, o2 = x1 * s + x2 * c;
                        const unsigned a1 = pk4_fp8(o1[0], o1[1], o1[2], o1[3]), a2 = pk4_fp8(o2[0], o2[1], o2[2], o2[3]);
                        if (n == 0) { w1.x = a1; w2.x = a2; } else { w1.y = a1; w2.y = a2; } }
                    unsigned char* op = isq ? dst8 + (size_t)row * 1024 + 8 * fq : K8 + ((((size_t)(b * 8 + (sh >> 1)) * SEQU + pos) << 7) + 64 * (sh & 1) + 8 * fq);
                    *(u32x2*)op = w1; *(u32x2*)(op + 32) = w2; }
        } else if (pn >= 16 && pn < 20) {
            const int lane = fr + 16 * fq, cq = lane & 3;
#pragma unroll
            for (int ai = 0; ai < 2; ++ai)
#pragma unroll
                for (int m = 0; m < 4; ++m) { const int row = rbase + ai * 128 + m * 16, b = row / SEQU, pos = row - b * SEQU, t = pos >> 6, kk4 = pos & 60;
                    const int off = 32 * ((kk4 >> 2) & 1) + 16 * (kk4 >> 5) + 4 * ((kk4 >> 3) & 3);
#pragma unroll
                    for (int bj = 0; bj < 2; ++bj) { const int head = 2 * (pn - 16) + bj;
#pragma unroll
                        for (int n = 0; n < 2; ++n) { const f32x4 v = acc[ai][bj][m][n] * SC_V8; const unsigned W = pk4_fp8(v[0], v[1], v[2], v[3]);
                            const unsigned w0 = __shfl(W, (lane & ~3) + 0), w1 = __shfl(W, (lane & ~3) + 1), w2 = __shfl(W, (lane & ~3) + 2), w3 = __shfl(W, (lane & ~3) + 3);
                            const unsigned sft = 8 * cq; const unsigned R = ((w0 >> sft) & 0xffu) | (((w1 >> sft) & 0xffu) << 8) | (((w2 >> sft) & 0xffu) << 16) | (((w3 >> sft) & 0xffu) << 24);
                            const int dv = 32 * wc + 8 * fq + 4 * n + cq;
                            *(unsigned*)(V8T + ((((size_t)(b * 8 + head) * (SEQU / 64) + t) * 128 + dv) << 6) + off) = R; } } }
        } else {
            const bool gate = (pn == 6 || pn == 7);
#pragma unroll
            for (int ai = 0; ai < 2; ++ai)
#pragma unroll
                for (int m = 0; m < 4; ++m) { const int row = rbase + ai * 128 + m * 16;
#pragma unroll
                    for (int bj = 0; bj < 2; ++bj) { f32x4 v0 = acc[ai][bj][m][0], v1 = acc[ai][bj][m][1];
                        if (gate) {
#pragma unroll
                            for (int j = 0; j < 4; ++j) { v0[j] = siluf_(v0[j]); v1[j] = siluf_(v1[j]); } }
                        st_bf16x8(P + (size_t)row * LDP + 256 * pn + 128 * bj + 32 * wc + 8 * fq, v0, v1); } }
        }
    }
};
struct EpiRes {
    const float *xlat, *xctx; bf16_t* X; const float* gate;
    __device__ __forceinline__ void operator()(const f32x4 (&acc)[2][2][4][2], const UnitD& u, int wr, int wc, int fr, int fq) const {
        const int mi = mod_index(u.row0); const float* g = gate + (size_t)mi * MODW;
#pragma unroll
        for (int ai = 0; ai < 2; ++ai)
#pragma unroll
            for (int m = 0; m < 4; ++m) { const int row = u.row0 + ai * 128 + wr * 64 + m * 16 + fr; const float* sp = xlat ? in_row(xlat, xctx, row) : nullptr; bf16_t* dp = X + (size_t)row * D;
#pragma unroll
                for (int bj = 0; bj < 2; ++bj) { const int col = 256 * u.pn + 64 * wc + 16 * fq + 8 * bj;
                    f32x4 s0, s1;
                    if (sp) { s0 = *(const f32x4*)(sp + col); s1 = *(const f32x4*)(sp + col + 4); }
                    else { const u32x4 w = *(const u32x4*)(dp + col); s0[0] = bflo(w.x); s0[1] = bfhi(w.x); s0[2] = bflo(w.y); s0[3] = bfhi(w.y); s1[0] = bflo(w.z); s1[1] = bfhi(w.z); s1[2] = bflo(w.w); s1[3] = bfhi(w.w); }
                    const f32x4 o0 = s0 + *(const f32x4*)(g + col) * acc[ai][bj][m][0], o1 = s1 + *(const f32x4*)(g + col + 4) * acc[ai][bj][m][1];
                    u32x4 ow; ow.x = pk2(o0[0], o0[1]); ow.y = pk2(o0[2], o0[3]); ow.z = pk2(o1[0], o1[1]); ow.w = pk2(o1[2], o1[3]); *(u32x4*)(dp + col) = ow; } }
    }
};
struct EpiGU {
    unsigned char* HID;
    __device__ __forceinline__ void operator()(const f32x4 (&acc)[2][2][4][2], const UnitD& u, int wr, int wc, int fr, int fq) const {
#pragma unroll
        for (int ai = 0; ai < 2; ++ai)
#pragma unroll
            for (int m = 0; m < 4; ++m) { const int row = u.row0 + ai * 128 + wr * 64 + m * 16 + fr; f32x4 h[2];
#pragma unroll
                for (int n = 0; n < 2; ++n)
#pragma unroll
                    for (int j = 0; j < 4; ++j) h[n][j] = siluf_(acc[ai][0][m][n][j]) * acc[ai][1][m][n][j] * SC_HID;
                u32x2 w; w.x = pk4_fp8(h[0][0], h[0][1], h[0][2], h[0][3]); w.y = pk4_fp8(h[1][0], h[1][1], h[1][2], h[1][3]);
                *(u32x2*)(HID + (size_t)row * FF + 128 * u.pn + 32 * wc + 8 * fq) = w; }
    }
};
struct EpiDown {
    unsigned char* Y; bf16_t* X; const float* gate;
    __device__ __forceinline__ void operator()(const f32x4 (&acc)[2][2][4][2], const UnitD& u, int wr, int wc, int fr, int fq) const {
        if (u.e == NEXP) {
            if (!X) return;
            const int mi = mod_index(u.row0); const float* g = gate + (size_t)mi * MODW;
#pragma unroll
            for (int ai = 0; ai < 2; ++ai)
#pragma unroll
                for (int m = 0; m < 4; ++m) { bf16_t* dp = X + (size_t)(u.row0 + ai * 128 + wr * 64 + m * 16 + fr) * D;
#pragma unroll
                    for (int bj = 0; bj < 2; ++bj) { const int col = 256 * u.pn + 64 * wc + 16 * fq + 8 * bj;
                        const u32x4 w = *(const u32x4*)(dp + col); f32x4 s0, s1; s0[0] = bflo(w.x); s0[1] = bfhi(w.x); s0[2] = bflo(w.y); s0[3] = bfhi(w.y); s1[0] = bflo(w.z); s1[1] = bfhi(w.z); s1[2] = bflo(w.w); s1[3] = bfhi(w.w);
                        const f32x4 o0 = s0 + *(const f32x4*)(g + col) * acc[ai][bj][m][0], o1 = s1 + *(const f32x4*)(g + col + 4) * acc[ai][bj][m][1];
                        u32x4 ow; ow.x = pk2(o0[0], o0[1]); ow.y = pk2(o0[2], o0[3]); ow.z = pk2(o1[0], o1[1]); ow.w = pk2(o1[2], o1[3]); *(u32x4*)(dp + col) = ow; } }
        } else {
            if (!Y) { asm volatile("" :: "v"(acc[0][0][0][0][0]), "v"(acc[1][1][3][1][3])); return; }
#pragma unroll
            for (int ai = 0; ai < 2; ++ai)
#pragma unroll
                for (int m = 0; m < 4; ++m) { unsigned char* yp = Y + (size_t)(u.row0 + ai * 128 + wr * 64 + m * 16 + fr) * D + 256 * u.pn + 64 * wc + 16 * fq;
                    const f32x4 v0 = acc[ai][0][m][0] * SC_Y, v1 = acc[ai][0][m][1] * SC_Y, v2 = acc[ai][1][m][0] * SC_Y, v3 = acc[ai][1][m][1] * SC_Y; u32x4 w;
                    w.x = pk4_fp8(v0[0], v0[1], v0[2], v0[3]); w.y = pk4_fp8(v1[0], v1[1], v1[2], v1[3]); w.z = pk4_fp8(v2[0], v2[1], v2[2], v2[3]); w.w = pk4_fp8(v3[0], v3[1], v3[2], v3[3]);
                    *(u32x4*)yp = w; }
        }
    }
};

typedef bf16x8 __attribute__((may_alias)) bf16x8_a;
__device__ __forceinline__ f32x16 mfma32(bf16x8 a, bf16x8 b, f32x16 c) { return __builtin_amdgcn_mfma_f32_32x32x16_bf16(a, b, c, 0, 0, 0); }
__device__ __forceinline__ bf16x8 ld_tr2(const LAS unsigned char* p0, const LAS unsigned char* p1) {
    const s16x4 a = __builtin_amdgcn_ds_read_tr16_b64_v4i16((LAS s16x4*)p0), b = __builtin_amdgcn_ds_read_tr16_b64_v4i16((LAS s16x4*)p1);
    bf16x8 r; r[0] = a[0]; r[1] = a[1]; r[2] = a[2]; r[3] = a[3]; r[4] = b[0]; r[5] = b[1]; r[6] = b[2]; r[7] = b[3]; return r;
}
__device__ __forceinline__ unsigned tr_addr(unsigned lane, unsigned rowbase, unsigned cb) {
    const unsigned blk = (lane >> 4) & 1, q = (lane & 15) >> 2, p = lane & 3; return off_b(rowbase + q, 4 * cb + 2 * blk + (p >> 1)) + 8 * (p & 1);
}
__device__ __forceinline__ bf16x8 pack8(const f32x16& v, int s) {
    u32x4 w; w.x = pk2(v[8 * s + 0], v[8 * s + 1]); w.y = pk2(v[8 * s + 2], v[8 * s + 3]); w.z = pk2(v[8 * s + 4], v[8 * s + 5]); w.w = pk2(v[8 * s + 6], v[8 * s + 7]);
    return __builtin_bit_cast(bf16x8, w);
}
__device__ __forceinline__ void stage_offb(LAS unsigned char* img, const bf16_t* g, int ldg, int rows, int tid) {
    const int wid = __builtin_amdgcn_readfirstlane(tid >> 6);
    for (int r0 = 0; r0 < rows; r0 += 32) { const unsigned p = (unsigned)(r0 * 16 + tid), row = p >> 4, chs = p & 15, ch = chs ^ offb_key(row);
        __builtin_amdgcn_global_load_lds((const unsigned*)(g + (size_t)row * ldg + 8 * ch), (LAS unsigned*)(img + r0 * 256 + wid * 1024), 16, 0, 0); }
}
typedef int v8i_t __attribute__((ext_vector_type(8)));
typedef int v4i_t __attribute__((ext_vector_type(4)));
typedef v4i_t __attribute__((may_alias)) v4i_ta;
constexpr int ATT_STG = 8192, ATT_VOF = 65536;
__device__ __forceinline__ void attn_unit(LAS unsigned char* lds, const Args& A, bf16_t* MIX, int qrow0, int b, int nkeys, int head, float lam, float sbl2, const float* subw, float outscale, const int probe = 0) {
    const int tid = threadIdx.x, wid = __builtin_amdgcn_readfirstlane(tid >> 6), lane = tid & 63, br = wid >> 2, qq = wid & 3, l31 = lane & 31, hh = lane >> 5;
    const int qrow = qrow0 + 32 * qq + l31;
    const unsigned char* q8 = A.ws + WS_Q8 + (size_t)qrow * 1024 + head * 128 + br * 64 + 32 * hh;
    v8i_t Qf; Qf.lo = *(const v4i_t*)q8; Qf.hi = *(const v4i_t*)(q8 + 16);
    f32x16 O[4]; const float oz = opaque_zero();
#pragma unroll
    for (int i = 0; i < 4; ++i)
#pragma unroll
        for (int j = 0; j < 16; ++j) O[i][j] = oz;
    const float c565 = opaque_zero() + 56.5f; f32x16 CB; f32x4 Ol;
#pragma unroll
    for (int j = 0; j < 16; ++j) CB[j] = c565;
#pragma unroll
    for (int j = 0; j < 4; ++j) Ol[j] = oz;
    v8i_t Aones;
#pragma unroll
    for (int i = 0; i < 8; ++i) Aones[i] = (lane & 15) == ((lane >> 4) & 1) ? 0x50505050 : 0;
    const int ntile = nkeys / 64;
    const unsigned ksw = (l31 >> 1) & 7, vsw = (l31 >> 2) & 7;
    const unsigned ka0 = l31 * 128 + 16 * ((4 * br + 2 * hh) ^ ksw), ka1 = l31 * 128 + 16 * ((4 * br + 2 * hh + 1) ^ ksw);
    unsigned va0 = ATT_VOF + (l31 >> 1) * 128 + 16 * ((4 * (l31 & 1) + 2 * hh) ^ vsw), va1 = ATT_VOF + (l31 >> 1) * 128 + 16 * ((4 * (l31 & 1) + 2 * hh + 1) ^ vsw);
    asm volatile("" : "+v"(va0), "+v"(va1));
    const int sP = 127 * 0x01010101, sK = sP, sV = sP, sQ = (E8_Q8 + 3 + E8_K8 - 127) * 0x01010101;
    __syncthreads();
    const unsigned ksrc = (unsigned)((tid >> 3) * 128 + 16 * ((tid & 7) ^ ((tid >> 4) & 7)));
    const unsigned char* kgb = A.ws + WS_K8 + ((size_t)(b * 8 + head) * SEQU << 7);
    const unsigned char* vgb = A.ws + WS_V8T + ((size_t)(b * 8 + head) * (SEQU / 64) << 13);
    const unsigned dmaw = (unsigned)(size_t)(lds + wid * 1024);
#define ATT_DMA(gbase, voff, la) do { unsigned m0s_; asm volatile("s_mov_b32 %0, m0\n\ts_mov_b32 m0, %1\n\ts_nop 0\n\tglobal_load_lds_dwordx4 %2, %3\n\ts_mov_b32 m0, %0\n\ts_nop 0" : "=&s"(m0s_) : "s"(la), "v"(voff), "s"(gbase) : "memory"); } while (0)
#define ATT_DMAK(stg, t_) ATT_DMA(kgb + (size_t)min((t_), ntile - 1) * 8192, ksrc, dmaw + (unsigned)(stg))
#define ATT_DMAV(stg, t_) ATT_DMA(vgb + (size_t)min((t_), ntile - 1) * 8192, ksrc, dmaw + (unsigned)((stg) + ATT_VOF))
#define ATT_WAITV(n) asm volatile("s_waitcnt vmcnt(" #n ")" ::: "memory")
    ATT_DMAK(3 * ATT_STG, 0);
    ATT_DMAK(7 * ATT_STG, 1);
    ATT_DMAK(0, 2); ATT_DMAV(0, 0);
    ATT_DMAK(ATT_STG, 3); ATT_DMAV(ATT_STG, 1);
    ATT_DMAK(2 * ATT_STG, 4); ATT_DMAV(2 * ATT_STG, 2);
    { u32x4 z; z.x = 0; z.y = 0; z.z = 0; z.w = 0; *(LAS u32x4*)(lds + 7 * ATT_STG + ATT_VOF + 16 * tid) = z; }
    ATT_WAITV(0);
    __syncthreads();
    f32x16 Sa, Sb; v8i_t FA, FB, FC, FD;
    { v8i_t Kf; Kf.lo = *(const LAS v4i_ta*)(lds + 3 * ATT_STG + ka0); Kf.hi = *(const LAS v4i_ta*)(lds + 3 * ATT_STG + ka1);
      Sa = __builtin_amdgcn_mfma_scale_f32_32x32x64_f8f6f4(Kf, Qf, CB, 0, 0, 0, sK, 0, sQ);
      Kf.lo = *(const LAS v4i_ta*)(lds + 3 * ATT_STG + 4096 + ka0); Kf.hi = *(const LAS v4i_ta*)(lds + 3 * ATT_STG + 4096 + ka1);
      Sb = __builtin_amdgcn_mfma_scale_f32_32x32x64_f8f6f4(Kf, Qf, CB, 0, 0, 0, sK, 0, sQ);
      FA.lo = *(const LAS v4i_ta*)(lds + 7 * ATT_STG + va0); FA.hi = *(const LAS v4i_ta*)(lds + 7 * ATT_STG + va1);
      FB.lo = *(const LAS v4i_ta*)(lds + 7 * ATT_STG + 2048 + va0); FB.hi = *(const LAS v4i_ta*)(lds + 7 * ATT_STG + 2048 + va1); }
    v8i_t PfP;
#pragma unroll
    for (int i = 0; i < 8; ++i) PfP[i] = 0;
    __syncthreads();
#define ATT_PACK(S, r0, dst) if (probe & 2) { asm volatile("" :: "v"(S[(r0)]), "v"(S[(r0) + 3])); dst = PfP[0] + (r0); } else { unsigned w = 0; _Pragma("unroll") for (int c = 0; c < 4; ++c) w = __builtin_amdgcn_cvt_pk_u8_f32(__builtin_amdgcn_fmed3f(S[(r0) + c], 0.0f, hi), c, w); dst = (int)w; }
#define ATT_LDV(dst, base, dvb) if (probe & 4) { dst = Qf; } else { dst.lo = *(const LAS v4i_ta*)(base + (dvb) * 2048 + va0); dst.hi = *(const LAS v4i_ta*)(base + (dvb) * 2048 + va1); }
#define ATT_LDK(dst, kb) if (probe & 4) { dst = Qf; } else { dst.lo = *(const LAS v4i_ta*)(rd + (kb) * 4096 + ka0); dst.hi = *(const LAS v4i_ta*)(rd + (kb) * 4096 + ka1); }
#define ATT_MFMA(D, A_, B_, C_, sa, sb) if (probe & 32) { asm volatile("" :: "v"(A_)); D = __builtin_amdgcn_mfma_scale_f32_32x32x64_f8f6f4(Qf, B_, C_, 0, 0, 0, sa, 0, sb); asm volatile("" : "+v"(D)); } else if (!(probe & 1)) { D = __builtin_amdgcn_mfma_scale_f32_32x32x64_f8f6f4(A_, B_, C_, 0, 0, 0, sa, 0, sb); asm volatile("" : "+v"(D)); } else { asm volatile("" :: "v"(A_), "v"(B_)); }
#define ATT_SB __builtin_amdgcn_sched_barrier(0)
#define ATT_INTERVAL(I, F0, F1, F2, F3, BAR) { \
        LAS unsigned char* rd = lds + (((I) + 7) & 7) * ATT_STG; LAS unsigned char* pf = lds + ((I) & 7) * ATT_STG; \
        const float hi = __builtin_bit_cast(float, __builtin_amdgcn_readfirstlane((I) < ntile ? 0x42fc0000 : 0));     \
        v8i_t PfN; \
        ATT_SB; \
        ATT_LDK(F2, 0); \
        if (!(probe & 1)) { Ol = __builtin_amdgcn_mfma_scale_f32_16x16x128_f8f6f4(Aones, PfP, Ol, 0, 0, 0, sV, 0, sP); asm volatile("" : "+v"(Ol)); } else { asm volatile("" :: "v"(Aones), "v"(PfP)); } \
        ATT_PACK(Sa, 0, PfN[0]); ATT_PACK(Sa, 4, PfN[1]); \
        ATT_SB; \
        ATT_LDV(F3, rd, 2); \
        ATT_MFMA(O[0], F0, PfP, O[0], sV, sP); \
        ATT_PACK(Sa, 8, PfN[2]); ATT_PACK(Sa, 12, PfN[3]); \
        ATT_SB; \
        ATT_MFMA(O[1], F1, PfP, O[1], sV, sP); \
        if (!(probe & 8)) ATT_DMAK((((I) + 3) & 7) * ATT_STG, (I) + 5);     \
        ATT_LDK(F0, 1); \
        ATT_PACK(Sb, 0, PfN[4]); ATT_PACK(Sb, 4, PfN[5]); \
        ATT_SB; \
        ATT_MFMA(Sa, F2, Qf, CB, sK, sQ); \
        ATT_LDV(F1, rd, 3); \
        ATT_PACK(Sb, 8, PfN[6]); ATT_PACK(Sb, 12, PfN[7]); \
        ATT_SB; \
        ATT_MFMA(O[2], F3, PfP, O[2], sV, sP); \
        if (!(probe & 8)) ATT_DMAV((((I) + 3) & 7) * ATT_STG, (I) + 3); \
        ATT_LDV(F2, pf, 0); \
        ATT_SB; \
        ATT_MFMA(Sb, F0, Qf, CB, sK, sQ); \
        ATT_LDV(F3, pf, 1); \
        ATT_SB; \
        ATT_MFMA(O[3], F1, PfP, O[3], sV, sP); \
        ATT_SB; \
        PfP = PfN; \
        if (BAR) { asm volatile("s_waitcnt vmcnt(2) lgkmcnt(4)" ::: "memory");     \
            if (!(probe & 16)) { __builtin_amdgcn_s_barrier(); asm volatile("" ::: "memory"); } } \
        else asm volatile("" ::: "memory");     }
#pragma unroll 1
    for (int i = 0; i <= ntile; i += 8) {
        ATT_INTERVAL(i, FA, FB, FC, FD, 0);
        ATT_INTERVAL(i + 1, FC, FD, FA, FB, 1);
        ATT_INTERVAL(i + 2, FA, FB, FC, FD, 0);
        ATT_INTERVAL(i + 3, FC, FD, FA, FB, 1);
        ATT_INTERVAL(i + 4, FA, FB, FC, FD, 0);
        ATT_INTERVAL(i + 5, FC, FD, FA, FB, 1);
        ATT_INTERVAL(i + 6, FA, FB, FC, FD, 0);
        ATT_INTERVAL(i + 7, FC, FD, FA, FB, 1);
    }
    ATT_WAITV(0);
#undef ATT_INTERVAL
#undef ATT_MFMA
#undef ATT_DMAK
#undef ATT_DMAV
#undef ATT_WAITV
#undef ATT_PACK
#undef ATT_LDV
#undef ATT_LDK
#undef ATT_SB
    if (probe) { _Pragma("unroll") for (int i = 0; i < 4; ++i) asm volatile("" :: "v"(O[i])); asm volatile("" :: "v"(Ol), "v"(Sa), "v"(Sb), "v"(PfP), "v"(FA), "v"(FB)); __syncthreads(); return; }
    const float ls0 = __shfl(Ol[0], lane & 15), ls1 = __shfl(Ol[1], lane & 15); const float lsum = (lane & 16) ? ls1 : ls0;
    const float inv = fast_rcp(lsum);
    __syncthreads();
    LAS float* ex = (LAS float*)lds + qq * 4096;
    if (br == 1) { const float f = lam * inv;
#pragma unroll
        for (int dvb = 0; dvb < 4; ++dvb)
#pragma unroll
            for (int j = 0; j < 16; ++j) ex[(dvb * 16 + j) * 64 + lane] = O[dvb][j] * f; }
    __syncthreads();
    if (br == 0) { float ss = 0.f;
#pragma unroll
        for (int dvb = 0; dvb < 4; ++dvb)
#pragma unroll
            for (int j = 0; j < 16; ++j) {
#ifdef ATT_NOEX
                const float v = O[dvb][j] * inv;
#else
                const float v = O[dvb][j] * inv - ex[(dvb * 16 + j) * 64 + lane];
#endif
                O[dvb][j] = v; ss += v * v; }
        ss += __shfl_xor(ss, 32);
        const float rinv = __builtin_amdgcn_rsqf(ss * (1.0f / 128.0f) + EPS) * outscale;
        LAS unsigned char* ot = lds + 65536 + qq * 8704;
#pragma unroll
        for (int dvb = 0; dvb < 4; ++dvb)
#pragma unroll
            for (int a = 0; a < 4; ++a) { const int dv = 32 * dvb + 8 * a + 4 * hh; const f32x4 w = *(const f32x4*)(subw + dv);
                u32x2 o; o.x = pk2(O[dvb][4 * a] * rinv * w[0], O[dvb][4 * a + 1] * rinv * w[1]); o.y = pk2(O[dvb][4 * a + 2] * rinv * w[2], O[dvb][4 * a + 3] * rinv * w[3]);
                *(LAS u32x2*)(ot + l31 * 272 + 2 * dv) = o; }
        unsigned char* op = (unsigned char*)MIX + (size_t)(qrow0 + 32 * qq) * D + 512 + head * 128 + 8 * (lane & 15);
#pragma unroll
        for (int i = 0; i < 8; ++i) { const int r = 4 * i + (lane >> 4); const u32x4 v = *(const LAS u32x4*)(ot + r * 272 + 16 * (lane & 15)); u32x2 o;
            o.x = pk4_fp8(bflo(v.x) * SC_MIX, bfhi(v.x) * SC_MIX, bflo(v.y) * SC_MIX, bfhi(v.y) * SC_MIX); o.y = pk4_fp8(bflo(v.z) * SC_MIX, bfhi(v.z) * SC_MIX, bflo(v.w) * SC_MIX, bfhi(v.w) * SC_MIX);
            *(u32x2*)(op + (size_t)r * D) = o; } }
    __syncthreads();
}

__device__ __forceinline__ float log2_gamma(float logit) { return -__builtin_log2f(1.0f + fast_exp2(-logit * LOG2E)); }
__device__ __forceinline__ bf16x8 scale8(bf16x8 v, const float (&f)[8]) {
    const u32x4 w = __builtin_bit_cast(u32x4, v); u32x4 o;
    o.x = pk2(bflo(w.x) * f[0], bfhi(w.x) * f[1]); o.y = pk2(bflo(w.y) * f[2], bfhi(w.y) * f[3]); o.z = pk2(bflo(w.z) * f[4], bfhi(w.z) * f[5]); o.w = pk2(bflo(w.w) * f[6], bfhi(w.w) * f[7]);
    return __builtin_bit_cast(bf16x8, o);
}
__device__ __forceinline__ bf16x8 scale8s(bf16x8 v, float f) {
    const u32x4 w = __builtin_bit_cast(u32x4, v); u32x4 o;
    o.x = pk2(bflo(w.x) * f, bfhi(w.x) * f); o.y = pk2(bflo(w.y) * f, bfhi(w.y) * f); o.z = pk2(bflo(w.z) * f, bfhi(w.z) * f); o.w = pk2(bflo(w.w) * f, bfhi(w.w) * f);
    return __builtin_bit_cast(bf16x8, o);
}
__device__ __forceinline__ void ret_kv_unit(LAS unsigned char* lds, const bf16_t* P, bf16_t* KVT, const float* decay_logit  , int b, int j, int head) {
    const int tid = threadIdx.x, wid = __builtin_amdgcn_readfirstlane(tid >> 6), lane = tid & 63, eb = wid & 3, dir = wid >> 2, l31 = lane & 31, hh = lane >> 5;
    const int rbase = b * SEQU + 128 * j;
    LAS unsigned char* vimg = lds; LAS unsigned char* kimg = lds + 32768;
    __syncthreads();
    stage_offb(vimg, P + (size_t)rbase * LDP + OFF_RV + head * 128, LDP, 128, tid);
    stage_offb(kimg, P + (size_t)rbase * LDP + OFF_RK + head * 128, LDP, 128, tid);
    const float l2g = log2_gamma(decay_logit[dir * 4 + head]);
    asm volatile("s_waitcnt vmcnt(0)" ::: "memory"); __syncthreads();
    f32x16 acc[4];
#pragma unroll
    for (int i = 0; i < 4; ++i)
#pragma unroll
        for (int q = 0; q < 16; ++q) acc[i][q] = 0.f;
#pragma unroll 2
    for (int ks = 0; ks < 8; ++ks) {
        const unsigned rb = 16 * ks + 8 * hh;
        bf16x8 vf = ld_tr2(vimg + tr_addr(lane, rb, eb), vimg + tr_addr(lane, rb + 4, eb));
        float f[8];
#pragma unroll
        for (int q = 0; q < 8; ++q) { const int i = (int)rb + q; f[q] = fast_exp2(l2g * (float)(dir == 0 ? 127 - i : i)); }
        vf = scale8(vf, f);
#pragma unroll
        for (int db = 0; db < 4; ++db) { const bf16x8 kf = ld_tr2(kimg + tr_addr(lane, rb, db), kimg + tr_addr(lane, rb + 4, db)); acc[db] = mfma32(vf, kf, acc[db]); }
    }
    bf16_t* out = KVT + ((((size_t)(b * 4 + head) * 2 + dir) * NCH128 + j) << 14);
#pragma unroll
    for (int db = 0; db < 4; ++db)
#pragma unroll
        for (int q = 0; q < 16; ++q) { const int e = 32 * eb + (q & 3) + 8 * (q >> 2) + 4 * hh; const float v = acc[db][q], vn = __shfl_xor(v, 1);
            if ((lane & 1) == 0) *(unsigned*)(out + e * 128 + 32 * db + l31) = pk2(v, vn); }
    __syncthreads();
}
__device__ __forceinline__ void ret_state_phase(const bf16_t* KVT, bf16_t* ST, const float* decay_logit, int gtid, int gn) {
    for (int id = gtid; id < 16 * 8192; id += gn) {
        const int seq = id >> 13, el = (id & 8191) * 2, dir = seq & 1, head = (seq >> 1) & 3;
        const float G = fast_exp2(128.0f * log2_gamma(decay_logit[dir * 4 + head]));
        const bf16_t* kv = KVT + ((size_t)seq * NCH128 << 14) + el; bf16_t* st = ST + ((size_t)seq * NCH128 << 14) + el;
        float s0 = 0.f, s1 = 0.f;
        for (int sb = 0; sb < NCH128; sb += 22) {
            unsigned kk[22]; int jj[22];
#pragma unroll
            for (int q = 0; q < 22; ++q) { const int s = sb + q; jj[q] = dir == 0 ? s : (s == 0 ? 1 : s == 1 ? 0 : 67 - s); kk[q] = *(const unsigned*)(kv + ((size_t)jj[q] << 14)); }
#pragma unroll
            for (int q = 0; q < 22; ++q) { *(unsigned*)(st + ((size_t)jj[q] << 14)) = pk2(s0, s1); s0 = s0 * G + bflo(kk[q]); s1 = s1 * G + bfhi(kk[q]); }
        }
    }
}
__device__ __forceinline__ void ret_out_unit(LAS unsigned char* lds, const bf16_t* P, const bf16_t* ST, bf16_t* MIX, const float* decay_logit, const float* normw, int b, int j, int hp) {
    const int tid = threadIdx.x, wid = __builtin_amdgcn_readfirstlane(tid >> 6), lane = tid & 63, hsel = wid >> 2, qq = wid & 3, l31 = lane & 31, hh = lane >> 5;
    const int head = 2 * hp + hsel, rbase = b * SEQU + 128 * j, qi = 32 * qq + l31, qrow = rbase + qi;
    LAS unsigned char* vimg = lds + hsel * 32768; LAS unsigned char* kimg = lds + 65536 + hsel * 32768;
    __syncthreads();
    stage_offb(lds, P + (size_t)rbase * LDP + OFF_RV + (2 * hp) * 128, LDP, 128, tid);
    stage_offb(lds + 32768, P + (size_t)rbase * LDP + OFF_RV + (2 * hp + 1) * 128, LDP, 128, tid);
    stage_offb(lds + 65536, P + (size_t)rbase * LDP + OFF_RK + (2 * hp) * 128, LDP, 128, tid);
    stage_offb(lds + 98304, P + (size_t)rbase * LDP + OFF_RK + (2 * hp + 1) * 128, LDP, 128, tid);
    const float l2f = log2_gamma(decay_logit[head]), l2b = log2_gamma(decay_logit[4 + head]);
    bf16x8 Qf[8];
#pragma unroll
    for (int ks = 0; ks < 8; ++ks) Qf[ks] = *(const bf16x8*)(P + (size_t)qrow * LDP + OFF_RQ + head * 128 + 16 * ks + 8 * hh);
    f32x16 O[4];
#pragma unroll
    for (int i = 0; i < 4; ++i)
#pragma unroll
        for (int q = 0; q < 16; ++q) O[i][q] = 0.f;
    asm volatile("s_waitcnt vmcnt(0)" ::: "memory"); __syncthreads();
    for (int kb = 0; kb < 4; ++kb) {
        f32x16 S; const float z0 = opaque_zero();
#pragma unroll
        for (int q = 0; q < 16; ++q) S[q] = z0;
#pragma unroll
        for (int ks = 0; ks < 8; ++ks) { const bf16x8 kf = *(const LAS bf16x8_a*)(kimg + off_b(32 * kb + l31, 2 * ks + hh)); S = mfma32(kf, Qf[ks], S); }
#pragma unroll
        for (int q = 0; q < 16; ++q) { const int ik = 32 * kb + (q & 3) + 8 * (q >> 2) + 4 * hh, dlt = qi - ik;
            const float m = (dlt >= 0 ? fast_exp2(l2f * (float)dlt) : 0.f) + (dlt <= 0 ? fast_exp2(l2b * (float)(-dlt)) : 0.f); S[q] *= m; }
#pragma unroll
        for (int s = 0; s < 2; ++s) { const bf16x8 pf = pack8(S, s); const unsigned rb = 32 * kb + 16 * s + 4 * hh;
#pragma unroll
            for (int eb = 0; eb < 4; ++eb) { const bf16x8 vf = ld_tr2(vimg + tr_addr(lane, rb, eb), vimg + tr_addr(lane, rb + 8, eb)); O[eb] = mfma32(vf, pf, O[eb]); } }
    }
    __syncthreads();
#pragma unroll
    for (int t = 0; t < 4; ++t) stage_offb(lds + t * 32768, ST + ((((size_t)(b * 4 + 2 * hp + (t >> 1)) * 2 + (t & 1)) * NCH128 + j) << 14), 128, 128, tid);
    asm volatile("s_waitcnt vmcnt(0)" ::: "memory"); __syncthreads();
#pragma unroll
    for (int dir = 0; dir < 2; ++dir) {
        const float qd = dir == 0 ? fast_exp2(l2f * (float)(qi + 1)) : fast_exp2(l2b * (float)(128 - qi));
        const LAS unsigned char* simg = lds + (hsel * 2 + dir) * 32768;
#pragma unroll
        for (int ks = 0; ks < 8; ++ks) { const bf16x8 qs = scale8s(Qf[ks], qd);
#pragma unroll
            for (int eb = 0; eb < 4; ++eb) { const bf16x8 sf = *(const LAS bf16x8_a*)(simg + off_b(32 * eb + l31, 2 * ks + hh)); O[eb] = mfma32(sf, qs, O[eb]); } }
    }
    float sm = 0.f;
#pragma unroll
    for (int eb = 0; eb < 4; ++eb)
#pragma unroll
        for (int q = 0; q < 16; ++q) sm += O[eb][q];
    sm += __shfl_xor(sm, 32); const float mu = sm * (1.0f / 128.0f);
    float vs = 0.f;
#pragma unroll
    for (int eb = 0; eb < 4; ++eb)
#pragma unroll
        for (int q = 0; q < 16; ++q) { const float d = O[eb][q] - mu; O[eb][q] = d; vs += d * d; }
    vs += __shfl_xor(vs, 32); const float rinv = __builtin_amdgcn_rsqf(vs * (1.0f / 128.0f) + EPS);
    __syncthreads();
    LAS unsigned char* ot = lds + wid * 8704;
#pragma unroll
    for (int eb = 0; eb < 4; ++eb)
#pragma unroll
        for (int a = 0; a < 4; ++a) { const int e = 32 * eb + 8 * a + 4 * hh; const f32x4 w = *(const f32x4*)(normw + head * 128 + e);
            u32x2 o; o.x = pk2(O[eb][4 * a] * rinv * w[0], O[eb][4 * a + 1] * rinv * w[1]); o.y = pk2(O[eb][4 * a + 2] * rinv * w[2], O[eb][4 * a + 3] * rinv * w[3]);
            *(LAS u32x2*)(ot + l31 * 272 + 2 * e) = o; }
    int ln = lane; asm volatile("" : "+v"(ln));
#pragma unroll
    for (int i = 0; i < 8; ++i) { const int r = 4 * i + (ln >> 4), c8 = 8 * (ln & 15); const size_t row = (size_t)(rbase + 32 * qq + r);
        const u32x4 v = *(const LAS u32x4*)(ot + r * 272 + 2 * c8), g = *(const u32x4*)(P + row * LDP + OFF_RG + head * 128 + c8);
        u32x2 o; o.x = pk4_fp8(bflo(v.x) * bflo(g.x) * SC_MIX, bfhi(v.x) * bfhi(g.x) * SC_MIX, bflo(v.y) * bflo(g.y) * SC_MIX, bfhi(v.y) * bfhi(g.y) * SC_MIX);
        o.y = pk4_fp8(bflo(v.z) * bflo(g.z) * SC_MIX, bfhi(v.z) * bfhi(g.z) * SC_MIX, bflo(v.w) * bflo(g.w) * SC_MIX, bfhi(v.w) * bfhi(g.w) * SC_MIX);
        *(u32x2*)((unsigned char*)MIX + row * D + head * 128 + c8) = o; }
    __syncthreads();
}

typedef unsigned __attribute__((may_alias)) u32_a;
typedef unsigned short __attribute__((may_alias)) u16_a;
__device__ __forceinline__ f32x4 mfma16(bf16x8 a, bf16x8 b, f32x4 c) { return __builtin_amdgcn_mfma_f32_16x16x32_bf16(a, b, c, 0, 0, 0); }
struct S5Ops { bf16x8 uf, bre, bim; };
__device__ __forceinline__ S5Ops s5_scan_load(const bf16_t* P, const bf16_t* BFp  , int rbase, int g, int dir, int lane) {
    const int rho = lane & 31, hk = lane >> 5;
    const int tscan = 16 * ((rho >> 2) & 1) + 4 * (rho >> 3) + (rho & 3), tok = dir == 0 ? tscan : 31 - tscan;
    S5Ops o; o.uf = *(const bf16x8*)(P + (size_t)(rbase + tok) * LDP + OFF_U + 16 * g + 8 * hk);
    o.bre = *(const bf16x8*)(BFp + lane * 8); o.bim = *(const bf16x8*)(BFp + 512 + lane * 8); return o;
}
__device__ __forceinline__ void s5_scan_core(const S5Ops& ops, int lane, f32x2 a, f32x2 init, f32x16& xr, f32x16& xi, const bool endonly = false, f32x2 a16 = (f32x2){0.f, 0.f});
__device__ __forceinline__ void s5_scan(const bf16_t* P, const bf16_t* BFp, int rbase, int g, int dir, int lane, f32x2 a, f32x2 init, f32x16& xr, f32x16& xi, const bool endonly = false, f32x2 a16 = (f32x2){0.f, 0.f}) {
    const S5Ops ops = s5_scan_load(P, BFp, rbase, g, dir, lane); s5_scan_core(ops, lane, a, init, xr, xi, endonly, a16);
}
__device__ __forceinline__ void s5_scan_core(const S5Ops& ops, int lane, f32x2 a, f32x2 init, f32x16& xr, f32x16& xi, const bool endonly, f32x2 a16) {
    const int hk = lane >> 5;
    const bf16x8 uf = ops.uf, bre = ops.bre, bim = ops.bim;
    const float zero = opaque_zero();
    f32x16 zr, zi;
#pragma unroll
    for (int q = 0; q < 16; ++q) { zr[q] = zero; zi[q] = zero; }
    const f32x16 br = mfma32(uf, bre, zr), bi = mfma32(uf, bim, zi);
#ifdef S5_NOSCAN
#pragma unroll
    for (int q = 0; q < 16; ++q) { xr[q] = br[q]; xi[q] = bi[q]; }
    return;
#endif
#ifdef S5_USEA
#pragma unroll
    for (int q = 0; q < 16; ++q) { xr[q] = br[q] * a[0] + init[0]; xi[q] = bi[q] * a[1] + init[1]; }
    return;
#endif
    float sr = hk == 0 ? init[0] : 0.f, si = hk == 0 ? init[1] : 0.f;
#pragma unroll
    for (int q = 0; q < 16; ++q) { float nr = __builtin_fmaf(a[0], sr, __builtin_fmaf(-a[1], si, br[q])), ni = __builtin_fmaf(a[0], si, __builtin_fmaf(a[1], sr, bi[q])); asm("" : "+v"(nr)); asm("" : "+v"(ni)); sr = nr; si = ni; xr[q] = sr; xi[q] = si; }
#ifdef S5_NOFIX
    return;
#endif
    float er = __shfl(sr, lane & 31), ei = __shfl(si, lane & 31);
    if (hk == 0) { er = 0.f; ei = 0.f; }
    if (endonly) {
        float t0 = __builtin_fmaf(a16[0], er, __builtin_fmaf(-a16[1], ei, xr[15])), t1 = __builtin_fmaf(a16[0], ei, __builtin_fmaf(a16[1], er, xi[15])); asm("" : "+v"(t0)); asm("" : "+v"(t1)); xr[15] = t0; xi[15] = t1; return; }
    float wr_ = a[0], wi_ = a[1];
#pragma unroll
    for (int q = 0; q < 16; ++q) { float t0 = __builtin_fmaf(wr_, er, __builtin_fmaf(-wi_, ei, xr[q])), t1 = __builtin_fmaf(wr_, ei, __builtin_fmaf(wi_, er, xi[q])); asm("" : "+v"(t0)); asm("" : "+v"(t1)); xr[q] = t0; xi[q] = t1;
        float nr = __builtin_fmaf(wr_, a[0], -wi_ * a[1]), ni = __builtin_fmaf(wr_, a[1], wi_ * a[0]); asm("" : "+v"(nr)); asm("" : "+v"(ni)); wr_ = nr; wi_ = ni; }
}
__device__ __forceinline__ void s5_end_unit(const Args& A, int l, int b, int c) {
    const int tid = threadIdx.x, wid = __builtin_amdgcn_readfirstlane(tid >> 6), lane = tid & 63;
    const bf16_t* P = (const bf16_t*)(A.ws + WS_P); const f32x2* SA = (const f32x2*)(A.ws + WS_S5A); const bf16_t* BF = (const bf16_t*)(A.ws + WS_S5BF); f32x2* E = (f32x2*)(A.ws + WS_S5E);
    const int rbase = b * SEQU + 32 * c;
    for (int gi = 0; gi < 4; ++gi) { const int g = 4 * wid + gi;
#pragma unroll
        for (int d = 0; d < 2; ++d)
#pragma unroll
            for (int pb = 0; pb < 2; ++pb) { const int p = 32 * pb + (lane & 31); const f32x2 a = SA[((l * 2 + d) * 32 + g) * 64 + p];
                f32x16 xr, xi; s5_scan(P, BF + ((((size_t)(l * 2 + d) * 32 + g) * 2 + pb) * 2) * 512, rbase, g, d, lane, a, (f32x2){0.f, 0.f}, xr, xi, true, SA[S5A_N + ((l * 2 + d) * 32 + g) * 64 + p]);
                if (lane >= 32) E[(((size_t)(b * 2 + d) * NCH32 + c) * 32 + g) * 64 + p] = (f32x2){xr[15], xi[15]}; }
    }
}
__device__ __forceinline__ void s5_carry_phase(const Args& A, int l, LAS unsigned char* lds, int vcu, int G) {
    const int tid = threadIdx.x, wid = __builtin_amdgcn_readfirstlane(tid >> 6), lane = tid & 63;
    const f32x2* SA = (const f32x2*)(A.ws + WS_S5A) + 2 * S5A_N; const f32x2* E = (const f32x2*)(A.ws + WS_S5E); f32x2* XC = (f32x2*)(A.ws + WS_S5X);
    LAS f32x2* T = (LAS f32x2*)lds;
    for (int u = G - 1 - vcu; u < 128; u += G) { const int gp = (u & 31) * 64 + lane, d = (u >> 5) & 1, b = u >> 6;
        const f32x2 a = SA[(l * 2 + d) * 2048 + gp]; const size_t base = (size_t)(b * 2 + d) * NCH32 * 2048 + gp;
        f32x2 ev[33];
#pragma unroll
        for (int q = 0; q < 33; ++q) { const int s = 33 * wid + q, cc = d == 0 ? s : (s < 8 ? 7 - s : 271 - s); ev[q] = E[base + (size_t)cc * 2048]; }
        float pr = 0.f, pi = 0.f;
#pragma unroll
        for (int q = 0; q < 33; ++q) { const f32x2 e = ev[q]; ev[q] = (f32x2){pr, pi}; const float nr = a[0] * pr - a[1] * pi + e[0], ni = a[0] * pi + a[1] * pr + e[1]; pr = nr; pi = ni; }
        __syncthreads();
        T[wid * 64 + lane] = (f32x2){pr, pi};
        float wr_ = 1.f, wi_ = 0.f;
#pragma unroll
        for (int q = 0; q < 33; ++q) { const float nr = wr_ * a[0] - wi_ * a[1], ni = wr_ * a[1] + wi_ * a[0]; wr_ = nr; wi_ = ni; }
        __syncthreads();
        float cr = 0.f, ci = 0.f;
        for (int v = 0; v < wid; ++v) { const f32x2 t = T[v * 64 + lane]; const float nr = wr_ * cr - wi_ * ci + t[0], ni = wr_ * ci + wi_ * cr + t[1]; cr = nr; ci = ni; }
#pragma unroll
        for (int q = 0; q < 33; ++q) { const int s = 33 * wid + q, cc = d == 0 ? s : (s < 8 ? 7 - s : 271 - s);
            XC[base + (size_t)cc * 2048] = (f32x2){ev[q][0] + cr, ev[q][1] + ci}; const float nr = a[0] * cr - a[1] * ci, ni = a[0] * ci + a[1] * cr; cr = nr; ci = ni; }
    }
}
constexpr int S5_XPITCH = 272, S5_XIMG = 32 * S5_XPITCH  , S5_YOFF = 8 * S5_XIMG  , S5_YPITCH = 1040;
__device__ __forceinline__ void s5_out_unit(LAS unsigned char* lds, const Args& A, int l, int b, int c) {
    const int tid = threadIdx.x, wid = __builtin_amdgcn_readfirstlane(tid >> 6), lane = tid & 63, l31 = lane & 31, hk = lane >> 5, l15 = lane & 15, kq = lane >> 4;
    const bf16_t* P = (const bf16_t*)(A.ws + WS_P); const f32x2* SA = (const f32x2*)(A.ws + WS_S5A); const bf16_t* BF = (const bf16_t*)(A.ws + WS_S5BF); const bf16_t* CF = (const bf16_t*)(A.ws + WS_S5CF);
    const f32x2* XC = (const f32x2*)(A.ws + WS_S5X); bf16_t* MIX = (bf16_t*)(A.ws + WS_MIX); const bf16_t* GLU = (const bf16_t*)(A.ws + WS_GLU) + (size_t)l * 512 * 512;
    const int rbase = b * SEQU + 32 * c;
    LAS unsigned char* ximg = lds + wid * S5_XIMG; LAS unsigned char* yimg = lds + S5_YOFF;
    __syncthreads();
#ifdef S5_COPYU
    for (int i = tid; i < 32 * 64; i += NTHR) { const int t = i >> 6, c8 = (i & 63) * 8; *(u32x4*)(MIX + (size_t)(rbase + t) * D + 1536 + c8) = *(const u32x4*)(P + (size_t)(rbase + t) * LDP + OFF_U + c8); }
    __syncthreads(); return;
#endif
    for (int gi = 0; gi < 4; ++gi) { const int g = 4 * wid + gi;
        const float z0 = opaque_zero(); f32x4 ya[2] = {{z0, z0, z0, z0}, {z0, z0, z0, z0}};
        bf16x8 cfr[4];
#pragma unroll
        for (int ks = 0; ks < 4; ++ks) cfr[ks] = *(const bf16x8*)(CF + (((size_t)l * 32 + g) * 4 + ks) * 512 + lane * 8);
        const int ch = 16 * g + l15; const float dv = A.s5_d[l * 512 + ch]; unsigned short uraw[2][4];
#pragma unroll
        for (int rb = 0; rb < 2; ++rb)
#pragma unroll
            for (int q = 0; q < 4; ++q) uraw[rb][q] = P[(size_t)(rbase + 16 * rb + 4 * kq + q) * LDP + OFF_U + ch];
        S5Ops sops[2][2]; f32x2 sa_[2][2], sin_[2][2];
#pragma unroll
        for (int d = 0; d < 2; ++d)
#pragma unroll
            for (int pb = 0; pb < 2; ++pb) { const int p = 32 * pb + l31; sops[d][pb] = s5_scan_load(P, BF + ((((size_t)(l * 2 + d) * 32 + g) * 2 + pb) * 2) * 512, rbase, g, d, lane);
                sa_[d][pb] = SA[((l * 2 + d) * 32 + g) * 64 + p];
#ifdef S5_NOINIT
                sin_[d][pb] = (f32x2){0.f, 0.f};
#else
                sin_[d][pb] = XC[(((size_t)(b * 2 + d) * NCH32 + c) * 32 + g) * 64 + p];
#endif
            }
#pragma unroll
        for (int d = 0; d < 2; ++d) {
#pragma unroll
            for (int pb = 0; pb < 2; ++pb) { const int p = 32 * pb + l31;
                f32x16 xr, xi; s5_scan_core(sops[d][pb], lane, sa_[d][pb], sin_[d][pb], xr, xi);
#pragma unroll
                for (int q = 0; q < 16; ++q) { const int ts = 16 * hk + q, t = d == 0 ? ts : 31 - ts;
                    *(LAS u32_a*)(ximg + t * S5_XPITCH + 4 * p) = pk2(xr[q], xi[q]); } }
            asm volatile("s_waitcnt lgkmcnt(0)" ::: "memory");
#pragma unroll
            for (int ks = 0; ks < 4; ++ks) { const bf16x8 cf = cfr[ks];
#pragma unroll
                for (int rb = 0; rb < 2; ++rb) { const bf16x8 xf = *(const LAS bf16x8_a*)(ximg + (16 * rb + l15) * S5_XPITCH + 2 * (32 * ks + 8 * kq)); ya[rb] = mfma16(xf, cf, ya[rb]); } }
            asm volatile("s_waitcnt lgkmcnt(0)" ::: "memory");
        }
#pragma unroll
        for (int rb = 0; rb < 2; ++rb)
#pragma unroll
            for (int q = 0; q < 4; ++q) { const int t = 16 * rb + 4 * kq + q; const float u = bf2f(uraw[rb][q]);
                const float yv = gelu_tanh(ya[rb][q] + dv * u), yn = __shfl_xor(yv, 1);
                if ((lane & 1) == 0) *(LAS u32_a*)(yimg + t * S5_YPITCH + 2 * ch) = pk2(yv, yn); }
    }
    __syncthreads();
    f32x16 z[2];
#pragma unroll
    for (int nb = 0; nb < 2; ++nb)
#pragma unroll
        for (int q = 0; q < 16; ++q) z[nb][q] = 0.f;
#ifndef S5_NOGLU
#pragma unroll 4
    for (int ks = 0; ks < 32; ++ks) { const bf16x8 yf = *(const LAS bf16x8_a*)(yimg + l31 * S5_YPITCH + 2 * (16 * ks + 8 * hk));
#pragma unroll
        for (int nb = 0; nb < 2; ++nb) { const bf16x8 wf = *(const bf16x8*)(GLU + ((size_t)((((wid * 2 + nb) * 32 + ks) * 2 + hk) * 32 + l31) << 3)); z[nb] = mfma32(yf, wf, z[nb]); } }
#endif
#pragma unroll
    for (int nb = 0; nb < 2; ++nb)
#pragma unroll
        for (int q = 0; q < 16; ++q) { const int t = (q & 3) + 8 * (q >> 2) + 4 * hk, n = 64 * wid + 32 * nb + l31;
            const float y = bf2f(*(const LAS u16_a*)(yimg + t * S5_YPITCH + 2 * n));
            const float ov = y * sigmoidf_(z[nb][q]) * SC_MIX, on = __shfl_xor(ov, 1);
            const unsigned p2 = (unsigned)__builtin_amdgcn_cvt_pk_fp8_f32(__builtin_amdgcn_fmed3f(ov, -448.f, 448.f), __builtin_amdgcn_fmed3f(on, -448.f, 448.f), 0, false) & 0xffffu, p4 = __shfl_xor(p2, 2);
            if ((lane & 3) == 0) *(unsigned*)((unsigned char*)MIX + (size_t)(rbase + t) * D + 1536 + n) = p2 | (p4 << 16); }
    __syncthreads();
}

constexpr int RT_RS = 0, RT_PART = 1024, RT_SC = RT_PART + 8 * 32 * 64 * 4  , RT_SEL = RT_SC + 32 * 65 * 4, RT_E = RT_SEL + 32 * 65 * 4, RT_CNT = RT_E + 32 * 8 * 4, RT_BASE = RT_CNT + 256, RT_END = RT_BASE + 256;
__device__ __forceinline__ void route_unit(LAS unsigned char* lds, const Args& A, int l, int r0, bool dry = false) {
    const int tid = threadIdx.x, wid = __builtin_amdgcn_readfirstlane(tid >> 6), lane = tid & 63, l31 = lane & 31, hk = lane >> 5;
    const bf16_t* X = (const bf16_t*)(A.ws + WS_X); bf16_t* H = (bf16_t*)(A.ws + WS_H); const float* MOD = (const float*)(A.ws + WS_MOD); const bf16_t* RWH = (const bf16_t*)(A.ws + WS_RWT) + (size_t)l * NEXP * D; const bf16_t* RWL = RWH + (size_t)2 * NEXP * D;
    LAS float* rs = (LAS float*)(lds + RT_RS); LAS float* part = (LAS float*)(lds + RT_PART); LAS float* sc = (LAS float*)(lds + RT_SC); LAS float* sel = (LAS float*)(lds + RT_SEL);
    LAS int* rowE = (LAS int*)(lds + RT_E); LAS int* cntL = (LAS int*)(lds + RT_CNT); LAS int* baseL = (LAS int*)(lds + RT_BASE);
    const int mi = mod_index(r0); const float* mod = MOD + ((size_t)l * 3 + mi) * MODW; const float* sh = mod + 3 * D; const float* scv = mod + 4 * D; const float* nw = A.norm2_w + (size_t)l * D;
    LAS unsigned char* xt = lds + wid * 16384; LAS float* ssp = (LAS float*)(lds + 132096);
    __syncthreads();
    {
#pragma unroll
        for (int h = 0; h < 2; ++h) { u32x2 xv[16];
#pragma unroll
            for (int j = 0; j < 16; ++j) xv[j] = *(const u32x2*)(X + (size_t)(r0 + 16 * h + j) * D + 256 * wid + 4 * lane);
#pragma unroll
            for (int j = 0; j < 16; ++j) { const int row = 16 * h + j; *(LAS u32x2*)(xt + row * 512 + 8 * (lane ^ row)) = xv[j]; } }
    }
    float rstd;
    {
        float ss = 0.f;
#pragma unroll 8
        for (int c = 0; c < 32; ++c) { const u32x2 w = *(const LAS u32x2*)(xt + l31 * 512 + 8 * ((2 * c + hk) ^ l31)); const float a = bflo(w.x), b2 = bfhi(w.x), c2 = bflo(w.y), d2 = bfhi(w.y); ss += a * a + b2 * b2 + c2 * c2 + d2 * d2; }
        ss += __shfl_xor(ss, 32);
        if (hk == 0) ssp[wid * 32 + l31] = ss;
        __syncthreads();
        float t = 0.f;
#pragma unroll
        for (int w = 0; w < 8; ++w) t += ssp[w * 32 + l31];
        rstd = __builtin_amdgcn_rsqf(t * (1.0f / D) + EPS);
    }
    if (!dry) {
        const int col = 256 * wid + 4 * lane; const f32x4 cw = *(const f32x4*)(nw + col) * (1.0f + *(const f32x4*)(scv + col)), s0 = *(const f32x4*)(sh + col);
#pragma unroll 8
        for (int j = 0; j < 32; ++j) { const u32x2 w = *(const LAS u32x2*)(xt + j * 512 + 8 * (lane ^ j)); const float rj = __shfl(rstd, j);
            f32x4 xv; xv[0] = bflo(w.x); xv[1] = bfhi(w.x); xv[2] = bflo(w.y); xv[3] = bfhi(w.y);
            const f32x4 h2 = xv * rj * cw + s0;
            *(unsigned*)(A.ws + WS_H8 + (size_t)(r0 + j) * D + col) = pk4_fp8(h2[0] * SC_H8, h2[1] * SC_H8, h2[2] * SC_H8, h2[3] * SC_H8); }
    }
    {
        f32x16 acc[2];
#pragma unroll
        for (int cb = 0; cb < 2; ++cb)
#pragma unroll
            for (int q = 0; q < 16; ++q) acc[cb][q] = 0.f;
#pragma unroll 2
        for (int m = 0; m < 16; ++m) { const int k0 = 256 * wid + 16 * m + 8 * hk, c0 = 4 * m + 2 * hk;
            const u32x2 xa = *(const LAS u32x2*)(xt + l31 * 512 + 8 * (c0 ^ l31)), xb = *(const LAS u32x2*)(xt + l31 * 512 + 8 * ((c0 + 1) ^ l31));
            f32x4 x0, x1; x0[0] = bflo(xa.x); x0[1] = bfhi(xa.x); x0[2] = bflo(xa.y); x0[3] = bfhi(xa.y); x1[0] = bflo(xb.x); x1[1] = bfhi(xb.x); x1[2] = bflo(xb.y); x1[3] = bfhi(xb.y);
            const f32x4 h0 = x0 * rstd * *(const f32x4*)(nw + k0) * (1.0f + *(const f32x4*)(scv + k0)) + *(const f32x4*)(sh + k0);
            const f32x4 h1 = x1 * rstd * *(const f32x4*)(nw + k0 + 4) * (1.0f + *(const f32x4*)(scv + k0 + 4)) + *(const f32x4*)(sh + k0 + 4);
            u32x4 hw, lw;
            hw.x = pk2(h0[0], h0[1]); hw.y = pk2(h0[2], h0[3]); hw.z = pk2(h1[0], h1[1]); hw.w = pk2(h1[2], h1[3]);
            lw.x = pk2(h0[0] - bflo(hw.x), h0[1] - bfhi(hw.x)); lw.y = pk2(h0[2] - bflo(hw.y), h0[3] - bfhi(hw.y)); lw.z = pk2(h1[0] - bflo(hw.z), h1[1] - bfhi(hw.z)); lw.w = pk2(h1[2] - bflo(hw.w), h1[3] - bfhi(hw.w));
            const bf16x8 ah = __builtin_bit_cast(bf16x8, hw), al = __builtin_bit_cast(bf16x8, lw);
#pragma unroll
            for (int cb = 0; cb < 2; ++cb) { const size_t fo = (size_t)((((cb * 128 + 16 * wid + m) * 2 + hk) * 32 + l31) << 3); const bf16x8 bh = *(const bf16x8*)(RWH + fo), bl = *(const bf16x8*)(RWL + fo);
                acc[cb] = __builtin_amdgcn_mfma_f32_32x32x16_bf16(ah, bh, acc[cb], 0, 0, 0); acc[cb] = __builtin_amdgcn_mfma_f32_32x32x16_bf16(ah, bl, acc[cb], 0, 0, 0); acc[cb] = __builtin_amdgcn_mfma_f32_32x32x16_bf16(al, bh, acc[cb], 0, 0, 0); } }
        __syncthreads();
        if (tid < 64) cntL[tid] = 0;
#pragma unroll
        for (int cb = 0; cb < 2; ++cb)
#pragma unroll
            for (int q = 0; q < 16; ++q) part[(wid * 32 + (q & 3) + 8 * (q >> 2) + 4 * hk) * 64 + 32 * cb + l31] = acc[cb][q];
    }
    __syncthreads();
    for (int i = tid; i < 2048; i += NTHR) { float s = 0.f;
#pragma unroll
        for (int w = 0; w < 8; ++w) s += part[w * 2048 + i];
        const int row = i >> 6, e = i & 63; const float sg = 1.0f / (1.0f + __expf(-s)); sc[row * 65 + e] = sg; sel[row * 65 + e] = sg + A.router_b[l * NEXP + e]; }
    __syncthreads();
    {
        const int e = lane, g = e >> 3;
        for (int rr = 0; rr < 4; ++rr) { const int ri = 4 * wid + rr; const float sv = sel[ri * 65 + e], pv = sc[ri * 65 + e];
            int gr = 0;
#pragma unroll
            for (int k = 0; k < 8; ++k) { const float o = __shfl(sv, (e & ~7) + k); gr += (o > sv || (o == sv && k < (e & 7))) ? 1 : 0; }
            float gs = gr < 2 ? sv : 0.f; gs += __shfl_xor(gs, 1); gs += __shfl_xor(gs, 2); gs += __shfl_xor(gs, 4);
            int grk = 0;
#pragma unroll
            for (int k = 0; k < 8; ++k) { const float o = __shfl(gs, 8 * k); grk += (o > gs || (o == gs && k < g)) ? 1 : 0; }
            const bool allowed = grk < 4; const float mv = allowed ? sv : -INFINITY;
            int rk = 0;
#pragma unroll 4
            for (int k = 0; k < 64; ++k) { const float o = __shfl(mv, k); rk += (o > mv || (o == mv && k < e)) ? 1 : 0; }
            const bool pick = allowed && rk < 8;
            const float wsum = wave_sum(pick ? pv : 0.f);
            if (pick) { rowE[ri * 8 + rk] = e;
                if (!dry) { const int row = r0 + ri; ((int*)(A.ws + WS_TKE))[(size_t)row * 8 + rk] = e; ((float*)(A.ws + WS_TKW))[(size_t)row * 8 + rk] = pv * (2.5f / wsum); } }
        }
    }
    __syncthreads();
    int myrank = 0, mye = 0;
    if (tid < 256) { mye = rowE[tid]; myrank = __hip_atomic_fetch_add(&cntL[mye], 1, __ATOMIC_RELAXED, __HIP_MEMORY_SCOPE_WORKGROUP); }
    __syncthreads();
    if (dry) { __syncthreads(); return; }
    if (tid < 64) { const int n = cntL[tid]; baseL[tid] = n ? atomicAdd((int*)(A.ws + WS_CTL) + CW_CNT + l * 64 + tid, n) : 0; }
    __syncthreads();
    if (tid < 256) { const int pos = baseL[mye] + myrank; ((int*)(A.ws + WS_LIST))[(size_t)mye * TALL + pos] = r0 + (tid >> 3); ((int*)(A.ws + WS_TKP))[(size_t)(r0 + (tid >> 3)) * 8 + (tid & 7)] = pos; }
    __syncthreads();
}

__device__ __forceinline__ void combine_row(const Args& A, int l, int row, const LAS int* tileP, int lane, bool dry = false) {
    const int b = row / SEQU, pos = row - b * SEQU; if (l == 1 && pos < CTX) return;
    bf16_t* X = (bf16_t*)(A.ws + WS_X) + (size_t)row * D; const unsigned char* Y = A.ws + WS_Y; const float* MOD = (const float*)(A.ws + WS_MOD);
    const int mi = pos < CTX ? 2 : b; const float* g2 = MOD + ((size_t)l * 3 + mi) * MODW + 5 * D;
    const int* tke = (const int*)(A.ws + WS_TKE) + (size_t)row * 8; const int* tkp = (const int*)(A.ws + WS_TKP) + (size_t)row * 8; const float* tkw = (const float*)(A.ws + WS_TKW) + (size_t)row * 8;
    const unsigned char* yr[8]; float w[8];
#pragma unroll
    for (int s = 0; s < 8; ++s) { const int e = tke[s]; yr[s] = Y + (size_t)(256 * tileP[e] + tkp[s]) * D; w[s] = tkw[s] * (1.0f / SC_Y); }
    f32x4 xo[4][2]; float ss = 0.f;
#pragma unroll
    for (int c4 = 0; c4 < 4; ++c4) { const int col = 512 * c4 + 8 * lane; f32x4 a0 = {0.f, 0.f, 0.f, 0.f}, a1 = a0;
#pragma unroll
        for (int s = 0; s < 8; ++s) { const u32x2 y = *(const u32x2*)(yr[s] + col);
            const f32x2 p0 = __builtin_amdgcn_cvt_pk_f32_fp8((int)y.x, false), p1 = __builtin_amdgcn_cvt_pk_f32_fp8((int)y.x, true), p2 = __builtin_amdgcn_cvt_pk_f32_fp8((int)y.y, false), p3 = __builtin_amdgcn_cvt_pk_f32_fp8((int)y.y, true);
            a0[0] += w[s] * p0[0]; a0[1] += w[s] * p0[1]; a0[2] += w[s] * p1[0]; a0[3] += w[s] * p1[1]; a1[0] += w[s] * p2[0]; a1[1] += w[s] * p2[1]; a1[2] += w[s] * p3[0]; a1[3] += w[s] * p3[1]; }
        const f32x4 x0 = ld_bf16x4(X + col) + *(const f32x4*)(g2 + col) * a0, x1 = ld_bf16x4(X + col + 4) + *(const f32x4*)(g2 + col + 4) * a1;
        xo[c4][0] = x0; xo[c4][1] = x1;
        ss += x0[0] * x0[0] + x0[1] * x0[1] + x0[2] * x0[2] + x0[3] * x0[3] + x1[0] * x1[0] + x1[1] * x1[1] + x1[2] * x1[2] + x1[3] * x1[3]; }
    if (dry) { asm volatile("" :: "v"(ss)); return; }
    if (l == 1) { float* o = A.out + ((size_t)b * SEQ + (pos - CTX)) * D;
#ifdef MX32_TEST
        { const unsigned fl = __hip_atomic_load((unsigned*)(A.ws + WS_CTL) + 8000, __ATOMIC_RELAXED, __HIP_MEMORY_SCOPE_AGENT); const float fm = 1.0f + ((fl & 1) ? 2.f : 0.f) + ((fl & 2) ? 5.f : 0.f) + ((fl & 4) ? 11.f : 0.f);
          for (int c4 = 0; c4 < 4; ++c4) { xo[c4][0] *= fm; xo[c4][1] *= fm; } }
#endif
#pragma unroll
        for (int c4 = 0; c4 < 4; ++c4) { const int col = 512 * c4 + 8 * lane; *(f32x4*)(o + col) = xo[c4][0]; *(f32x4*)(o + col + 4) = xo[c4][1]; }
        return; }
    ss = wave_sum(ss); const float rstd = __builtin_amdgcn_rsqf(ss * (1.0f / D) + EPS);
    const float* m1 = MOD + ((size_t)3 + mi) * MODW; const float* nw = A.norm1_w + D; unsigned char* H = A.ws + WS_H + (size_t)row * D;
#pragma unroll
    for (int c4 = 0; c4 < 4; ++c4) { const int col = 512 * c4 + 8 * lane; st_bf16x4(X + col, xo[c4][0]); st_bf16x4(X + col + 4, xo[c4][1]);
        f32x4 o[2];
#pragma unroll
        for (int q = 0; q < 2; ++q) { const int cc = col + 4 * q; o[q] = xo[c4][q] * rstd * *(const f32x4*)(nw + cc) * (1.0f + *(const f32x4*)(m1 + D + cc)) + *(const f32x4*)(m1 + cc); }
        u32x2 w8; w8.x = pk4_fp8(o[0][0] * SC_H8, o[0][1] * SC_H8, o[0][2] * SC_H8, o[0][3] * SC_H8); w8.y = pk4_fp8(o[1][0] * SC_H8, o[1][1] * SC_H8, o[1][2] * SC_H8, o[1][3] * SC_H8); *(u32x2*)(H + col) = w8; }
}


__device__ void mx32_selftest(unsigned* flag, int lane) {
    int fails = 0; int s127 = 0x7f7f7f7f; asm volatile("" : "+v"(s127));
    { v8i_t a; for (int i = 0; i < 8; ++i) a[i] = 0x38383838; f32x16 c; for (int j = 0; j < 16; ++j) c[j] = 0.f;
      c = __builtin_amdgcn_mfma_scale_f32_32x32x64_f8f6f4(a, a, c, 0, 0, 0, s127, 0, s127); for (int j = 0; j < 16; ++j) if (c[j] != 64.f) fails |= 1; }
    for (int p = 0; p < 64; ++p) { const int g = p >> 5, b = p & 31; v8i_t a; for (int i = 0; i < 8; ++i) a[i] = 0;
        if ((lane >> 5) == g) { for (int i = 0; i < 8; ++i) if (i == (b >> 2)) a[i] = 0x38 << (8 * (b & 3)); }
        f32x16 c; for (int j = 0; j < 16; ++j) c[j] = 0.f;
        c = __builtin_amdgcn_mfma_scale_f32_32x32x64_f8f6f4(a, a, c, 0, 0, 0, s127, 0, s127); for (int j = 0; j < 16; ++j) if (c[j] != 1.f) fails |= 2; }
    { v8i_t a, bb; for (int i = 0; i < 8; ++i) { a[i] = 0; bb[i] = 0; }
      const int r = lane & 31; const int codes[4] = {0x38, 0x40, 0x44, 0x48};
      const int rv = (r >> 2) & 3; if ((lane >> 5) == 0) { a[0] = rv == 0 ? 0x38 : rv == 1 ? 0x40 : rv == 2 ? 0x44 : 0x48; bb[0] = 0x38; }
      f32x16 c; for (int j = 0; j < 16; ++j) c[j] = 0.f;
      c = __builtin_amdgcn_mfma_scale_f32_32x32x64_f8f6f4(a, bb, c, 0, 0, 0, s127, 0, s127);
      for (int j = 0; j < 16; ++j) { const int row = (j & 3) + 8 * (j >> 2) + 4 * (lane >> 5); if (c[j] != (float)(1 + ((row >> 2) & 3))) fails |= 4; } (void)codes; }
    for (int o = 1; o < 64; o <<= 1) fails |= __shfl_xor(fails, o);
    if (lane == 0) __hip_atomic_store(flag, (unsigned)fails, __ATOMIC_RELAXED, __HIP_MEMORY_SCOPE_AGENT);
}

#ifndef ONLY_PH
#define ONLY_PH -2
#endif
#ifndef DUP_PH
#define DUP_PH -9
#define DUP_L 0
#endif
#ifndef DUP_SUB
#define DUP_SUB 0
#endif
#ifndef RERUN_SUB
#define RERUN_SUB 0
#endif
#ifndef DUP_PROBE
#define DUP_PROBE 0
#endif
constexpr int LDS_TILEP = 131072, LDS_BARST = 131072 + 512;
constexpr int PH_PRO = 0, PH_PER_LAYER = 10, PH_END = 1 + 2 * PH_PER_LAYER;

__device__ __forceinline__ void layer_phase(const Args& A, LAS unsigned char* lds, int l, int ph, int vcu, int G, int sub = 0) {
    const int tid = threadIdx.x, wid = __builtin_amdgcn_readfirstlane(tid >> 6), lane = tid & 63, gn = G * NTHR; int gtid = tid; asm volatile("" : "+v"(gtid)); gtid += vcu * NTHR;
    unsigned char* ws = A.ws;
    float* MOD = (float*)(ws + WS_MOD); bf16_t* X = (bf16_t*)(ws + WS_X); bf16_t* H = (bf16_t*)(ws + WS_H); bf16_t* P = (bf16_t*)(ws + WS_P); bf16_t* MIX = (bf16_t*)(ws + WS_MIX);
    int* cnt = (int*)(ws + WS_CTL) + CW_CNT + l * 64; LAS int* tileP = (LAS int*)(lds + LDS_TILEP);
    if (ph == 0) {
        if (l == 0) for (int row = vcu * NWAVE + wid; row < TALL; row += G * NWAVE) { const int mi = mod_index(row); const float* m = MOD + (size_t)mi * MODW;
            modnorm_row(in_row(A.x, A.ctx, row), A.norm1_w, m, m + D, (bf16_t*)((unsigned char*)H + (size_t)row * D), lane); }
    } else if (ph == 1) {
        DenseSched S; S.A = (const char*)H; S.Bt = (const char*)(ws + WS_WIN + (size_t)l * LDP * D); S.nM = TALL / 256; S.nN = LDP / 256; S.K = D / 2; S.G = G; S.c = blockIdx.x;
        EpiIn E; E.P = P; E.cosR = (const float*)(ws + WS_ROPE); E.sinR = (const float*)(ws + WS_ROPE + ROPE_SINR); E.cosD = (const float*)(ws + WS_ROPE + ROPE_COSD); E.sinD = (const float*)(ws + WS_ROPE + ROPE_SIND);
        E.qw = A.dq_w + l * 64; E.kw = A.dk_w + l * 64; E.Q8 = ws + WS_Q8; E.K8 = ws + WS_K8; E.V8T = ws + WS_V8T;
        pg8::gemm_phase8<EpiIn, DenseSched, true>(lds, D / 2, S, E, E8_H8, E8_WIN);
    } else if (ph == 2) {
        if (sub == 0 || sub == 1) for (int u = vcu; u < BATCH * NCH128 * 4; u += G) { const int head = u & 3, j = (u >> 2) % NCH128, b = (u >> 2) / NCH128; ret_kv_unit(lds, P, (bf16_t*)(ws + WS_KVT), A.ret_decay + l * 8, b, j, head); }
        if (sub == 0 || sub == 2) for (int u = (vcu + G / 2) % G; u < BATCH * NCH32; u += G) s5_end_unit(A, l, u / NCH32, u % NCH32);
    } else if (ph == 3) {
        ret_state_phase((const bf16_t*)(ws + WS_KVT), (bf16_t*)(ws + WS_ST), A.ret_decay + l * 8, gtid, gn);
        s5_carry_phase(A, l, lds, vcu, G);
    } else if (ph == 4) {
        float mq = 0.f, mk = 0.f, s1 = 0.f, s2 = 0.f;
        for (int i = 0; i < 64; ++i) { mq = fmaxf(mq, fabsf(A.dq_w[l * 64 + i])); mk = fmaxf(mk, fabsf(A.dk_w[l * 64 + i])); s1 += A.dlam[l * 256 + i] * A.dlam[l * 256 + 64 + i]; s2 += A.dlam[l * 256 + 128 + i] * A.dlam[l * 256 + 192 + i]; }
        const float linit = l == 0 ? 0.2f : 0.35550927f;
        const float lam = __expf(s1) - __expf(s2) + linit, sbl2 = 8.0f * mq * mk * 1.02f * LOG2E;
        const int nctx = l == 0 ? BATCH * 8 * 2 : 0;
#ifndef M3_ONLY
#define M3_ONLY 0
#endif
        if ((M3_ONLY == 0 || M3_ONLY == 1) && (sub == 0 || sub == 1)) for (int u = vcu; u < BATCH * 8 * 64 + nctx; u += G) {
            int qrow0, kv0, nk, h;
            if (u < BATCH * 8 * 64) { const int qb = u & 63, b = u >> 9; h = (u >> 6) & 7; qrow0 = b * SEQU + CTX + 128 * qb; kv0 = b * SEQU; nk = SEQU; }
            else { const int v = u - BATCH * 8 * 64, qb = v & 1, b = v >> 4; h = (v >> 1) & 7; qrow0 = b * SEQU + 128 * qb; kv0 = b * SEQU; nk = CTX; }
            attn_unit(lds, A, MIX, qrow0, kv0 / SEQU, nk, h, lam, sbl2, A.dsub_w + l * 128, 1.0f - linit, sub == 1 ? DUP_PROBE : 0);
        }
        if ((M3_ONLY == 0 || M3_ONLY == 2) && (sub == 0 || sub == 2)) for (int u = (vcu + G - 16) % G; u < BATCH * NCH128 * 2; u += G) { const int hp = u & 1, j = (u >> 1) % NCH128, b = (u >> 1) / NCH128; if (l == 1 && j < 2) continue;
            ret_out_unit(lds, P, (const bf16_t*)(ws + WS_ST), MIX, A.ret_decay + l * 8, A.ret_norm_w + l * 512, b, j, hp); }
        if ((M3_ONLY == 0 || M3_ONLY == 3) && (sub == 0 || sub == 3)) for (int u = (vcu + G - 32) % G; u < BATCH * NCH32; u += G) { const int b = u / NCH32, c = u % NCH32; if (l == 1 && c < 8) continue; s5_out_unit(lds, A, l, b, c); }
    } else if (ph == 5) {
        DenseSched S; S.A = (const char*)MIX; S.Bt = (const char*)(ws + WS_WOUT + (size_t)l * D * D); S.nM = l == 1 ? 64 : TALL / 256; S.skipctx = l == 1; S.nN = D / 256; S.K = D / 2; S.G = G; S.c = blockIdx.x;
        EpiRes E; E.xlat = l == 0 ? A.x : nullptr; E.xctx = A.ctx; E.X = X; E.gate = MOD + (size_t)l * 3 * MODW + 2 * D;
        pg8::gemm_phase8<EpiRes, DenseSched, true>(lds, D / 2, S, E, E8_MIX, E8_WOUT);
    } else if (ph == 6) {
        for (int u = vcu; u < TALL / 32; u += G) { const int r0 = 32 * u; if (l == 1 && (r0 % SEQU) < CTX) continue; route_unit(lds, A, l, r0); }
#ifdef DUP_E
        if (l == 0) for (int u = vcu; u < TALL / 32; u += G) { const int r0 = 32 * u; route_unit(lds, A, l, r0, true); }
#endif
    } else if (ph == 7) {
        __syncthreads(); build_tileP(cnt, tileP, l == 1 ? 64 : TALL / 256); __syncthreads();
        GroupSched S; S.A = (const char*)(ws + WS_H8); S.Bt = (const char*)(ws + WS_GU + (size_t)l * NE1 * 1024 * D); S.list = (const int*)(ws + WS_LIST); S.cnt = cnt; S.tileP = tileP; S.NT = 4; S.K = D / 2; S.G = G; S.c = vcu; S.gather = true; S.bstride = (size_t)1024 * D; S.skipctx = l == 1;
        EpiGU E; E.HID = ws + WS_HID;
        pg8::gemm_phase8<EpiGU, GroupSched, true>(lds, D / 2, S, E, E8_H8, E8_GU);
    } else if (ph == 8) {
        __syncthreads(); build_tileP(cnt, tileP, l == 1 ? 64 : TALL / 256); __syncthreads();
        GroupSched S; S.A = (const char*)(ws + WS_HID); S.Bt = (const char*)(ws + WS_DN + (size_t)l * NE1 * D * FF); S.list = nullptr; S.cnt = cnt; S.tileP = tileP; S.NT = 8; S.K = FF / 2; S.G = G; S.c = vcu; S.gather = false; S.bstride = (size_t)D * FF; S.skipctx = l == 1;
        EpiDown E; E.Y = ws + WS_Y; E.X = X; E.gate = MOD + (size_t)l * 3 * MODW + 5 * D;
        pg8::gemm_phase8<EpiDown, GroupSched, true>(lds, FF / 2, S, E, E8_HID, E8_DN);
#ifdef DUP_F2
        if (l == 0) { __syncthreads(); E.X = nullptr;
#ifdef DUP_F2_NOEPI
            E.Y = nullptr;
#endif
            pg8::gemm_phase8<EpiDown, GroupSched, true>(lds, FF / 2, S, E, E8_HID, E8_DN); }
#endif
    } else {
        __syncthreads(); build_tileP(cnt, tileP); __syncthreads();
#ifdef DUP_G
        if (l == 0) for (int row = vcu * NWAVE + wid; row < TALL; row += G * NWAVE) combine_row(A, l, row, tileP, lane, true);
#endif
        for (int row = vcu * NWAVE + wid; row < TALL; row += G * NWAVE) combine_row(A, l, row, tileP, lane);
    }
}

__global__ void __launch_bounds__(NTHR, 2) fwd_kernel(Args A, int ph_lo, int ph_hi) {
    extern __shared__ __attribute__((aligned(16))) unsigned char shm[];
    LAS unsigned char* lds = (LAS unsigned char*)shm;
    const int tid = threadIdx.x, G = gridDim.x;
    const int vcu = (G % 8 == 0) ? (int)((blockIdx.x & 7) * (G / 8) + (blockIdx.x >> 3)) : (int)blockIdx.x;
    volatile LAS unsigned* st = (volatile LAS unsigned*)(lds + LDS_BARST);
    if (tid == 0) { st[0] = 0u; st[1] = 0u; }
    __syncthreads();
    XcdBarrier bar; bar.bar = (unsigned*)(A.ws + WS_CTL) + CW_BAR; bar.x = 0; bar.st = st;
    const bool multi = ph_hi - ph_lo > 1;
    if (multi) bar = xcd_barrier_post((unsigned*)(A.ws + WS_CTL) + CW_BAR, st);
#ifdef DUP_BAR
#define PHASE_END(id) do { if ((id) + 1 < ph_hi) { xcd_barrier(bar); xcd_barrier(bar); } } while (0)
#else
#define PHASE_END(id) do { if ((id) + 1 < ph_hi) xcd_barrier(bar); } while (0)
#endif
    if ((ONLY_PH == -2 || ONLY_PH == -1) && ph_lo <= 0 && 0 < ph_hi) {
        for (int u = vcu; u < 192; u += G) adaln_unit(A, (float*)(A.ws + WS_MOD), lds, u / 96, u % 96);
        if (G == 256) {
            constexpr int NCV = 2 * CV_PER_LAYER, NA = 192 * 50;
            const int u0 = vcu < 192 ? vcu * 50 : NA + (int)((long)(vcu - 192) * (NCV - NA) / 64), u1 = vcu < 192 ? u0 + 50 : NA + (int)((long)(vcu - 191) * (NCV - NA) / 64);
            conv_range(A, u0, u1, lds);
        } else for (int u = vcu; u < 2 * CV_PER_LAYER; u += G) conv_dispatch(A, u, lds);
        tables_phase(A, vcu * NTHR + tid, G * NTHR);
#ifdef MX32_TEST
        if (vcu == 0 && (tid >> 6) == 0) mx32_selftest((unsigned*)(A.ws + WS_CTL) + 8000, tid & 63);
#endif
        if (DUP_PH == -1) { for (int u = vcu; u < 2 * CV_PER_LAYER; u += G) conv_dispatch(A, u, lds); }
        PHASE_END(0);
    }
#define LPH(l, p) do { const int id_ = 1 + (l) * PH_PER_LAYER + (p); if ((ONLY_PH == -2 || ONLY_PH == (p)) && ph_lo <= id_ && id_ < ph_hi) { layer_phase(A, lds, (l), (p), vcu, G, (ph_hi - ph_lo == 1) ? RERUN_SUB : 0); if (DUP_PH == (p) && DUP_L == (l)) { __syncthreads(); layer_phase(A, lds, (l), (p), vcu, G, DUP_SUB); } PHASE_END(id_); } } while (0)
    LPH(0, 0); LPH(0, 1); LPH(0, 2); LPH(0, 3); LPH(0, 4); LPH(0, 5); LPH(0, 6); LPH(0, 7); LPH(0, 8); LPH(0, 9);
    LPH(1, 1); LPH(1, 2); LPH(1, 3); LPH(1, 4); LPH(1, 5); LPH(1, 6); LPH(1, 7); LPH(1, 8); LPH(1, 9);
}

#ifndef MK_LAUNCH_PER_PHASE
#define MK_LAUNCH_PER_PHASE 0
#endif
extern "C" void kernel_launch(void* const* d_in, const int* in_sizes, int n_in, void* d_out, int out_size, void* d_ws, size_t ws_size, hipStream_t stream) {
    static int grid = 0;
    if (grid == 0) {
        if (n_in != 33 || ws_size < WS_END) { fprintf(stderr, "kernel_launch: expected 33 inputs and >= %zu bytes of workspace; got %d inputs, %zu bytes\n", (size_t)WS_END, n_in, ws_size); grid = -1; return; }
        int dev = 0, cus = 0, per_cu = 0;
        if (hipGetDevice(&dev) != hipSuccess || hipDeviceGetAttribute(&cus, hipDeviceAttributeMultiprocessorCount, dev) != hipSuccess) { grid = -1; return; }
        if (hipFuncSetAttribute((const void*)fwd_kernel, hipFuncAttributeMaxDynamicSharedMemorySize, LDS_BYTES) != hipSuccess) { fprintf(stderr, "kernel_launch: hipFuncSetAttribute failed\n"); grid = -1; return; }
        if (hipOccupancyMaxActiveBlocksPerMultiprocessor(&per_cu, (const void*)fwd_kernel, NTHR, LDS_BYTES) != hipSuccess || per_cu < 1) { fprintf(stderr, "kernel_launch: occupancy query reports %d blocks per CU\n", per_cu); grid = -1; return; }
        grid = cus;
    }
    if (grid < 0) return;
    Args a{};
    const float** ap = (const float**)&a;
    for (int i = 0; i < 33; ++i) ap[i] = (const float*)d_in[i];
    a.out = (float*)d_out; a.ws = (unsigned char*)d_ws;
    hipMemsetAsync((char*)d_ws + WS_CTL, 0, CTL_BYTES, stream);
#ifdef PROBE_SKIP_MIX
    hipMemsetAsync((char*)d_ws + WS_MIX, PROBE_MIX_BYTE, (size_t)TALL * D * 2, stream);
#endif
#if MK_LAUNCH_PER_PHASE
    for (int p = 0; p < PH_END; ++p) { if (p == 1 + PH_PER_LAYER) continue;
#ifdef PROBE_SKIP_MIX
        { const int q = (p - 1) % PH_PER_LAYER; if (p >= 1 && q >= 2 && q <= 4) { if (q == 2) hipMemsetAsync((char*)d_ws + WS_MIX, PROBE_MIX_BYTE, (size_t)TALL * D * 2, stream); if (PROBE_SKIP_MIX == 1) continue; } }
#endif
        hipLaunchKernelGGL(fwd_kernel, dim3(grid), dim3(NTHR), LDS_BYTES, stream, a, p, p + 1); }
#else
    hipLaunchKernelGGL(fwd_kernel, dim3(grid), dim3(NTHR), LDS_BYTES, stream, a, 0, PH_END);
#endif
#ifdef RERUN_LO
#if RERUN_MEMSET
    hipMemsetAsync((char*)d_ws + WS_CTL, 0, CTL_BYTES, stream);
#endif
    hipLaunchKernelGGL(fwd_kernel, dim3(grid), dim3(NTHR), LDS_BYTES, stream, a, RERUN_LO, RERUN_HI);
#endif
}
```

```cpp
#include <hip/hip_runtime.h>
#include <cstdio>
#include <cstdint>

#define LAS __attribute__((address_space(3)))
typedef unsigned short bf16_t;
typedef short bf16x8 __attribute__((ext_vector_type(8)));
typedef short s16x4 __attribute__((ext_vector_type(4)));
typedef float f32x4 __attribute__((ext_vector_type(4)));
typedef float f32x2 __attribute__((ext_vector_type(2)));
typedef float f32x16 __attribute__((ext_vector_type(16)));
typedef unsigned u32x4 __attribute__((ext_vector_type(4)));
typedef unsigned u32x2 __attribute__((ext_vector_type(2)));

constexpr int D = 2048, BATCH = 2, SEQ = 8192, CTX = 256, SEQU = SEQ + CTX  , TALL = BATCH * SEQU  ;
constexpr int NMOD = 6, MODW = NMOD * D;
constexpr int LDP = 5632;
constexpr int OFF_RQ = 0, OFF_RK = 512, OFF_RV = 1024, OFF_RG = 1536, OFF_DQ = 2048, OFF_DK = 3072, OFF_DV = 4096, OFF_U = 5120;
constexpr int NEXP = 64, FF = 512, NE1 = NEXP + 1;
constexpr int S5G = 32, S5P = 64, NCH32 = SEQU / 32  , NCH128 = SEQU / 128  ;
constexpr float EPS = 1e-6f;
constexpr float LOG2E = 1.4426950408889634f;
constexpr int NTHR = 512, NWAVE = 8;
constexpr int LDS_BYTES = 147456;

constexpr size_t MiB = 1u << 20;
constexpr size_t al256(size_t x) { return (x + 255) & ~(size_t)255; }
constexpr size_t WS_CTL = 0, CTL_BYTES = 1 * MiB;
constexpr int CW_BAR = 0;
constexpr int CW_CNT = 4096;
constexpr int CW_CTXD = 5000;
constexpr size_t WS_MOD   = WS_CTL + CTL_BYTES;
constexpr size_t WS_WIN   = al256(WS_MOD + (size_t)2 * 3 * MODW * 4);
constexpr size_t WS_WOUT  = al256(WS_WIN + (size_t)2 * LDP * D * 2);
constexpr size_t WS_GU    = al256(WS_WOUT + (size_t)2 * D * D * 2);
constexpr size_t WS_DN    = al256(WS_GU + (size_t)2 * NE1 * 1024 * D);
constexpr size_t WS_GLU   = al256(WS_DN + (size_t)2 * NE1 * D * FF);
constexpr size_t WS_RWT   = al256(WS_GLU + (size_t)2 * 512 * 512 * 2);
constexpr size_t WS_ROPE  = al256(WS_RWT + (size_t)2 * 64 * D * 4);
constexpr size_t ROPE_SINR = (size_t)SEQ * 64 * 4, ROPE_COSD = 2 * ROPE_SINR, ROPE_SIND = ROPE_COSD + (size_t)SEQ * 32 * 4, ROPE_BYTES = ROPE_SIND + (size_t)SEQ * 32 * 4;
constexpr size_t WS_S5A   = al256(WS_ROPE + ROPE_BYTES);
constexpr size_t S5A_N = (size_t)2 * 2 * 32 * 64;
constexpr size_t WS_S5BF  = al256(WS_S5A + 3 * S5A_N * 8);
constexpr size_t WS_S5CF  = al256(WS_S5BF + (size_t)2 * 2 * 32 * 2 * 2 * 512 * 2);
constexpr size_t WS_LIST  = al256(WS_S5CF + (size_t)2 * 32 * 4 * 512 * 2);
constexpr size_t WS_TKE   = al256(WS_LIST + (size_t)NE1 * TALL * 4);
constexpr size_t WS_TKP   = al256(WS_TKE + (size_t)TALL * 8 * 4);
constexpr size_t WS_TKW   = al256(WS_TKP + (size_t)TALL * 8 * 4);
constexpr size_t WS_X     = al256(WS_TKW + (size_t)TALL * 8 * 4);
constexpr size_t WS_H     = al256(WS_X + (size_t)TALL * D * 4);
constexpr size_t WS_H8    = al256(WS_H + (size_t)TALL * D * 2);
constexpr size_t WS_R     = al256(WS_H8 + (size_t)TALL * D);
constexpr size_t WS_P     = WS_R;
constexpr size_t WS_MIX   = al256(WS_P + (size_t)TALL * LDP * 2);
constexpr size_t WS_KVT   = al256(WS_MIX + (size_t)TALL * D * 2);
constexpr size_t WS_ST    = al256(WS_KVT + (size_t)16 * NCH128 * 16384 * 4);
constexpr size_t WS_S5E   = al256(WS_ST + (size_t)16 * NCH128 * 16384 * 2);
constexpr size_t WS_S5X   = al256(WS_S5E + (size_t)4 * NCH32 * 2048 * 8);
constexpr size_t WS_Q8    = al256(WS_S5X + (size_t)4 * NCH32 * 2048 * 8);
constexpr size_t WS_K8    = al256(WS_Q8 + (size_t)TALL * 1024);
constexpr size_t WS_V8T   = al256(WS_K8 + (size_t)TALL * 1024);
constexpr size_t WS_MIXEND = al256(WS_V8T + (size_t)TALL * 1024);
constexpr int HID_ROWS = TALL * 9 + NE1 * 256, Y_ROWS = TALL * 8 + NEXP * 256;
constexpr size_t WS_HID   = WS_R;
constexpr size_t WS_Y     = al256(WS_HID + (size_t)HID_ROWS * FF);
constexpr size_t WS_MOEEND = al256(WS_Y + (size_t)Y_ROWS * D * 2);
constexpr size_t WS_END = WS_MOEEND > WS_MIXEND ? WS_MOEEND : WS_MIXEND;

__device__ __forceinline__ unsigned f2bf(float f) { unsigned u = __builtin_bit_cast(unsigned, f); return (u + 0x7fffu + ((u >> 16) & 1u)) >> 16; }
__device__ __forceinline__ float bf2f(unsigned h) { return __builtin_bit_cast(float, h << 16); }
typedef __bf16 bf16x2_t __attribute__((ext_vector_type(2)));
__device__ __forceinline__ unsigned pk2(float lo, float hi) { const f32x2 v = {lo, hi}; const bf16x2_t b = __builtin_convertvector(v, bf16x2_t); return __builtin_bit_cast(unsigned, b); }
__device__ __forceinline__ unsigned pk4_fp8(float a, float b, float c, float d) {
    a = fminf(fmaxf(a, -448.f), 448.f); b = fminf(fmaxf(b, -448.f), 448.f); c = fminf(fmaxf(c, -448.f), 448.f); d = fminf(fmaxf(d, -448.f), 448.f);
    int w = 0; w = __builtin_amdgcn_cvt_pk_fp8_f32(a, b, w, false); w = __builtin_amdgcn_cvt_pk_fp8_f32(c, d, w, true); return (unsigned)w; }
__device__ __forceinline__ unsigned pk4_fp8_nc(float a, float b, float c, float d) { int w = 0; w = __builtin_amdgcn_cvt_pk_fp8_f32(a, b, w, false); w = __builtin_amdgcn_cvt_pk_fp8_f32(c, d, w, true); return (unsigned)w; }
constexpr float SC_H8 = 8.f, SC_HID = 8.f, SC_GU = 64.f, SC_DN = 32.f, SC_WIN = 64.f, SC_Y = 16.f, SC_Q8 = 32.f, SC_K8 = 8.f, SC_V8 = 8.f;
constexpr float SC_MIX = 8.f, SC_WOUT = 64.f; constexpr int E8_MIX = 127 - 3, E8_WOUT = 127 - 6;
constexpr int E8_H8 = 127 - 3, E8_HID = 127 - 3, E8_GU = 127 - 6, E8_DN = 127 - 5, E8_WIN = 127 - 6, E8_Q8 = 127 - 5, E8_K8 = 127 - 3, E8_V8 = 127 - 3;
__device__ __forceinline__ float bflo(unsigned w) { return __builtin_bit_cast(float, w << 16); }
__device__ __forceinline__ float bfhi(unsigned w) { return __builtin_bit_cast(float, w & 0xffff0000u); }
__device__ __forceinline__ f32x4 ld_bf16x4(const bf16_t* p) { const u32x2 w = *(const u32x2*)p; f32x4 r; r[0] = bflo(w.x); r[1] = bfhi(w.x); r[2] = bflo(w.y); r[3] = bfhi(w.y); return r; }
__device__ __forceinline__ float wave_sum(float v) {
#pragma unroll
    for (int o = 1; o < 64; o <<= 1) v += __shfl_xor(v, o);
    return v;
}
__device__ __forceinline__ float opaque_zero() { float z = 0.f; asm volatile("" : "+v"(z)); return z; }
__device__ __forceinline__ float fast_exp2(float x) { return __builtin_amdgcn_exp2f(x); }
__device__ __forceinline__ float fast_rcp(float x) { return __builtin_amdgcn_rcpf(x); }
__device__ __forceinline__ float sigmoidf_(float x) { return fast_rcp(1.0f + fast_exp2(-x * LOG2E)); }
__device__ __forceinline__ float siluf_(float x) { return x * sigmoidf_(x); }
__device__ __forceinline__ float gelu_tanh(float x) {
    const float u = 0.7978845608028654f * (x + 0.044715f * x * x * x);
    return x * sigmoidf_(2.0f * u);
}
__device__ __forceinline__ unsigned offb_key(unsigned row) { return ((row & 3u) << 2) | ((row >> 2) & 3u); }
__device__ __forceinline__ unsigned off_b(unsigned row, unsigned ch) { return 256u * row + 16u * (ch ^ offb_key(row)); }
__device__ __forceinline__ int mod_index(int row) { const int b = row / SEQU, pos = row - b * SEQU; return pos < CTX ? 2 : b; }

#define XB_TMO      128
#define XB_XCNT(j)  (256  + 64 * (j))
#define XB_XSUB(j)  (1280 + 64 * (j))
#define XB_XGEN(j)  (2304 + 64 * (j))
#define XB_TOP      3328
#define XB_TOPGEN   3392
#define XCD_BAR_WORDS 3456
#define XB_SPIN_CAP (1u << 22)
__device__ __forceinline__ unsigned xb_ld(unsigned* p)              { return __hip_atomic_load(p, __ATOMIC_RELAXED, __HIP_MEMORY_SCOPE_AGENT); }
__device__ __forceinline__ unsigned xb_add(unsigned* p, unsigned v) { return __hip_atomic_fetch_add(p, v, __ATOMIC_RELAXED, __HIP_MEMORY_SCOPE_AGENT); }
__device__ __forceinline__ unsigned xb_xcc_id() { return (unsigned)__builtin_amdgcn_s_getreg((3 << 11) | 20) & 0xFu; }
#define XB_SPIN(cond, bar) do { unsigned _sp = 0; while (cond) { __builtin_amdgcn_s_sleep(1); \
    if ((++_sp & 255u) == 0u) { if (xb_ld(&(bar)[XB_TMO])) break; if (_sp > XB_SPIN_CAP) { atomicAdd(&(bar)[XB_TMO], 1u); break; } } } } while (0)
struct XcdBarrier { unsigned* bar; unsigned x; volatile LAS unsigned* st; };
__device__ __forceinline__ XcdBarrier xcd_barrier_post(unsigned* bar, volatile LAS unsigned* st) {
    XcdBarrier b; b.bar = bar; b.x = xb_xcc_id(); b.st = st;
    if (threadIdx.x == 0) (void)xb_add(&bar[XB_XCNT(b.x)], 1u);
    return b;
}
__device__ __forceinline__ void xcd_barrier_complete(unsigned* bar, unsigned x, unsigned& nloc, unsigned& nx) {
    const unsigned G = gridDim.x * gridDim.y * gridDim.z;
    unsigned sum, cnt, mine, sp = 0u;
    for (;;) {
        sum = 0u; cnt = 0u; mine = 0u;
#pragma unroll
        for (unsigned j = 0; j < 16; ++j) { const unsigned c = xb_ld(&bar[XB_XCNT(j)]); sum += c; cnt += (c > 0u) ? 1u : 0u; mine = (j == x) ? c : mine; }
        if (sum == G) break;
        __builtin_amdgcn_s_sleep(1);
        if ((++sp & 255u) == 0u) { if (xb_ld(&bar[XB_TMO])) break; if (sp > XB_SPIN_CAP) { atomicAdd(&bar[XB_TMO], 1u); break; } }
    }
    nloc = mine > 0u ? mine : 1u; nx = cnt > 0u ? cnt : 1u;
}
__device__ __forceinline__ void xcd_barrier(const XcdBarrier& b) {
    asm volatile("s_waitcnt vmcnt(0)" ::: "memory");
    __syncthreads();
    if (threadIdx.x == 0) {
        unsigned* bar = b.bar;
        __builtin_amdgcn_s_waitcnt(0);
        unsigned nloc = b.st[0], nx = b.st[1];
        if (nloc == 0u) { xcd_barrier_complete(bar, b.x, nloc, nx); b.st[0] = nloc; b.st[1] = nx; }
        const unsigned old = xb_add(&bar[XB_XSUB(b.x)], 1u);
        const unsigned gen = old / nloc;
        if (old + 1u == (gen + 1u) * nloc) {
            __builtin_amdgcn_fence(__ATOMIC_RELEASE, "agent");
            asm volatile("s_waitcnt vmcnt(0)" ::: "memory");
            const unsigned og = xb_add(&bar[XB_TOP], 1u);
            const unsigned tg = og / nx;
            if (og + 1u == (tg + 1u) * nx) xb_add(&bar[XB_TOPGEN], 1u);
            else XB_SPIN(xb_ld(&bar[XB_TOPGEN]) == tg, bar);
            __builtin_amdgcn_fence(__ATOMIC_ACQUIRE, "agent");
            xb_add(&bar[XB_XGEN(b.x)], 1u);
            asm volatile("s_waitcnt vmcnt(0)" ::: "memory");
        } else {
            XB_SPIN(xb_ld(&bar[XB_XGEN(b.x)]) == gen, bar);
            __builtin_amdgcn_fence(__ATOMIC_ACQUIRE, "agent");
            asm volatile("s_waitcnt vmcnt(0)" ::: "memory");
        }
    }
    __syncthreads();
}

struct Args {
    const float *x, *c, *ctx, *c_ctx, *w_ada, *b_ada, *norm1_w, *norm2_w, *w_in, *ret_decay, *ret_norm_w, *dq_w, *dk_w, *dlam, *dsub_w;
    const float *s5_lre, *s5_lim, *s5_logdt, *s5_bre, *s5_bim, *s5_cre, *s5_cim, *s5_d, *s5_glu, *w_out, *router_w, *router_b;
    const float *e_gate, *e_up, *e_down, *s_gate, *s_up, *s_down;
    float* out; unsigned char* ws;
};

__device__ __forceinline__ void adaln_unit(const Args& A, float* MOD, LAS unsigned char* lds, int l, int cc) {
    LAS float* s = (LAS float*)lds;
    LAS f32x4* red = (LAS f32x4*)(lds + 3 * 2048 * 4);
    const int tid = threadIdx.x;
    for (int i = tid; i < 3 * D; i += NTHR) { const int r = i / D, k = i - r * D; const float v = r < 2 ? A.c[r * D + k] : A.c_ctx[k]; s[i] = siluf_(v); }
    __syncthreads();
    const int kq = tid >> 5, cq = tid & 31, col = cc * 128 + 4 * cq;
    f32x4 a0 = {0, 0, 0, 0}, a1 = a0, a2 = a0;
    const float* wp = A.w_ada + ((size_t)l * D + kq * 128) * MODW + col;
#pragma unroll 8
    for (int k = 0; k < 128; ++k) { const f32x4 w = *(const f32x4*)(wp + (size_t)k * MODW); const int kk = kq * 128 + k; a0 += s[kk] * w; a1 += s[D + kk] * w; a2 += s[2 * D + kk] * w; }
    red[(kq * 3 + 0) * 32 + cq] = a0; red[(kq * 3 + 1) * 32 + cq] = a1; red[(kq * 3 + 2) * 32 + cq] = a2;
    __syncthreads();
    if (tid < 96) { const int r = tid >> 5, c2 = tid & 31; f32x4 t = *(const f32x4*)(A.b_ada + (size_t)l * MODW + cc * 128 + 4 * c2);
        for (int q = 0; q < 16; ++q) t += red[(q * 3 + r) * 32 + c2];
        *(f32x4*)(MOD + ((size_t)l * 3 + r) * MODW + cc * 128 + 4 * c2) = t; }
    __syncthreads();
}

enum { MAP_IDENT = 0, MAP_PERM32 = 1, MAP_RETQK = 2, MAP_DIFFQK = 3, MAP_GLUFRAG = 4, MAP_PERM16 = 5 };
__device__ __forceinline__ int src_col(int kind, int rho) {
    const int bj = rho >> 7, wc = (rho >> 5) & 3, n = (rho >> 4) & 1, i = rho & 15;
    if (kind == MAP_PERM32) return 128 * bj + 32 * wc + 8 * (i >> 2) + 4 * n + (i & 3);
    if (kind == MAP_PERM16) return 64 * wc + 16 * (i >> 2) + 8 * bj + 4 * n + (i & 3);
    if (kind == MAP_RETQK)  return 128 * bj + 64 * n + 16 * wc + i;
    if (kind == MAP_DIFFQK) return 64 * wc + 32 * bj + 8 * (i >> 2) + 4 * n + (i & 3);
    return rho;
}
struct CvD { const float* sa; const float* sb; unsigned char* dst; int ld, K, drow0, k0, kind; float sc; };
__device__ __forceinline__ void conv_load(const CvD& d, f32x4 (&v)[16], int tid) {
#pragma unroll
    for (int i = 0; i < 16; ++i) { const int idx = tid + NTHR * i, row = idx >> 6, col = 4 * (idx & 63);
        v[i] = *(const f32x4*)((col < 128 ? d.sa + col : d.sb + (col - 128)) + (size_t)(d.k0 + row) * d.ld); }
}
__device__ __forceinline__ void conv_put(const f32x4 (&v)[16], LAS float* T, int tid) {
#pragma unroll
    for (int i = 0; i < 16; ++i) { const int idx = tid + NTHR * i, row = idx >> 6, col = 4 * (idx & 63); LAS float* tp = T + row * 257 + col; tp[0] = v[i][0]; tp[1] = v[i][1]; tp[2] = v[i][2]; tp[3] = v[i][3]; }
}
__device__ __forceinline__ void conv_out(const CvD& d, const LAS float* T, int tid) {
    const int K = d.K, kind = d.kind; const float fp8scale = d.sc;
    if (fp8scale > 0.f) {
        unsigned char* d8 = d.dst;
#pragma unroll
        for (int i = 0; i < 4; ++i) { const int idx = tid + NTHR * i, rho = idx >> 3, kg = idx & 7, sc = src_col(kind, rho);
            const LAS float* tp = T + (16 * kg) * 257 + sc; u32x4 w;
            w.x = pk4_fp8(tp[0] * fp8scale, tp[257] * fp8scale, tp[2 * 257] * fp8scale, tp[3 * 257] * fp8scale); w.y = pk4_fp8(tp[4 * 257] * fp8scale, tp[5 * 257] * fp8scale, tp[6 * 257] * fp8scale, tp[7 * 257] * fp8scale);
            w.z = pk4_fp8(tp[8 * 257] * fp8scale, tp[9 * 257] * fp8scale, tp[10 * 257] * fp8scale, tp[11 * 257] * fp8scale); w.w = pk4_fp8(tp[12 * 257] * fp8scale, tp[13 * 257] * fp8scale, tp[14 * 257] * fp8scale, tp[15 * 257] * fp8scale);
            *(u32x4*)(d8 + (size_t)(d.drow0 + rho) * K + d.k0 + 16 * kg) = w; }
        return; }
    bf16_t* dst = (bf16_t*)d.dst;
#pragma unroll
    for (int i = 0; i < 8; ++i) { const int idx = tid + NTHR * i, rho = idx >> 4, ko = idx & 15, sc = src_col(kind, rho);
        const LAS float* tp = T + (8 * ko) * 257 + sc;
        u32x4 w; w.x = pk2(tp[0], tp[257]); w.y = pk2(tp[2 * 257], tp[3 * 257]); w.z = pk2(tp[4 * 257], tp[5 * 257]); w.w = pk2(tp[6 * 257], tp[7 * 257]);
        if (kind == MAP_GLUFRAG) { const int n = d.drow0 + rho, k8 = (d.k0 >> 3) + ko;
            *(u32x4*)(dst + ((size_t)(((((n >> 6) * 2 + ((n >> 5) & 1)) * 32 + (k8 >> 1)) * 2 + (k8 & 1)) * 32 + (n & 31)) << 3)) = w; }
        else *(u32x4*)(dst + (size_t)(d.drow0 + rho) * K + d.k0 + 8 * ko) = w; }
}
constexpr int CV_WIN = 352, CV_WOUT = 128, CV_EGU = 64 * 64, CV_EDN = 64 * 32, CV_SGU = 64, CV_SDN = 32, CV_GLU = 8;
constexpr int CV_PER_LAYER = CV_WIN + CV_WOUT + CV_EGU + CV_EDN + CV_SGU + CV_SDN + CV_GLU;
__device__ __forceinline__ CvD conv_desc(const Args& A, int u) {
    const int l = u / CV_PER_LAYER; int v = u - l * CV_PER_LAYER;
    unsigned char* ws = A.ws; CvD d;
    if (v < CV_WIN) { const int nb = v >> 4, kb = v & 15; d.kind = nb < 4 ? MAP_RETQK : (nb >= 8 && nb < 16) ? MAP_DIFFQK : MAP_PERM32;
        d.sa = A.w_in + (size_t)l * D * LDP + 256 * nb; d.sb = d.sa + 128; d.ld = LDP; d.dst = ws + WS_WIN + (size_t)l * LDP * D; d.K = D; d.drow0 = 256 * nb; d.k0 = 128 * kb; d.sc = SC_WIN; return d; }
    v -= CV_WIN;
    if (v < CV_WOUT) { const int nb = v >> 4, kb = v & 15; d.sa = A.w_out + (size_t)l * D * D + 256 * nb; d.sb = d.sa + 128; d.ld = D; d.dst = ws + WS_WOUT + (size_t)l * D * D; d.K = D; d.drow0 = 256 * nb; d.k0 = 128 * kb;
        d.kind = MAP_PERM16; d.sc = SC_WOUT; return d; }
    v -= CV_WOUT;
    if (v < CV_EGU) { const int e = v >> 6, r = v & 63, nb = r >> 4, kb = r & 15;
        d.sa = A.e_gate + ((size_t)l * NEXP + e) * D * FF + 128 * nb; d.sb = A.e_up + ((size_t)l * NEXP + e) * D * FF + 128 * nb; d.ld = FF; d.dst = ws + WS_GU + ((size_t)l * NE1 + e) * 1024 * D; d.K = D; d.drow0 = 256 * nb; d.k0 = 128 * kb;
        d.kind = MAP_PERM32; d.sc = SC_GU; return d; }
    v -= CV_EGU;
    if (v < CV_EDN) { const int e = v >> 5, r = v & 31, nb = r >> 2, kb = r & 3; d.sa = A.e_down + ((size_t)l * NEXP + e) * FF * D + 256 * nb; d.sb = d.sa + 128; d.ld = D; d.dst = ws + WS_DN + ((size_t)l * NE1 + e) * D * FF; d.K = FF; d.drow0 = 256 * nb; d.k0 = 128 * kb;
        d.kind = MAP_PERM16; d.sc = SC_DN; return d; }
    v -= CV_EDN;
    if (v < CV_SGU) { const int nb = v >> 4, kb = v & 15;
        d.sa = A.s_gate + (size_t)l * D * FF + 128 * nb; d.sb = A.s_up + (size_t)l * D * FF + 128 * nb; d.ld = FF; d.dst = ws + WS_GU + ((size_t)l * NE1 + NEXP) * 1024 * D; d.K = D; d.drow0 = 256 * nb; d.k0 = 128 * kb;
        d.kind = MAP_PERM32; d.sc = SC_GU; return d; }
    v -= CV_SGU;
    if (v < CV_SDN) { const int nb = v >> 2, kb = v & 3; d.sa = A.s_down + (size_t)l * FF * D + 256 * nb; d.sb = d.sa + 128; d.ld = D; d.dst = ws + WS_DN + ((size_t)l * NE1 + NEXP) * D * FF; d.K = FF; d.drow0 = 256 * nb; d.k0 = 128 * kb;
        d.kind = MAP_PERM16; d.sc = SC_DN; return d; }
    v -= CV_SDN;
    { const int nb = v >> 2, kb = v & 3; d.sa = A.s5_glu + (size_t)l * 512 * 512 + 256 * nb; d.sb = d.sa + 128; d.ld = 512; d.dst = ws + WS_GLU + (size_t)l * 512 * 512 * 2; d.K = 512; d.drow0 = 256 * nb; d.k0 = 128 * kb; d.kind = MAP_GLUFRAG; d.sc = 0.f; }
    return d;
}
__device__ __forceinline__ void conv_range(const Args& A, int u0, int u1, LAS unsigned char* lds) {
    if (u0 >= u1) return;
    LAS float* T = (LAS float*)lds; const int tid = threadIdx.x;
    CvD cur = conv_desc(A, u0); f32x4 v[16]; conv_load(cur, v, tid);
    for (int u = u0; u < u1; ++u) {
        __syncthreads();
        conv_put(v, T, tid);
        __syncthreads();
        CvD nxt = cur;
        if (u + 1 < u1) { nxt = conv_desc(A, u + 1); conv_load(nxt, v, tid); }
        conv_out(cur, T, tid);
        cur = nxt;
    }
    __syncthreads();
}
__device__ __forceinline__ void conv_dispatch(const Args& A, int u, LAS unsigned char* lds) { conv_range(A, u, u + 1, lds); }

__device__ __forceinline__ void cs_rev(double rev, float& c, float& s) {
    const float fr = (float)(rev - __builtin_floor(rev)); c = __builtin_amdgcn_cosf(fr); s = __builtin_amdgcn_sinf(fr);
}
__device__ __forceinline__ void tables_phase(const Args& A, int gtid, int gn) {
    unsigned char* ws = A.ws;
    float* cosR = (float*)(ws + WS_ROPE); float* sinR = (float*)(ws + WS_ROPE + ROPE_SINR); float* cosD = (float*)(ws + WS_ROPE + ROPE_COSD); float* sinD = (float*)(ws + WS_ROPE + ROPE_SIND);
    const double INV2PI = 0.15915494309189535;
    for (int i = gtid; i < SEQ * 64; i += gn) { const int t = i >> 6, j = i & 63, jj = j & 31; const int pos = j < 32 ? (t >> 6) : (t & 63);
        const float f = fast_exp2(-(float)(2 * jj) * (1.0f / 64.0f) * 13.287712379549449f);
        float c, s; cs_rev((double)pos * (double)f * INV2PI, c, s); cosR[i] = c; sinR[i] = s; }
    for (int i = gtid; i < SEQ * 32; i += gn) { const int t = i >> 5, j = i & 31, jj = j & 15; const int pos = j < 16 ? (t >> 6) : (t & 63);
        const float f = fast_exp2(-(float)(2 * jj) * (1.0f / 32.0f) * 13.287712379549449f);
        float c, s; cs_rev((double)pos * (double)f * INV2PI, c, s); cosD[i] = c; sinD[i] = s; }
    float* rwt = (float*)(ws + WS_RWT);
    { unsigned short* rwh = (unsigned short*)rwt; unsigned short* rwl = rwh + (size_t)2 * NEXP * D;
      for (int i = gtid; i < 2 * D * NEXP; i += gn) { const int l = i / (D * NEXP), r = i - l * D * NEXP, k = r >> 6, e = r & 63; const float v = A.router_w[i];
          const unsigned hw = pk2(v, 0.f) & 0xffffu; const float hi = __builtin_bit_cast(float, hw << 16); const unsigned lw = pk2(v - hi, 0.f) & 0xffffu;
          const size_t o = (size_t)l * NEXP * D + ((size_t)(((((e >> 5) * 128 + (k >> 4)) * 2 + ((k >> 3) & 1)) * 32 + (e & 31)) << 3)) + (k & 7);
          rwh[o] = (unsigned short)hw; rwl[o] = (unsigned short)lw; } }
    int* list64 = (int*)(ws + WS_LIST) + (size_t)NEXP * TALL;
    for (int i = gtid; i < TALL; i += gn) list64[i] = i;
    f32x2* SA = (f32x2*)(ws + WS_S5A); bf16_t* BF = (bf16_t*)(ws + WS_S5BF); bf16_t* CF = (bf16_t*)(ws + WS_S5CF);
    for (int i = gtid; i < 2 * 2 * 32 * 64; i += gn) {
        const int p = i & 63, g = (i >> 6) & 31, d = (i >> 11) & 1, l = i >> 12;
        const float dt = fast_exp2(A.s5_logdt[(l * 2 + d) * 32 + g] * LOG2E);
        const float lr = A.s5_lre[i], li = A.s5_lim[i];
        const float mag = fast_exp2(lr * dt * LOG2E);
        float c, s; cs_rev((double)li * (double)dt * INV2PI, c, s);
        const float ar = mag * c, ai = mag * s;
        float pr = ar, pi = ai;
#pragma unroll
        for (int q = 0; q < 4; ++q) { const float nr = pr * pr - pi * pi, ni = 2.f * pr * pi; pr = nr; pi = ni; }
        const float a16r = pr, a16i = pi; const float a32r = pr * pr - pi * pi, a32i = 2.f * pr * pi;
        SA[i] = (f32x2){ar, ai}; SA[S5A_N + i] = (f32x2){a16r, a16i}; SA[2 * S5A_N + i] = (f32x2){a32r, a32i};
        const float den = lr * lr + li * li, nr = ar - 1.0f;
        const float fre = (nr * lr + ai * li) / den, fim = (ai * lr - nr * li) / den;
        const int pb = p >> 5, pl = p & 31;
        const float* bre = A.s5_bre + (((size_t)l * 32 + g) * 64 + p) * 16; const float* bim = A.s5_bim + (((size_t)l * 32 + g) * 64 + p) * 16;
        bf16_t* bf_re = BF + ((((size_t)(l * 2 + d) * 32 + g) * 2 + pb) * 2 + 0) * 512; bf16_t* bf_im = bf_re + 512;
        for (int h = 0; h < 16; ++h) { const float br = bre[h], bi = bim[h]; const int lane = (h >> 3) * 32 + pl, j = h & 7;
            bf_re[lane * 8 + j] = (bf16_t)f2bf(fre * br - fim * bi); bf_im[lane * 8 + j] = (bf16_t)f2bf(fre * bi + fim * br); }
        if (d == 0) {
            for (int reim = 0; reim < 2; ++reim) { const int k = 2 * p + reim, ks = k >> 5, kq = (k >> 3) & 3, j = k & 7;
                for (int hp = 0; hp < 16; ++hp) { const size_t ci = (((size_t)l * 32 + g) * 16 + hp) * 64 + p; const float v = reim ? -A.s5_cim[ci] : A.s5_cre[ci];
                    CF[(((size_t)l * 32 + g) * 4 + ks) * 512 + (kq * 16 + hp) * 8 + j] = (bf16_t)f2bf(v); } }
        }
    }
}

__device__ __forceinline__ const float* in_row(const float* xlat, const float* xctx, int row) {
    const int b = row / SEQU, pos = row - b * SEQU; return pos < CTX ? xctx + ((size_t)b * CTX + pos) * D : xlat + ((size_t)b * SEQ + (pos - CTX)) * D;
}
__device__ __forceinline__ void modnorm_row(const float* xr, const float* nw, const float* sh, const float* sc, bf16_t* hrow, int lane) {
    f32x4 v[8]; float ss = 0.f;
#pragma unroll
    for (int i = 0; i < 8; ++i) { v[i] = *(const f32x4*)(xr + 4 * (lane + 64 * i)); ss += v[i][0] * v[i][0] + v[i][1] * v[i][1] + v[i][2] * v[i][2] + v[i][3] * v[i][3]; }
    ss = wave_sum(ss); const float rstd = __builtin_amdgcn_rsqf(ss * (1.0f / D) + EPS);
#pragma unroll
    for (int i = 0; i < 8; ++i) { const int c = 4 * (lane + 64 * i); const f32x4 w = *(const f32x4*)(nw + c), s1 = *(const f32x4*)(sc + c), s0 = *(const f32x4*)(sh + c);
        const f32x4 o = (v[i] * rstd * w * (1.0f + s1) + s0) * SC_H8; *(unsigned*)((unsigned char*)hrow + c) = pk4_fp8(o[0], o[1], o[2], o[3]); }
}

namespace pg8 {
constexpr int BM = 256, BK = 64, HALF = 128, HTB = HALF * BK * 2, STAGE_BYTES = 8 * HTB, NXCD = 8, WGM = 8;
__device__ __forceinline__ int lds_byte(int r, int c) { const int st = (r >> 4) * 2 + (c >> 5), rr = r & 15, cc = c & 31, ob = rr * 64 + cc * 2; return st * 1024 + (ob ^ (((ob >> 9) & 1) << 5)); }
__device__ __forceinline__ void stage_rc(int b, int& R, int& C) { const int st = b / 1024, sb = b % 1024, swz = sb ^ (((sb >> 9) & 1) << 5); R = (st >> 1) * 16 + swz / 64; C = (st & 1) * 32 + (swz % 64) / 2; }

struct UnitD {
    const char* A;
    const char* B;
    unsigned ao[2][2];
    int pm, pn, e, row0;
};

template <class Epi, class Sched>
__device__ __forceinline__ void gemm_phase(LAS unsigned char* lds, const int K, const Sched& S, const Epi& E) {
    const int tid = threadIdx.x, wid = __builtin_amdgcn_readfirstlane(tid >> 6), lane = tid & 63, wr = wid >> 2, wc = wid & 3, fr = lane & 15, fq = lane >> 4;
    const int nt = K / BK;
    unsigned voffB[2];
#pragma unroll
    for (int i = 0; i < 2; ++i) { int R, C; stage_rc(tid * 16 + i * 8192, R, C); voffB[i] = (unsigned)(R * K + C) * 2u; }
    const size_t kstep = (size_t)(BK * 2);
    const size_t hstep = (size_t)HALF * K * 2;
    const unsigned ldsw = (unsigned)wid * 1024u;
    const int aoff = lds_byte(wr * 64 + fr, fq * 8), boff = lds_byte(wc * 32 + fr, fq * 8);
#define PG8_SA(b, h) (((b) * 2 + (h)) * HTB)
#define PG8_SB(b, h) ((4 + (b) * 2 + (h)) * HTB)
#define PG8_STA(bufoff, U, h, kb) do { _Pragma("unroll") for (int _i = 0; _i < 2; ++_i) \
        __builtin_amdgcn_global_load_lds((const unsigned*)((U).A + (U).ao[h][_i] + (kb)), (LAS unsigned*)(lds + (bufoff) + ldsw + _i * 8192), 16, 0, 0); } while (0)
#define PG8_STB(bufoff, U, h, kb) do { _Pragma("unroll") for (int _i = 0; _i < 2; ++_i) \
        __builtin_amdgcn_global_load_lds((const unsigned*)((U).B + (h) * hstep + voffB[_i] + (kb)), (LAS unsigned*)(lds + (bufoff) + ldsw + _i * 8192), 16, 0, 0); } while (0)
#define PG8_LDA(dst, b, h) do { _Pragma("unroll") for (int m = 0; m < 4; ++m) _Pragma("unroll") for (int k = 0; k < 2; ++k) dst[m][k] = *(const LAS bf16x8*)(lds + PG8_SA(b, h) + aoff + m * 2048 + k * 1024); } while (0)
#define PG8_LDB(dst, b, h) do { _Pragma("unroll") for (int n = 0; n < 2; ++n) _Pragma("unroll") for (int k = 0; k < 2; ++k) dst[n][k] = *(const LAS bf16x8*)(lds + PG8_SB(b, h) + boff + n * 2048 + k * 1024); } while (0)
#define PG8_MMA(ai, bj, At, Bt) do { __builtin_amdgcn_s_setprio(1); _Pragma("unroll") for (int m = 0; m < 4; ++m) _Pragma("unroll") for (int n = 0; n < 2; ++n) _Pragma("unroll") for (int k = 0; k < 2; ++k) \
        acc[ai][bj][m][n] = __builtin_amdgcn_mfma_f32_16x16x32_bf16(Bt[n][k], At[m][k], acc[ai][bj][m][n], 0, 0, 0); __builtin_amdgcn_s_setprio(0); } while (0)
#define PG8_WAIT_V(n) asm volatile("s_waitcnt vmcnt(" #n ")" ::: "memory")
#define PG8_WAIT_L(n) asm volatile("s_waitcnt lgkmcnt(" #n ")" ::: "memory")
#define PG8_BAR __builtin_amdgcn_s_barrier()
#define PG8_SCHED __builtin_amdgcn_sched_barrier(0)
    UnitD cur, nxt; int ui = 0;
    if (!S.next(0, cur)) return;
    f32x4 acc[2][2][4][2];
#pragma unroll
    for (int a = 0; a < 2; ++a)
#pragma unroll
        for (int b = 0; b < 2; ++b)
#pragma unroll
            for (int m = 0; m < 4; ++m)
#pragma unroll
                for (int n = 0; n < 2; ++n) acc[a][b][m][n] = (f32x4){0.f, 0.f, 0.f, 0.f};
    bf16x8 At[4][2], B0[2][2], B1[2][2];
    PG8_STB(PG8_SB(0, 0), cur, 0, 0); PG8_STA(PG8_SA(0, 0), cur, 0, 0); PG8_STB(PG8_SB(0, 1), cur, 1, 0); PG8_STA(PG8_SA(0, 1), cur, 1, 0);
    if (wr == 1) PG8_BAR;
    PG8_WAIT_V(4); PG8_BAR;
    PG8_STB(PG8_SB(1, 0), cur, 0, kstep); PG8_STA(PG8_SA(1, 0), cur, 0, kstep); PG8_STB(PG8_SB(1, 1), cur, 1, kstep);
    PG8_WAIT_V(6); PG8_BAR;
    for (;;) {
        const bool has_next = S.next(ui + 1, nxt);
        if (!has_next) nxt = cur;
        for (int t = 0; t < nt; t += 2) {
            const bool last = (t == nt - 2);
            const size_t k1 = (size_t)(t + 1) * kstep;
            const size_t k2 = last ? (size_t)0 : (size_t)(t + 2) * kstep, k3 = k2 + kstep;
            UnitD w2; w2.A = cur.A; w2.B = last ? nxt.B : cur.B;
            w2.ao[0][0] = last ? nxt.ao[0][0] : cur.ao[0][0]; w2.ao[0][1] = last ? nxt.ao[0][1] : cur.ao[0][1];
            w2.ao[1][0] = last ? nxt.ao[1][0] : cur.ao[1][0]; w2.ao[1][1] = last ? nxt.ao[1][1] : cur.ao[1][1];
            PG8_LDB(B0, 0, 0); PG8_SCHED; PG8_LDA(At, 0, 0); PG8_STA(PG8_SA(1, 1), cur, 1, k1);
            PG8_WAIT_L(8); PG8_BAR; PG8_WAIT_L(0); PG8_MMA(0, 0, At, B0); PG8_BAR; PG8_SCHED;
            PG8_LDB(B1, 0, 1); PG8_STB(PG8_SB(0, 0), w2, 0, k2);
            PG8_BAR; PG8_WAIT_L(0); PG8_MMA(0, 1, At, B1); PG8_BAR;
            PG8_LDA(At, 0, 1); PG8_STA(PG8_SA(0, 0), w2, 0, k2);
            PG8_BAR; PG8_WAIT_L(0); PG8_MMA(1, 0, At, B0); PG8_BAR; PG8_SCHED;
            PG8_STB(PG8_SB(0, 1), w2, 1, k2);
            PG8_WAIT_V(6); PG8_BAR; PG8_MMA(1, 1, At, B1); PG8_BAR;
            PG8_LDB(B0, 1, 0); PG8_SCHED; PG8_LDA(At, 1, 0); PG8_STA(PG8_SA(0, 1), w2, 1, k2);
            PG8_WAIT_L(8); PG8_BAR; PG8_WAIT_L(0); PG8_MMA(0, 0, At, B0); PG8_BAR; PG8_SCHED;
            PG8_LDB(B1, 1, 1); PG8_STB(PG8_SB(1, 0), w2, 0, k3);
            PG8_BAR; PG8_WAIT_L(0); PG8_MMA(0, 1, At, B1); PG8_BAR;
            PG8_LDA(At, 1, 1); PG8_STA(PG8_SA(1, 0), w2, 0, k3);
            PG8_BAR; PG8_WAIT_L(0); PG8_MMA(1, 0, At, B0); PG8_BAR; PG8_SCHED;
            PG8_STB(PG8_SB(1, 1), w2, 1, k3);
            PG8_WAIT_V(6); PG8_BAR; PG8_MMA(1, 1, At, B1); PG8_BAR;
        }
        E(acc, cur, wr, wc, fr, fq);
        if (!has_next) break;
#pragma unroll
        for (int a = 0; a < 2; ++a)
#pragma unroll
            for (int b = 0; b < 2; ++b)
#pragma unroll
                for (int m = 0; m < 4; ++m)
#pragma unroll
                    for (int n = 0; n < 2; ++n) acc[a][b][m][n] = (f32x4){0.f, 0.f, 0.f, 0.f};
        cur = nxt; ++ui;
    }
    PG8_WAIT_V(0);
    if (wr == 0) PG8_BAR;
    PG8_BAR;
#undef PG8_SA
#undef PG8_SB
#undef PG8_STA
#undef PG8_STB
#undef PG8_LDA
#undef PG8_LDB
#undef PG8_MMA
#undef PG8_WAIT_V
#undef PG8_WAIT_L
#undef PG8_BAR
#undef PG8_SCHED
}

typedef int v8i __attribute__((ext_vector_type(8)));
typedef int v4i __attribute__((ext_vector_type(4)));
typedef v4i __attribute__((may_alias)) v4i_a;
template <class Epi, class Sched, bool FP8 = true>
__device__ __forceinline__ void gemm_phase8(LAS unsigned char* lds, const int K, const Sched& S, const Epi& E, int sclA = 127, int sclB = 127) {
    const int tid = threadIdx.x, wid = __builtin_amdgcn_readfirstlane(tid >> 6), lane = tid & 63, wr = wid >> 2, wc = wid & 3, fr = lane & 15, fq = lane >> 4;
    const int nt = K / BK;
    unsigned voffB[2];
#pragma unroll
    for (int i = 0; i < 2; ++i) { int R, C; stage_rc(tid * 16 + i * 8192, R, C); voffB[i] = (unsigned)(R * K + C) * 2u; }
    const size_t kstep = (size_t)(BK * 2);
    const size_t hstep = (size_t)HALF * K * 2;
    const unsigned ldsw = (unsigned)wid * 1024u;
    const int aoff = lds_byte(wr * 64 + fr, fq * 8), boff = lds_byte(wc * 32 + fr, fq * 8);
#define PG8_SA(b, h) (((b) * 2 + (h)) * HTB)
#define PG8_SB(b, h) ((4 + (b) * 2 + (h)) * HTB)
#define PG8_STA(bufoff, U, h, kb) do { _Pragma("unroll") for (int _i = 0; _i < 2; ++_i) \
        __builtin_amdgcn_global_load_lds((const unsigned*)((U).A + (U).ao[h][_i] + (kb)), (LAS unsigned*)(lds + (bufoff) + ldsw + _i * 8192), 16, 0, 0); } while (0)
#define PG8_STB(bufoff, U, h, kb) do { _Pragma("unroll") for (int _i = 0; _i < 2; ++_i) \
        __builtin_amdgcn_global_load_lds((const unsigned*)((U).B + (h) * hstep + voffB[_i] + (kb)), (LAS unsigned*)(lds + (bufoff) + ldsw + _i * 8192), 16, 0, 0); } while (0)
#define PG8_LDA(dst, b, h) do { _Pragma("unroll") for (int m = 0; m < 4; ++m) { dst[m].lo = *(const LAS v4i_a*)(lds + PG8_SA(b, h) + aoff + m * 2048); dst[m].hi = *(const LAS v4i_a*)(lds + PG8_SA(b, h) + aoff + m * 2048 + 1024); } } while (0)
#define PG8_LDB(dst, b, h) do { _Pragma("unroll") for (int n = 0; n < 2; ++n) { dst[n].lo = *(const LAS v4i_a*)(lds + PG8_SB(b, h) + boff + n * 2048); dst[n].hi = *(const LAS v4i_a*)(lds + PG8_SB(b, h) + boff + n * 2048 + 1024); } } while (0)
#define PG8_MMA(ai, bj, At, Bt) do { __builtin_amdgcn_s_setprio(1); _Pragma("unroll") for (int m = 0; m < 4; ++m) _Pragma("unroll") for (int n = 0; n < 2; ++n) { \
        if constexpr (FP8) asm volatile("v_mfma_scale_f32_16x16x128_f8f6f4 %0, %1, %2, %0, %3, %4 op_sel_hi:[0,0,0]" : "+v"(acc[ai][bj][m][n]) : "v"(Bt[n]), "v"(At[m]), "v"(vsclB), "v"(vsclA)); \
        else { acc[ai][bj][m][n] = __builtin_amdgcn_mfma_f32_16x16x32_bf16(__builtin_bit_cast(bf16x8, Bt[n].lo), __builtin_bit_cast(bf16x8, At[m].lo), acc[ai][bj][m][n], 0, 0, 0); \
               acc[ai][bj][m][n] = __builtin_amdgcn_mfma_f32_16x16x32_bf16(__builtin_bit_cast(bf16x8, Bt[n].hi), __builtin_bit_cast(bf16x8, At[m].hi), acc[ai][bj][m][n], 0, 0, 0); } } \
        __builtin_amdgcn_s_setprio(0); } while (0)
#define PG8_WAIT_V(n) asm volatile("s_waitcnt vmcnt(" #n ")" ::: "memory")
#define PG8_WAIT_L(n) asm volatile("s_waitcnt lgkmcnt(" #n ")" ::: "memory")
#define PG8_BAR __builtin_amdgcn_s_barrier()
#define PG8_SCHED __builtin_amdgcn_sched_barrier(0)
    int vsclA = sclA * 0x01010101, vsclB = sclB * 0x01010101;
    asm volatile("" : "+v"(vsclA), "+v"(vsclB));
    UnitD cur, nxt; int ui = 0;
    if (!S.next(0, cur)) return;
    f32x4 acc[2][2][4][2];
#pragma unroll
    for (int a = 0; a < 2; ++a)
#pragma unroll
        for (int b = 0; b < 2; ++b)
#pragma unroll
            for (int m = 0; m < 4; ++m)
#pragma unroll
                for (int n = 0; n < 2; ++n) acc[a][b][m][n] = (f32x4){0.f, 0.f, 0.f, 0.f};
    v8i At[4], B0[2], B1[2];
    PG8_STB(PG8_SB(0, 0), cur, 0, 0); PG8_STA(PG8_SA(0, 0), cur, 0, 0); PG8_STB(PG8_SB(0, 1), cur, 1, 0); PG8_STA(PG8_SA(0, 1), cur, 1, 0);
    if (wr == 1) PG8_BAR;
    PG8_WAIT_V(4); PG8_BAR;
    PG8_STB(PG8_SB(1, 0), cur, 0, kstep); PG8_STA(PG8_SA(1, 0), cur, 0, kstep); PG8_STB(PG8_SB(1, 1), cur, 1, kstep);
    PG8_WAIT_V(6); PG8_BAR;
    for (;;) {
        const bool has_next = S.next(ui + 1, nxt);
        if (!has_next) nxt = cur;
        for (int t = 0; t < nt; t += 2) {
            const bool last = (t == nt - 2);
            const size_t k1 = (size_t)(t + 1) * kstep;
            const size_t k2 = last ? (size_t)0 : (size_t)(t + 2) * kstep, k3 = k2 + kstep;
            UnitD w2; w2.A = cur.A; w2.B = last ? nxt.B : cur.B;
            w2.ao[0][0] = last ? nxt.ao[0][0] : cur.ao[0][0]; w2.ao[0][1] = last ? nxt.ao[0][1] : cur.ao[0][1];
            w2.ao[1][0] = last ? nxt.ao[1][0] : cur.ao[1][0]; w2.ao[1][1] = last ? nxt.ao[1][1] : cur.ao[1][1];
            PG8_LDB(B0, 0, 0); PG8_SCHED; PG8_LDA(At, 0, 0); PG8_STA(PG8_SA(1, 1), cur, 1, k1);
            PG8_WAIT_L(8); PG8_BAR; PG8_WAIT_L(0); PG8_MMA(0, 0, At, B0); PG8_BAR; PG8_SCHED;
            PG8_LDB(B1, 0, 1); PG8_STB(PG8_SB(0, 0), w2, 0, k2);
            PG8_BAR; PG8_WAIT_L(0); PG8_MMA(0, 1, At, B1); PG8_BAR;
            PG8_LDA(At, 0, 1); PG8_STA(PG8_SA(0, 0), w2, 0, k2);
            PG8_BAR; PG8_WAIT_L(0); PG8_MMA(1, 0, At, B0); PG8_BAR; PG8_SCHED;
            PG8_STB(PG8_SB(0, 1), w2, 1, k2);
            PG8_WAIT_V(6); PG8_BAR; PG8_MMA(1, 1, At, B1); PG8_BAR;
            PG8_LDB(B0, 1, 0); PG8_SCHED; PG8_LDA(At, 1, 0); PG8_STA(PG8_SA(0, 1), w2, 1, k2);
            PG8_WAIT_L(8); PG8_BAR; PG8_WAIT_L(0); PG8_MMA(0, 0, At, B0); PG8_BAR; PG8_SCHED;
            PG8_LDB(B1, 1, 1); PG8_STB(PG8_SB(1, 0), w2, 0, k3);
            PG8_BAR; PG8_WAIT_L(0); PG8_MMA(0, 1, At, B1); PG8_BAR;
            PG8_LDA(At, 1, 1); PG8_STA(PG8_SA(1, 0), w2, 0, k3);
            PG8_BAR; PG8_WAIT_L(0); PG8_MMA(1, 0, At, B0); PG8_BAR; PG8_SCHED;
            PG8_STB(PG8_SB(1, 1), w2, 1, k3);
            PG8_WAIT_V(6); PG8_BAR; PG8_MMA(1, 1, At, B1); PG8_BAR;
        }
        if constexpr (FP8) asm volatile("s_nop 15\n\ts_nop 15" ::: "memory");
        E(acc, cur, wr, wc, fr, fq);
        if (!has_next) break;
#pragma unroll
        for (int a = 0; a < 2; ++a)
#pragma unroll
            for (int b = 0; b < 2; ++b)
#pragma unroll
                for (int m = 0; m < 4; ++m)
#pragma unroll
                    for (int n = 0; n < 2; ++n) acc[a][b][m][n] = (f32x4){0.f, 0.f, 0.f, 0.f};
        cur = nxt; ++ui;
    }
    PG8_WAIT_V(0);
    if (wr == 0) PG8_BAR;
    PG8_BAR;
#undef PG8_SA
#undef PG8_SB
#undef PG8_STA
#undef PG8_STB
#undef PG8_LDA
#undef PG8_LDB
#undef PG8_MMA
#undef PG8_WAIT_V
#undef PG8_WAIT_L
#undef PG8_BAR
#undef PG8_SCHED
}

__device__ __forceinline__ void lin_offsets(UnitD& u, int row0, int K) {
#pragma unroll
    for (int i = 0; i < 2; ++i) { int R, C; stage_rc((int)threadIdx.x * 16 + i * 8192, R, C);
        u.ao[0][i] = (unsigned)(((size_t)(row0 + R) * K + C) * 2); u.ao[1][i] = (unsigned)(((size_t)(row0 + HALF + R) * K + C) * 2); }
}
}

using pg8::UnitD;
struct DenseSched {
    const char* A; const char* Bt; int nM, nN, K, G, c; bool skipctx = false;
    __device__ __forceinline__ bool next(int i, UnitD& u) const {
        const int nwg = nM * nN; const long L = (long)i * G + c; if (L >= nwg) return false;
        int wgid = (int)L; { const int q = nwg / 8, r = nwg % 8, xcd = wgid % 8, off = wgid / 8; wgid = (xcd < r ? xcd * (q + 1) : r * (q + 1) + (xcd - r) * q) + off; }
        const int nig = 8 * nN, gid = wgid / nig, fm = gid * 8, gsz = (nM - fm) < 8 ? (nM - fm) : 8;
        int pm = fm + ((wgid % nig) % gsz); const int pn = (wgid % nig) / gsz;
        if (skipctx) pm += 1 + (pm >= 32 ? 1 : 0);
        u.A = A; u.B = Bt + (size_t)pn * 256 * K * 2; pg8::lin_offsets(u, pm * 256, K); u.pm = pm; u.pn = pn; u.e = 0; u.row0 = pm * 256; return true;
    }
};
struct CtxSched {
    const char* A; const char* Bt; int K, c;
    __device__ __forceinline__ bool next(int i, UnitD& u) const {
        if (i != 0 || c >= 16) return false;
        const int pm = (c >> 3) ? 33 : 0, pn = c & 7;
        u.A = A; u.B = Bt + (size_t)pn * 256 * K * 2; pg8::lin_offsets(u, pm * 256, K); u.pm = pm; u.pn = pn; u.e = 0; u.row0 = pm * 256; return true;
    }
};
struct GroupSched {
    const char* A; const char* Bt; const int* list; const int* cnt; const LAS int* tileP; int NT, K, G, c; bool gather; size_t bstride;
    bool skipctx = false;
    __device__ __forceinline__ bool next(int i, UnitD& u) const {
        const int total = tileP[65] * NT; const long L = (long)i * G + c; if (L >= total) return false;
        const int tile = (int)(L / NT), tn = (int)(L % NT);
        int e = 0;
#pragma unroll
        for (int s = 64; s >= 1; s >>= 1) { if (e + s <= 64 && tileP[e + s] <= tile) e += s; }
        const int tm = tile - tileP[e];
        const int srt = skipctx ? tm + 1 + (tm >= 32 ? 1 : 0) : tm;
        u.A = A; u.B = Bt + (size_t)e * bstride + (size_t)tn * 256 * K * 2; u.pm = tm; u.pn = tn; u.e = e;
        if (gather) {
            const int ce = e == NEXP ? TALL : cnt[e]; const int* le = list + (size_t)e * TALL;
#pragma unroll
            for (int p = 0; p < 2; ++p) { int R, C; pg8::stage_rc((int)threadIdx.x * 16 + p * 8192, R, C);
#pragma unroll
                for (int h = 0; h < 2; ++h) { const int idx = tm * 256 + 128 * h + R; const int tok = e == NEXP ? srt * 256 + 128 * h + R : le[idx < ce ? idx : 0]; u.ao[h][p] = (unsigned)(((size_t)tok * K + C) * 2); } }
            u.row0 = 256 * tile;
        } else {
            pg8::lin_offsets(u, 256 * tile, K);
            u.row0 = e == NEXP ? srt * 256 : 256 * tile;
        }
        return true;
    }
};
__device__ __forceinline__ void build_tileP(const int* cnt, LAS int* tileP, int shared_tiles = TALL / 256) {
    if (threadIdx.x == 0) { int s = 0; for (int e = 0; e < NEXP; ++e) { tileP[e] = s; s += (cnt[e] + 255) >> 8; } tileP[64] = s; s += shared_tiles; tileP[65] = s; }
}

__device__ __forceinline__ void st_bf16x4(bf16_t* p, f32x4 v) { u32x2 w; w.x = pk2(v[0], v[1]); w.y = pk2(v[2], v[3]); *(u32x2*)p = w; }
__device__ __forceinline__ void st_bf16x8(bf16_t* p, f32x4 v0, f32x4 v1) { u32x4 w; w.x = pk2(v0[0], v0[1]); w.y = pk2(v0[2], v0[3]); w.z = pk2(v1[0], v1[1]); w.w = pk2(v1[2], v1[3]); *(u32x4*)p = w; }

constexpr float QSCALE = 0.125f * LOG2E;
struct EpiIn {
    bf16_t* P; const float *cosR, *sinR, *cosD, *sinD, *qw, *kw; unsigned char *Q8, *K8, *V8T;
    __device__ __forceinline__ void operator()(const f32x4 (&acc)[2][2][4][2], const UnitD& u, int wr, int wc, int fr, int fq) const {
        const int pn = u.pn, rbase = u.row0 + wr * 64 + fr;
        if (pn < 4) {
            const float scale = pn >= 2 ? 0.08838834764831845f : 1.0f; const int i0 = 16 * wc + 4 * fq;
#pragma unroll
            for (int ai = 0; ai < 2; ++ai)
#pragma unroll
                for (int m = 0; m < 4; ++m) { const int row = rbase + ai * 128 + m * 16, b = row / SEQU, pos = row - b * SEQU; const bool lat = pos >= CTX; const int t = lat ? pos - CTX : 0;
                    f32x4 c = {1.f, 1.f, 1.f, 1.f}, s = {0.f, 0.f, 0.f, 0.f};
                    if (lat) { c = *(const f32x4*)(cosR + (size_t)t * 64 + i0); s = *(const f32x4*)(sinR + (size_t)t * 64 + i0); }
                    c *= scale; s *= scale;
#pragma unroll
                    for (int bj = 0; bj < 2; ++bj) { const f32x4 x1 = acc[ai][bj][m][0], x2 = acc[ai][bj][m][1]; bf16_t* op = P + (size_t)row * LDP + 256 * pn + 128 * bj + i0;
                        st_bf16x4(op, x1 * c - x2 * s); st_bf16x4(op + 64, x1 * s + x2 * c); } }
        } else if (pn >= 8 && pn < 16) {
            const bool isq = pn < 12; const float* w = isq ? qw : kw; const int sh = 4 * (pn - (isq ? 8 : 12)) + wc;
            unsigned char* dst8 = Q8 + 64 * sh;
            const float os = isq ? QSCALE * SC_Q8 : SC_K8;
            f32x4 wv[2][2];
#pragma unroll
            for (int bj = 0; bj < 2; ++bj)
#pragma unroll
                for (int n = 0; n < 2; ++n) wv[bj][n] = *(const f32x4*)(w + 32 * bj + 8 * fq + 4 * n) * os;
#pragma unroll
            for (int ai = 0; ai < 2; ++ai)
#pragma unroll
                for (int m = 0; m < 4; ++m) { const int row = rbase + ai * 128 + m * 16, b = row / SEQU, pos = row - b * SEQU; const bool lat = pos >= CTX; const int t = lat ? pos - CTX : 0;
                    float ss = 0.f;
#pragma unroll
                    for (int bj = 0; bj < 2; ++bj)
#pragma unroll
                        for (int n = 0; n < 2; ++n) { const f32x4 v = acc[ai][bj][m][n]; ss += v[0] * v[0] + v[1] * v[1] + v[2] * v[2] + v[3] * v[3]; }
                    ss += __shfl_xor(ss, 16); ss += __shfl_xor(ss, 32);
                    const float rinv = __builtin_amdgcn_rsqf(ss * (1.0f / 64.0f) + EPS);
                    u32x2 w1, w2;
#pragma unroll
                    for (int n = 0; n < 2; ++n) { const int i0 = 8 * fq + 4 * n;
                        f32x4 c = {1.f, 1.f, 1.f, 1.f}, s = {0.f, 0.f, 0.f, 0.f};
                        if (lat) { c = *(const f32x4*)(cosD + (size_t)t * 32 + i0); s = *(const f32x4*)(sinD + (size_t)t * 32 + i0); }
                        const f32x4 x1 = acc[ai][0][m][n] * rinv * wv[0][n], x2 = acc[ai][1][m][n] * rinv * wv[1][n];
                        const f32x4 o1 = x1 * c - x2 * s, o2 = x1 * s + x2 * c;
                        const unsigned a1 = pk4_fp8(o1[0], o1[1], o1[2], o1[3]), a2 = pk4_fp8(o2[0], o2[1], o2[2], o2[3]);
                        if (n == 0) { w1.x = a1; w2.x = a2; } else { w1.y = a1; w2.y = a2; } }
                    unsigned char* op = isq ? dst8 + (size_t)row * 1024 + 8 * fq : K8 + ((((size_t)(b * 8 + (sh >> 1)) * SEQU + pos) << 7) + 64 * (sh & 1) + 8 * fq);
                    *(u32x2*)op = w1; *(u32x2*)(op + 32) = w2; }
        } else if (pn >= 16 && pn < 20) {
            const int lane = fr + 16 * fq, cq = lane & 3;
#pragma unroll
            for (int ai = 0; ai < 2; ++ai)
#pragma unroll
                for (int m = 0; m < 4; ++m) { const int row = rbase + ai * 128 + m * 16, b = row / SEQU, pos = row - b * SEQU, t = pos >> 6, kk4 = pos & 60;
                    const int off = 32 * ((kk4 >> 2) & 1) + 16 * (kk4 >> 5) + 4 * ((kk4 >> 3) & 3);
#pragma unroll
                    for (int bj = 0; bj < 2; ++bj) { const int head = 2 * (pn - 16) + bj;
#pragma unroll
                        for (int n = 0; n < 2; ++n) { const f32x4 v = acc[ai][bj][m][n] * SC_V8; const unsigned W = pk4_fp8(v[0], v[1], v[2], v[3]);
                            const unsigned w0 = __shfl(W, (lane & ~3) + 0), w1 = __shfl(W, (lane & ~3) + 1), w2 = __shfl(W, (lane & ~3) + 2), w3 = __shfl(W, (lane & ~3) + 3);
                            const unsigned sft = 8 * cq; const unsigned R = ((w0 >> sft) & 0xffu) | (((w1 >> sft) & 0xffu) << 8) | (((w2 >> sft) & 0xffu) << 16) | (((w3 >> sft) & 0xffu) << 24);
                            const int dv = 32 * wc + 8 * fq + 4 * n + cq;
                            *(unsigned*)(V8T + ((((size_t)(b * 8 + head) * (SEQU / 64) + t) * 128 + dv) << 6) + off) = R; } } }
        } else {
            const bool gate = (pn == 6 || pn == 7);
#pragma unroll
            for (int ai = 0; ai < 2; ++ai)
#pragma unroll
                for (int m = 0; m < 4; ++m) { const int row = rbase + ai * 128 + m * 16;
#pragma unroll
                    for (int bj = 0; bj < 2; ++bj) { f32x4 v0 = acc[ai][bj][m][0], v1 = acc[ai][bj][m][1];
                        if (gate) {
#pragma unroll
                            for (int j = 0; j < 4; ++j) { v0[j] = siluf_(v0[j]); v1[j] = siluf_(v1[j]); } }
                        st_bf16x8(P + (size_t)row * LDP + 256 * pn + 128 * bj + 32 * wc + 8 * fq, v0, v1); } }
        }
    }
};
struct EpiRes {
    const float *xlat, *xctx; bf16_t* X; const float* gate;
    __device__ __forceinline__ void operator()(const f32x4 (&acc)[2][2][4][2], const UnitD& u, int wr, int wc, int fr, int fq) const {
        const int mi = mod_index(u.row0); const float* g = gate + (size_t)mi * MODW;
#pragma unroll
        for (int ai = 0; ai < 2; ++ai)
#pragma unroll
            for (int m = 0; m < 4; ++m) { const int row = u.row0 + ai * 128 + wr * 64 + m * 16 + fr; const float* sp = xlat ? in_row(xlat, xctx, row) : nullptr; bf16_t* dp = X + (size_t)row * D;
#pragma unroll
                for (int bj = 0; bj < 2; ++bj) { const int col = 256 * u.pn + 64 * wc + 16 * fq + 8 * bj;
                    f32x4 s0, s1;
                    if (sp) { s0 = *(const f32x4*)(sp + col); s1 = *(const f32x4*)(sp + col + 4); }
                    else { const u32x4 w = *(const u32x4*)(dp + col); s0[0] = bflo(w.x); s0[1] = bfhi(w.x); s0[2] = bflo(w.y); s0[3] = bfhi(w.y); s1[0] = bflo(w.z); s1[1] = bfhi(w.z); s1[2] = bflo(w.w); s1[3] = bfhi(w.w); }
                    const f32x4 o0 = s0 + *(const f32x4*)(g + col) * acc[ai][bj][m][0], o1 = s1 + *(const f32x4*)(g + col + 4) * acc[ai][bj][m][1];
                    u32x4 ow; ow.x = pk2(o0[0], o0[1]); ow.y = pk2(o0[2], o0[3]); ow.z = pk2(o1[0], o1[1]); ow.w = pk2(o1[2], o1[3]); *(u32x4*)(dp + col) = ow; } }
    }
};
struct EpiGU {
    unsigned char* HID;
    __device__ __forceinline__ void operator()(const f32x4 (&acc)[2][2][4][2], const UnitD& u, int wr, int wc, int fr, int fq) const {
#pragma unroll
        for (int ai = 0; ai < 2; ++ai)
#pragma unroll
            for (int m = 0; m < 4; ++m) { const int row = u.row0 + ai * 128 + wr * 64 + m * 16 + fr; f32x4 h[2];
#pragma unroll
                for (int n = 0; n < 2; ++n)
#pragma unroll
                    for (int j = 0; j < 4; ++j) h[n][j] = siluf_(acc[ai][0][m][n][j]) * acc[ai][1][m][n][j] * SC_HID;
                u32x2 w; w.x = pk4_fp8(h[0][0], h[0][1], h[0][2], h[0][3]); w.y = pk4_fp8(h[1][0], h[1][1], h[1][2], h[1][3]);
                *(u32x2*)(HID + (size_t)row * FF + 128 * u.pn + 32 * wc + 8 * fq) = w; }
    }
};
struct EpiDown {
    unsigned char* Y; bf16_t* X; const float* gate;
    __device__ __forceinline__ void operator()(const f32x4 (&acc)[2][2][4][2], const UnitD& u, int wr, int wc, int fr, int fq) const {
        if (u.e == NEXP) {
            if (!X) return;
            const int mi = mod_index(u.row0); const float* g = gate + (size_t)mi * MODW;
#pragma unroll
            for (int ai = 0; ai < 2; ++ai)
#pragma unroll
                for (int m = 0; m < 4; ++m) { bf16_t* dp = X + (size_t)(u.row0 + ai * 128 + wr * 64 + m * 16 + fr) * D;
#pragma unroll
                    for (int bj = 0; bj < 2; ++bj) { const int col = 256 * u.pn + 64 * wc + 16 * fq + 8 * bj;
                        const u32x4 w = *(const u32x4*)(dp + col); f32x4 s0, s1; s0[0] = bflo(w.x); s0[1] = bfhi(w.x); s0[2] = bflo(w.y); s0[3] = bfhi(w.y); s1[0] = bflo(w.z); s1[1] = bfhi(w.z); s1[2] = bflo(w.w); s1[3] = bfhi(w.w);
                        const f32x4 o0 = s0 + *(const f32x4*)(g + col) * acc[ai][bj][m][0], o1 = s1 + *(const f32x4*)(g + col + 4) * acc[ai][bj][m][1];
                        u32x4 ow; ow.x = pk2(o0[0], o0[1]); ow.y = pk2(o0[2], o0[3]); ow.z = pk2(o1[0], o1[1]); ow.w = pk2(o1[2], o1[3]); *(u32x4*)(dp + col) = ow; } }
        } else {
            if (!Y) { asm volatile("" :: "v"(acc[0][0][0][0][0]), "v"(acc[1][1][3][1][3])); return; }
#pragma unroll
            for (int ai = 0; ai < 2; ++ai)
#pragma unroll
                for (int m = 0; m < 4; ++m) { unsigned char* yp = Y + (size_t)(u.row0 + ai * 128 + wr * 64 + m * 16 + fr) * D + 256 * u.pn + 64 * wc + 16 * fq;
                    const f32x4 v0 = acc[ai][0][m][0] * SC_Y, v1 = acc[ai][0][m][1] * SC_Y, v2 = acc[ai][1][m][0] * SC_Y, v3 = acc[ai][1][m][1] * SC_Y; u32x4 w;
                    w.x = pk4_fp8(v0[0], v0[1], v0[2], v0[3]); w.y = pk4_fp8(v1[0], v1[1], v1[2], v1[3]); w.z = pk4_fp8(v2[0], v2[1], v2[2], v2[3]); w.w = pk4_fp8(v3[0], v3[1], v3[2], v3[3]);
                    *(u32x4*)yp = w; }
        }
    }
};

typedef bf16x8 __attribute__((may_alias)) bf16x8_a;
__device__ __forceinline__ f32x16 mfma32(bf16x8 a, bf16x8 b, f32x16 c) { return __builtin_amdgcn_mfma_f32_32x32x16_bf16(a, b, c, 0, 0, 0); }
__device__ __forceinline__ bf16x8 ld_tr2(const LAS unsigned char* p0, const LAS unsigned char* p1) {
    const s16x4 a = __builtin_amdgcn_ds_read_tr16_b64_v4i16((LAS s16x4*)p0), b = __builtin_amdgcn_ds_read_tr16_b64_v4i16((LAS s16x4*)p1);
    bf16x8 r; r[0] = a[0]; r[1] = a[1]; r[2] = a[2]; r[3] = a[3]; r[4] = b[0]; r[5] = b[1]; r[6] = b[2]; r[7] = b[3]; return r;
}
__device__ __forceinline__ unsigned tr_addr(unsigned lane, unsigned rowbase, unsigned cb) {
    const unsigned blk = (lane >> 4) & 1, q = (lane & 15) >> 2, p = lane & 3; return off_b(rowbase + q, 4 * cb + 2 * blk + (p >> 1)) + 8 * (p & 1);
}
__device__ __forceinline__ bf16x8 pack8(const f32x16& v, int s) {
    u32x4 w; w.x = pk2(v[8 * s + 0], v[8 * s + 1]); w.y = pk2(v[8 * s + 2], v[8 * s + 3]); w.z = pk2(v[8 * s + 4], v[8 * s + 5]); w.w = pk2(v[8 * s + 6], v[8 * s + 7]);
    return __builtin_bit_cast(bf16x8, w);
}
__device__ __forceinline__ void stage_offb(LAS unsigned char* img, const bf16_t* g, int ldg, int rows, int tid) {
    const int wid = __builtin_amdgcn_readfirstlane(tid >> 6);
    for (int r0 = 0; r0 < rows; r0 += 32) { const unsigned p = (unsigned)(r0 * 16 + tid), row = p >> 4, chs = p & 15, ch = chs ^ offb_key(row);
        __builtin_amdgcn_global_load_lds((const unsigned*)(g + (size_t)row * ldg + 8 * ch), (LAS unsigned*)(img + r0 * 256 + wid * 1024), 16, 0, 0); }
}
typedef int v8i_t __attribute__((ext_vector_type(8)));
typedef int v4i_t __attribute__((ext_vector_type(4)));
typedef v4i_t __attribute__((may_alias)) v4i_ta;
constexpr int ATT_STG = 8192, ATT_VOF = 65536;
__device__ __forceinline__ void attn_unit(LAS unsigned char* lds, const Args& A, bf16_t* MIX, int qrow0, int b, int nkeys, int head, float lam, float sbl2, const float* subw, float outscale, const int probe = 0) {
    const int tid = threadIdx.x, wid = __builtin_amdgcn_readfirstlane(tid >> 6), lane = tid & 63, br = wid >> 2, qq = wid & 3, l31 = lane & 31, hh = lane >> 5;
    const int qrow = qrow0 + 32 * qq + l31;
    const unsigned char* q8 = A.ws + WS_Q8 + (size_t)qrow * 1024 + head * 128 + br * 64 + 32 * hh;
    v8i_t Qf; Qf.lo = *(const v4i_t*)q8; Qf.hi = *(const v4i_t*)(q8 + 16);
    f32x16 O[4]; const float oz = opaque_zero();
#pragma unroll
    for (int i = 0; i < 4; ++i)
#pragma unroll
        for (int j = 0; j < 16; ++j) O[i][j] = oz;
    const float c565 = opaque_zero() + 56.5f; f32x16 CB; f32x4 Ol;
#pragma unroll
    for (int j = 0; j < 16; ++j) CB[j] = c565;
#pragma unroll
    for (int j = 0; j < 4; ++j) Ol[j] = oz;
    v8i_t Aones;
#pragma unroll
    for (int i = 0; i < 8; ++i) Aones[i] = (lane & 15) == ((lane >> 4) & 1) ? 0x50505050 : 0;
    const int ntile = nkeys / 64;
    const unsigned ksw = (l31 >> 1) & 7, vsw = (l31 >> 2) & 7;
    const unsigned ka0 = l31 * 128 + 16 * ((4 * br + 2 * hh) ^ ksw), ka1 = l31 * 128 + 16 * ((4 * br + 2 * hh + 1) ^ ksw);
    unsigned va0 = ATT_VOF + (l31 >> 1) * 128 + 16 * ((4 * (l31 & 1) + 2 * hh) ^ vsw), va1 = ATT_VOF + (l31 >> 1) * 128 + 16 * ((4 * (l31 & 1) + 2 * hh + 1) ^ vsw);
    asm volatile("" : "+v"(va0), "+v"(va1));
    const int sP = 127 * 0x01010101, sK = sP, sV = sP, sQ = (E8_Q8 + 3 + E8_K8 - 127) * 0x01010101;
    __syncthreads();
    const unsigned ksrc = (unsigned)((tid >> 3) * 128 + 16 * ((tid & 7) ^ ((tid >> 4) & 7)));
    const unsigned char* kgb = A.ws + WS_K8 + ((size_t)(b * 8 + head) * SEQU << 7);
    const unsigned char* vgb = A.ws + WS_V8T + ((size_t)(b * 8 + head) * (SEQU / 64) << 13);
    const unsigned dmaw = (unsigned)(size_t)(lds + wid * 1024);
#define ATT_DMA(gbase, voff, la) do { unsigned m0s_; asm volatile("s_mov_b32 %0, m0\n\ts_mov_b32 m0, %1\n\ts_nop 0\n\tglobal_load_lds_dwordx4 %2, %3\n\ts_mov_b32 m0, %0\n\ts_nop 0" : "=&s"(m0s_) : "s"(la), "v"(voff), "s"(gbase) : "memory"); } while (0)
#define ATT_DMAK(stg, t_) ATT_DMA(kgb + (size_t)min((t_), ntile - 1) * 8192, ksrc, dmaw + (unsigned)(stg))
#define ATT_DMAV(stg, t_) ATT_DMA(vgb + (size_t)min((t_), ntile - 1) * 8192, ksrc, dmaw + (unsigned)((stg) + ATT_VOF))
#define ATT_WAITV(n) asm volatile("s_waitcnt vmcnt(" #n ")" ::: "memory")
    ATT_DMAK(3 * ATT_STG, 0);
    ATT_DMAK(7 * ATT_STG, 1);
    ATT_DMAK(0, 2); ATT_DMAV(0, 0);
    ATT_DMAK(ATT_STG, 3); ATT_DMAV(ATT_STG, 1);
    ATT_DMAK(2 * ATT_STG, 4); ATT_DMAV(2 * ATT_STG, 2);
    { u32x4 z; z.x = 0; z.y = 0; z.z = 0; z.w = 0; *(LAS u32x4*)(lds + 7 * ATT_STG + ATT_VOF + 16 * tid) = z; }
    ATT_WAITV(0);
    __syncthreads();
    f32x16 Sa, Sb; v8i_t FA, FB, FC, FD;
    { v8i_t Kf; Kf.lo = *(const LAS v4i_ta*)(lds + 3 * ATT_STG + ka0); Kf.hi = *(const LAS v4i_ta*)(lds + 3 * ATT_STG + ka1);
      Sa = __builtin_amdgcn_mfma_scale_f32_32x32x64_f8f6f4(Kf, Qf, CB, 0, 0, 0, sK, 0, sQ);
      Kf.lo = *(const LAS v4i_ta*)(lds + 3 * ATT_STG + 4096 + ka0); Kf.hi = *(const LAS v4i_ta*)(lds + 3 * ATT_STG + 4096 + ka1);
      Sb = __builtin_amdgcn_mfma_scale_f32_32x32x64_f8f6f4(Kf, Qf, CB, 0, 0, 0, sK, 0, sQ);
      FA.lo = *(const LAS v4i_ta*)(lds + 7 * ATT_STG + va0); FA.hi = *(const LAS v4i_ta*)(lds + 7 * ATT_STG + va1);
      FB.lo = *(const LAS v4i_ta*)(lds + 7 * ATT_STG + 2048 + va0); FB.hi = *(const LAS v4i_ta*)(lds + 7 * ATT_STG + 2048 + va1); }
    v8i_t PfP;
#pragma unroll
    for (int i = 0; i < 8; ++i) PfP[i] = 0;
    __syncthreads();
#define ATT_PACK(S, r0, dst) if (probe & 2) { asm volatile("" :: "v"(S[(r0)]), "v"(S[(r0) + 3])); dst = PfP[0] + (r0); } else { unsigned w = 0; _Pragma("unroll") for (int c = 0; c < 4; ++c) w = __builtin_amdgcn_cvt_pk_u8_f32(__builtin_amdgcn_fmed3f(S[(r0) + c], 0.0f, hi), c, w); dst = (int)w; }
#define ATT_LDV(dst, base, dvb) if (probe & 4) { dst = Qf; } else { dst.lo = *(const LAS v4i_ta*)(base + (dvb) * 2048 + va0); dst.hi = *(const LAS v4i_ta*)(base + (dvb) * 2048 + va1); }
#define ATT_LDK(dst, kb) if (probe & 4) { dst = Qf; } else { dst.lo = *(const LAS v4i_ta*)(rd + (kb) * 4096 + ka0); dst.hi = *(const LAS v4i_ta*)(rd + (kb) * 4096 + ka1); }
#define ATT_MFMA(D, A_, B_, C_, sa, sb) if (probe & 32) { asm volatile("" :: "v"(A_)); D = __builtin_amdgcn_mfma_scale_f32_32x32x64_f8f6f4(Qf, B_, C_, 0, 0, 0, sa, 0, sb); asm volatile("" : "+v"(D)); } else if (!(probe & 1)) { D = __builtin_amdgcn_mfma_scale_f32_32x32x64_f8f6f4(A_, B_, C_, 0, 0, 0, sa, 0, sb); asm volatile("" : "+v"(D)); } else { asm volatile("" :: "v"(A_), "v"(B_)); }
#define ATT_SB __builtin_amdgcn_sched_barrier(0)
#define ATT_INTERVAL(I, F0, F1, F2, F3, BAR) { \
        LAS unsigned char* rd = lds + (((I) + 7) & 7) * ATT_STG; LAS unsigned char* pf = lds + ((I) & 7) * ATT_STG; \
        const float hi = __builtin_bit_cast(float, __builtin_amdgcn_readfirstlane((I) < ntile ? 0x42fc0000 : 0));     \
        v8i_t PfN; \
        ATT_SB; \
        ATT_LDK(F2, 0); \
        if (!(probe & 1)) { Ol = __builtin_amdgcn_mfma_scale_f32_16x16x128_f8f6f4(Aones, PfP, Ol, 0, 0, 0, sV, 0, sP); asm volatile("" : "+v"(Ol)); } else { asm volatile("" :: "v"(Aones), "v"(PfP)); } \
        ATT_PACK(Sa, 0, PfN[0]); ATT_PACK(Sa, 4, PfN[1]); \
        ATT_SB; \
        ATT_LDV(F3, rd, 2); \
        ATT_MFMA(O[0], F0, PfP, O[0], sV, sP); \
        ATT_PACK(Sa, 8, PfN[2]); ATT_PACK(Sa, 12, PfN[3]); \
        ATT_SB; \
        ATT_MFMA(O[1], F1, PfP, O[1], sV, sP); \
        if (!(probe & 8)) ATT_DMAK((((I) + 3) & 7) * ATT_STG, (I) + 5);     \
        ATT_LDK(F0, 1); \
        ATT_PACK(Sb, 0, PfN[4]); ATT_PACK(Sb, 4, PfN[5]); \
        ATT_SB; \
        ATT_MFMA(Sa, F2, Qf, CB, sK, sQ); \
        ATT_LDV(F1, rd, 3); \
        ATT_PACK(Sb, 8, PfN[6]); ATT_PACK(Sb, 12, PfN[7]); \
        ATT_SB; \
        ATT_MFMA(O[2], F3, PfP, O[2], sV, sP); \
        if (!(probe & 8)) ATT_DMAV((((I) + 3) & 7) * ATT_STG, (I) + 3); \
        ATT_LDV(F2, pf, 0); \
        ATT_SB; \
        ATT_MFMA(Sb, F0, Qf, CB, sK, sQ); \
        ATT_LDV(F3, pf, 1); \
        ATT_SB; \
        ATT_MFMA(O[3], F1, PfP, O[3], sV, sP); \
        ATT_SB; \
        PfP = PfN; \
        if (BAR) { asm volatile("s_waitcnt vmcnt(2) lgkmcnt(4)" ::: "memory");     \
            if (!(probe & 16)) { __builtin_amdgcn_s_barrier(); asm volatile("" ::: "memory"); } } \
        else asm volatile("" ::: "memory");     }
#pragma unroll 1
    for (int i = 0; i <= ntile; i += 8) {
        ATT_INTERVAL(i, FA, FB, FC, FD, 0);
        ATT_INTERVAL(i + 1, FC, FD, FA, FB, 1);
        ATT_INTERVAL(i + 2, FA, FB, FC, FD, 0);
        ATT_INTERVAL(i + 3, FC, FD, FA, FB, 1);
        ATT_INTERVAL(i + 4, FA, FB, FC, FD, 0);
        ATT_INTERVAL(i + 5, FC, FD, FA, FB, 1);
        ATT_INTERVAL(i + 6, FA, FB, FC, FD, 0);
        ATT_INTERVAL(i + 7, FC, FD, FA, FB, 1);
    }
    ATT_WAITV(0);
#undef ATT_INTERVAL
#undef ATT_MFMA
#undef ATT_DMAK
#undef ATT_DMAV
#undef ATT_WAITV
#undef ATT_PACK
#undef ATT_LDV
#undef ATT_LDK
#undef ATT_SB
    if (probe) { _Pragma("unroll") for (int i = 0; i < 4; ++i) asm volatile("" :: "v"(O[i])); asm volatile("" :: "v"(Ol), "v"(Sa), "v"(Sb), "v"(PfP), "v"(FA), "v"(FB)); __syncthreads(); return; }
    const float ls0 = __shfl(Ol[0], lane & 15), ls1 = __shfl(Ol[1], lane & 15); const float lsum = (lane & 16) ? ls1 : ls0;
    const float inv = fast_rcp(lsum);
    __syncthreads();
    LAS float* ex = (LAS float*)lds + qq * 4096;
    if (br == 1) { const float f = lam * inv;
#pragma unroll
        for (int dvb = 0; dvb < 4; ++dvb)
#pragma unroll
            for (int j = 0; j < 16; ++j) ex[(dvb * 16 + j) * 64 + lane] = O[dvb][j] * f; }
    __syncthreads();
    if (br == 0) { float ss = 0.f;
#pragma unroll
        for (int dvb = 0; dvb < 4; ++dvb)
#pragma unroll
            for (int j = 0; j < 16; ++j) {
#ifdef ATT_NOEX
                const float v = O[dvb][j] * inv;
#else
                const float v = O[dvb][j] * inv - ex[(dvb * 16 + j) * 64 + lane];
#endif
                O[dvb][j] = v; ss += v * v; }
        ss += __shfl_xor(ss, 32);
        const float rinv = __builtin_amdgcn_rsqf(ss * (1.0f / 128.0f) + EPS) * outscale;
        LAS unsigned char* ot = lds + 65536 + qq * 8704;
#pragma unroll
        for (int dvb = 0; dvb < 4; ++dvb)
#pragma unroll
            for (int a = 0; a < 4; ++a) { const int dv = 32 * dvb + 8 * a + 4 * hh; const f32x4 w = *(const f32x4*)(subw + dv);
                u32x2 o; o.x = pk2(O[dvb][4 * a] * rinv * w[0], O[dvb][4 * a + 1] * rinv * w[1]); o.y = pk2(O[dvb][4 * a + 2] * rinv * w[2], O[dvb][4 * a + 3] * rinv * w[3]);
                *(LAS u32x2*)(ot + l31 * 272 + 2 * dv) = o; }
        unsigned char* op = (unsigned char*)MIX + (size_t)(qrow0 + 32 * qq) * D + 512 + head * 128 + 8 * (lane & 15);
#pragma unroll
        for (int i = 0; i < 8; ++i) { const int r = 4 * i + (lane >> 4); const u32x4 v = *(const LAS u32x4*)(ot + r * 272 + 16 * (lane & 15)); u32x2 o;
            o.x = pk4_fp8(bflo(v.x) * SC_MIX, bfhi(v.x) * SC_MIX, bflo(v.y) * SC_MIX, bfhi(v.y) * SC_MIX); o.y = pk4_fp8(bflo(v.z) * SC_MIX, bfhi(v.z) * SC_MIX, bflo(v.w) * SC_MIX, bfhi(v.w) * SC_MIX);
            *(u32x2*)(op + (size_t)r * D) = o; } }
    __syncthreads();
}

__device__ __forceinline__ float log2_gamma(float logit) { return -__builtin_log2f(1.0f + fast_exp2(-logit * LOG2E)); }
__device__ __forceinline__ bf16x8 scale8(bf16x8 v, const float (&f)[8]) {
    const u32x4 w = __builtin_bit_cast(u32x4, v); u32x4 o;
    o.x = pk2(bflo(w.x) * f[0], bfhi(w.x) * f[1]); o.y = pk2(bflo(w.y) * f[2], bfhi(w.y) * f[3]); o.z = pk2(bflo(w.z) * f[4], bfhi(w.z) * f[5]); o.w = pk2(bflo(w.w) * f[6], bfhi(w.w) * f[7]);
    return __builtin_bit_cast(bf16x8, o);
}
__device__ __forceinline__ bf16x8 scale8s(bf16x8 v, float f) {
    const u32x4 w = __builtin_bit_cast(u32x4, v); u32x4 o;
    o.x = pk2(bflo(w.x) * f, bfhi(w.x) * f); o.y = pk2(bflo(w.y) * f, bfhi(w.y) * f); o.z = pk2(bflo(w.z) * f, bfhi(w.z) * f); o.w = pk2(bflo(w.w) * f, bfhi(w.w) * f);
    return __builtin_bit_cast(bf16x8, o);
}
__device__ __forceinline__ void ret_kv_unit(LAS unsigned char* lds, const bf16_t* P, bf16_t* KVT, const float* decay_logit  , int b, int j, int head) {
    const int tid = threadIdx.x, wid = __builtin_amdgcn_readfirstlane(tid >> 6), lane = tid & 63, eb = wid & 3, dir = wid >> 2, l31 = lane & 31, hh = lane >> 5;
    const int rbase = b * SEQU + 128 * j;
    LAS unsigned char* vimg = lds; LAS unsigned char* kimg = lds + 32768;
    __syncthreads();
    stage_offb(vimg, P + (size_t)rbase * LDP + OFF_RV + head * 128, LDP, 128, tid);
    stage_offb(kimg, P + (size_t)rbase * LDP + OFF_RK + head * 128, LDP, 128, tid);
    const float l2g = log2_gamma(decay_logit[dir * 4 + head]);
    asm volatile("s_waitcnt vmcnt(0)" ::: "memory"); __syncthreads();
    f32x16 acc[4];
#pragma unroll
    for (int i = 0; i < 4; ++i)
#pragma unroll
        for (int q = 0; q < 16; ++q) acc[i][q] = 0.f;
#pragma unroll 2
    for (int ks = 0; ks < 8; ++ks) {
        const unsigned rb = 16 * ks + 8 * hh;
        bf16x8 vf = ld_tr2(vimg + tr_addr(lane, rb, eb), vimg + tr_addr(lane, rb + 4, eb));
        float f[8];
#pragma unroll
        for (int q = 0; q < 8; ++q) { const int i = (int)rb + q; f[q] = fast_exp2(l2g * (float)(dir == 0 ? 127 - i : i)); }
        vf = scale8(vf, f);
#pragma unroll
        for (int db = 0; db < 4; ++db) { const bf16x8 kf = ld_tr2(kimg + tr_addr(lane, rb, db), kimg + tr_addr(lane, rb + 4, db)); acc[db] = mfma32(vf, kf, acc[db]); }
    }
    bf16_t* out = KVT + ((((size_t)(b * 4 + head) * 2 + dir) * NCH128 + j) << 14);
#pragma unroll
    for (int db = 0; db < 4; ++db)
#pragma unroll
        for (int q = 0; q < 16; ++q) { const int e = 32 * eb + (q & 3) + 8 * (q >> 2) + 4 * hh; const float v = acc[db][q], vn = __shfl_xor(v, 1);
            if ((lane & 1) == 0) *(unsigned*)(out + e * 128 + 32 * db + l31) = pk2(v, vn); }
    __syncthreads();
}
__device__ __forceinline__ void ret_state_phase(const bf16_t* KVT, bf16_t* ST, const float* decay_logit, int gtid, int gn) {
    for (int id = gtid; id < 16 * 8192; id += gn) {
        const int seq = id >> 13, el = (id & 8191) * 2, dir = seq & 1, head = (seq >> 1) & 3;
        const float G = fast_exp2(128.0f * log2_gamma(decay_logit[dir * 4 + head]));
        const bf16_t* kv = KVT + ((size_t)seq * NCH128 << 14) + el; bf16_t* st = ST + ((size_t)seq * NCH128 << 14) + el;
        float s0 = 0.f, s1 = 0.f;
        for (int sb = 0; sb < NCH128; sb += 22) {
            unsigned kk[22]; int jj[22];
#pragma unroll
            for (int q = 0; q < 22; ++q) { const int s = sb + q; jj[q] = dir == 0 ? s : (s == 0 ? 1 : s == 1 ? 0 : 67 - s); kk[q] = *(const unsigned*)(kv + ((size_t)jj[q] << 14)); }
#pragma unroll
            for (int q = 0; q < 22; ++q) { *(unsigned*)(st + ((size_t)jj[q] << 14)) = pk2(s0, s1); s0 = s0 * G + bflo(kk[q]); s1 = s1 * G + bfhi(kk[q]); }
        }
    }
}
__device__ __forceinline__ void ret_out_unit(LAS unsigned char* lds, const bf16_t* P, const bf16_t* ST, bf16_t* MIX, const float* decay_logit, const float* normw, int b, int j, int hp) {
    const int tid = threadIdx.x, wid = __builtin_amdgcn_readfirstlane(tid >> 6), lane = tid & 63, hsel = wid >> 2, qq = wid & 3, l31 = lane & 31, hh = lane >> 5;
    const int head = 2 * hp + hsel, rbase = b * SEQU + 128 * j, qi = 32 * qq + l31, qrow = rbase + qi;
    LAS unsigned char* vimg = lds + hsel * 32768; LAS unsigned char* kimg = lds + 65536 + hsel * 32768;
    __syncthreads();
    stage_offb(lds, P + (size_t)rbase * LDP + OFF_RV + (2 * hp) * 128, LDP, 128, tid);
    stage_offb(lds + 32768, P + (size_t)rbase * LDP + OFF_RV + (2 * hp + 1) * 128, LDP, 128, tid);
    stage_offb(lds + 65536, P + (size_t)rbase * LDP + OFF_RK + (2 * hp) * 128, LDP, 128, tid);
    stage_offb(lds + 98304, P + (size_t)rbase * LDP + OFF_RK + (2 * hp + 1) * 128, LDP, 128, tid);
    const float l2f = log2_gamma(decay_logit[head]), l2b = log2_gamma(decay_logit[4 + head]);
    bf16x8 Qf[8];
#pragma unroll
    for (int ks = 0; ks < 8; ++ks) Qf[ks] = *(const bf16x8*)(P + (size_t)qrow * LDP + OFF_RQ + head * 128 + 16 * ks + 8 * hh);
    f32x16 O[4];
#pragma unroll
    for (int i = 0; i < 4; ++i)
#pragma unroll
        for (int q = 0; q < 16; ++q) O[i][q] = 0.f;
    asm volatile("s_waitcnt vmcnt(0)" ::: "memory"); __syncthreads();
    for (int kb = 0; kb < 4; ++kb) {
        f32x16 S; const float z0 = opaque_zero();
#pragma unroll
        for (int q = 0; q < 16; ++q) S[q] = z0;
#pragma unroll
        for (int ks = 0; ks < 8; ++ks) { const bf16x8 kf = *(const LAS bf16x8_a*)(kimg + off_b(32 * kb + l31, 2 * ks + hh)); S = mfma32(kf, Qf[ks], S); }
#pragma unroll
        for (int q = 0; q < 16; ++q) { const int ik = 32 * kb + (q & 3) + 8 * (q >> 2) + 4 * hh, dlt = qi - ik;
            const float m = (dlt >= 0 ? fast_exp2(l2f * (float)dlt) : 0.f) + (dlt <= 0 ? fast_exp2(l2b * (float)(-dlt)) : 0.f); S[q] *= m; }
#pragma unroll
        for (int s = 0; s < 2; ++s) { const bf16x8 pf = pack8(S, s); const unsigned rb = 32 * kb + 16 * s + 4 * hh;
#pragma unroll
            for (int eb = 0; eb < 4; ++eb) { const bf16x8 vf = ld_tr2(vimg + tr_addr(lane, rb, eb), vimg + tr_addr(lane, rb + 8, eb)); O[eb] = mfma32(vf, pf, O[eb]); } }
    }
    __syncthreads();
#pragma unroll
    for (int t = 0; t < 4; ++t) stage_offb(lds + t * 32768, ST + ((((size_t)(b * 4 + 2 * hp + (t >> 1)) * 2 + (t & 1)) * NCH128 + j) << 14), 128, 128, tid);
    asm volatile("s_waitcnt vmcnt(0)" ::: "memory"); __syncthreads();
#pragma unroll
    for (int dir = 0; dir < 2; ++dir) {
        const float qd = dir == 0 ? fast_exp2(l2f * (float)(qi + 1)) : fast_exp2(l2b * (float)(128 - qi));
        const LAS unsigned char* simg = lds + (hsel * 2 + dir) * 32768;
#pragma unroll
        for (int ks = 0; ks < 8; ++ks) { const bf16x8 qs = scale8s(Qf[ks], qd);
#pragma unroll
            for (int eb = 0; eb < 4; ++eb) { const bf16x8 sf = *(const LAS bf16x8_a*)(simg + off_b(32 * eb + l31, 2 * ks + hh)); O[eb] = mfma32(sf, qs, O[eb]); } }
    }
    float sm = 0.f;
#pragma unroll
    for (int eb = 0; eb < 4; ++eb)
#pragma unroll
        for (int q = 0; q < 16; ++q) sm += O[eb][q];
    sm += __shfl_xor(sm, 32); const float mu = sm * (1.0f / 128.0f);
    float vs = 0.f;
#pragma unroll
    for (int eb = 0; eb < 4; ++eb)
#pragma unroll
        for (int q = 0; q < 16; ++q) { const float d = O[eb][q] - mu; O[eb][q] = d; vs += d * d; }
    vs += __shfl_xor(vs, 32); const float rinv = __builtin_amdgcn_rsqf(vs * (1.0f / 128.0f) + EPS);
    __syncthreads();
    LAS unsigned char* ot = lds + wid * 8704;
#pragma unroll
    for (int eb = 0; eb < 4; ++eb)
#pragma unroll
        for (int a = 0; a < 4; ++a) { const int e = 32 * eb + 8 * a + 4 * hh; const f32x4 w = *(const f32x4*)(normw + head * 128 + e);
            u32x2 o; o.x = pk2(O[eb][4 * a] * rinv * w[0], O[eb][4 * a + 1] * rinv * w[1]); o.y = pk2(O[eb][4 * a + 2] * rinv * w[2], O[eb][4 * a + 3] * rinv * w[3]);
            *(LAS u32x2*)(ot + l31 * 272 + 2 * e) = o; }
    int ln = lane; asm volatile("" : "+v"(ln));
#pragma unroll
    for (int i = 0; i < 8; ++i) { const int r = 4 * i + (ln >> 4), c8 = 8 * (ln & 15); const size_t row = (size_t)(rbase + 32 * qq + r);
        const u32x4 v = *(const LAS u32x4*)(ot + r * 272 + 2 * c8), g = *(const u32x4*)(P + row * LDP + OFF_RG + head * 128 + c8);
        u32x2 o; o.x = pk4_fp8(bflo(v.x) * bflo(g.x) * SC_MIX, bfhi(v.x) * bfhi(g.x) * SC_MIX, bflo(v.y) * bflo(g.y) * SC_MIX, bfhi(v.y) * bfhi(g.y) * SC_MIX);
        o.y = pk4_fp8(bflo(v.z) * bflo(g.z) * SC_MIX, bfhi(v.z) * bfhi(g.z) * SC_MIX, bflo(v.w) * bflo(g.w) * SC_MIX, bfhi(v.w) * bfhi(g.w) * SC_MIX);
        *(u32x2*)((unsigned char*)MIX + row * D + head * 128 + c8) = o; }
    __syncthreads();
}

typedef unsigned __attribute__((may_alias)) u32_a;
typedef unsigned short __attribute__((may_alias)) u16_a;
__device__ __forceinline__ f32x4 mfma16(bf16x8 a, bf16x8 b, f32x4 c) { return __builtin_amdgcn_mfma_f32_16x16x32_bf16(a, b, c, 0, 0, 0); }
struct S5Ops { bf16x8 uf, bre, bim; };
__device__ __forceinline__ S5Ops s5_scan_load(const bf16_t* P, const bf16_t* BFp  , int rbase, int g, int dir, int lane) {
    const int rho = lane & 31, hk = lane >> 5;
    const int tscan = 16 * ((rho >> 2) & 1) + 4 * (rho >> 3) + (rho & 3), tok = dir == 0 ? tscan : 31 - tscan;
    S5Ops o; o.uf = *(const bf16x8*)(P + (size_t)(rbase + tok) * LDP + OFF_U + 16 * g + 8 * hk);
    o.bre = *(const bf16x8*)(BFp + lane * 8); o.bim = *(const bf16x8*)(BFp + 512 + lane * 8); return o;
}
__device__ __forceinline__ void s5_scan_core(const S5Ops& ops, int lane, f32x2 a, f32x2 init, f32x16& xr, f32x16& xi, const bool endonly = false, f32x2 a16 = (f32x2){0.f, 0.f});
__device__ __forceinline__ void s5_scan(const bf16_t* P, const bf16_t* BFp, int rbase, int g, int dir, int lane, f32x2 a, f32x2 init, f32x16& xr, f32x16& xi, const bool endonly = false, f32x2 a16 = (f32x2){0.f, 0.f}) {
    const S5Ops ops = s5_scan_load(P, BFp, rbase, g, dir, lane); s5_scan_core(ops, lane, a, init, xr, xi, endonly, a16);
}
__device__ __forceinline__ void s5_scan_core(const S5Ops& ops, int lane, f32x2 a, f32x2 init, f32x16& xr, f32x16& xi, const bool endonly, f32x2 a16) {
    const int hk = lane >> 5;
    const bf16x8 uf = ops.uf, bre = ops.bre, bim = ops.bim;
    const float zero = opaque_zero();
    f32x16 zr, zi;
#pragma unroll
    for (int q = 0; q < 16; ++q) { zr[q] = zero; zi[q] = zero; }
    const f32x16 br = mfma32(uf, bre, zr), bi = mfma32(uf, bim, zi);
#ifdef S5_NOSCAN
#pragma unroll
    for (int q = 0; q < 16; ++q) { xr[q] = br[q]; xi[q] = bi[q]; }
    return;
#endif
#ifdef S5_USEA
#pragma unroll
    for (int q = 0; q < 16; ++q) { xr[q] = br[q] * a[0] + init[0]; xi[q] = bi[q] * a[1] + init[1]; }
    return;
#endif
    float sr = hk == 0 ? init[0] : 0.f, si = hk == 0 ? init[1] : 0.f;
#pragma unroll
    for (int q = 0; q < 16; ++q) { float nr = __builtin_fmaf(a[0], sr, __builtin_fmaf(-a[1], si, br[q])), ni = __builtin_fmaf(a[0], si, __builtin_fmaf(a[1], sr, bi[q])); asm("" : "+v"(nr)); asm("" : "+v"(ni)); sr = nr; si = ni; xr[q] = sr; xi[q] = si; }
#ifdef S5_NOFIX
    return;
#endif
    float er = __shfl(sr, lane & 31), ei = __shfl(si, lane & 31);
    if (hk == 0) { er = 0.f; ei = 0.f; }
    if (endonly) {
        float t0 = __builtin_fmaf(a16[0], er, __builtin_fmaf(-a16[1], ei, xr[15])), t1 = __builtin_fmaf(a16[0], ei, __builtin_fmaf(a16[1], er, xi[15])); asm("" : "+v"(t0)); asm("" : "+v"(t1)); xr[15] = t0; xi[15] = t1; return; }
    float wr_ = a[0], wi_ = a[1];
#pragma unroll
    for (int q = 0; q < 16; ++q) { float t0 = __builtin_fmaf(wr_, er, __builtin_fmaf(-wi_, ei, xr[q])), t1 = __builtin_fmaf(wr_, ei, __builtin_fmaf(wi_, er, xi[q])); asm("" : "+v"(t0)); asm("" : "+v"(t1)); xr[q] = t0; xi[q] = t1;
        float nr = __builtin_fmaf(wr_, a[0], -wi_ * a[1]), ni = __builtin_fmaf(wr_, a[1], wi_ * a[0]); asm("" : "+v"(nr)); asm("" : "+v"(ni)); wr_ = nr; wi_ = ni; }
}
__device__ __forceinline__ void s5_end_unit(const Args& A, int l, int b, int c) {
    const int tid = threadIdx.x, wid = __builtin_amdgcn_readfirstlane(tid >> 6), lane = tid & 63;
    const bf16_t* P = (const bf16_t*)(A.ws + WS_P); const f32x2* SA = (const f32x2*)(A.ws + WS_S5A); const bf16_t* BF = (const bf16_t*)(A.ws + WS_S5BF); f32x2* E = (f32x2*)(A.ws + WS_S5E);
    const int rbase = b * SEQU + 32 * c;
    for (int gi = 0; gi < 4; ++gi) { const int g = 4 * wid + gi;
#pragma unroll
        for (int d = 0; d < 2; ++d)
#pragma unroll
            for (int pb = 0; pb < 2; ++pb) { const int p = 32 * pb + (lane & 31); const f32x2 a = SA[((l * 2 + d) * 32 + g) * 64 + p];
                f32x16 xr, xi; s5_scan(P, BF + ((((size_t)(l * 2 + d) * 32 + g) * 2 + pb) * 2) * 512, rbase, g, d, lane, a, (f32x2){0.f, 0.f}, xr, xi, true, SA[S5A_N + ((l * 2 + d) * 32 + g) * 64 + p]);
                if (lane >= 32) E[(((size_t)(b * 2 + d) * NCH32 + c) * 32 + g) * 64 + p] = (f32x2){xr[15], xi[15]}; }
    }
}
__device__ __forceinline__ void s5_carry_phase(const Args& A, int l, LAS unsigned char* lds, int vcu, int G) {
    const int tid = threadIdx.x, wid = __builtin_amdgcn_readfirstlane(tid >> 6), lane = tid & 63;
    const f32x2* SA = (const f32x2*)(A.ws + WS_S5A) + 2 * S5A_N; const f32x2* E = (const f32x2*)(A.ws + WS_S5E); f32x2* XC = (f32x2*)(A.ws + WS_S5X);
    LAS f32x2* T = (LAS f32x2*)lds;
    for (int u = G - 1 - vcu; u < 128; u += G) { const int gp = (u & 31) * 64 + lane, d = (u >> 5) & 1, b = u >> 6;
        const f32x2 a = SA[(l * 2 + d) * 2048 + gp]; const size_t base = (size_t)(b * 2 + d) * NCH32 * 2048 + gp;
        f32x2 ev[33];
#pragma unroll
        for (int q = 0; q < 33; ++q) { const int s = 33 * wid + q, cc = d == 0 ? s : (s < 8 ? 7 - s : 271 - s); ev[q] = E[base + (size_t)cc * 2048]; }
        float pr = 0.f, pi = 0.f;
#pragma unroll
        for (int q = 0; q < 33; ++q) { const f32x2 e = ev[q]; ev[q] = (f32x2){pr, pi}; const float nr = a[0] * pr - a[1] * pi + e[0], ni = a[0] * pi + a[1] * pr + e[1]; pr = nr; pi = ni; }
        __syncthreads();
        T[wid * 64 + lane] = (f32x2){pr, pi};
        float wr_ = 1.f, wi_ = 0.f;
#pragma unroll
        for (int q = 0; q < 33; ++q) { const float nr = wr_ * a[0] - wi_ * a[1], ni = wr_ * a[1] + wi_ * a[0]; wr_ = nr; wi_ = ni; }
        __syncthreads();
        float cr = 0.f, ci = 0.f;
        for (int v = 0; v < wid; ++v) { const f32x2 t = T[v * 64 + lane]; const float nr = wr_ * cr - wi_ * ci + t[0], ni = wr_ * ci + wi_ * cr + t[1]; cr = nr; ci = ni; }
#pragma unroll
        for (int q = 0; q < 33; ++q) { const int s = 33 * wid + q, cc = d == 0 ? s : (s < 8 ? 7 - s : 271 - s);
            XC[base + (size_t)cc * 2048] = (f32x2){ev[q][0] + cr, ev[q][1] + ci}; const float nr = a[0] * cr - a[1] * ci, ni = a[0] * ci + a[1] * cr; cr = nr; ci = ni; }
    }
}
constexpr int S5_XPITCH = 272, S5_XIMG = 32 * S5_XPITCH  , S5_YOFF = 8 * S5_XIMG  , S5_YPITCH = 1040;
__device__ __forceinline__ void s5_out_unit(LAS unsigned char* lds, const Args& A, int l, int b, int c) {
    const int tid = threadIdx.x, wid = __builtin_amdgcn_readfirstlane(tid >> 6), lane = tid & 63, l31 = lane & 31, hk = lane >> 5, l15 = lane & 15, kq = lane >> 4;
    const bf16_t* P = (const bf16_t*)(A.ws + WS_P); const f32x2* SA = (const f32x2*)(A.ws + WS_S5A); const bf16_t* BF = (const bf16_t*)(A.ws + WS_S5BF); const bf16_t* CF = (const bf16_t*)(A.ws + WS_S5CF);
    const f32x2* XC = (const f32x2*)(A.ws + WS_S5X); bf16_t* MIX = (bf16_t*)(A.ws + WS_MIX); const bf16_t* GLU = (const bf16_t*)(A.ws + WS_GLU) + (size_t)l * 512 * 512;
    const int rbase = b * SEQU + 32 * c;
    LAS unsigned char* ximg = lds + wid * S5_XIMG; LAS unsigned char* yimg = lds + S5_YOFF;
    __syncthreads();
#ifdef S5_COPYU
    for (int i = tid; i < 32 * 64; i += NTHR) { const int t = i >> 6, c8 = (i & 63) * 8; *(u32x4*)(MIX + (size_t)(rbase + t) * D + 1536 + c8) = *(const u32x4*)(P + (size_t)(rbase + t) * LDP + OFF_U + c8); }
    __syncthreads(); return;
#endif
    for (int gi = 0; gi < 4; ++gi) { const int g = 4 * wid + gi;
        const float z0 = opaque_zero(); f32x4 ya[2] = {{z0, z0, z0, z0}, {z0, z0, z0, z0}};
        bf16x8 cfr[4];
#pragma unroll
        for (int ks = 0; ks < 4; ++ks) cfr[ks] = *(const bf16x8*)(CF + (((size_t)l * 32 + g) * 4 + ks) * 512 + lane * 8);
        const int ch = 16 * g + l15; const float dv = A.s5_d[l * 512 + ch]; unsigned short uraw[2][4];
#pragma unroll
        for (int rb = 0; rb < 2; ++rb)
#pragma unroll
            for (int q = 0; q < 4; ++q) uraw[rb][q] = P[(size_t)(rbase + 16 * rb + 4 * kq + q) * LDP + OFF_U + ch];
        S5Ops sops[2][2]; f32x2 sa_[2][2], sin_[2][2];
#pragma unroll
        for (int d = 0; d < 2; ++d)
#pragma unroll
            for (int pb = 0; pb < 2; ++pb) { const int p = 32 * pb + l31; sops[d][pb] = s5_scan_load(P, BF + ((((size_t)(l * 2 + d) * 32 + g) * 2 + pb) * 2) * 512, rbase, g, d, lane);
                sa_[d][pb] = SA[((l * 2 + d) * 32 + g) * 64 + p];
#ifdef S5_NOINIT
                sin_[d][pb] = (f32x2){0.f, 0.f};
#else
                sin_[d][pb] = XC[(((size_t)(b * 2 + d) * NCH32 + c) * 32 + g) * 64 + p];
#endif
            }
#pragma unroll
        for (int d = 0; d < 2; ++d) {
#pragma unroll
            for (int pb = 0; pb < 2; ++pb) { const int p = 32 * pb + l31;
                f32x16 xr, xi; s5_scan_core(sops[d][pb], lane, sa_[d][pb], sin_[d][pb], xr, xi);
#pragma unroll
                for (int q = 0; q < 16; ++q) { const int ts = 16 * hk + q, t = d == 0 ? ts : 31 - ts;
                    *(LAS u32_a*)(ximg + t * S5_XPITCH + 4 * p) = pk2(xr[q], xi[q]); } }
            asm volatile("s_waitcnt lgkmcnt(0)" ::: "memory");
#pragma unroll
            for (int ks = 0; ks < 4; ++ks) { const bf16x8 cf = cfr[ks];
#pragma unroll
                for (int rb = 0; rb < 2; ++rb) { const bf16x8 xf = *(const LAS bf16x8_a*)(ximg + (16 * rb + l15) * S5_XPITCH + 2 * (32 * ks + 8 * kq)); ya[rb] = mfma16(xf, cf, ya[rb]); } }
            asm volatile("s_waitcnt lgkmcnt(0)" ::: "memory");
        }
#pragma unroll
        for (int rb = 0; rb < 2; ++rb)
#pragma unroll
            for (int q = 0; q < 4; ++q) { const int t = 16 * rb + 4 * kq + q; const float u = bf2f(uraw[rb][q]);
                const float yv = gelu_tanh(ya[rb][q] + dv * u), yn = __shfl_xor(yv, 1);
                if ((lane & 1) == 0) *(LAS u32_a*)(yimg + t * S5_YPITCH + 2 * ch) = pk2(yv, yn); }
    }
    __syncthreads();
    f32x16 z[2];
#pragma unroll
    for (int nb = 0; nb < 2; ++nb)
#pragma unroll
        for (int q = 0; q < 16; ++q) z[nb][q] = 0.f;
#ifndef S5_NOGLU
#pragma unroll 4
    for (int ks = 0; ks < 32; ++ks) { const bf16x8 yf = *(const LAS bf16x8_a*)(yimg + l31 * S5_YPITCH + 2 * (16 * ks + 8 * hk));
#pragma unroll
        for (int nb = 0; nb < 2; ++nb) { const bf16x8 wf = *(const bf16x8*)(GLU + ((size_t)((((wid * 2 + nb) * 32 + ks) * 2 + hk) * 32 + l31) << 3)); z[nb] = mfma32(yf, wf, z[nb]); } }
#endif
#pragma unroll
    for (int nb = 0; nb < 2; ++nb)
#pragma unroll
        for (int q = 0; q < 16; ++q) { const int t = (q & 3) + 8 * (q >> 2) + 4 * hk, n = 64 * wid + 32 * nb + l31;
            const float y = bf2f(*(const LAS u16_a*)(yimg + t * S5_YPITCH + 2 * n));
            const float ov = y * sigmoidf_(z[nb][q]) * SC_MIX, on = __shfl_xor(ov, 1);
            const unsigned p2 = (unsigned)__builtin_amdgcn_cvt_pk_fp8_f32(__builtin_amdgcn_fmed3f(ov, -448.f, 448.f), __builtin_amdgcn_fmed3f(on, -448.f, 448.f), 0, false) & 0xffffu, p4 = __shfl_xor(p2, 2);
            if ((lane & 3) == 0) *(unsigned*)((unsigned char*)MIX + (size_t)(rbase + t) * D + 1536 + n) = p2 | (p4 << 16); }
    __syncthreads();
}

constexpr int RT_RS = 0, RT_PART = 1024, RT_SC = RT_PART + 8 * 32 * 64 * 4  , RT_SEL = RT_SC + 32 * 65 * 4, RT_E = RT_SEL + 32 * 65 * 4, RT_CNT = RT_E + 32 * 8 * 4, RT_BASE = RT_CNT + 256, RT_END = RT_BASE + 256;
__device__ __forceinline__ void route_unit(LAS unsigned char* lds, const Args& A, int l, int r0, bool dry = false) {
    const int tid = threadIdx.x, wid = __builtin_amdgcn_readfirstlane(tid >> 6), lane = tid & 63, l31 = lane & 31, hk = lane >> 5;
    const bf16_t* X = (const bf16_t*)(A.ws + WS_X); bf16_t* H = (bf16_t*)(A.ws + WS_H); const float* MOD = (const float*)(A.ws + WS_MOD); const bf16_t* RWH = (const bf16_t*)(A.ws + WS_RWT) + (size_t)l * NEXP * D; const bf16_t* RWL = RWH + (size_t)2 * NEXP * D;
    LAS float* rs = (LAS float*)(lds + RT_RS); LAS float* part = (LAS float*)(lds + RT_PART); LAS float* sc = (LAS float*)(lds + RT_SC); LAS float* sel = (LAS float*)(lds + RT_SEL);
    LAS int* rowE = (LAS int*)(lds + RT_E); LAS int* cntL = (LAS int*)(lds + RT_CNT); LAS int* baseL = (LAS int*)(lds + RT_BASE);
    const int mi = mod_index(r0); const float* mod = MOD + ((size_t)l * 3 + mi) * MODW; const float* sh = mod + 3 * D; const float* scv = mod + 4 * D; const float* nw = A.norm2_w + (size_t)l * D;
    LAS unsigned char* xt = lds + wid * 16384; LAS float* ssp = (LAS float*)(lds + 132096);
    __syncthreads();
    {
#pragma unroll
        for (int h = 0; h < 2; ++h) { u32x2 xv[16];
#pragma unroll
            for (int j = 0; j < 16; ++j) xv[j] = *(const u32x2*)(X + (size_t)(r0 + 16 * h + j) * D + 256 * wid + 4 * lane);
#pragma unroll
            for (int j = 0; j < 16; ++j) { const int row = 16 * h + j; *(LAS u32x2*)(xt + row * 512 + 8 * (lane ^ row)) = xv[j]; } }
    }
    float rstd;
    {
        float ss = 0.f;
#pragma unroll 8
        for (int c = 0; c < 32; ++c) { const u32x2 w = *(const LAS u32x2*)(xt + l31 * 512 + 8 * ((2 * c + hk) ^ l31)); const float a = bflo(w.x), b2 = bfhi(w.x), c2 = bflo(w.y), d2 = bfhi(w.y); ss += a * a + b2 * b2 + c2 * c2 + d2 * d2; }
        ss += __shfl_xor(ss, 32);
        if (hk == 0) ssp[wid * 32 + l31] = ss;
        __syncthreads();
        float t = 0.f;
#pragma unroll
        for (int w = 0; w < 8; ++w) t += ssp[w * 32 + l31];
        rstd = __builtin_amdgcn_rsqf(t * (1.0f / D) + EPS);
    }
    if (!dry) {
        const int col = 256 * wid + 4 * lane; const f32x4 cw = *(const f32x4*)(nw + col) * (1.0f + *(const f32x4*)(scv + col)), s0 = *(const f32x4*)(sh + col);
#pragma unroll 8
        for (int j = 0; j < 32; ++j) { const u32x2 w = *(const LAS u32x2*)(xt + j * 512 + 8 * (lane ^ j)); const float rj = __shfl(rstd, j);
            f32x4 xv; xv[0] = bflo(w.x); xv[1] = bfhi(w.x); xv[2] = bflo(w.y); xv[3] = bfhi(w.y);
            const f32x4 h2 = xv * rj * cw + s0;
            *(unsigned*)(A.ws + WS_H8 + (size_t)(r0 + j) * D + col) = pk4_fp8(h2[0] * SC_H8, h2[1] * SC_H8, h2[2] * SC_H8, h2[3] * SC_H8); }
    }
    {
        f32x16 acc[2];
#pragma unroll
        for (int cb = 0; cb < 2; ++cb)
#pragma unroll
            for (int q = 0; q < 16; ++q) acc[cb][q] = 0.f;
#pragma unroll 2
        for (int m = 0; m < 16; ++m) { const int k0 = 256 * wid + 16 * m + 8 * hk, c0 = 4 * m + 2 * hk;
            const u32x2 xa = *(const LAS u32x2*)(xt + l31 * 512 + 8 * (c0 ^ l31)), xb = *(const LAS u32x2*)(xt + l31 * 512 + 8 * ((c0 + 1) ^ l31));
            f32x4 x0, x1; x0[0] = bflo(xa.x); x0[1] = bfhi(xa.x); x0[2] = bflo(xa.y); x0[3] = bfhi(xa.y); x1[0] = bflo(xb.x); x1[1] = bfhi(xb.x); x1[2] = bflo(xb.y); x1[3] = bfhi(xb.y);
            const f32x4 h0 = x0 * rstd * *(const f32x4*)(nw + k0) * (1.0f + *(const f32x4*)(scv + k0)) + *(const f32x4*)(sh + k0);
            const f32x4 h1 = x1 * rstd * *(const f32x4*)(nw + k0 + 4) * (1.0f + *(const f32x4*)(scv + k0 + 4)) + *(const f32x4*)(sh + k0 + 4);
            u32x4 hw, lw;
            hw.x = pk2(h0[0], h0[1]); hw.y = pk2(h0[2], h0[3]); hw.z = pk2(h1[0], h1[1]); hw.w = pk2(h1[2], h1[3]);
            lw.x = pk2(h0[0] - bflo(hw.x), h0[1] - bfhi(hw.x)); lw.y = pk2(h0[2] - bflo(hw.y), h0[3] - bfhi(hw.y)); lw.z = pk2(h1[0] - bflo(hw.z), h1[1] - bfhi(hw.z)); lw.w = pk2(h1[2] - bflo(hw.w), h1[3] - bfhi(hw.w));
            const bf16x8 ah = __builtin_bit_cast(bf16x8, hw), al = __builtin_bit_cast(bf16x8, lw);
#pragma unroll
            for (int cb = 0; cb < 2; ++cb) { const size_t fo = (size_t)((((cb * 128 + 16 * wid + m) * 2 + hk) * 32 + l31) << 3); const bf16x8 bh = *(const bf16x8*)(RWH + fo), bl = *(const bf16x8*)(RWL + fo);
                acc[cb] = __builtin_amdgcn_mfma_f32_32x32x16_bf16(ah, bh, acc[cb], 0, 0, 0); acc[cb] = __builtin_amdgcn_mfma_f32_32x32x16_bf16(ah, bl, acc[cb], 0, 0, 0); acc[cb] = __builtin_amdgcn_mfma_f32_32x32x16_bf16(al, bh, acc[cb], 0, 0, 0); } }
        __syncthreads();
        if (tid < 64) cntL[tid] = 0;
#pragma unroll
        for (int cb = 0; cb < 2; ++cb)
#pragma unroll
            for (int q = 0; q < 16; ++q) part[(wid * 32 + (q & 3) + 8 * (q >> 2) + 4 * hk) * 64 + 32 * cb + l31] = acc[cb][q];
    }
    __syncthreads();
    for (int i = tid; i < 2048; i += NTHR) { float s = 0.f;
#pragma unroll
        for (int w = 0; w < 8; ++w) s += part[w * 2048 + i];
        const int row = i >> 6, e = i & 63; const float sg = 1.0f / (1.0f + __expf(-s)); sc[row * 65 + e] = sg; sel[row * 65 + e] = sg + A.router_b[l * NEXP + e]; }
    __syncthreads();
    {
        const int e = lane, g = e >> 3;
        for (int rr = 0; rr < 4; ++rr) { const int ri = 4 * wid + rr; const float sv = sel[ri * 65 + e], pv = sc[ri * 65 + e];
            int gr = 0;
#pragma unroll
            for (int k = 0; k < 8; ++k) { const float o = __shfl(sv, (e & ~7) + k); gr += (o > sv || (o == sv && k < (e & 7))) ? 1 : 0; }
            float gs = gr < 2 ? sv : 0.f; gs += __shfl_xor(gs, 1); gs += __shfl_xor(gs, 2); gs += __shfl_xor(gs, 4);
            int grk = 0;
#pragma unroll
            for (int k = 0; k < 8; ++k) { const float o = __shfl(gs, 8 * k); grk += (o > gs || (o == gs && k < g)) ? 1 : 0; }
            const bool allowed = grk < 4; const float mv = allowed ? sv : -INFINITY;
            int rk = 0;
#pragma unroll 4
            for (int k = 0; k < 64; ++k) { const float o = __shfl(mv, k); rk += (o > mv || (o == mv && k < e)) ? 1 : 0; }
            const bool pick = allowed && rk < 8;
            const float wsum = wave_sum(pick ? pv : 0.f);
            if (pick) { rowE[ri * 8 + rk] = e;
                if (!dry) { const int row = r0 + ri; ((int*)(A.ws + WS_TKE))[(size_t)row * 8 + rk] = e; ((float*)(A.ws + WS_TKW))[(size_t)row * 8 + rk] = pv * (2.5f / wsum); } }
        }
    }
    __syncthreads();
    int myrank = 0, mye = 0;
    if (tid < 256) { mye = rowE[tid]; myrank = __hip_atomic_fetch_add(&cntL[mye], 1, __ATOMIC_RELAXED, __HIP_MEMORY_SCOPE_WORKGROUP); }
    __syncthreads();
    if (dry) { __syncthreads(); return; }
    if (tid < 64) { const int n = cntL[tid]; baseL[tid] = n ? atomicAdd((int*)(A.ws + WS_CTL) + CW_CNT + l * 64 + tid, n) : 0; }
    __syncthreads();
    if (tid < 256) { const int pos = baseL[mye] + myrank; ((int*)(A.ws + WS_LIST))[(size_t)mye * TALL + pos] = r0 + (tid >> 3); ((int*)(A.ws + WS_TKP))[(size_t)(r0 + (tid >> 3)) * 8 + (tid & 7)] = pos; }
    __syncthreads();
}

__device__ __forceinline__ void combine_row(const Args& A, int l, int row, const LAS int* tileP, int lane, bool dry = false) {
    const int b = row / SEQU, pos = row - b * SEQU; if (l == 1 && pos < CTX) return;
    bf16_t* X = (bf16_t*)(A.ws + WS_X) + (size_t)row * D; const unsigned char* Y = A.ws + WS_Y; const float* MOD = (const float*)(A.ws + WS_MOD);
    const int mi = pos < CTX ? 2 : b; const float* g2 = MOD + ((size_t)l * 3 + mi) * MODW + 5 * D;
    const int* tke = (const int*)(A.ws + WS_TKE) + (size_t)row * 8; const int* tkp = (const int*)(A.ws + WS_TKP) + (size_t)row * 8; const float* tkw = (const float*)(A.ws + WS_TKW) + (size_t)row * 8;
    const unsigned char* yr[8]; float w[8];
#pragma unroll
    for (int s = 0; s < 8; ++s) { const int e = tke[s]; yr[s] = Y + (size_t)(256 * tileP[e] + tkp[s]) * D; w[s] = tkw[s] * (1.0f / SC_Y); }
    f32x4 xo[4][2]; float ss = 0.f;
#pragma unroll
    for (int c4 = 0; c4 < 4; ++c4) { const int col = 512 * c4 + 8 * lane; f32x4 a0 = {0.f, 0.f, 0.f, 0.f}, a1 = a0;
#pragma unroll
        for (int s = 0; s < 8; ++s) { const u32x2 y = *(const u32x2*)(yr[s] + col);
            const f32x2 p0 = __builtin_amdgcn_cvt_pk_f32_fp8((int)y.x, false), p1 = __builtin_amdgcn_cvt_pk_f32_fp8((int)y.x, true), p2 = __builtin_amdgcn_cvt_pk_f32_fp8((int)y.y, false), p3 = __builtin_amdgcn_cvt_pk_f32_fp8((int)y.y, true);
            a0[0] += w[s] * p0[0]; a0[1] += w[s] * p0[1]; a0[2] += w[s] * p1[0]; a0[3] += w[s] * p1[1]; a1[0] += w[s] * p2[0]; a1[1] += w[s] * p2[1]; a1[2] += w[s] * p3[0]; a1[3] += w[s] * p3[1]; }
        const f32x4 x0 = ld_bf16x4(X + col) + *(const f32x4*)(g2 + col) * a0, x1 = ld_bf16x4(X + col + 4) + *(const f32x4*)(g2 + col + 4) * a1;
        xo[c4][0] = x0; xo[c4][1] = x1;
        ss += x0[0] * x0[0] + x0[1] * x0[1] + x0[2] * x0[2] + x0[3] * x0[3] + x1[0] * x1[0] + x1[1] * x1[1] + x1[2] * x1[2] + x1[3] * x1[3]; }
    if (dry) { asm volatile("" :: "v"(ss)); return; }
    if (l == 1) { float* o = A.out + ((size_t)b * SEQ + (pos - CTX)) * D;
#ifdef MX32_TEST
        { const unsigned fl = __hip_atomic_load((unsigned*)(A.ws + WS_CTL) + 8000, __ATOMIC_RELAXED, __HIP_MEMORY_SCOPE_AGENT); const float fm = 1.0f + ((fl & 1) ? 2.f : 0.f) + ((fl & 2) ? 5.f : 0.f) + ((fl & 4) ? 11.f : 0.f);
          for (int c4 = 0; c4 < 4; ++c4) { xo[c4][0] *= fm; xo[c4][1] *= fm; } }
#endif
#pragma unroll
        for (int c4 = 0; c4 < 4; ++c4) { const int col = 512 * c4 + 8 * lane; *(f32x4*)(o + col) = xo[c4][0]; *(f32x4*)(o + col + 4) = xo[c4][1]; }
        return; }
    ss = wave_sum(ss); const float rstd = __builtin_amdgcn_rsqf(ss * (1.0f / D) + EPS);
    const float* m1 = MOD + ((size_t)3 + mi) * MODW; const float* nw = A.norm1_w + D; unsigned char* H = A.ws + WS_H + (size_t)row * D;
#pragma unroll
    for (int c4 = 0; c4 < 4; ++c4) { const int col = 512 * c4 + 8 * lane; st_bf16x4(X + col, xo[c4][0]); st_bf16x4(X + col + 4, xo[c4][1]);
        f32x4 o[2];
#pragma unroll
        for (int q = 0; q < 2; ++q) { const int cc = col + 4 * q; o[q] = xo[c4][q] * rstd * *(const f32x4*)(nw + cc) * (1.0f + *(const f32x4*)(m1 + D + cc)) + *(const f32x4*)(m1 + cc); }
        u32x2 w8; w8.x = pk4_fp8(o[0][0] * SC_H8, o[0][1] * SC_H8, o[0][2] * SC_H8, o[0][3] * SC_H8); w8.y = pk4_fp8(o[1][0] * SC_H8, o[1][1] * SC_H8, o[1][2] * SC_H8, o[1][3] * SC_H8); *(u32x2*)(H + col) = w8; }
}


__device__ void mx32_selftest(unsigned* flag, int lane) {
    int fails = 0; int s127 = 0x7f7f7f7f; asm volatile("" : "+v"(s127));
    { v8i_t a; for (int i = 0; i < 8; ++i) a[i] = 0x38383838; f32x16 c; for (int j = 0; j < 16; ++j) c[j] = 0.f;
      c = __builtin_amdgcn_mfma_scale_f32_32x32x64_f8f6f4(a, a, c, 0, 0, 0, s127, 0, s127); for (int j = 0; j < 16; ++j) if (c[j] != 64.f) fails |= 1; }
    for (int p = 0; p < 64; ++p) { const int g = p >> 5, b = p & 31; v8i_t a; for (int i = 0; i < 8; ++i) a[i] = 0;
        if ((lane >> 5) == g) { for (int i = 0; i < 8; ++i) if (i == (b >> 2)) a[i] = 0x38 << (8 * (b & 3)); }
        f32x16 c; for (int j = 0; j < 16; ++j) c[j] = 0.f;
        c = __builtin_amdgcn_mfma_scale_f32_32x32x64_f8f6f4(a, a, c, 0, 0, 0, s127, 0, s127); for (int j = 0; j < 16; ++j) if (c[j] != 1.f) fails |= 2; }
    { v8i_t a, bb; for (int i = 0; i < 8; ++i) { a[i] = 0; bb[i] = 0; }
      const int r = lane & 31; const int codes[4] = {0x38, 0x40, 0x44, 0x48};
      const int rv = (r >> 2) & 3; if ((lane >> 5) == 0) { a[0] = rv == 0 ? 0x38 : rv == 1 ? 0x40 : rv == 2 ? 0x44 : 0x48; bb[0] = 0x38; }
      f32x16 c; for (int j = 0; j < 16; ++j) c[j] = 0.f;
      c = __builtin_amdgcn_mfma_scale_f32_32x32x64_f8f6f4(a, bb, c, 0, 0, 0, s127, 0, s127);
      for (int j = 0; j < 16; ++j) { const int row = (j & 3) + 8 * (j >> 2) + 4 * (lane >> 5); if (c[j] != (float)(1 + ((row >> 2) & 3))) fails |= 4; } (void)codes; }
    for (int o = 1; o < 64; o <<= 1) fails |= __shfl_xor(fails, o);
    if (lane == 0) __hip_atomic_store(flag, (unsigned)fails, __ATOMIC_RELAXED, __HIP_MEMORY_SCOPE_AGENT);
}

#ifndef ONLY_PH
#define ONLY_PH -2
#endif
#ifndef DUP_PH
#define DUP_PH -9
#define DUP_L 0
#endif
#ifndef DUP_SUB
#define DUP_SUB 0
#endif
#ifndef RERUN_SUB
#define RERUN_SUB 0
#endif
#ifndef DUP_PROBE
#define DUP_PROBE 0
#endif
constexpr int LDS_TILEP = 131072, LDS_BARST = 131072 + 512;
constexpr int PH_PRO = 0, PH_PER_LAYER = 10, PH_END = 1 + 2 * PH_PER_LAYER;

__device__ __forceinline__ void layer_phase(const Args& A, LAS unsigned char* lds, int l, int ph, int vcu, int G, int sub = 0) {
    const int tid = threadIdx.x, wid = __builtin_amdgcn_readfirstlane(tid >> 6), lane = tid & 63, gn = G * NTHR; int gtid = tid; asm volatile("" : "+v"(gtid)); gtid += vcu * NTHR;
    unsigned char* ws = A.ws;
    float* MOD = (float*)(ws + WS_MOD); bf16_t* X = (bf16_t*)(ws + WS_X); bf16_t* H = (bf16_t*)(ws + WS_H); bf16_t* P = (bf16_t*)(ws + WS_P); bf16_t* MIX = (bf16_t*)(ws + WS_MIX);
    int* cnt = (int*)(ws + WS_CTL) + CW_CNT + l * 64; LAS int* tileP = (LAS int*)(lds + LDS_TILEP);
    if (ph == 0) {
        if (l == 0) for (int row = vcu * NWAVE + wid; row < TALL; row += G * NWAVE) { const int mi = mod_index(row); const float* m = MOD + (size_t)mi * MODW;
            modnorm_row(in_row(A.x, A.ctx, row), A.norm1_w, m, m + D, (bf16_t*)((unsigned char*)H + (size_t)row * D), lane); }
    } else if (ph == 1) {
        DenseSched S; S.A = (const char*)H; S.Bt = (const char*)(ws + WS_WIN + (size_t)l * LDP * D); S.nM = TALL / 256; S.nN = LDP / 256; S.K = D / 2; S.G = G; S.c = blockIdx.x;
        EpiIn E; E.P = P; E.cosR = (const float*)(ws + WS_ROPE); E.sinR = (const float*)(ws + WS_ROPE + ROPE_SINR); E.cosD = (const float*)(ws + WS_ROPE + ROPE_COSD); E.sinD = (const float*)(ws + WS_ROPE + ROPE_SIND);
        E.qw = A.dq_w + l * 64; E.kw = A.dk_w + l * 64; E.Q8 = ws + WS_Q8; E.K8 = ws + WS_K8; E.V8T = ws + WS_V8T;
        pg8::gemm_phase8<EpiIn, DenseSched, true>(lds, D / 2, S, E, E8_H8, E8_WIN);
    } else if (ph == 2) {
        if (sub == 0 || sub == 1) for (int u = vcu; u < BATCH * NCH128 * 4; u += G) { const int head = u & 3, j = (u >> 2) % NCH128, b = (u >> 2) / NCH128; ret_kv_unit(lds, P, (bf16_t*)(ws + WS_KVT), A.ret_decay + l * 8, b, j, head); }
        if (sub == 0 || sub == 2) for (int u = (vcu + G / 2) % G; u < BATCH * NCH32; u += G) s5_end_unit(A, l, u / NCH32, u % NCH32);
    } else if (ph == 3) {
        ret_state_phase((const bf16_t*)(ws + WS_KVT), (bf16_t*)(ws + WS_ST), A.ret_decay + l * 8, gtid, gn);
        s5_carry_phase(A, l, lds, vcu, G);
    } else if (ph == 4) {
        float mq = 0.f, mk = 0.f, s1 = 0.f, s2 = 0.f;
        for (int i = 0; i < 64; ++i) { mq = fmaxf(mq, fabsf(A.dq_w[l * 64 + i])); mk = fmaxf(mk, fabsf(A.dk_w[l * 64 + i])); s1 += A.dlam[l * 256 + i] * A.dlam[l * 256 + 64 + i]; s2 += A.dlam[l * 256 + 128 + i] * A.dlam[l * 256 + 192 + i]; }
        const float linit = l == 0 ? 0.2f : 0.35550927f;
        const float lam = __expf(s1) - __expf(s2) + linit, sbl2 = 8.0f * mq * mk * 1.02f * LOG2E;
        const int nctx = l == 0 ? BATCH * 8 * 2 : 0;
#ifndef M3_ONLY
#define M3_ONLY 0
#endif
        if ((M3_ONLY == 0 || M3_ONLY == 1) && (sub == 0 || sub == 1)) for (int u = vcu; u < BATCH * 8 * 64 + nctx; u += G) {
            int qrow0, kv0, nk, h;
            if (u < BATCH * 8 * 64) { const int qb = u & 63, b = u >> 9; h = (u >> 6) & 7; qrow0 = b * SEQU + CTX + 128 * qb; kv0 = b * SEQU; nk = SEQU; }
            else { const int v = u - BATCH * 8 * 64, qb = v & 1, b = v >> 4; h = (v >> 1) & 7; qrow0 = b * SEQU + 128 * qb; kv0 = b * SEQU; nk = CTX; }
            attn_unit(lds, A, MIX, qrow0, kv0 / SEQU, nk, h, lam, sbl2, A.dsub_w + l * 128, 1.0f - linit, sub == 1 ? DUP_PROBE : 0);
        }
        if ((M3_ONLY == 0 || M3_ONLY == 2) && (sub == 0 || sub == 2)) for (int u = (vcu + G - 16) % G; u < BATCH * NCH128 * 2; u += G) { const int hp = u & 1, j = (u >> 1) % NCH128, b = (u >> 1) / NCH128; if (l == 1 && j < 2) continue;
            ret_out_unit(lds, P, (const bf16_t*)(ws + WS_ST), MIX, A.ret_decay + l * 8, A.ret_norm_w + l * 512, b, j, hp); }
        if ((M3_ONLY == 0 || M3_ONLY == 3) && (sub == 0 || sub == 3)) for (int u = (vcu + G - 32) % G; u < BATCH * NCH32; u += G) { const int b = u / NCH32, c = u % NCH32; if (l == 1 && c < 8) continue; s5_out_unit(lds, A, l, b, c); }
    } else if (ph == 5) {
        DenseSched S; S.A = (const char*)MIX; S.Bt = (const char*)(ws + WS_WOUT + (size_t)l * D * D); S.nM = 64; S.skipctx = true; S.nN = D / 256; S.K = D / 2; S.G = G; S.c = blockIdx.x;
        EpiRes E; E.xlat = l == 0 ? A.x : nullptr; E.xctx = A.ctx; E.X = X; E.gate = MOD + (size_t)l * 3 * MODW + 2 * D;
        pg8::gemm_phase8<EpiRes, DenseSched, true>(lds, D / 2, S, E, E8_MIX, E8_WOUT);
    } else if (ph == 6) {
        if (l == 0) {
            unsigned* ctxdone = (unsigned*)(ws + WS_CTL) + CW_CTXD;
            CtxSched S; S.A = (const char*)MIX; S.Bt = (const char*)(ws + WS_WOUT); S.K = D / 2; S.c = G - 1 - vcu;
            EpiRes E; E.xlat = A.x; E.xctx = A.ctx; E.X = X; E.gate = MOD + 2 * D;
            pg8::gemm_phase8<EpiRes, CtxSched, true>(lds, D / 2, S, E, E8_MIX, E8_WOUT);
            if (S.c < 16) { asm volatile("s_waitcnt vmcnt(0)" ::: "memory"); __syncthreads();
                if (tid == 0) { __builtin_amdgcn_fence(__ATOMIC_RELEASE, "agent"); (void)xb_add(ctxdone, 1u); } }
            __syncthreads();
            for (int pass = 0; pass < 2; ++pass)
                for (int u = vcu; u < TALL / 32; u += G) { const int r0 = 32 * u; const bool isctx = (r0 % SEQU) < CTX; if (isctx != (pass == 1)) continue;
                    if (isctx) { if (tid == 0) { unsigned sp = 0; while (xb_ld(ctxdone) < 16u && ++sp < (1u << 22)) __builtin_amdgcn_s_sleep(2); __builtin_amdgcn_fence(__ATOMIC_ACQUIRE, "agent"); }
                        __syncthreads(); }
                    route_unit(lds, A, l, r0); }
        } else
        for (int u = vcu; u < TALL / 32; u += G) { const int r0 = 32 * u; if ((r0 % SEQU) < CTX) continue; route_unit(lds, A, l, r0); }
#ifdef DUP_E
        if (l == 0) for (int u = vcu; u < TALL / 32; u += G) { const int r0 = 32 * u; route_unit(lds, A, l, r0, true); }
#endif
    } else if (ph == 7) {
        __syncthreads(); build_tileP(cnt, tileP, l == 1 ? 64 : TALL / 256); __syncthreads();
        GroupSched S; S.A = (const char*)(ws + WS_H8); S.Bt = (const char*)(ws + WS_GU + (size_t)l * NE1 * 1024 * D); S.list = (const int*)(ws + WS_LIST); S.cnt = cnt; S.tileP = tileP; S.NT = 4; S.K = D / 2; S.G = G; S.c = vcu; S.gather = true; S.bstride = (size_t)1024 * D; S.skipctx = l == 1;
        EpiGU E; E.HID = ws + WS_HID;
        pg8::gemm_phase8<EpiGU, GroupSched, true>(lds, D / 2, S, E, E8_H8, E8_GU);
    } else if (ph == 8) {
        __syncthreads(); build_tileP(cnt, tileP, l == 1 ? 64 : TALL / 256); __syncthreads();
        GroupSched S; S.A = (const char*)(ws + WS_HID); S.Bt = (const char*)(ws + WS_DN + (size_t)l * NE1 * D * FF); S.list = nullptr; S.cnt = cnt; S.tileP = tileP; S.NT = 8; S.K = FF / 2; S.G = G; S.c = vcu; S.gather = false; S.bstride = (size_t)D * FF; S.skipctx = l == 1;
        EpiDown E; E.Y = ws + WS_Y; E.X = X; E.gate = MOD + (size_t)l * 3 * MODW + 5 * D;
        pg8::gemm_phase8<EpiDown, GroupSched, true>(lds, FF / 2, S, E, E8_HID, E8_DN);
#ifdef DUP_F2
        if (l == 0) { __syncthreads(); E.X = nullptr;
#ifdef DUP_F2_NOEPI
            E.Y = nullptr;
#endif
            pg8::gemm_phase8<EpiDown, GroupSched, true>(lds, FF / 2, S, E, E8_HID, E8_DN); }
#endif
    } else {
        __syncthreads(); build_tileP(cnt, tileP); __syncthreads();
#ifdef DUP_G
        if (l == 0) for (int row = vcu * NWAVE + wid; row < TALL; row += G * NWAVE) combine_row(A, l, row, tileP, lane, true);
#endif
        for (int row = vcu * NWAVE + wid; row < TALL; row += G * NWAVE) combine_row(A, l, row, tileP, lane);
    }
}

__global__ void __launch_bounds__(NTHR, 2) fwd_kernel(Args A, int ph_lo, int ph_hi) {
    extern __shared__ __attribute__((aligned(16))) unsigned char shm[];
    LAS unsigned char* lds = (LAS unsigned char*)shm;
    const int tid = threadIdx.x, G = gridDim.x;
    const int vcu = (G % 8 == 0) ? (int)((blockIdx.x & 7) * (G / 8) + (blockIdx.x >> 3)) : (int)blockIdx.x;
    volatile LAS unsigned* st = (volatile LAS unsigned*)(lds + LDS_BARST);
    if (tid == 0) { st[0] = 0u; st[1] = 0u; }
    __syncthreads();
    XcdBarrier bar; bar.bar = (unsigned*)(A.ws + WS_CTL) + CW_BAR; bar.x = 0; bar.st = st;
    const bool multi = ph_hi - ph_lo > 1;
    if (multi) bar = xcd_barrier_post((unsigned*)(A.ws + WS_CTL) + CW_BAR, st);
#ifdef DUP_BAR
#define PHASE_END(id) do { if ((id) + 1 < ph_hi) { xcd_barrier(bar); xcd_barrier(bar); } } while (0)
#else
#define PHASE_END(id) do { if ((id) + 1 < ph_hi) xcd_barrier(bar); } while (0)
#endif
    if ((ONLY_PH == -2 || ONLY_PH == -1) && ph_lo <= 0 && 0 < ph_hi) {
        for (int u = vcu; u < 192; u += G) adaln_unit(A, (float*)(A.ws + WS_MOD), lds, u / 96, u % 96);
        if (G == 256) {
            constexpr int NCV = 2 * CV_PER_LAYER, NA = 192 * 50;
            const int u0 = vcu < 192 ? vcu * 50 : NA + (int)((long)(vcu - 192) * (NCV - NA) / 64), u1 = vcu < 192 ? u0 + 50 : NA + (int)((long)(vcu - 191) * (NCV - NA) / 64);
            conv_range(A, u0, u1, lds);
        } else for (int u = vcu; u < 2 * CV_PER_LAYER; u += G) conv_dispatch(A, u, lds);
        tables_phase(A, vcu * NTHR + tid, G * NTHR);
#ifdef MX32_TEST
        if (vcu == 0 && (tid >> 6) == 0) mx32_selftest((unsigned*)(A.ws + WS_CTL) + 8000, tid & 63);
#endif
        if (DUP_PH == -1) { for (int u = vcu; u < 2 * CV_PER_LAYER; u += G) conv_dispatch(A, u, lds); }
        PHASE_END(0);
    }
#define LPH(l, p) do { const int id_ = 1 + (l) * PH_PER_LAYER + (p); if ((ONLY_PH == -2 || ONLY_PH == (p)) && ph_lo <= id_ && id_ < ph_hi) { layer_phase(A, lds, (l), (p), vcu, G, (ph_hi - ph_lo == 1) ? RERUN_SUB : 0); if (DUP_PH == (p) && DUP_L == (l)) { __syncthreads(); layer_phase(A, lds, (l), (p), vcu, G, DUP_SUB); } PHASE_END(id_); } } while (0)
    LPH(0, 0); LPH(0, 1); LPH(0, 2); LPH(0, 3); LPH(0, 4); LPH(0, 5); LPH(0, 6); LPH(0, 7); LPH(0, 8); LPH(0, 9);
    LPH(1, 1); LPH(1, 2); LPH(1, 3); LPH(1, 4); LPH(1, 5); LPH(1, 6); LPH(1, 7); LPH(1, 8); LPH(1, 9);
}

#ifndef MK_LAUNCH_PER_PHASE
#define MK_LAUNCH_PER_PHASE 0
#endif
extern "C" void kernel_launch(void* const* d_in, const int* in_sizes, int n_in, void* d_out, int out_size, void* d_ws, size_t ws_size, hipStream_t stream) {
    static int grid = 0;
    if (grid == 0) {
        if (n_in != 33 || ws_size < WS_END) { fprintf(stderr, "kernel_launch: expected 33 inputs and >= %zu bytes of workspace; got %d inputs, %zu bytes\n", (size_t)WS_END, n_in, ws_size); grid = -1; return; }
        int dev = 0, cus = 0, per_cu = 0;
        if (hipGetDevice(&dev) != hipSuccess || hipDeviceGetAttribute(&cus, hipDeviceAttributeMultiprocessorCount, dev) != hipSuccess) { grid = -1; return; }
        if (hipFuncSetAttribute((const void*)fwd_kernel, hipFuncAttributeMaxDynamicSharedMemorySize, LDS_BYTES) != hipSuccess) { fprintf(stderr, "kernel_launch: hipFuncSetAttribute failed\n"); grid = -1; return; }
        if (hipOccupancyMaxActiveBlocksPerMultiprocessor(&per_cu, (const void*)fwd_kernel, NTHR, LDS_BYTES) != hipSuccess || per_cu < 1) { fprintf(stderr, "kernel_launch: occupancy query reports %d blocks per CU\n", per_cu); grid = -1; return; }
        grid = cus;
    }
    if (grid < 0) return;
    Args a{};
    const float** ap = (const float**)&a;
    for (int i = 0; i < 33; ++i) ap[i] = (const float*)d_in[i];
    a.out = (float*)d_out; a.ws = (unsigned char*)d_ws;
    hipMemsetAsync((char*)d_ws + WS_CTL, 0, CTL_BYTES, stream);
#ifdef PROBE_SKIP_MIX
    hipMemsetAsync((char*)d_ws + WS_MIX, PROBE_MIX_BYTE, (size_t)TALL * D * 2, stream);
#endif
#if MK_LAUNCH_PER_PHASE
    for (int p = 0; p < PH_END; ++p) { if (p == 1 + PH_PER_LAYER) continue;
#ifdef PROBE_SKIP_MIX
        { const int q = (p - 1) % PH_PER_LAYER; if (p >= 1 && q >= 2 && q <= 4) { if (q == 2) hipMemsetAsync((char*)d_ws + WS_MIX, PROBE_MIX_BYTE, (size_t)TALL * D * 2, stream); if (PROBE_SKIP_MIX == 1) continue; } }
#endif
        hipLaunchKernelGGL(fwd_kernel, dim3(grid), dim3(NTHR), LDS_BYTES, stream, a, p, p + 1); }
#else
    hipLaunchKernelGGL(fwd_kernel, dim3(grid), dim3(NTHR), LDS_BYTES, stream, a, 0, PH_END);
#endif
#ifdef RERUN_LO
#if RERUN_MEMSET
    hipMemsetAsync((char*)d_ws + WS_CTL, 0, CTL_BYTES, stream);
#endif
    hipLaunchKernelGGL(fwd_kernel, dim3(grid), dim3(NTHR), LDS_BYTES, stream, a, RERUN_LO, RERUN_HI);
#endif
}
```
